# Optimizing an MI355X kernel written in HIP

```python
import math
import jax
import jax.numpy as jnp
from jax import lax
import numpy as np


D_MODEL = 1024
BATCH = 4
SEQ = 4096
DEPTH = 2
DEC_BATCH = 2
DEC_SEQ = 16384
PAST_LEN = 128

GRID_W = 64
PLE_DIM = 256
D_FF = 2816
QBLK = 128
NORM_EPS = 1e-6
ROPE_THETA = 10000.0
NEG_INF = -1e30

HA = 8
Q_RANK = 256
KV_RANK = 128
NOPE_A = 64
ROPE_A = 32
V_A = 64
QK_A = NOPE_A + ROPE_A

HD = 64
DIL_PAIRS = ((128, 1), (512, 4), (2048, 16))
N_GROUPS_B = 3
HPG_B = 4
N_HEADS_B = N_GROUPS_B * HPG_B
T5_BUCKETS = 32
T5_MAX_DIST = 1024

HC = 8
KVC = 2
GC = HC // KVC

N_BRANCH = 3
A_COLS = Q_RANK + KV_RANK + ROPE_A
B_COLS = 3 * N_HEADS_B * HD
C_COLS = (HC + 2 * KVC) * HD
IN_COLS = A_COLS + B_COLS + C_COLS

kernel_name = 'hybrid_gated_mla_dilated_axialgqa_encoder'


def rmsnorm(x, g):
    xf = x.astype(jnp.float32)
    y = xf * lax.rsqrt(jnp.mean(xf * xf, axis=-1, keepdims=True) + NORM_EPS)
    return (y * g.astype(jnp.float32)).astype(x.dtype)


def swiglu(x, w_in, w_out):
    a, b = jnp.split(x @ w_in, 2, axis=-1)
    return (jax.nn.silu(a) * b) @ w_out


def rope(x, pos):
    half = x.shape[-1] // 2
    freqs = (ROPE_THETA ** (-np.arange(half) / half)).astype(np.float32)
    ang = pos.astype(jnp.float32)[:, None] * jnp.asarray(freqs)[None, :]
    cos = jnp.cos(ang)[:, None, :].astype(x.dtype)
    sin = jnp.sin(ang)[:, None, :].astype(x.dtype)
    x1, x2 = x[..., :half], x[..., half:]
    return jnp.concatenate([x1 * cos - x2 * sin, x1 * sin + x2 * cos], axis=-1)


def dense_attn(q, k, v, scale):
    B, S, Hk, G, dk = q.shape
    nq = S // QBLK
    qb = q.reshape(B, nq, QBLK, Hk, G, dk).transpose(1, 0, 2, 3, 4, 5)

    def one_block(qi):
        s = jnp.einsum('bqhgd,bkhd->bhgqk', qi, k).astype(jnp.float32) * scale
        p = jax.nn.softmax(s, axis=-1).astype(v.dtype)
        return jnp.einsum('bhgqk,bkhd->bqhgd', p, v)

    o = lax.map(one_block, qb)
    return o.transpose(1, 0, 2, 3, 4, 5).reshape(B, S, Hk, G, v.shape[-1])


def t5_bucket(rel):
    nb = T5_BUCKETS // 2
    max_exact = nb // 2
    n = np.abs(rel)
    large = max_exact + (np.log(np.maximum(n, 1) / max_exact) / math.log(T5_MAX_DIST / max_exact) * (nb - max_exact)).astype(np.int32)
    large = np.minimum(large, nb - 1)
    return (rel > 0).astype(np.int32) * nb + np.where(n < max_exact, n, large).astype(np.int32)


def local_attn(q, k, v, bias, R):
    N, L, H, dh = q.shape
    nb = -(-L // R)
    Lp = nb * R
    qp = jnp.pad(q, ((0, 0), (0, Lp - L), (0, 0), (0, 0))).reshape(N, nb, R, H, dh)
    kpad = ((0, 0), (R, Lp - L + R), (0, 0), (0, 0))
    kb = jnp.pad(k, kpad).reshape(N, nb + 2, R, H, dh)
    vb = jnp.pad(v, kpad).reshape(N, nb + 2, R, H, dh)
    kw = jnp.concatenate([kb[:, :-2], kb[:, 1:-1], kb[:, 2:]], axis=2)
    vw = jnp.concatenate([vb[:, :-2], vb[:, 1:-1], vb[:, 2:]], axis=2)
    qpos = np.arange(Lp).reshape(nb, R)[:, :, None]
    kpos = (np.arange(nb)[:, None] * R - R + np.arange(3 * R)[None, :])[:, None, :]
    valid = (np.abs(kpos - qpos) <= R) & (kpos >= 0) & (kpos < L)
    s = jnp.einsum('nbqhd,nbkhd->nbhqk', qp, kw).astype(jnp.float32) * (dh ** -0.5) + bias
    s = jnp.where(jnp.asarray(valid)[None, :, None], s, NEG_INF)
    lse = jax.nn.logsumexp(s, axis=-1)
    p = jnp.exp(s - lse[..., None]).astype(v.dtype)
    o = jnp.einsum('nbhqk,nbkhd->nbqhd', p, vw).reshape(N, Lp, H, dh)[:, :L]
    lse = lse.transpose(0, 1, 3, 2).reshape(N, Lp, H)[:, :L]
    return o, lse


def dilated_group(q, k, v, tab, window, dil):
    B, S, H, dh = q.shape
    R = window // (2 * dil)
    L = S // dil

    def split(t):
        return t.reshape(B, L, dil, H, dh).transpose(0, 2, 1, 3, 4).reshape(B * dil, L, H, dh)

    qi = np.arange(R)[:, None]
    kj = np.arange(3 * R)[None, :]
    bucket = t5_bucket((kj - R - qi) * dil)
    bias = jnp.transpose(tab[bucket], (2, 0, 1)).astype(jnp.float32)
    o, lse = local_attn(split(q), split(k), split(v), bias, R)
    o = o.reshape(B, dil, L, H, dh).transpose(0, 2, 1, 3, 4).reshape(B, S, H, dh)
    lse = lse.reshape(B, dil, L, H).transpose(0, 2, 1, 3).reshape(B, S, H)
    return o, lse


def mla_mixer(a_in, pos, g_cq, g_ckv, w_uq, w_ukv, g_q, g_k):
    B, S, _ = a_in.shape
    c_q = rmsnorm(a_in[..., :Q_RANK], g_cq)
    c_kv = rmsnorm(a_in[..., Q_RANK:Q_RANK + KV_RANK], g_ckv)
    k_rope = a_in[..., Q_RANK + KV_RANK:][:, :, None, :]
    q = (c_q @ w_uq).reshape(B, S, HA, QK_A)
    kv = (c_kv @ w_ukv).reshape(B, S, HA, NOPE_A + V_A)
    q_nope = rmsnorm(q[..., :NOPE_A], g_q[:NOPE_A])
    q_rope = rope(rmsnorm(q[..., NOPE_A:], g_q[NOPE_A:]), pos)
    k_nope = rmsnorm(kv[..., :NOPE_A], g_k[:NOPE_A])
    k_rope = rope(rmsnorm(k_rope, g_k[NOPE_A:]), pos)
    q = jnp.concatenate([q_nope, q_rope], axis=-1)
    k = jnp.concatenate([k_nope, jnp.broadcast_to(k_rope, (B, S, HA, ROPE_A))], axis=-1)
    v = kv[..., NOPE_A:]
    o = dense_attn(q[:, :, :, None, :], k, v, QK_A ** -0.5)
    return o.reshape(B, S, HA * V_A)


def dilated_mixer(b_in, g_q, g_k, rel_bias):
    B, S, _ = b_in.shape
    qkv = b_in.reshape(B, S, 3, N_GROUPS_B, HPG_B, HD)
    q = rmsnorm(qkv[:, :, 0], g_q)
    k = rmsnorm(qkv[:, :, 1], g_k)
    v = qkv[:, :, 2]
    outs = []
    lses = []
    for g, (window, dil) in enumerate(DIL_PAIRS):
        tab = rel_bias[:, g * HPG_B:(g + 1) * HPG_B]
        o, l = dilated_group(q[:, :, g], k[:, :, g], v[:, :, g], tab, window, dil)
        outs.append(o)
        lses.append(l)
    outs = jnp.stack(outs, axis=0)
    lses = jnp.stack(lses, axis=0)
    alpha = jax.nn.softmax(lses, axis=0).astype(outs.dtype)
    o = jnp.sum(alpha[..., None] * outs, axis=0)
    return o.reshape(B, S, HPG_B * HD)


def axial_rope(t, row_pos, col_pos):
    h = t.shape[-1] // 2
    return jnp.concatenate([rope(t[..., :h], row_pos), rope(t[..., h:], col_pos)], axis=-1)


def axial_gqa_mixer(c_in, row_pos, col_pos, g_q, g_k):
    B, S, _ = c_in.shape
    q = c_in[..., :HC * HD].reshape(B, S, HC, HD)
    k = c_in[..., HC * HD:(HC + KVC) * HD].reshape(B, S, KVC, HD)
    v = c_in[..., (HC + KVC) * HD:].reshape(B, S, KVC, HD)
    q = axial_rope(rmsnorm(q, g_q), row_pos, col_pos)
    k = axial_rope(rmsnorm(k, g_k), row_pos, col_pos)
    o = dense_attn(q.reshape(B, S, KVC, GC, HD), k, v, HD ** -0.5)
    return o.reshape(B, S, HC * HD)


def _layer(x, pe, W, i, pos, row_pos, col_pos):
    B, S, _ = x.shape
    x = x + 0.5 * swiglu(rmsnorm(x, W['g_ffn1'][i]), W['w_ffn1_in'][i], W['w_ffn1_out'][i])
    u = rmsnorm(x, W['g_mix'][i])
    proj = u @ W['w_in'][i]
    a_in = proj[..., :A_COLS]
    b_in = proj[..., A_COLS:A_COLS + B_COLS]
    c_in = proj[..., A_COLS + B_COLS:]
    o_a = mla_mixer(a_in, pos, W['g_cq'][i], W['g_ckv'][i], W['w_uq'][i], W['w_ukv'][i], W['g_qa'][i], W['g_ka'][i])
    o_b = dilated_mixer(b_in, W['g_qb'][i], W['g_kb'][i], W['rel_bias'])
    o_c = axial_gqa_mixer(c_in, row_pos, col_pos, W['g_qc'][i], W['g_kc'][i])
    gates = jax.nn.sigmoid(u @ W['w_gate'][i] + W['b_gate'][i]).reshape(B, S, N_BRANCH, D_MODEL)
    merged = (gates[:, :, 0] * (o_a @ W['w_oa'][i])
              + gates[:, :, 1] * (o_b @ W['w_ob'][i])
              + gates[:, :, 2] * (o_c @ W['w_oc'][i]))
    x = x + merged @ W['w_out'][i]
    x = x + 0.5 * swiglu(rmsnorm(x, W['g_ffn2'][i]), W['w_ffn2_in'][i], W['w_ffn2_out'][i])
    g = jax.nn.sigmoid(rmsnorm(x, W['g_ple'][i]) @ W['w_pg'][i])
    return x + g * (pe @ W['w_ple'][i])


def _trunk(x, p, W):
    S = x.shape[1]
    rows = S // GRID_W
    pos = jnp.arange(S, dtype=jnp.int32)
    row_pos = jnp.repeat(jnp.arange(rows, dtype=jnp.int32), GRID_W)
    col_pos = pos % GRID_W
    for i in range(DEPTH):
        x = _layer(x, p[i], W, i, pos, row_pos, col_pos)
    return x


def setup_inputs(seed: int = 0) -> dict:
    key = jax.random.key(seed)
    keys = jax.random.split(key, 32)
    cnt = [0]

    def nk():
        k = keys[cnt[0]]
        cnt[0] += 1
        return k

    def nrm(shape, fan_in):
        return jax.random.normal(nk(), shape, jnp.float32) * (fan_in ** -0.5)

    def gain(shape):
        return 1.0 + 0.05 * jax.random.normal(nk(), shape, jnp.float32)

    L = DEPTH
    return {
        'x_prompt': jax.random.normal(nk(), (BATCH, SEQ, D_MODEL), jnp.float32),
        'x_sample': jax.random.normal(nk(), (DEC_BATCH, DEC_SEQ, D_MODEL), jnp.float32),
        'p_prompt': jax.random.normal(nk(), (DEPTH, BATCH, SEQ, PLE_DIM), jnp.float32),
        'p_sample': jax.random.normal(nk(), (DEPTH, DEC_BATCH, DEC_SEQ, PLE_DIM), jnp.float32),
        'g_ffn1': gain((L, D_MODEL)),
        'w_ffn1_in': nrm((L, D_MODEL, 2 * D_FF), D_MODEL),
        'w_ffn1_out': nrm((L, D_FF, D_MODEL), D_FF),
        'g_mix': gain((L, D_MODEL)),
        'w_in': nrm((L, D_MODEL, IN_COLS), D_MODEL),
        'g_cq': gain((L, Q_RANK)),
        'g_ckv': gain((L, KV_RANK)),
        'w_uq': nrm((L, Q_RANK, HA * QK_A), Q_RANK),
        'w_ukv': nrm((L, KV_RANK, HA * (NOPE_A + V_A)), KV_RANK),
        'g_qa': gain((L, QK_A)),
        'g_ka': gain((L, QK_A)),
        'g_qb': gain((L, HD)),
        'g_kb': gain((L, HD)),
        'rel_bias': 0.5 * jax.random.normal(nk(), (T5_BUCKETS, N_HEADS_B), jnp.float32),
        'g_qc': gain((L, HD)),
        'g_kc': gain((L, HD)),
        'w_gate': nrm((L, D_MODEL, N_BRANCH * D_MODEL), D_MODEL),
        'b_gate': 0.1 * jax.random.normal(nk(), (L, N_BRANCH * D_MODEL), jnp.float32),
        'w_oa': nrm((L, HA * V_A, D_MODEL), HA * V_A),
        'w_ob': nrm((L, HPG_B * HD, D_MODEL), HPG_B * HD),
        'w_oc': nrm((L, HC * HD, D_MODEL), HC * HD),
        'w_out': nrm((L, D_MODEL, D_MODEL), D_MODEL),
        'g_ffn2': gain((L, D_MODEL)),
        'w_ffn2_in': nrm((L, D_MODEL, 2 * D_FF), D_MODEL),
        'w_ffn2_out': nrm((L, D_FF, D_MODEL), D_FF),
        'g_ple': gain((L, D_MODEL)),
        'w_pg': nrm((L, D_MODEL, D_MODEL), D_MODEL),
        'w_ple': nrm((L, PLE_DIM, D_MODEL), PLE_DIM),
    }


def reference(x_prompt, x_sample, p_prompt, p_sample, g_ffn1, w_ffn1_in, w_ffn1_out, g_mix, w_in,
              g_cq, g_ckv, w_uq, w_ukv, g_qa, g_ka, g_qb, g_kb, rel_bias, g_qc, g_kc,
              w_gate, b_gate, w_oa, w_ob, w_oc, w_out, g_ffn2, w_ffn2_in, w_ffn2_out,
              g_ple, w_pg, w_ple):
    W = dict(g_ffn1=g_ffn1, w_ffn1_in=w_ffn1_in, w_ffn1_out=w_ffn1_out, g_mix=g_mix, w_in=w_in,
             g_cq=g_cq, g_ckv=g_ckv, w_uq=w_uq, w_ukv=w_ukv, g_qa=g_qa, g_ka=g_ka,
             g_qb=g_qb, g_kb=g_kb, rel_bias=rel_bias, g_qc=g_qc, g_kc=g_kc,
             w_gate=w_gate, b_gate=b_gate, w_oa=w_oa, w_ob=w_ob, w_oc=w_oc, w_out=w_out,
             g_ffn2=g_ffn2, w_ffn2_in=w_ffn2_in, w_ffn2_out=w_ffn2_out,
             g_ple=g_ple, w_pg=w_pg, w_ple=w_ple)
    y_prompt = _trunk(x_prompt, p_prompt, W)
    y_sample = _trunk(x_sample, p_sample, W)
    return (y_prompt, y_sample)
```

```cpp
#include <hip/hip_runtime.h>
#include <hip/hip_cooperative_groups.h>
#include <stdint.h>
#include <cstdio>
namespace cg = cooperative_groups;

typedef unsigned short bf16_t;
typedef short bf16x8 __attribute__((ext_vector_type(8)));
typedef float f32x16 __attribute__((ext_vector_type(16)));
typedef float f32x4 __attribute__((ext_vector_type(4)));
typedef float f32x2 __attribute__((ext_vector_type(2)));
typedef unsigned u32x4 __attribute__((ext_vector_type(4)));
typedef unsigned u32x2 __attribute__((ext_vector_type(2)));
typedef __bf16 bf16x2_t __attribute__((ext_vector_type(2)));
#define DI __device__ __forceinline__
#define MFMA(a, b, c) __builtin_amdgcn_mfma_f32_32x32x16_bf16((a), (b), (c), 0, 0, 0)

constexpr int TC = 16384;
constexpr int DM = 1024;
constexpr int DFF = 2816;
constexpr float EPS = 1e-6f;
constexpr float LOG2E = 1.4426950408889634f;
constexpr float LN2 = 0.6931471805599453f;
constexpr int NTHREADS = 256;

constexpr size_t W_FFN1_IN = 0;
constexpr size_t W_FFN1_OUT = W_FFN1_IN + (size_t)5632 * 1024;
constexpr size_t W_IN = W_FFN1_OUT + (size_t)1024 * 2816;
constexpr size_t W_GATE = W_IN + (size_t)3584 * 1024;
constexpr size_t W_UQ = W_GATE + (size_t)3072 * 1024;
constexpr size_t W_UKV = W_UQ + (size_t)768 * 256;
constexpr size_t W_OA = W_UKV + (size_t)1024 * 128;
constexpr size_t W_OB = W_OA + (size_t)1024 * 512;
constexpr size_t W_OC = W_OB + (size_t)1024 * 256;
constexpr size_t W_OUT = W_OC + (size_t)1024 * 512;
constexpr size_t W_FFN2_IN = W_OUT + (size_t)1024 * 1024;
constexpr size_t W_FFN2_OUT = W_FFN2_IN + (size_t)5632 * 1024;
constexpr size_t W_PG = W_FFN2_OUT + (size_t)1024 * 2816;
constexpr size_t W_PLE = W_PG + (size_t)1024 * 1024;
constexpr size_t W_LAYER = W_PLE + (size_t)1024 * 256;

constexpr size_t AL(size_t x) { return (x + 255) & ~(size_t)255; }
constexpr size_t OFF_W = 0;
constexpr size_t OFF_ROPE = AL(OFF_W + 2 * W_LAYER * 2);
constexpr size_t OFF_BIAS = AL(OFF_ROPE + (size_t)16384 * 16 * 8);
constexpr size_t OFF_SS = AL(OFF_BIAS + 12 * 132 * 4);
constexpr size_t OFF_XB = AL(OFF_SS + (size_t)3 * 6 * TC * 4);
constexpr size_t OFF_PEB = AL(OFF_XB + (size_t)TC * 1024 * 2);
constexpr size_t OFF_BIG = AL(OFF_PEB + (size_t)2 * TC * 256 * 2);
constexpr size_t OFF_ACT = OFF_BIG;
constexpr size_t OFF_CQ = OFF_BIG;
constexpr size_t OFF_CKV = AL(OFF_CQ + (size_t)TC * 256 * 2);
constexpr size_t OFF_QA = AL(OFF_CKV + (size_t)TC * 128 * 2);
constexpr size_t OFF_KA = AL(OFF_QA + (size_t)TC * 768 * 2);
constexpr size_t OFF_VTA = AL(OFF_KA + (size_t)TC * 768 * 2);
constexpr size_t OFF_QB = AL(OFF_VTA + (size_t)TC * 512 * 2);
constexpr size_t OFF_KB = AL(OFF_QB + (size_t)TC * 768 * 2);
constexpr size_t OFF_VTB = AL(OFF_KB + (size_t)TC * 768 * 2);
constexpr size_t OFF_QC = AL(OFF_VTB + (size_t)TC * 768 * 2);
constexpr size_t OFF_KC = AL(OFF_QC + (size_t)TC * 512 * 2);
constexpr size_t OFF_VTC = AL(OFF_KC + (size_t)TC * 128 * 2);
constexpr size_t OFF_OA = AL(OFF_VTC + (size_t)TC * 128 * 2);
constexpr size_t OFF_OBG = AL(OFF_OA + (size_t)TC * 512 * 2);
constexpr size_t OFF_LSE = AL(OFF_OBG + (size_t)TC * 768 * 2);
constexpr size_t OFF_OB = AL(OFF_LSE + (size_t)TC * 12 * 4);
constexpr size_t OFF_OC = AL(OFF_OB + (size_t)TC * 256 * 2);
constexpr size_t OFF_MRG = AL(OFF_OC + (size_t)TC * 512 * 2);
constexpr size_t OFF_END = AL(OFF_MRG + (size_t)TC * 1024 * 2);
static_assert(OFF_END < (size_t)500 * 1024 * 1024, "workspace too large");
static_assert(OFF_ACT + (size_t)TC * DFF * 2 <= OFF_END, "act fits");

struct Params {
  const float* in[32];
  float* out;
  char* ws;
};

constexpr int LROW = 144;
constexpr int STAGE_OP = 128 * LROW;
constexpr int STAGE = 2 * STAGE_OP;
constexpr int CLD = 132;
constexpr int OFF_RR = 2 * STAGE;
constexpr int LDS_BYTES = 2 * STAGE + 1024;
static_assert(128 * CLD * 4 <= OFF_RR, "lds");

DI int tid_() { int t = threadIdx.x; asm volatile("" : "+v"(t)); return t; }
DI unsigned pk2(float a, float b) { f32x2 v = {a, b}; bf16x2_t r = __builtin_convertvector(v, bf16x2_t); return __builtin_bit_cast(unsigned, r); }
DI bf16_t f2bf(float a) { return (bf16_t)(pk2(a, 0.f) & 0xffffu); }
DI float bf2f(bf16_t v) { return __uint_as_float(((unsigned)v) << 16); }
DI float sigmoidf_(float x) { return 1.0f / (1.0f + __expf(-x)); }

DI int map_col(int map, int n) {
  switch (map) {
    case 0: return n;
    case 1: { int t = n >> 7, w = n & 127; return w < 64 ? t * 64 + w : DFF + t * 64 + (w - 64); }
    case 2: { int slot = n >> 6, d = n & 63; if (slot < 6) return n; if (slot == 6) return d < 32 ? 384 + d : -1; if (slot < 55) return 416 + (n - 448); return -1; }
    case 3: { if (n < 512) return (n >> 6) * 96 + (n & 63); int i = n - 512; return (i >> 5) * 96 + 64 + (i & 31); }
    default: { if (n < 512) return (n >> 6) * 128 + (n & 63); int i = n - 512; return (i >> 6) * 128 + 64 + (i & 63); }
  }
}

DI void transpose_mat(const float* __restrict__ src, int ld_src, bf16_t* __restrict__ dst, int N, int K, const float* __restrict__ gain, int map, float* lds, int rot) {
  const int ntk = K >> 6, ntn = N >> 6, nt = ntk * ntn;
  const int tid = tid_(), c = tid & 63, rq = tid >> 6;
  int b0 = (int)blockIdx.x - (rot % (int)gridDim.x); if (b0 < 0) b0 += gridDim.x;
  for (int t = b0; t < nt; t += gridDim.x) {
    const int tn = t / ntk, tk = t - tn * ntk;
    const int n0 = tn << 6, k0 = tk << 6;
    const int sc = map_col(map, n0 + c);
#pragma unroll 4
    for (int r = 0; r < 16; ++r) {
      const int kk = r * 4 + rq;
      float v = 0.f;
      if (sc >= 0) { v = src[(size_t)(k0 + kk) * ld_src + sc]; if (gain) v *= gain[k0 + kk]; }
      lds[c * 65 + kk] = v;
    }
    __syncthreads();
#pragma unroll 4
    for (int r = 0; r < 16; ++r) {
      const int nn = r * 4 + rq;
      dst[(size_t)(n0 + nn) * K + k0 + c] = f2bf(lds[nn * 65 + c]);
    }
    __syncthreads();
  }
}

template <int NJ> DI void zero_acc(f32x16 (&acc)[2][NJ]) {
#pragma unroll
  for (int i = 0; i < 2; ++i)
#pragma unroll
    for (int j = 0; j < NJ; ++j)
#pragma unroll
      for (int r = 0; r < 16; ++r) acc[i][j][r] = 0.f;
}

template <int NJ> DI void gemm_mainloop(const bf16_t* __restrict__ A, int lda, const bf16_t* __restrict__ Bt, int ldb, int K, f32x16 (&acc)[2][NJ], char* lds) {
  const int tid = tid_(), lane = tid & 63, w = tid >> 6, wm = w >> 1, wn = w & 1;
  const int lr = tid >> 3, lc = tid & 7;
  const bf16_t* ap = A + (size_t)lr * lda + lc * 8;
  const bf16_t* bp = Bt + (size_t)lr * ldb + lc * 8;
  const size_t astep = (size_t)32 * lda, bstep = (size_t)32 * ldb;
  constexpr int NB = 2 * NJ;
  u32x4 ra[4], rb[NB];
#pragma unroll
  for (int i = 0; i < 4; ++i) ra[i] = *(const u32x4*)(ap + i * astep);
#pragma unroll
  for (int i = 0; i < NB; ++i) rb[i] = *(const u32x4*)(bp + i * bstep);
  const int wofs = lr * LROW + lc * 16;
#pragma unroll
  for (int i = 0; i < 4; ++i) *(u32x4*)(lds + wofs + i * 32 * LROW) = ra[i];
#pragma unroll
  for (int i = 0; i < NB; ++i) *(u32x4*)(lds + STAGE_OP + wofs + i * 32 * LROW) = rb[i];
  __syncthreads();
  const int nk = K >> 6;
  const int a_rd = (wm * 64 + (lane & 31)) * LROW + (lane >> 5) * 16;
  const int b_rd = STAGE_OP + (wn * 32 * NJ + (lane & 31)) * LROW + (lane >> 5) * 16;
  for (int kt = 0; kt < nk; ++kt) {
    const char* st = lds + (kt & 1) * STAGE;
    const bool more = (kt + 1 < nk);
    if (more) {
      ap += 64; bp += 64;
#pragma unroll
      for (int i = 0; i < 4; ++i) ra[i] = *(const u32x4*)(ap + i * astep);
#pragma unroll
      for (int i = 0; i < NB; ++i) rb[i] = *(const u32x4*)(bp + i * bstep);
    }
#pragma unroll
    for (int ks = 0; ks < 4; ++ks) {
      const bf16x8 a0 = *(const bf16x8*)(st + a_rd + ks * 32);
      const bf16x8 a1 = *(const bf16x8*)(st + a_rd + 32 * LROW + ks * 32);
#pragma unroll
      for (int j = 0; j < NJ; ++j) {
        const bf16x8 b = *(const bf16x8*)(st + b_rd + j * 32 * LROW + ks * 32);
        acc[0][j] = MFMA(a0, b, acc[0][j]);
        acc[1][j] = MFMA(a1, b, acc[1][j]);
      }
    }
    if (more) {
      char* sn = lds + ((kt + 1) & 1) * STAGE;
#pragma unroll
      for (int i = 0; i < 4; ++i) *(u32x4*)(sn + wofs + i * 32 * LROW) = ra[i];
#pragma unroll
      for (int i = 0; i < NB; ++i) *(u32x4*)(sn + STAGE_OP + wofs + i * 32 * LROW) = rb[i];
    }
    __syncthreads();
  }
}

template <int NJ> DI void acc_to_lds(const f32x16 (&acc)[2][NJ], float* cl) {
  const int tid = tid_(), lane = tid & 63, w = tid >> 6, wm = w >> 1, wn = w & 1, h = lane >> 5, c = lane & 31;
#pragma unroll
  for (int i = 0; i < 2; ++i)
#pragma unroll
    for (int j = 0; j < NJ; ++j)
#pragma unroll
      for (int r = 0; r < 16; ++r) {
        const int row = wm * 64 + i * 32 + (r & 3) + 8 * (r >> 2) + 4 * h;
        cl[row * CLD + wn * 32 * NJ + j * 32 + c] = acc[i][j][r];
      }
}

DI void resid_epilogue(float* __restrict__ x, bf16_t* __restrict__ xb, float* __restrict__ ssn, int mt, int nt, const float* cl, float scale) {
  const int tid = tid_(), c4 = (tid & 31) * 4, r0 = tid >> 5;
#pragma unroll 4
  for (int it = 0; it < 16; ++it) {
    const int row = r0 + 8 * it;
    const f32x4 c = *(const f32x4*)(cl + row * CLD + c4);
    const size_t gi = (size_t)(mt * 128 + row) * DM + nt * 128 + c4;
    f32x4 xv = *(const f32x4*)(x + gi);
    xv = xv + scale * c;
    *(f32x4*)(x + gi) = xv;
    u32x2 p; p.x = pk2(xv[0], xv[1]); p.y = pk2(xv[2], xv[3]);
    *(u32x2*)(xb + gi) = p;
    float s = xv[0] * xv[0] + xv[1] * xv[1] + xv[2] * xv[2] + xv[3] * xv[3];
    s += __shfl_xor(s, 16); s += __shfl_xor(s, 8); s += __shfl_xor(s, 4); s += __shfl_xor(s, 2); s += __shfl_xor(s, 1);
    if ((tid & 31) == 0) atomicAdd(ssn + mt * 128 + row, s);
  }
}

struct Ctx {
  const Params* p;
  int chunk, layer;
  int S, sshift;
  float* x;
  const float* xin;
  const float* pe0; size_t pe_ls;
  char* ws;
  char* lds;
};
DI bf16_t* wsb(const Ctx& c, size_t off) { return (bf16_t*)(c.ws + off); }
DI float* ss_site(const Ctx& c, int layer, int site) { return (float*)(c.ws + OFF_SS) + ((size_t)layer * 6 + site) * TC; }
DI const bf16_t* wgt(const Ctx& c, size_t off) { return (const bf16_t*)(c.ws + OFF_W) + (size_t)c.layer * W_LAYER + off; }
DI const float* inl(const Ctx& c, int idx, size_t per_layer) { return c.p->in[idx] + (size_t)c.layer * per_layer; }

DI void phase_ffn_in(const Ctx& c, size_t woff, int site) {
  const bf16_t* A = wsb(c, OFF_XB);
  const bf16_t* Bt = wgt(c, woff);
  bf16_t* act = wsb(c, OFF_ACT);
  const float* ss = ss_site(c, c.layer, site);
  float* cl = (float*)c.lds; float* rr = (float*)(c.lds + OFF_RR);
  const int tid = tid_();
  for (int t = blockIdx.x; t < 128 * 44; t += gridDim.x) {
    const int mt = t / 44, nt = t - mt * 44;
    f32x16 acc[2][2]; zero_acc<2>(acc);
    gemm_mainloop<2>(A + (size_t)mt * 128 * DM, DM, Bt + (size_t)nt * 128 * DM, DM, DM, acc, c.lds);
    acc_to_lds<2>(acc, cl);
    if (tid < 128) rr[tid] = rsqrtf(ss[mt * 128 + tid] * (1.0f / DM) + EPS);
    __syncthreads();
    const int c4 = (tid & 15) * 4, r0 = tid >> 4;
#pragma unroll 2
    for (int it = 0; it < 8; ++it) {
      const int row = r0 + 16 * it;
      const float r = rr[row];
      const f32x4 a = *(const f32x4*)(cl + row * CLD + c4);
      const f32x4 b = *(const f32x4*)(cl + row * CLD + 64 + c4);
      float o[4];
#pragma unroll
      for (int e = 0; e < 4; ++e) { const float av = a[e] * r, bv = b[e] * r; o[e] = av * sigmoidf_(av) * bv; }
      u32x2 pq; pq.x = pk2(o[0], o[1]); pq.y = pk2(o[2], o[3]);
      *(u32x2*)(act + (size_t)(mt * 128 + row) * DFF + nt * 64 + c4) = pq;
    }
    __syncthreads();
  }
}

DI void phase_resid_gemm(const Ctx& c, const bf16_t* A, int K, size_t woff, float scale, float* ssn) {
  const bf16_t* Bt = wgt(c, woff);
  bf16_t* xb = wsb(c, OFF_XB);
  float* cl = (float*)c.lds;
  for (int t = blockIdx.x; t < 128 * 8; t += gridDim.x) {
    const int mt = t >> 3, nt = t & 7;
    f32x16 acc[2][2]; zero_acc<2>(acc);
    gemm_mainloop<2>(A + (size_t)mt * 128 * K, K, Bt + (size_t)nt * 128 * K, K, K, acc, c.lds);
    acc_to_lds<2>(acc, cl);
    __syncthreads();
    resid_epilogue(c.x, xb, ssn, mt, nt, cl, scale);
    __syncthreads();
  }
}

DI void load_slot(const float* cl, int row, int col0, float (&v)[64]) {
#pragma unroll
  for (int q = 0; q < 16; ++q) { const f32x4 t = *(const f32x4*)(cl + row * CLD + col0 + q * 4); v[4 * q] = t[0]; v[4 * q + 1] = t[1]; v[4 * q + 2] = t[2]; v[4 * q + 3] = t[3]; }
}
template <int N> DI void store_bf16(bf16_t* dst, const float* v) {
#pragma unroll
  for (int q = 0; q < N / 8; ++q) { u32x4 p; p.x = pk2(v[8 * q], v[8 * q + 1]); p.y = pk2(v[8 * q + 2], v[8 * q + 3]); p.z = pk2(v[8 * q + 4], v[8 * q + 5]); p.w = pk2(v[8 * q + 6], v[8 * q + 7]); *(u32x4*)(dst + 8 * q) = p; }
}
template <int N> DI void rmsnorm_inplace(float* v, const float* __restrict__ g) {
  float s = 0.f;
#pragma unroll
  for (int i = 0; i < N; ++i) s += v[i] * v[i];
  const float r = rsqrtf(s * (1.0f / N) + EPS);
#pragma unroll
  for (int i = 0; i < N; ++i) v[i] = v[i] * r * g[i];
}
DI void rope32(float* v, const f32x2* __restrict__ tab  ) {
#pragma unroll
  for (int i = 0; i < 16; ++i) { const f32x2 cs = tab[i]; const float x1 = v[i], x2 = v[i + 16]; v[i] = x1 * cs.x - x2 * cs.y; v[i + 16] = x1 * cs.y + x2 * cs.x; }
}
DI void vt_write(const float* cl, const float* rr, int col0, int u, bf16_t* dst_row  , int dsh, int L, int pos0) {
  const int d = u & 63, th = u >> 6;
  float v[64];
#pragma unroll
  for (int i = 0; i < 64; ++i) v[i] = cl[(th * 64 + i) * CLD + col0 + d] * rr[th * 64 + i];
  const int p0 = pos0 + th * 64;
  if (dsh == 0) {
    store_bf16<64>(dst_row + p0, v);
  } else if (dsh == 2) {
#pragma unroll
    for (int rr_ = 0; rr_ < 4; ++rr_) {
      float t[16];
#pragma unroll
      for (int a = 0; a < 16; ++a) t[a] = v[4 * a + rr_];
      store_bf16<16>(dst_row + rr_ * L + (p0 >> 2), t);
    }
  } else {
#pragma unroll
    for (int rr_ = 0; rr_ < 16; ++rr_) {
      u32x2 p; p.x = pk2(v[rr_], v[16 + rr_]); p.y = pk2(v[32 + rr_], v[48 + rr_]);
      *(u32x2*)(dst_row + rr_ * L + (p0 >> 4)) = p;
    }
  }
}

DI void phase_proj(const Ctx& c) {
  const bf16_t* A = wsb(c, OFF_XB);
  const bf16_t* Bt = wgt(c, W_IN);
  const float* ss = ss_site(c, c.layer, 1);
  float* ss_cq = ss_site(c, c.layer, 4);
  float* ss_ckv = ss_site(c, c.layer, 5);
  float* cl = (float*)c.lds; float* rr = (float*)(c.lds + OFF_RR);
  const f32x2* rope = (const f32x2*)(c.ws + OFF_ROPE);
  const int tid = tid_(), half = tid >> 7, u = tid & 127;
  const int S = c.S, sshift = c.sshift;
  for (int t = blockIdx.x; t < 128 * 28; t += gridDim.x) {
    const int mt = t / 28, nt = t - mt * 28;
    f32x16 acc[2][2]; zero_acc<2>(acc);
    gemm_mainloop<2>(A + (size_t)mt * 128 * DM, DM, Bt + (size_t)nt * 128 * DM, DM, DM, acc, c.lds);
    acc_to_lds<2>(acc, cl);
    if (tid < 128) rr[tid] = rsqrtf(ss[mt * 128 + tid] * (1.0f / DM) + EPS);
    __syncthreads();
    const int slot = nt * 2 + half, col0 = half * 64;
    const int tl0 = mt * 128, seq = tl0 >> sshift, pos0 = tl0 & (S - 1);
    const bool is_vb = (slot >= 31 && slot < 43), is_vc = (slot == 53 || slot == 54);
    if (is_vb) {
      const int hb = slot - 31, dsh = 2 * (hb >> 2);
      bf16_t* dst = wsb(c, OFF_VTB) + ((size_t)(seq * 12 + hb) * 64 + (u & 63)) * S;
      vt_write(cl, rr, col0, u, dst, dsh, S >> dsh, pos0);
    } else if (is_vc) {
      const int hv = slot - 53;
      bf16_t* dst = wsb(c, OFF_VTC) + ((size_t)(seq * 2 + hv) * 64 + (u & 63)) * S;
      vt_write(cl, rr, col0, u, dst, 0, S, pos0);
    } else if (slot < 55) {
      const int row = u, tl = tl0 + row, pos = pos0 + row;
      const float r = rr[row];
      float v[64];
      load_slot(cl, row, col0, v);
#pragma unroll
      for (int i = 0; i < 64; ++i) v[i] *= r;
      if (slot < 6) {
        float s = 0.f;
#pragma unroll
        for (int i = 0; i < 64; ++i) s += v[i] * v[i];
        if (slot < 4) { store_bf16<64>(wsb(c, OFF_CQ) + (size_t)tl * 256 + slot * 64, v); atomicAdd(ss_cq + tl, s); }
        else { store_bf16<64>(wsb(c, OFF_CKV) + (size_t)tl * 128 + (slot - 4) * 64, v); atomicAdd(ss_ckv + tl, s); }
      } else if (slot == 6) {
        rmsnorm_inplace<32>(v, inl(c, 14, 96) + 64);
        rope32(v, rope + (size_t)pos * 16);
        bf16_t* dst = wsb(c, OFF_KA) + ((size_t)(seq * 8) * S + pos) * 96 + 64;
#pragma unroll
        for (int hh = 0; hh < 8; ++hh) store_bf16<32>(dst + (size_t)hh * S * 96, v);
      } else if (slot < 31) {
        const bool isq = slot < 19;
        const int hb = isq ? slot - 7 : slot - 19, dsh = 2 * (hb >> 2), L = S >> dsh;
        rmsnorm_inplace<64>(v, inl(c, isq ? 15 : 16, 64));
        const int srow = (pos & ((1 << dsh) - 1)) * L + (pos >> dsh);
        bf16_t* dst = wsb(c, isq ? OFF_QB : OFF_KB) + ((size_t)(seq * 12 + hb) * S + srow) * 64;
        store_bf16<64>(dst, v);
      } else {
        const bool isq = slot < 51;
        rmsnorm_inplace<64>(v, inl(c, isq ? 18 : 19, 64));
        rope32(v, rope + (size_t)(pos >> 6) * 16);
        rope32(v + 32, rope + (size_t)(pos & 63) * 16);
        bf16_t* dst = isq ? wsb(c, OFF_QC) + ((size_t)(seq * 8 + (slot - 43)) * S + pos) * 64
                          : wsb(c, OFF_KC) + ((size_t)(seq * 2 + (slot - 51)) * S + pos) * 64;
        store_bf16<64>(dst, v);
      }
    }
    __syncthreads();
  }
}

DI void phase_mlaup(const Ctx& c) {
  const float* ss_cq = ss_site(c, c.layer, 4);
  const float* ss_ckv = ss_site(c, c.layer, 5);
  float* cl = (float*)c.lds; float* rr = (float*)(c.lds + OFF_RR);
  const f32x2* rope = (const f32x2*)(c.ws + OFF_ROPE);
  const int tid = tid_(), half = tid >> 7, u = tid & 127;
  const int S = c.S, sshift = c.sshift;
  for (int t = blockIdx.x; t < 128 * 14; t += gridDim.x) {
    const int mt = t / 14, nt = t - mt * 14;
    const bool isq = nt < 6;
    f32x16 acc[2][2]; zero_acc<2>(acc);
    if (isq) gemm_mainloop<2>(wsb(c, OFF_CQ) + (size_t)mt * 128 * 256, 256, wgt(c, W_UQ) + (size_t)nt * 128 * 256, 256, 256, acc, c.lds);
    else gemm_mainloop<2>(wsb(c, OFF_CKV) + (size_t)mt * 128 * 128, 128, wgt(c, W_UKV) + (size_t)(nt - 6) * 128 * 128, 128, 128, acc, c.lds);
    acc_to_lds<2>(acc, cl);
    if (tid < 128) rr[tid] = isq ? rsqrtf(ss_cq[mt * 128 + tid] * (1.0f / 256) + EPS) : rsqrtf(ss_ckv[mt * 128 + tid] * (1.0f / 128) + EPS);
    __syncthreads();
    const int col0 = half * 64;
    const int tl0 = mt * 128, seq = tl0 >> sshift, pos0 = tl0 & (S - 1);
    if (!isq && nt >= 10) {
      const int hv = (nt - 10) * 2 + half;
      bf16_t* dst = wsb(c, OFF_VTA) + ((size_t)(seq * 8 + hv) * 64 + (u & 63)) * S;
      vt_write(cl, rr, col0, u, dst, 0, S, pos0);
    } else {
      const int row = u, pos = pos0 + row;
      const float r = rr[row];
      float v[64];
      load_slot(cl, row, col0, v);
#pragma unroll
      for (int i = 0; i < 64; ++i) v[i] *= r;
      if (isq && nt < 4) {
        const int hh = nt * 2 + half;
        rmsnorm_inplace<64>(v, inl(c, 13, 96));
        store_bf16<64>(wsb(c, OFF_QA) + ((size_t)(seq * 8 + hh) * S + pos) * 96, v);
      } else if (isq) {
        const int h0 = ((nt - 4) * 2 + half) * 2;
        rmsnorm_inplace<32>(v, inl(c, 13, 96) + 64);
        rmsnorm_inplace<32>(v + 32, inl(c, 13, 96) + 64);
        rope32(v, rope + (size_t)pos * 16);
        rope32(v + 32, rope + (size_t)pos * 16);
        store_bf16<32>(wsb(c, OFF_QA) + ((size_t)(seq * 8 + h0) * S + pos) * 96 + 64, v);
        store_bf16<32>(wsb(c, OFF_QA) + ((size_t)(seq * 8 + h0 + 1) * S + pos) * 96 + 64, v + 32);
      } else {
        const int hh = (nt - 6) * 2 + half;
        rmsnorm_inplace<64>(v, inl(c, 14, 96));
        store_bf16<64>(wsb(c, OFF_KA) + ((size_t)(seq * 8 + hh) * S + pos) * 96, v);
      }
    }
    __syncthreads();
  }
}

template <int DQK, bool BAND, int QT>
DI void attn_item(const bf16_t* __restrict__ Q, const bf16_t* __restrict__ Kp, const bf16_t* __restrict__ Vt, int ldv,
                  int kbeg, int kend, int q0, const float* bias_g, float scale_log2,
                  bf16_t* __restrict__ out, size_t out_rs, float* __restrict__ lse, int lse_rs, char* lds) {
  constexpr int KROW = DQK * 2 + 16;
  constexpr int KST = 64 * KROW, VST = 64 * LROW, ST = KST + VST;
  constexpr int NKS = DQK / 16;
  constexpr int KV4 = DQK / 8;
  constexpr int NKL = (64 * KV4) / 256;
  constexpr int WQ = 32 * QT;
  const int tid = tid_(), lane = tid & 63, w = tid >> 6, h = lane >> 5, ql = lane & 31;
  float* bias_l = (float*)(lds + 2 * ST);
  if (BAND) { if (tid < 129) bias_l[tid] = bias_g[tid]; }
  bf16x8 qf[QT][NKS];
#pragma unroll
  for (int qt = 0; qt < QT; ++qt)
#pragma unroll
    for (int ks = 0; ks < NKS; ++ks) qf[qt][ks] = *(const bf16x8*)(Q + (size_t)(w * WQ + qt * 32 + ql) * DQK + ks * 16 + h * 8);
  f32x16 o[2][QT];
#pragma unroll
  for (int a = 0; a < 2; ++a)
#pragma unroll
    for (int b = 0; b < QT; ++b)
#pragma unroll
      for (int r = 0; r < 16; ++r) o[a][b][r] = 0.f;
  float m[QT], l[QT];
#pragma unroll
  for (int qt = 0; qt < QT; ++qt) { m[qt] = -1e30f; l[qt] = 0.f; }
  u32x4 rk[NKL], rv[2];
  const int vrow0 = tid >> 3, vch = tid & 7;
  auto gload = [&](int kt) {
#pragma unroll
    for (int i = 0; i < NKL; ++i) { const int idx = tid + i * 256, kr = idx / KV4, kc = idx - kr * KV4; rk[i] = *(const u32x4*)(Kp + (size_t)(kt + kr) * DQK + kc * 8); }
#pragma unroll
    for (int i = 0; i < 2; ++i) rv[i] = *(const u32x4*)(Vt + (size_t)(vrow0 + 32 * i) * ldv + kt + vch * 8);
  };
  auto lstore = [&](char* st) {
#pragma unroll
    for (int i = 0; i < NKL; ++i) { const int idx = tid + i * 256, kr = idx / KV4, kc = idx - kr * KV4; *(u32x4*)(st + kr * KROW + kc * 16) = rk[i]; }
#pragma unroll
    for (int i = 0; i < 2; ++i) *(u32x4*)(st + KST + (vrow0 + 32 * i) * LROW + vch * 16) = rv[i];
  };
  gload(kbeg);
  lstore(lds);
  __syncthreads();
  const int pr = (ql & ~12) | ((ql & 4) << 1) | ((ql & 8) >> 1);
  const int k_rd = pr * KROW + h * 16;
  const int v_rd = KST + ql * LROW + h * 16;
  const int qw0 = q0 + w * WQ;
  int it = 0;
  for (int kt = kbeg; kt < kend; kt += 64, ++it) {
    const char* st = lds + (it & 1) * ST;
    const bool more = (kt + 64 < kend);
    if (more) gload(kt + 64);
    bool need = true;
    if (BAND) need = (kt + 63 >= qw0 - 64) && (kt <= qw0 + WQ - 1 + 64);
    if (need) {
      f32x16 s[2][QT];
#pragma unroll
      for (int a = 0; a < 2; ++a)
#pragma unroll
        for (int b = 0; b < QT; ++b)
#pragma unroll
          for (int r = 0; r < 16; ++r) s[a][b][r] = 0.f;
#pragma unroll
      for (int ks = 0; ks < NKS; ++ks) {
        const bf16x8 k0 = *(const bf16x8*)(st + k_rd + ks * 32);
        const bf16x8 k1 = *(const bf16x8*)(st + k_rd + 32 * KROW + ks * 32);
#pragma unroll
        for (int qt = 0; qt < QT; ++qt) {
          s[0][qt] = MFMA(k0, qf[qt][ks], s[0][qt]);
          s[1][qt] = MFMA(k1, qf[qt][ks], s[1][qt]);
        }
      }
      bf16x8 pf[QT][4];
#pragma unroll
      for (int qt = 0; qt < QT; ++qt) {
        float mx = -1e30f;
#pragma unroll
        for (int a = 0; a < 2; ++a)
#pragma unroll
          for (int r = 0; r < 16; ++r) {
            float v = s[a][qt][r] * scale_log2;
            if (BAND) {
              const int kidx = kt + 32 * a + (r & 7) + 8 * h + 16 * (r >> 3);
              const int rel = kidx - (qw0 + qt * 32 + ql);
              const bool ok = (rel >= -64) && (rel <= 64);
              const int bi = ok ? rel + 64 : 0;
              v = ok ? v + bias_l[bi] : -1e30f;
            }
            s[a][qt][r] = v;
            mx = fmaxf(mx, v);
          }
        mx = fmaxf(mx, __shfl_xor(mx, 32));
        const float mn = fmaxf(m[qt], mx);
        const float alpha = __builtin_amdgcn_exp2f(m[qt] - mn);
        m[qt] = mn;
        float ls = 0.f;
#pragma unroll
        for (int a = 0; a < 2; ++a) {
#pragma unroll
          for (int r = 0; r < 16; ++r) { const float pv = __builtin_amdgcn_exp2f(s[a][qt][r] - mn); s[a][qt][r] = pv; ls += pv; }
#pragma unroll
          for (int s2 = 0; s2 < 2; ++s2) {
            u32x4 pk;
            pk.x = pk2(s[a][qt][8 * s2 + 0], s[a][qt][8 * s2 + 1]);
            pk.y = pk2(s[a][qt][8 * s2 + 2], s[a][qt][8 * s2 + 3]);
            pk.z = pk2(s[a][qt][8 * s2 + 4], s[a][qt][8 * s2 + 5]);
            pk.w = pk2(s[a][qt][8 * s2 + 6], s[a][qt][8 * s2 + 7]);
            pf[qt][a * 2 + s2] = __builtin_bit_cast(bf16x8, pk);
          }
        }
        l[qt] = l[qt] * alpha + ls;
#pragma unroll
        for (int r = 0; r < 16; ++r) { o[0][qt][r] *= alpha; o[1][qt][r] *= alpha; }
      }
#pragma unroll
      for (int ks = 0; ks < 4; ++ks) {
        const bf16x8 v0 = *(const bf16x8*)(st + v_rd + ks * 32);
        const bf16x8 v1 = *(const bf16x8*)(st + v_rd + 32 * LROW + ks * 32);
#pragma unroll
        for (int qt = 0; qt < QT; ++qt) {
          o[0][qt] = MFMA(v0, pf[qt][ks], o[0][qt]);
          o[1][qt] = MFMA(v1, pf[qt][ks], o[1][qt]);
        }
      }
    }
    if (more) lstore(lds + ((it + 1) & 1) * ST);
    __syncthreads();
  }
#pragma unroll
  for (int qt = 0; qt < QT; ++qt) {
    const float lt = l[qt] + __shfl_xor(l[qt], 32);
    const float inv = 1.0f / lt;
    const int qi = w * WQ + qt * 32 + ql;
    bf16_t* orow = out + (size_t)qi * out_rs;
#pragma unroll
    for (int dt = 0; dt < 2; ++dt)
#pragma unroll
      for (int g = 0; g < 4; ++g) {
        u32x2 p; p.x = pk2(o[dt][qt][4 * g] * inv, o[dt][qt][4 * g + 1] * inv); p.y = pk2(o[dt][qt][4 * g + 2] * inv, o[dt][qt][4 * g + 3] * inv);
        *(u32x2*)(orow + dt * 32 + 8 * g + 4 * h) = p;
      }
    if (BAND) { if (h == 0) lse[(size_t)qi * lse_rs] = m[qt] * LN2 + __logf(lt); }
  }
}

constexpr int AQT = 1;
constexpr int QBLK = 128 * AQT;
DI void phase_attn(const Ctx& c) {
  const int S = c.S, nseq = TC / S, nqb = S / QBLK;
  const int n_mla = nseq * 8 * nqb, n_gqa = n_mla, n_dil = nseq * 12 * nqb;
  const float* bias = (const float*)(c.ws + OFF_BIAS);
  for (int item = blockIdx.x; item < n_mla + n_gqa + n_dil; item += gridDim.x) {
    if (item < n_mla) {
      const int hh = item & 7, rest = item >> 3, seq = rest / nqb, qb = rest - seq * nqb;
      const size_t hs = (size_t)(seq * 8 + hh) * S;
      attn_item<96, false, AQT>(wsb(c, OFF_QA) + (hs + qb * QBLK) * 96, wsb(c, OFF_KA) + hs * 96, wsb(c, OFF_VTA) + hs * 64, S,
                           0, S, 0, nullptr, 0.10206207261596577f * LOG2E,
                           wsb(c, OFF_OA) + ((size_t)seq * S + qb * QBLK) * 512 + hh * 64, 512, nullptr, 0, c.lds);
    } else if (item < n_mla + n_gqa) {
      const int i2 = item - n_mla;
      const int hq = i2 & 7, rest = i2 >> 3, seq = rest / nqb, qb = rest - seq * nqb;
      const size_t hs = (size_t)(seq * 8 + hq) * S, ks = (size_t)(seq * 2 + (hq >> 2)) * S;
      attn_item<64, false, AQT>(wsb(c, OFF_QC) + (hs + qb * QBLK) * 64, wsb(c, OFF_KC) + ks * 64, wsb(c, OFF_VTC) + ks * 64, S,
                           0, S, 0, nullptr, 0.125f * LOG2E,
                           wsb(c, OFF_OC) + ((size_t)seq * S + qb * QBLK) * 512 + hq * 64, 512, nullptr, 0, c.lds);
    } else {
      const int i2 = item - n_mla - n_gqa;
      const int hb = i2 % 12, rest = i2 / 12, seq = rest / nqb, blk = rest - seq * nqb;
      const int dsh = 2 * (hb >> 2), L = S >> dsh, dil = 1 << dsh;
      const int srow0 = blk * QBLK, rr = srow0 / L, l0 = srow0 - rr * L;
      const size_t hs = (size_t)(seq * 12 + hb) * S;
      int kb = l0 - 64; if (kb < 0) kb = 0;
      int ke = l0 + QBLK + 64; if (ke > L) ke = L;
      const size_t tok0 = (size_t)seq * S + (size_t)l0 * dil + rr;
      attn_item<64, true, AQT>(wsb(c, OFF_QB) + (hs + srow0) * 64, wsb(c, OFF_KB) + (hs + (size_t)rr * L) * 64, wsb(c, OFF_VTB) + hs * 64 + (size_t)rr * L, S,
                          kb, ke, l0, bias + hb * 132, 0.125f * LOG2E,
                          wsb(c, OFF_OBG) + tok0 * 768 + hb * 64, (size_t)dil * 768, (float*)(c.ws + OFF_LSE) + tok0 * 12 + hb, dil * 12, c.lds);
    }
    __syncthreads();
  }
}

DI void phase_combine(const Ctx& c) {
  const bf16_t* obg = wsb(c, OFF_OBG);
  const float* lse = (const float*)(c.ws + OFF_LSE);
  bf16_t* ob = wsb(c, OFF_OB);
  const int total = TC * 4 * 8;
  for (int idx = blockIdx.x * NTHREADS + tid_(); idx < total; idx += gridDim.x * NTHREADS) {
    const int d8 = idx & 7, j = (idx >> 3) & 3, tl = idx >> 5;
    const float l0 = lse[tl * 12 + j], l1 = lse[tl * 12 + 4 + j], l2 = lse[tl * 12 + 8 + j];
    const float mx = fmaxf(l0, fmaxf(l1, l2));
    float w0 = __expf(l0 - mx), w1 = __expf(l1 - mx), w2 = __expf(l2 - mx);
    const float inv = 1.0f / (w0 + w1 + w2);
    w0 *= inv; w1 *= inv; w2 *= inv;
    const u32x4 a = *(const u32x4*)(obg + (size_t)tl * 768 + j * 64 + d8 * 8);
    const u32x4 b = *(const u32x4*)(obg + (size_t)tl * 768 + (4 + j) * 64 + d8 * 8);
    const u32x4 d = *(const u32x4*)(obg + (size_t)tl * 768 + (8 + j) * 64 + d8 * 8);
    u32x4 r;
#pragma unroll
    for (int e = 0; e < 4; ++e) {
      const float lo = w0 * __uint_as_float(a[e] << 16) + w1 * __uint_as_float(b[e] << 16) + w2 * __uint_as_float(d[e] << 16);
      const float hi = w0 * __uint_as_float(a[e] & 0xffff0000u) + w1 * __uint_as_float(b[e] & 0xffff0000u) + w2 * __uint_as_float(d[e] & 0xffff0000u);
      r[e] = pk2(lo, hi);
    }
    *(u32x4*)(ob + (size_t)tl * 256 + j * 64 + d8 * 8) = r;
  }
}

DI void phase_merge(const Ctx& c) {
  const bf16_t* xb = wsb(c, OFF_XB);
  const float* ss = ss_site(c, c.layer, 1);
  const float* bgate = inl(c, 21, 3072);
  bf16_t* mrg = wsb(c, OFF_MRG);
  float* cl = (float*)c.lds; float* rr = (float*)(c.lds + OFF_RR);
  const int tid = tid_(), lane = tid & 63, w = tid >> 6, wm = w >> 1, wn = w & 1, h = lane >> 5, cc = lane & 31;
  for (int t = blockIdx.x; t < 128 * 16; t += gridDim.x) {
    const int mt = t >> 4, nt = t & 15;
    __syncthreads();
    if (tid < 128) rr[tid] = rsqrtf(ss[mt * 128 + tid] * (1.0f / DM) + EPS);
    f32x16 macc[2][1]; zero_acc<1>(macc);
#pragma unroll 1
    for (int k = 0; k < 3; ++k) {
      f32x16 gacc[2][1]; zero_acc<1>(gacc);
      gemm_mainloop<1>(xb + (size_t)mt * 128 * DM, DM, wgt(c, W_GATE) + (size_t)(k * 1024 + nt * 64) * DM, DM, DM, gacc, c.lds);
      const float bv = bgate[k * 1024 + nt * 64 + wn * 32 + cc];
#pragma unroll
      for (int i = 0; i < 2; ++i)
#pragma unroll
        for (int r = 0; r < 16; ++r) {
          const float rv = rr[wm * 64 + i * 32 + (r & 3) + 8 * (r >> 2) + 4 * h];
          gacc[i][0][r] = sigmoidf_(gacc[i][0][r] * rv + bv);
        }
      f32x16 acc[2][1]; zero_acc<1>(acc);
      const int Kk = (k == 1) ? 256 : 512;
      const bf16_t* Ao = wsb(c, k == 0 ? OFF_OA : (k == 1 ? OFF_OB : OFF_OC));
      const bf16_t* Wo = wgt(c, k == 0 ? W_OA : (k == 1 ? W_OB : W_OC));
      gemm_mainloop<1>(Ao + (size_t)mt * 128 * Kk, Kk, Wo + (size_t)nt * 64 * Kk, Kk, Kk, acc, c.lds);
#pragma unroll
      for (int i = 0; i < 2; ++i)
#pragma unroll
        for (int r = 0; r < 16; ++r) macc[i][0][r] += gacc[i][0][r] * acc[i][0][r];
    }
    acc_to_lds<1>(macc, cl);
    __syncthreads();
    const int c4 = (tid & 15) * 4, r0 = tid >> 4;
#pragma unroll 4
    for (int it = 0; it < 8; ++it) {
      const int row = r0 + 16 * it;
      const f32x4 v = *(const f32x4*)(cl + row * CLD + c4);
      u32x2 p; p.x = pk2(v[0], v[1]); p.y = pk2(v[2], v[3]);
      *(u32x2*)(mrg + (size_t)(mt * 128 + row) * DM + nt * 64 + c4) = p;
    }
    __syncthreads();
  }
}

DI void phase_ple(const Ctx& c) {
  const bf16_t* xb = wsb(c, OFF_XB);
  const float* ss = ss_site(c, c.layer, 3);
  float* ssn = ss_site(c, c.layer + 1, 0);
  const bf16_t* peb = wsb(c, OFF_PEB) + (size_t)c.layer * TC * 256;
  float* cl = (float*)c.lds; float* rr = (float*)(c.lds + OFF_RR);
  const int tid = tid_(), lane = tid & 63, w = tid >> 6, wm = w >> 1, h = lane >> 5;
  for (int t = blockIdx.x; t < 128 * 8; t += gridDim.x) {
    const int mt = t >> 3, nt = t & 7;
    if (tid < 128) rr[tid] = rsqrtf(ss[mt * 128 + tid] * (1.0f / DM) + EPS);
    f32x16 g[2][2]; zero_acc<2>(g);
    gemm_mainloop<2>(xb + (size_t)mt * 128 * DM, DM, wgt(c, W_PG) + (size_t)nt * 128 * DM, DM, DM, g, c.lds);
#pragma unroll
    for (int i = 0; i < 2; ++i)
#pragma unroll
      for (int r = 0; r < 16; ++r) {
        const float rv = rr[wm * 64 + i * 32 + (r & 3) + 8 * (r >> 2) + 4 * h];
        g[i][0][r] = sigmoidf_(g[i][0][r] * rv);
        g[i][1][r] = sigmoidf_(g[i][1][r] * rv);
      }
    f32x16 acc[2][2]; zero_acc<2>(acc);
    gemm_mainloop<2>(peb + (size_t)mt * 128 * 256, 256, wgt(c, W_PLE) + (size_t)nt * 128 * 256, 256, 256, acc, c.lds);
#pragma unroll
    for (int i = 0; i < 2; ++i)
#pragma unroll
      for (int j = 0; j < 2; ++j)
#pragma unroll
        for (int r = 0; r < 16; ++r) acc[i][j][r] *= g[i][j][r];
    acc_to_lds<2>(acc, cl);
    __syncthreads();
    resid_epilogue(c.x, wsb(c, OFF_XB), ssn, mt, nt, cl, 1.0f);
    __syncthreads();
  }
}

DI void phase_prologue(const Params& p, char* lds) {
  float* tl = (float*)lds;
  bf16_t* W = (bf16_t*)(p.ws + OFF_W);
  int rot = 0;
  for (int L = 0; L < 2; ++L) {
    bf16_t* wl = W + (size_t)L * W_LAYER;
    transpose_mat(p.in[5] + (size_t)L * 1024 * 5632, 5632, wl + W_FFN1_IN, 5632, 1024, p.in[4] + L * 1024, 1, tl, rot); rot += 88 * 16;
    transpose_mat(p.in[6] + (size_t)L * 2816 * 1024, 1024, wl + W_FFN1_OUT, 1024, 2816, nullptr, 0, tl, rot); rot += 16 * 44;
    transpose_mat(p.in[8] + (size_t)L * 1024 * 3488, 3488, wl + W_IN, 3584, 1024, p.in[7] + L * 1024, 2, tl, rot); rot += 56 * 16;
    transpose_mat(p.in[20] + (size_t)L * 1024 * 3072, 3072, wl + W_GATE, 3072, 1024, p.in[7] + L * 1024, 0, tl, rot); rot += 48 * 16;
    transpose_mat(p.in[11] + (size_t)L * 256 * 768, 768, wl + W_UQ, 768, 256, p.in[9] + L * 256, 3, tl, rot); rot += 12 * 4;
    transpose_mat(p.in[12] + (size_t)L * 128 * 1024, 1024, wl + W_UKV, 1024, 128, p.in[10] + L * 128, 4, tl, rot); rot += 16 * 2;
    transpose_mat(p.in[22] + (size_t)L * 512 * 1024, 1024, wl + W_OA, 1024, 512, nullptr, 0, tl, rot); rot += 16 * 8;
    transpose_mat(p.in[23] + (size_t)L * 256 * 1024, 1024, wl + W_OB, 1024, 256, nullptr, 0, tl, rot); rot += 16 * 4;
    transpose_mat(p.in[24] + (size_t)L * 512 * 1024, 1024, wl + W_OC, 1024, 512, nullptr, 0, tl, rot); rot += 16 * 8;
    transpose_mat(p.in[25] + (size_t)L * 1024 * 1024, 1024, wl + W_OUT, 1024, 1024, nullptr, 0, tl, rot); rot += 16 * 16;
    transpose_mat(p.in[27] + (size_t)L * 1024 * 5632, 5632, wl + W_FFN2_IN, 5632, 1024, p.in[26] + L * 1024, 1, tl, rot); rot += 88 * 16;
    transpose_mat(p.in[28] + (size_t)L * 2816 * 1024, 1024, wl + W_FFN2_OUT, 1024, 2816, nullptr, 0, tl, rot); rot += 16 * 44;
    transpose_mat(p.in[30] + (size_t)L * 1024 * 1024, 1024, wl + W_PG, 1024, 1024, p.in[29] + L * 1024, 0, tl, rot); rot += 16 * 16;
    transpose_mat(p.in[31] + (size_t)L * 256 * 1024, 1024, wl + W_PLE, 1024, 256, nullptr, 0, tl, rot); rot += 16 * 4;
  }
  const int gtid = blockIdx.x * NTHREADS + tid_(), gn = gridDim.x * NTHREADS;
  f32x2* rope = (f32x2*)(p.ws + OFF_ROPE);
  for (int idx = gtid; idx < 16384 * 16; idx += gn) {
    const int pos = idx >> 4, i = idx & 15;
    const float freq = (float)pow(10000.0, -(double)i / 16.0);
    const float ang = (float)pos * freq;
    f32x2 cs; cs.x = (float)cos((double)ang); cs.y = (float)sin((double)ang);
    rope[idx] = cs;
  }
  float* bias = (float*)(p.ws + OFF_BIAS);
  for (int idx = gtid; idx < 12 * 129; idx += gn) {
    const int hb = idx / 129, jj = idx - hb * 129;
    const int dil = 1 << (2 * (hb >> 2));
    const int rel = (jj - 64) * dil;
    const int n = rel < 0 ? -rel : rel;
    int b;
    if (n < 8) b = n;
    else { int lg = 8 + (int)(log((double)n / 8.0) / log(128.0) * 8.0); if (lg > 15) lg = 15; b = lg; }
    if (rel > 0) b += 16;
    bias[hb * 132 + jj] = p.in[17][b * 12 + hb] * LOG2E;
  }
}

DI void phase_init(const Ctx& c) {
  const int tid = tid_(), lane = tid & 63;
  const int gw = blockIdx.x * 4 + (tid >> 6), nw = gridDim.x * 4;
  bf16_t* xb = wsb(c, OFF_XB);
  float* ss0 = ss_site(c, 0, 0);
  for (int row = gw; row < TC; row += nw) {
    float s = 0.f;
#pragma unroll
    for (int i = 0; i < 4; ++i) {
      const size_t gi = (size_t)row * DM + i * 256 + lane * 4;
      const f32x4 v = *(const f32x4*)(c.xin + gi);
      *(f32x4*)(c.x + gi) = v;
      u32x2 p; p.x = pk2(v[0], v[1]); p.y = pk2(v[2], v[3]);
      *(u32x2*)(xb + gi) = p;
      s += v[0] * v[0] + v[1] * v[1] + v[2] * v[2] + v[3] * v[3];
    }
#pragma unroll
    for (int o = 32; o >= 1; o >>= 1) s += __shfl_xor(s, o);
    if (lane == 0) ss0[row] = s;
  }
  const int gtid = blockIdx.x * NTHREADS + tid, gn = gridDim.x * NTHREADS;
  float* ssall = (float*)(c.ws + OFF_SS);
  for (int idx = gtid + TC; idx < 3 * 6 * TC; idx += gn) ssall[idx] = 0.f;
  bf16_t* peb = wsb(c, OFF_PEB);
  for (int idx = gtid; idx < 2 * TC * 64; idx += gn) {
    const int L = idx / (TC * 64), r = idx - L * (TC * 64);
    const f32x4 v = *(const f32x4*)(c.pe0 + (size_t)L * c.pe_ls + (size_t)r * 4);
    u32x2 p; p.x = pk2(v[0], v[1]); p.y = pk2(v[2], v[3]);
    *(u32x2*)(peb + (size_t)idx * 4) = p;
  }
}

#ifndef ONLY
#define ONLY -1
#endif
#define PH(n) (ONLY < 0 || ONLY == (n))
__global__ void __launch_bounds__(NTHREADS, 2) mega_kernel(Params p) {
  extern __shared__ __attribute__((aligned(16))) char lds[];
  cg::grid_group grid = cg::this_grid();
  if (PH(0)) phase_prologue(p, lds);
  grid.sync();
  for (int chunk = 0; chunk < 3; ++chunk) {
    Ctx c;
    c.p = &p; c.chunk = chunk; c.layer = 0; c.ws = p.ws; c.lds = lds;
    c.S = chunk == 0 ? 4096 : 16384; c.sshift = chunk == 0 ? 12 : 14;
    c.x = p.out + (size_t)chunk * TC * DM;
    c.xin = chunk == 0 ? p.in[0] : p.in[1] + (size_t)(chunk - 1) * TC * DM;
    c.pe0 = chunk == 0 ? p.in[2] : p.in[3] + (size_t)(chunk - 1) * TC * 256;
    c.pe_ls = chunk == 0 ? (size_t)TC * 256 : (size_t)2 * TC * 256;
    if (PH(1)) phase_init(c);
    grid.sync();
#pragma unroll 1
    for (int layer = 0; layer < 2; ++layer) {
      c.layer = layer;
      if (PH(2)) phase_ffn_in(c, W_FFN1_IN, 0);
      grid.sync();
      if (PH(3)) phase_resid_gemm(c, wsb(c, OFF_ACT), DFF, W_FFN1_OUT, 0.5f, ss_site(c, layer, 1));
      grid.sync();
      if (PH(4)) phase_proj(c);
      grid.sync();
      if (PH(5)) phase_mlaup(c);
      grid.sync();
      if (PH(6)) phase_attn(c);
      grid.sync();
      if (PH(7)) phase_combine(c);
      grid.sync();
      if (PH(8)) phase_merge(c);
      grid.sync();
      if (PH(9)) phase_resid_gemm(c, wsb(c, OFF_MRG), DM, W_OUT, 1.0f, ss_site(c, layer, 2));
      grid.sync();
      if (PH(10)) phase_ffn_in(c, W_FFN2_IN, 2);
      grid.sync();
      if (PH(11)) phase_resid_gemm(c, wsb(c, OFF_ACT), DFF, W_FFN2_OUT, 0.5f, ss_site(c, layer, 3));
      grid.sync();
      if (PH(12)) phase_ple(c);
      grid.sync();
    }
  }
}

extern "C" void kernel_launch(void* const* d_in, const int* in_sizes, int n_in, void* d_out, int out_size, void* d_ws, size_t ws_size, hipStream_t stream) {
  static int grid_blocks = 0;
  if (!grid_blocks) {
    int dev = 0, cus = 0, per_cu = 0;
    hipGetDevice(&dev);
    hipDeviceGetAttribute(&cus, hipDeviceAttributeMultiprocessorCount, dev);
    hipFuncSetAttribute((const void*)mega_kernel, hipFuncAttributeMaxDynamicSharedMemorySize, LDS_BYTES);
    hipOccupancyMaxActiveBlocksPerMultiprocessor(&per_cu, mega_kernel, NTHREADS, LDS_BYTES);
    if (per_cu > 2) per_cu = 2;
    if (per_cu < 1) per_cu = 1;
    grid_blocks = cus * per_cu;
  }
  Params p{};
  for (int i = 0; i < 32; ++i) p.in[i] = (const float*)d_in[i];
  p.out = (float*)d_out;
  p.ws = (char*)d_ws;
  void* args[] = {&p};
  hipError_t e = hipLaunchCooperativeKernel((const void*)mega_kernel, dim3(grid_blocks), dim3(NTHREADS), args, LDS_BYTES, stream);
  if (e != hipSuccess) fprintf(stderr, "cooperative launch failed: %s (grid %d)\n", hipGetErrorString(e), grid_blocks);
}
```

```cpp
#include <hip/hip_runtime.h>
#include <hip/hip_cooperative_groups.h>
#include <stdint.h>
#include <cstdio>
namespace cg = cooperative_groups;

typedef unsigned short bf16_t;
typedef short bf16x8 __attribute__((ext_vector_type(8)));
typedef float f32x16 __attribute__((ext_vector_type(16)));
typedef float f32x4 __attribute__((ext_vector_type(4)));
typedef float f32x2 __attribute__((ext_vector_type(2)));
typedef unsigned u32x4 __attribute__((ext_vector_type(4)));
typedef unsigned u32x2 __attribute__((ext_vector_type(2)));
typedef __bf16 bf16x2_t __attribute__((ext_vector_type(2)));
#define DI __device__ __forceinline__
#define MFMA(a, b, c) __builtin_amdgcn_mfma_f32_32x32x16_bf16((a), (b), (c), 0, 0, 0)

constexpr int TC = 16384;
constexpr int DM = 1024;
constexpr int DFF = 2816;
constexpr float EPS = 1e-6f;
constexpr float LOG2E = 1.4426950408889634f;
constexpr float LN2 = 0.6931471805599453f;
constexpr int NTHREADS = 256;

constexpr size_t W_FFN1_IN = 0;
constexpr size_t W_FFN1_OUT = W_FFN1_IN + (size_t)5632 * 1024;
constexpr size_t W_IN = W_FFN1_OUT + (size_t)1024 * 2816;
constexpr size_t W_GATE = W_IN + (size_t)3584 * 1024;
constexpr size_t W_UQ = W_GATE + (size_t)3072 * 1024;
constexpr size_t W_UKV = W_UQ + (size_t)768 * 256;
constexpr size_t W_OA = W_UKV + (size_t)1024 * 128;
constexpr size_t W_OB = W_OA + (size_t)1024 * 512;
constexpr size_t W_OC = W_OB + (size_t)1024 * 256;
constexpr size_t W_OUT = W_OC + (size_t)1024 * 512;
constexpr size_t W_FFN2_IN = W_OUT + (size_t)1024 * 1024;
constexpr size_t W_FFN2_OUT = W_FFN2_IN + (size_t)5632 * 1024;
constexpr size_t W_PG = W_FFN2_OUT + (size_t)1024 * 2816;
constexpr size_t W_PLE = W_PG + (size_t)1024 * 1024;
constexpr size_t W_LAYER = W_PLE + (size_t)1024 * 256;

constexpr size_t AL(size_t x) { return (x + 255) & ~(size_t)255; }
constexpr size_t OFF_W = 0;
constexpr size_t OFF_BAR = AL(OFF_W + 2 * W_LAYER * 2);
constexpr size_t OFF_ROPE = AL(OFF_BAR + 16384);
constexpr size_t OFF_BIAS = AL(OFF_ROPE + (size_t)16384 * 16 * 8);
constexpr size_t OFF_SS = AL(OFF_BIAS + 12 * 132 * 4);
constexpr size_t OFF_XB = AL(OFF_SS + (size_t)3 * 6 * TC * 4);
constexpr size_t OFF_PEB = AL(OFF_XB + (size_t)TC * 1024 * 2);
constexpr size_t OFF_BIG = AL(OFF_PEB + (size_t)2 * TC * 256 * 2);
constexpr size_t OFF_ACT = OFF_BIG;
constexpr size_t OFF_CQ = OFF_BIG;
constexpr size_t OFF_CKV = AL(OFF_CQ + (size_t)TC * 256 * 2);
constexpr size_t OFF_QA = AL(OFF_CKV + (size_t)TC * 128 * 2);
constexpr size_t OFF_KA = AL(OFF_QA + (size_t)TC * 768 * 2);
constexpr size_t OFF_VTA = AL(OFF_KA + (size_t)TC * 768 * 2);
constexpr size_t OFF_QB = AL(OFF_VTA + (size_t)TC * 512 * 2);
constexpr size_t OFF_KB = AL(OFF_QB + (size_t)TC * 768 * 2);
constexpr size_t OFF_VTB = AL(OFF_KB + (size_t)TC * 768 * 2);
constexpr size_t OFF_QC = AL(OFF_VTB + (size_t)TC * 768 * 2);
constexpr size_t OFF_KC = AL(OFF_QC + (size_t)TC * 512 * 2);
constexpr size_t OFF_VTC = AL(OFF_KC + (size_t)TC * 128 * 2);
constexpr size_t OFF_OA = AL(OFF_VTC + (size_t)TC * 128 * 2);
constexpr size_t OFF_OBG = AL(OFF_OA + (size_t)TC * 512 * 2);
constexpr size_t OFF_LSE = AL(OFF_OBG + (size_t)TC * 768 * 2);
constexpr size_t OFF_OB = AL(OFF_LSE + (size_t)TC * 12 * 4);
constexpr size_t OFF_OC = AL(OFF_OB + (size_t)TC * 256 * 2);
constexpr size_t OFF_MRG = AL(OFF_OC + (size_t)TC * 512 * 2);
constexpr size_t OFF_END = AL(OFF_MRG + (size_t)TC * 1024 * 2);
static_assert(OFF_END < (size_t)500 * 1024 * 1024, "workspace too large");
static_assert(OFF_ACT + (size_t)TC * DFF * 2 <= OFF_END, "act fits");

struct Params {
  const float* in[32];
  float* out;
  char* ws;
};

constexpr int LROW = 144;
constexpr int STAGE_OP = 128 * LROW;
constexpr int STAGE = 2 * STAGE_OP;
constexpr int CLD = 132;
constexpr int OFF_RR = 2 * STAGE;
constexpr int LDS_BYTES = 2 * STAGE + 1024;
static_assert(128 * CLD * 4 <= OFF_RR, "lds");

DI int tid_() { int t = threadIdx.x; asm volatile("" : "+v"(t)); return t; }
DI unsigned pk2(float a, float b) { f32x2 v = {a, b}; bf16x2_t r = __builtin_convertvector(v, bf16x2_t); return __builtin_bit_cast(unsigned, r); }
DI bf16_t f2bf(float a) { return (bf16_t)(pk2(a, 0.f) & 0xffffu); }
DI float bf2f(bf16_t v) { return __uint_as_float(((unsigned)v) << 16); }
DI float sigmoidf_(float x) { return 1.0f / (1.0f + __expf(-x)); }

DI int map_col(int map, int n) {
  switch (map) {
    case 0: return n;
    case 1: { int t = n >> 7, w = n & 127; return w < 64 ? t * 64 + w : DFF + t * 64 + (w - 64); }
    case 2: { int slot = n >> 6, d = n & 63; if (slot < 6) return n; if (slot == 6) return d < 32 ? 384 + d : -1; if (slot < 55) return 416 + (n - 448); return -1; }
    case 3: { if (n < 512) return (n >> 6) * 96 + (n & 63); int i = n - 512; return (i >> 5) * 96 + 64 + (i & 31); }
    default: { if (n < 512) return (n >> 6) * 128 + (n & 63); int i = n - 512; return (i >> 6) * 128 + 64 + (i & 63); }
  }
}

DI void transpose_mat(const float* __restrict__ src, int ld_src, bf16_t* __restrict__ dst, int N, int K, const float* __restrict__ gain, int map, float* lds, int rot) {
  const int ntk = K >> 6, ntn = N >> 6, nt = ntk * ntn;
  const int tid = tid_(), c = tid & 63, rq = tid >> 6;
  int b0 = (int)blockIdx.x - (rot % (int)gridDim.x); if (b0 < 0) b0 += gridDim.x;
  for (int t = b0; t < nt; t += gridDim.x) {
    const int tn = t / ntk, tk = t - tn * ntk;
    const int n0 = tn << 6, k0 = tk << 6;
    const int sc = map_col(map, n0 + c);
#pragma unroll 4
    for (int r = 0; r < 16; ++r) {
      const int kk = r * 4 + rq;
      float v = 0.f;
      if (sc >= 0) { v = src[(size_t)(k0 + kk) * ld_src + sc]; if (gain) v *= gain[k0 + kk]; }
      lds[c * 65 + kk] = v;
    }
    __syncthreads();
#pragma unroll 4
    for (int r = 0; r < 16; ++r) {
      const int nn = r * 4 + rq;
      dst[(size_t)(n0 + nn) * K + k0 + c] = f2bf(lds[nn * 65 + c]);
    }
    __syncthreads();
  }
}

template <int NJ> DI void zero_acc(f32x16 (&acc)[2][NJ]) {
#pragma unroll
  for (int i = 0; i < 2; ++i)
#pragma unroll
    for (int j = 0; j < NJ; ++j)
#pragma unroll
      for (int r = 0; r < 16; ++r) acc[i][j][r] = 0.f;
}

template <int NJ> DI void gemm_mainloop(const bf16_t* __restrict__ A, int lda, const bf16_t* __restrict__ Bt, int ldb, int K, f32x16 (&acc)[2][NJ], char* lds) {
  const int tid = tid_(), lane = tid & 63, w = tid >> 6, wm = w >> 1, wn = w & 1;
  const int lr = tid >> 3, lc = tid & 7;
  const bf16_t* ap = A + (size_t)lr * lda + lc * 8;
  const bf16_t* bp = Bt + (size_t)lr * ldb + lc * 8;
  const size_t astep = (size_t)32 * lda, bstep = (size_t)32 * ldb;
  constexpr int NB = 2 * NJ;
  u32x4 ra[4], rb[NB];
#pragma unroll
  for (int i = 0; i < 4; ++i) ra[i] = *(const u32x4*)(ap + i * astep);
#pragma unroll
  for (int i = 0; i < NB; ++i) rb[i] = *(const u32x4*)(bp + i * bstep);
  const int wofs = lr * LROW + lc * 16;
#pragma unroll
  for (int i = 0; i < 4; ++i) *(u32x4*)(lds + wofs + i * 32 * LROW) = ra[i];
#pragma unroll
  for (int i = 0; i < NB; ++i) *(u32x4*)(lds + STAGE_OP + wofs + i * 32 * LROW) = rb[i];
  __syncthreads();
  const int nk = K >> 6;
  const int a_rd = (wm * 64 + (lane & 31)) * LROW + (lane >> 5) * 16;
  const int b_rd = STAGE_OP + (wn * 32 * NJ + (lane & 31)) * LROW + (lane >> 5) * 16;
  for (int kt = 0; kt < nk; ++kt) {
    const char* st = lds + (kt & 1) * STAGE;
    const bool more = (kt + 1 < nk);
    if (more) {
      ap += 64; bp += 64;
#pragma unroll
      for (int i = 0; i < 4; ++i) ra[i] = *(const u32x4*)(ap + i * astep);
#pragma unroll
      for (int i = 0; i < NB; ++i) rb[i] = *(const u32x4*)(bp + i * bstep);
    }
#pragma unroll
    for (int ks = 0; ks < 4; ++ks) {
      const bf16x8 a0 = *(const bf16x8*)(st + a_rd + ks * 32);
      const bf16x8 a1 = *(const bf16x8*)(st + a_rd + 32 * LROW + ks * 32);
#pragma unroll
      for (int j = 0; j < NJ; ++j) {
        const bf16x8 b = *(const bf16x8*)(st + b_rd + j * 32 * LROW + ks * 32);
        acc[0][j] = MFMA(a0, b, acc[0][j]);
        acc[1][j] = MFMA(a1, b, acc[1][j]);
      }
    }
    if (more) {
      char* sn = lds + ((kt + 1) & 1) * STAGE;
#pragma unroll
      for (int i = 0; i < 4; ++i) *(u32x4*)(sn + wofs + i * 32 * LROW) = ra[i];
#pragma unroll
      for (int i = 0; i < NB; ++i) *(u32x4*)(sn + STAGE_OP + wofs + i * 32 * LROW) = rb[i];
    }
    __syncthreads();
  }
}

template <int NJ> DI void acc_to_lds(const f32x16 (&acc)[2][NJ], float* cl) {
  const int tid = tid_(), lane = tid & 63, w = tid >> 6, wm = w >> 1, wn = w & 1, h = lane >> 5, c = lane & 31;
#pragma unroll
  for (int i = 0; i < 2; ++i)
#pragma unroll
    for (int j = 0; j < NJ; ++j)
#pragma unroll
      for (int r = 0; r < 16; ++r) {
        const int row = wm * 64 + i * 32 + (r & 3) + 8 * (r >> 2) + 4 * h;
        cl[row * CLD + wn * 32 * NJ + j * 32 + c] = acc[i][j][r];
      }
}

DI void resid_epilogue(float* __restrict__ x, bf16_t* __restrict__ xb, float* __restrict__ ssn, int mt, int nt, const float* cl, float scale) {
  const int tid = tid_(), c4 = (tid & 31) * 4, r0 = tid >> 5;
#pragma unroll 4
  for (int it = 0; it < 16; ++it) {
    const int row = r0 + 8 * it;
    const f32x4 c = *(const f32x4*)(cl + row * CLD + c4);
    const size_t gi = (size_t)(mt * 128 + row) * DM + nt * 128 + c4;
    f32x4 xv = *(const f32x4*)(x + gi);
    xv = xv + scale * c;
    *(f32x4*)(x + gi) = xv;
    u32x2 p; p.x = pk2(xv[0], xv[1]); p.y = pk2(xv[2], xv[3]);
    *(u32x2*)(xb + gi) = p;
    float s = xv[0] * xv[0] + xv[1] * xv[1] + xv[2] * xv[2] + xv[3] * xv[3];
    s += __shfl_xor(s, 16); s += __shfl_xor(s, 8); s += __shfl_xor(s, 4); s += __shfl_xor(s, 2); s += __shfl_xor(s, 1);
    if ((tid & 31) == 0) atomicAdd(ssn + mt * 128 + row, s);
  }
}

#define XB_TMO      128
#define XB_XCNT(j)  (256  + 64 * (j))
#define XB_XSUB(j)  (1280 + 64 * (j))
#define XB_XGEN(j)  (2304 + 64 * (j))
#define XB_TOP      3328
#define XB_TOPGEN   3392
#define XCD_BAR_WORDS 3456
#define XB_SPIN_CAP (1u << 22)
#define LAS __attribute__((address_space(3)))
DI unsigned xb_ld(unsigned* p)              { return __hip_atomic_load(p, __ATOMIC_RELAXED, __HIP_MEMORY_SCOPE_AGENT); }
DI unsigned xb_add(unsigned* p, unsigned v) { return __hip_atomic_fetch_add(p, v, __ATOMIC_RELAXED, __HIP_MEMORY_SCOPE_AGENT); }
DI unsigned xb_xcc_id() { return (unsigned)__builtin_amdgcn_s_getreg((3 << 11) | 20) & 0xFu; }
#define XB_SPIN(cond, bar) do { unsigned _sp = 0; while (cond) { __builtin_amdgcn_s_sleep(1); \
    if ((++_sp & 255u) == 0u) { if (xb_ld(&(bar)[XB_TMO])) break; if (_sp > XB_SPIN_CAP) { atomicAdd(&(bar)[XB_TMO], 1u); break; } } } } while (0)
struct XcdBarrier { unsigned* bar; unsigned x; volatile LAS unsigned* st; };
DI XcdBarrier xcd_barrier_post(unsigned* bar, volatile LAS unsigned* st) {
  XcdBarrier b; b.bar = bar; b.x = xb_xcc_id(); b.st = st;
  if (threadIdx.x == 0) (void)xb_add(&bar[XB_XCNT(b.x)], 1u);
  return b;
}
DI void xcd_barrier_complete(unsigned* bar, unsigned x, unsigned& nloc, unsigned& nx) {
  const unsigned G = gridDim.x * gridDim.y * gridDim.z;
  unsigned sum, cnt, mine, sp = 0u;
  for (;;) {
    sum = 0u; cnt = 0u; mine = 0u;
#pragma unroll
    for (unsigned j = 0; j < 16; ++j) { const unsigned c = xb_ld(&bar[XB_XCNT(j)]); sum += c; cnt += (c > 0u) ? 1u : 0u; mine = (j == x) ? c : mine; }
    if (sum == G) break;
    __builtin_amdgcn_s_sleep(1);
    if ((++sp & 255u) == 0u) { if (xb_ld(&bar[XB_TMO])) break; if (sp > XB_SPIN_CAP) { atomicAdd(&bar[XB_TMO], 1u); break; } }
  }
  nloc = mine > 0u ? mine : 1u; nx = cnt > 0u ? cnt : 1u;
}
DI void xcd_barrier(const XcdBarrier& b) {
  asm volatile("s_waitcnt vmcnt(0)" ::: "memory");
  __syncthreads();
  if (threadIdx.x == 0) {
    unsigned* bar = b.bar;
    __builtin_amdgcn_s_waitcnt(0);
    unsigned nloc = b.st[0], nx = b.st[1];
    if (nloc == 0u) { xcd_barrier_complete(bar, b.x, nloc, nx); b.st[0] = nloc; b.st[1] = nx; }
    const unsigned old = xb_add(&bar[XB_XSUB(b.x)], 1u);
    const unsigned gen = old / nloc;
    if (old + 1u == (gen + 1u) * nloc) {
      __builtin_amdgcn_fence(__ATOMIC_RELEASE, "agent");
      asm volatile("s_waitcnt vmcnt(0)" ::: "memory");
      const unsigned og = xb_add(&bar[XB_TOP], 1u);
      const unsigned tg = og / nx;
      if (og + 1u == (tg + 1u) * nx) xb_add(&bar[XB_TOPGEN], 1u);
      else XB_SPIN(xb_ld(&bar[XB_TOPGEN]) == tg, bar);
      __builtin_amdgcn_fence(__ATOMIC_ACQUIRE, "agent");
      xb_add(&bar[XB_XGEN(b.x)], 1u);
      asm volatile("s_waitcnt vmcnt(0)" ::: "memory");
    } else {
      XB_SPIN(xb_ld(&bar[XB_XGEN(b.x)]) == gen, bar);
      __builtin_amdgcn_fence(__ATOMIC_ACQUIRE, "agent");
      asm volatile("s_waitcnt vmcnt(0)" ::: "memory");
    }
  }
  __syncthreads();
}

struct Ctx {
  const Params* p;
  int chunk, layer;
  int S, sshift;
  float* x;
  const float* xin;
  const float* pe0; size_t pe_ls;
  char* ws;
  char* lds;
};
DI bf16_t* wsb(const Ctx& c, size_t off) { return (bf16_t*)(c.ws + off); }
DI float* ss_site(const Ctx& c, int layer, int site) { return (float*)(c.ws + OFF_SS) + ((size_t)layer * 6 + site) * TC; }
DI const bf16_t* wgt(const Ctx& c, size_t off) { return (const bf16_t*)(c.ws + OFF_W) + (size_t)c.layer * W_LAYER + off; }
DI const float* inl(const Ctx& c, int idx, size_t per_layer) { return c.p->in[idx] + (size_t)c.layer * per_layer; }

DI void phase_ffn_in(const Ctx& c, size_t woff, int site) {
  const bf16_t* A = wsb(c, OFF_XB);
  const bf16_t* Bt = wgt(c, woff);
  bf16_t* act = wsb(c, OFF_ACT);
  const float* ss = ss_site(c, c.layer, site);
  float* cl = (float*)c.lds; float* rr = (float*)(c.lds + OFF_RR);
  const int tid = tid_();
  for (int t = blockIdx.x; t < 128 * 44; t += gridDim.x) {
    const int mt = t / 44, nt = t - mt * 44;
    f32x16 acc[2][2]; zero_acc<2>(acc);
    gemm_mainloop<2>(A + (size_t)mt * 128 * DM, DM, Bt + (size_t)nt * 128 * DM, DM, DM, acc, c.lds);
    acc_to_lds<2>(acc, cl);
    if (tid < 128) rr[tid] = rsqrtf(ss[mt * 128 + tid] * (1.0f / DM) + EPS);
    __syncthreads();
    const int c4 = (tid & 15) * 4, r0 = tid >> 4;
#pragma unroll 2
    for (int it = 0; it < 8; ++it) {
      const int row = r0 + 16 * it;
      const float r = rr[row];
      const f32x4 a = *(const f32x4*)(cl + row * CLD + c4);
      const f32x4 b = *(const f32x4*)(cl + row * CLD + 64 + c4);
      float o[4];
#pragma unroll
      for (int e = 0; e < 4; ++e) { const float av = a[e] * r, bv = b[e] * r; o[e] = av * sigmoidf_(av) * bv; }
      u32x2 pq; pq.x = pk2(o[0], o[1]); pq.y = pk2(o[2], o[3]);
      *(u32x2*)(act + (size_t)(mt * 128 + row) * DFF + nt * 64 + c4) = pq;
    }
    __syncthreads();
  }
}

DI void phase_resid_gemm(const Ctx& c, const bf16_t* A, int K, size_t woff, float scale, float* ssn) {
  const bf16_t* Bt = wgt(c, woff);
  bf16_t* xb = wsb(c, OFF_XB);
  float* cl = (float*)c.lds;
  for (int t = blockIdx.x; t < 128 * 8; t += gridDim.x) {
    const int mt = t >> 3, nt = t & 7;
    f32x16 acc[2][2]; zero_acc<2>(acc);
    gemm_mainloop<2>(A + (size_t)mt * 128 * K, K, Bt + (size_t)nt * 128 * K, K, K, acc, c.lds);
    acc_to_lds<2>(acc, cl);
    __syncthreads();
    resid_epilogue(c.x, xb, ssn, mt, nt, cl, scale);
    __syncthreads();
  }
}

DI void load_slot(const float* cl, int row, int col0, float (&v)[64]) {
#pragma unroll
  for (int q = 0; q < 16; ++q) { const f32x4 t = *(const f32x4*)(cl + row * CLD + col0 + q * 4); v[4 * q] = t[0]; v[4 * q + 1] = t[1]; v[4 * q + 2] = t[2]; v[4 * q + 3] = t[3]; }
}
template <int N> DI void store_bf16(bf16_t* dst, const float* v) {
#pragma unroll
  for (int q = 0; q < N / 8; ++q) { u32x4 p; p.x = pk2(v[8 * q], v[8 * q + 1]); p.y = pk2(v[8 * q + 2], v[8 * q + 3]); p.z = pk2(v[8 * q + 4], v[8 * q + 5]); p.w = pk2(v[8 * q + 6], v[8 * q + 7]); *(u32x4*)(dst + 8 * q) = p; }
}
template <int N> DI void rmsnorm_inplace(float* v, const float* __restrict__ g) {
  float s = 0.f;
#pragma unroll
  for (int i = 0; i < N; ++i) s += v[i] * v[i];
  const float r = rsqrtf(s * (1.0f / N) + EPS);
#pragma unroll
  for (int i = 0; i < N; ++i) v[i] = v[i] * r * g[i];
}
DI void rope32(float* v, const f32x2* __restrict__ tab  ) {
#pragma unroll
  for (int i = 0; i < 16; ++i) { const f32x2 cs = tab[i]; const float x1 = v[i], x2 = v[i + 16]; v[i] = x1 * cs.x - x2 * cs.y; v[i + 16] = x1 * cs.y + x2 * cs.x; }
}
DI void vt_write(const float* cl, const float* rr, int col0, int u, bf16_t* dst_row  , int dsh, int L, int pos0) {
  const int d = u & 63, th = u >> 6;
  float v[64];
#pragma unroll
  for (int i = 0; i < 64; ++i) v[i] = cl[(th * 64 + i) * CLD + col0 + d] * rr[th * 64 + i];
  const int p0 = pos0 + th * 64;
  if (dsh == 0) {
    store_bf16<64>(dst_row + p0, v);
  } else if (dsh == 2) {
#pragma unroll
    for (int rr_ = 0; rr_ < 4; ++rr_) {
      float t[16];
#pragma unroll
      for (int a = 0; a < 16; ++a) t[a] = v[4 * a + rr_];
      store_bf16<16>(dst_row + rr_ * L + (p0 >> 2), t);
    }
  } else {
#pragma unroll
    for (int rr_ = 0; rr_ < 16; ++rr_) {
      u32x2 p; p.x = pk2(v[rr_], v[16 + rr_]); p.y = pk2(v[32 + rr_], v[48 + rr_]);
      *(u32x2*)(dst_row + rr_ * L + (p0 >> 4)) = p;
    }
  }
}

DI void phase_proj(const Ctx& c) {
  const bf16_t* A = wsb(c, OFF_XB);
  const bf16_t* Bt = wgt(c, W_IN);
  const float* ss = ss_site(c, c.layer, 1);
  float* ss_cq = ss_site(c, c.layer, 4);
  float* ss_ckv = ss_site(c, c.layer, 5);
  float* cl = (float*)c.lds; float* rr = (float*)(c.lds + OFF_RR);
  const f32x2* rope = (const f32x2*)(c.ws + OFF_ROPE);
  const int tid = tid_(), half = tid >> 7, u = tid & 127;
  const int S = c.S, sshift = c.sshift;
  for (int t = blockIdx.x; t < 128 * 28; t += gridDim.x) {
    const int mt = t / 28, nt = t - mt * 28;
    f32x16 acc[2][2]; zero_acc<2>(acc);
    gemm_mainloop<2>(A + (size_t)mt * 128 * DM, DM, Bt + (size_t)nt * 128 * DM, DM, DM, acc, c.lds);
    acc_to_lds<2>(acc, cl);
    if (tid < 128) rr[tid] = rsqrtf(ss[mt * 128 + tid] * (1.0f / DM) + EPS);
    __syncthreads();
    const int slot = nt * 2 + half, col0 = half * 64;
    const int tl0 = mt * 128, seq = tl0 >> sshift, pos0 = tl0 & (S - 1);
    const bool is_vb = (slot >= 31 && slot < 43), is_vc = (slot == 53 || slot == 54);
    if (is_vb) {
      const int hb = slot - 31, dsh = 2 * (hb >> 2);
      bf16_t* dst = wsb(c, OFF_VTB) + ((size_t)(seq * 12 + hb) * 64 + (u & 63)) * S;
      vt_write(cl, rr, col0, u, dst, dsh, S >> dsh, pos0);
    } else if (is_vc) {
      const int hv = slot - 53;
      bf16_t* dst = wsb(c, OFF_VTC) + ((size_t)(seq * 2 + hv) * 64 + (u & 63)) * S;
      vt_write(cl, rr, col0, u, dst, 0, S, pos0);
    } else if (slot < 55) {
      const int row = u, tl = tl0 + row, pos = pos0 + row;
      const float r = rr[row];
      float v[64];
      load_slot(cl, row, col0, v);
#pragma unroll
      for (int i = 0; i < 64; ++i) v[i] *= r;
      if (slot < 6) {
        float s = 0.f;
#pragma unroll
        for (int i = 0; i < 64; ++i) s += v[i] * v[i];
        if (slot < 4) { store_bf16<64>(wsb(c, OFF_CQ) + (size_t)tl * 256 + slot * 64, v); atomicAdd(ss_cq + tl, s); }
        else { store_bf16<64>(wsb(c, OFF_CKV) + (size_t)tl * 128 + (slot - 4) * 64, v); atomicAdd(ss_ckv + tl, s); }
      } else if (slot == 6) {
        rmsnorm_inplace<32>(v, inl(c, 14, 96) + 64);
        rope32(v, rope + (size_t)pos * 16);
        bf16_t* dst = wsb(c, OFF_KA) + ((size_t)(seq * 8) * S + pos) * 96 + 64;
#pragma unroll
        for (int hh = 0; hh < 8; ++hh) store_bf16<32>(dst + (size_t)hh * S * 96, v);
      } else if (slot < 31) {
        const bool isq = slot < 19;
        const int hb = isq ? slot - 7 : slot - 19, dsh = 2 * (hb >> 2), L = S >> dsh;
        rmsnorm_inplace<64>(v, inl(c, isq ? 15 : 16, 64));
        const int srow = (pos & ((1 << dsh) - 1)) * L + (pos >> dsh);
        bf16_t* dst = wsb(c, isq ? OFF_QB : OFF_KB) + ((size_t)(seq * 12 + hb) * S + srow) * 64;
        store_bf16<64>(dst, v);
      } else {
        const bool isq = slot < 51;
        rmsnorm_inplace<64>(v, inl(c, isq ? 18 : 19, 64));
        rope32(v, rope + (size_t)(pos >> 6) * 16);
        rope32(v + 32, rope + (size_t)(pos & 63) * 16);
        bf16_t* dst = isq ? wsb(c, OFF_QC) + ((size_t)(seq * 8 + (slot - 43)) * S + pos) * 64
                          : wsb(c, OFF_KC) + ((size_t)(seq * 2 + (slot - 51)) * S + pos) * 64;
        store_bf16<64>(dst, v);
      }
    }
    __syncthreads();
  }
}

DI void phase_mlaup(const Ctx& c) {
  const float* ss_cq = ss_site(c, c.layer, 4);
  const float* ss_ckv = ss_site(c, c.layer, 5);
  float* cl = (float*)c.lds; float* rr = (float*)(c.lds + OFF_RR);
  const f32x2* rope = (const f32x2*)(c.ws + OFF_ROPE);
  const int tid = tid_(), half = tid >> 7, u = tid & 127;
  const int S = c.S, sshift = c.sshift;
  for (int t = blockIdx.x; t < 128 * 14; t += gridDim.x) {
    const int mt = t / 14, nt = t - mt * 14;
    const bool isq = nt < 6;
    f32x16 acc[2][2]; zero_acc<2>(acc);
    if (isq) gemm_mainloop<2>(wsb(c, OFF_CQ) + (size_t)mt * 128 * 256, 256, wgt(c, W_UQ) + (size_t)nt * 128 * 256, 256, 256, acc, c.lds);
    else gemm_mainloop<2>(wsb(c, OFF_CKV) + (size_t)mt * 128 * 128, 128, wgt(c, W_UKV) + (size_t)(nt - 6) * 128 * 128, 128, 128, acc, c.lds);
    acc_to_lds<2>(acc, cl);
    if (tid < 128) rr[tid] = isq ? rsqrtf(ss_cq[mt * 128 + tid] * (1.0f / 256) + EPS) : rsqrtf(ss_ckv[mt * 128 + tid] * (1.0f / 128) + EPS);
    __syncthreads();
    const int col0 = half * 64;
    const int tl0 = mt * 128, seq = tl0 >> sshift, pos0 = tl0 & (S - 1);
    if (!isq && nt >= 10) {
      const int hv = (nt - 10) * 2 + half;
      bf16_t* dst = wsb(c, OFF_VTA) + ((size_t)(seq * 8 + hv) * 64 + (u & 63)) * S;
      vt_write(cl, rr, col0, u, dst, 0, S, pos0);
    } else {
      const int row = u, pos = pos0 + row;
      const float r = rr[row];
      float v[64];
      load_slot(cl, row, col0, v);
#pragma unroll
      for (int i = 0; i < 64; ++i) v[i] *= r;
      if (isq && nt < 4) {
        const int hh = nt * 2 + half;
        rmsnorm_inplace<64>(v, inl(c, 13, 96));
        store_bf16<64>(wsb(c, OFF_QA) + ((size_t)(seq * 8 + hh) * S + pos) * 96, v);
      } else if (isq) {
        const int h0 = ((nt - 4) * 2 + half) * 2;
        rmsnorm_inplace<32>(v, inl(c, 13, 96) + 64);
        rmsnorm_inplace<32>(v + 32, inl(c, 13, 96) + 64);
        rope32(v, rope + (size_t)pos * 16);
        rope32(v + 32, rope + (size_t)pos * 16);
        store_bf16<32>(wsb(c, OFF_QA) + ((size_t)(seq * 8 + h0) * S + pos) * 96 + 64, v);
        store_bf16<32>(wsb(c, OFF_QA) + ((size_t)(seq * 8 + h0 + 1) * S + pos) * 96 + 64, v + 32);
      } else {
        const int hh = (nt - 6) * 2 + half;
        rmsnorm_inplace<64>(v, inl(c, 14, 96));
        store_bf16<64>(wsb(c, OFF_KA) + ((size_t)(seq * 8 + hh) * S + pos) * 96, v);
      }
    }
    __syncthreads();
  }
}

template <int DQK, bool BAND, int QT>
DI void attn_item(const bf16_t* __restrict__ Q, const bf16_t* __restrict__ Kp, const bf16_t* __restrict__ Vt, int ldv,
                  int kbeg, int kend, int q0, const float* bias_g, float scale_log2,
                  bf16_t* __restrict__ out, size_t out_rs, float* __restrict__ lse, int lse_rs, char* lds) {
  constexpr int KROW = DQK * 2 + 16;
  constexpr int KST = 64 * KROW, VST = 64 * LROW, ST = KST + VST;
  constexpr int NKS = DQK / 16;
  constexpr int KV4 = DQK / 8;
  constexpr int NKL = (64 * KV4) / 256;
  constexpr int WQ = 32 * QT;
  const int tid = tid_(), lane = tid & 63, w = tid >> 6, h = lane >> 5, ql = lane & 31;
  float* bias_l = (float*)(lds + 2 * ST);
  if (BAND) { if (tid < 129) bias_l[tid] = bias_g[tid]; }
  bf16x8 qf[QT][NKS];
#pragma unroll
  for (int qt = 0; qt < QT; ++qt)
#pragma unroll
    for (int ks = 0; ks < NKS; ++ks) qf[qt][ks] = *(const bf16x8*)(Q + (size_t)(w * WQ + qt * 32 + ql) * DQK + ks * 16 + h * 8);
  f32x16 o[2][QT];
#pragma unroll
  for (int a = 0; a < 2; ++a)
#pragma unroll
    for (int b = 0; b < QT; ++b)
#pragma unroll
      for (int r = 0; r < 16; ++r) o[a][b][r] = 0.f;
  float m[QT], l[QT];
#pragma unroll
  for (int qt = 0; qt < QT; ++qt) { m[qt] = -1e30f; l[qt] = 0.f; }
  u32x4 rk[NKL], rv[2];
  const int vrow0 = tid >> 3, vch = tid & 7;
  auto gload = [&](int kt) {
#pragma unroll
    for (int i = 0; i < NKL; ++i) { const int idx = tid + i * 256, kr = idx / KV4, kc = idx - kr * KV4; rk[i] = *(const u32x4*)(Kp + (size_t)(kt + kr) * DQK + kc * 8); }
#pragma unroll
    for (int i = 0; i < 2; ++i) rv[i] = *(const u32x4*)(Vt + (size_t)(vrow0 + 32 * i) * ldv + kt + vch * 8);
  };
  auto lstore = [&](char* st) {
#pragma unroll
    for (int i = 0; i < NKL; ++i) { const int idx = tid + i * 256, kr = idx / KV4, kc = idx - kr * KV4; *(u32x4*)(st + kr * KROW + kc * 16) = rk[i]; }
#pragma unroll
    for (int i = 0; i < 2; ++i) *(u32x4*)(st + KST + (vrow0 + 32 * i) * LROW + vch * 16) = rv[i];
  };
  gload(kbeg);
  lstore(lds);
  __syncthreads();
  const int pr = (ql & ~12) | ((ql & 4) << 1) | ((ql & 8) >> 1);
  const int k_rd = pr * KROW + h * 16;
  const int v_rd = KST + ql * LROW + h * 16;
  const int qw0 = q0 + w * WQ;
  int it = 0;
  for (int kt = kbeg; kt < kend; kt += 64, ++it) {
    const char* st = lds + (it & 1) * ST;
    const bool more = (kt + 64 < kend);
    if (more) gload(kt + 64);
    bool need = true;
    if (BAND) need = (kt + 63 >= qw0 - 64) && (kt <= qw0 + WQ - 1 + 64);
    if (need) {
      f32x16 s[2][QT];
#pragma unroll
      for (int a = 0; a < 2; ++a)
#pragma unroll
        for (int b = 0; b < QT; ++b)
#pragma unroll
          for (int r = 0; r < 16; ++r) s[a][b][r] = 0.f;
#pragma unroll
      for (int ks = 0; ks < NKS; ++ks) {
        const bf16x8 k0 = *(const bf16x8*)(st + k_rd + ks * 32);
        const bf16x8 k1 = *(const bf16x8*)(st + k_rd + 32 * KROW + ks * 32);
#pragma unroll
        for (int qt = 0; qt < QT; ++qt) {
          s[0][qt] = MFMA(k0, qf[qt][ks], s[0][qt]);
          s[1][qt] = MFMA(k1, qf[qt][ks], s[1][qt]);
        }
      }
      bf16x8 pf[QT][4];
#pragma unroll
      for (int qt = 0; qt < QT; ++qt) {
        float mx = -1e30f;
#pragma unroll
        for (int a = 0; a < 2; ++a)
#pragma unroll
          for (int r = 0; r < 16; ++r) {
            float v = s[a][qt][r] * scale_log2;
            if (BAND) {
              const int kidx = kt + 32 * a + (r & 7) + 8 * h + 16 * (r >> 3);
              const int rel = kidx - (qw0 + qt * 32 + ql);
              const bool ok = (rel >= -64) && (rel <= 64);
              const int bi = ok ? rel + 64 : 0;
              v = ok ? v + bias_l[bi] : -1e30f;
            }
            s[a][qt][r] = v;
            mx = fmaxf(mx, v);
          }
        mx = fmaxf(mx, __shfl_xor(mx, 32));
        const float mn = fmaxf(m[qt], mx);
        const float alpha = __builtin_amdgcn_exp2f(m[qt] - mn);
        m[qt] = mn;
        float ls = 0.f;
#pragma unroll
        for (int a = 0; a < 2; ++a) {
#pragma unroll
          for (int r = 0; r < 16; ++r) { const float pv = __builtin_amdgcn_exp2f(s[a][qt][r] - mn); s[a][qt][r] = pv; ls += pv; }
#pragma unroll
          for (int s2 = 0; s2 < 2; ++s2) {
            u32x4 pk;
            pk.x = pk2(s[a][qt][8 * s2 + 0], s[a][qt][8 * s2 + 1]);
            pk.y = pk2(s[a][qt][8 * s2 + 2], s[a][qt][8 * s2 + 3]);
            pk.z = pk2(s[a][qt][8 * s2 + 4], s[a][qt][8 * s2 + 5]);
            pk.w = pk2(s[a][qt][8 * s2 + 6], s[a][qt][8 * s2 + 7]);
            pf[qt][a * 2 + s2] = __builtin_bit_cast(bf16x8, pk);
          }
        }
        l[qt] = l[qt] * alpha + ls;
#pragma unroll
        for (int r = 0; r < 16; ++r) { o[0][qt][r] *= alpha; o[1][qt][r] *= alpha; }
      }
#pragma unroll
      for (int ks = 0; ks < 4; ++ks) {
        const bf16x8 v0 = *(const bf16x8*)(st + v_rd + ks * 32);
        const bf16x8 v1 = *(const bf16x8*)(st + v_rd + 32 * LROW + ks * 32);
#pragma unroll
        for (int qt = 0; qt < QT; ++qt) {
          o[0][qt] = MFMA(v0, pf[qt][ks], o[0][qt]);
          o[1][qt] = MFMA(v1, pf[qt][ks], o[1][qt]);
        }
      }
    }
    if (more) lstore(lds + ((it + 1) & 1) * ST);
    __syncthreads();
  }
#pragma unroll
  for (int qt = 0; qt < QT; ++qt) {
    const float lt = l[qt] + __shfl_xor(l[qt], 32);
    const float inv = 1.0f / lt;
    const int qi = w * WQ + qt * 32 + ql;
    bf16_t* orow = out + (size_t)qi * out_rs;
#pragma unroll
    for (int dt = 0; dt < 2; ++dt)
#pragma unroll
      for (int g = 0; g < 4; ++g) {
        u32x2 p; p.x = pk2(o[dt][qt][4 * g] * inv, o[dt][qt][4 * g + 1] * inv); p.y = pk2(o[dt][qt][4 * g + 2] * inv, o[dt][qt][4 * g + 3] * inv);
        *(u32x2*)(orow + dt * 32 + 8 * g + 4 * h) = p;
      }
    if (BAND) { if (h == 0) lse[(size_t)qi * lse_rs] = m[qt] * LN2 + __logf(lt); }
  }
}

constexpr int AQT = 1;
constexpr int QBLK = 128 * AQT;
DI void phase_attn(const Ctx& c) {
  const int S = c.S, nseq = TC / S, nqb = S / QBLK;
  const int n_mla = nseq * 8 * nqb, n_gqa = n_mla, n_dil = nseq * 12 * nqb;
  const float* bias = (const float*)(c.ws + OFF_BIAS);
  for (int item = blockIdx.x; item < n_mla + n_gqa + n_dil; item += gridDim.x) {
    if (item < n_mla) {
      const int hh = item & 7, rest = item >> 3, seq = rest / nqb, qb = rest - seq * nqb;
      const size_t hs = (size_t)(seq * 8 + hh) * S;
      attn_item<96, false, AQT>(wsb(c, OFF_QA) + (hs + qb * QBLK) * 96, wsb(c, OFF_KA) + hs * 96, wsb(c, OFF_VTA) + hs * 64, S,
                           0, S, 0, nullptr, 0.10206207261596577f * LOG2E,
                           wsb(c, OFF_OA) + ((size_t)seq * S + qb * QBLK) * 512 + hh * 64, 512, nullptr, 0, c.lds);
    } else if (item < n_mla + n_gqa) {
      const int i2 = item - n_mla;
      const int hq = i2 & 7, rest = i2 >> 3, seq = rest / nqb, qb = rest - seq * nqb;
      const size_t hs = (size_t)(seq * 8 + hq) * S, ks = (size_t)(seq * 2 + (hq >> 2)) * S;
      attn_item<64, false, AQT>(wsb(c, OFF_QC) + (hs + qb * QBLK) * 64, wsb(c, OFF_KC) + ks * 64, wsb(c, OFF_VTC) + ks * 64, S,
                           0, S, 0, nullptr, 0.125f * LOG2E,
                           wsb(c, OFF_OC) + ((size_t)seq * S + qb * QBLK) * 512 + hq * 64, 512, nullptr, 0, c.lds);
    } else {
      const int i2 = item - n_mla - n_gqa;
      const int hb = i2 % 12, rest = i2 / 12, seq = rest / nqb, blk = rest - seq * nqb;
      const int dsh = 2 * (hb >> 2), L = S >> dsh, dil = 1 << dsh;
      const int srow0 = blk * QBLK, rr = srow0 / L, l0 = srow0 - rr * L;
      const size_t hs = (size_t)(seq * 12 + hb) * S;
      int kb = l0 - 64; if (kb < 0) kb = 0;
      int ke = l0 + QBLK + 64; if (ke > L) ke = L;
      const size_t tok0 = (size_t)seq * S + (size_t)l0 * dil + rr;
      attn_item<64, true, AQT>(wsb(c, OFF_QB) + (hs + srow0) * 64, wsb(c, OFF_KB) + (hs + (size_t)rr * L) * 64, wsb(c, OFF_VTB) + hs * 64 + (size_t)rr * L, S,
                          kb, ke, l0, bias + hb * 132, 0.125f * LOG2E,
                          wsb(c, OFF_OBG) + tok0 * 768 + hb * 64, (size_t)dil * 768, (float*)(c.ws + OFF_LSE) + tok0 * 12 + hb, dil * 12, c.lds);
    }
    __syncthreads();
  }
}

DI void phase_combine(const Ctx& c) {
  const bf16_t* obg = wsb(c, OFF_OBG);
  const float* lse = (const float*)(c.ws + OFF_LSE);
  bf16_t* ob = wsb(c, OFF_OB);
  const int total = TC * 4 * 8;
  for (int idx = blockIdx.x * NTHREADS + tid_(); idx < total; idx += gridDim.x * NTHREADS) {
    const int d8 = idx & 7, j = (idx >> 3) & 3, tl = idx >> 5;
    const float l0 = lse[tl * 12 + j], l1 = lse[tl * 12 + 4 + j], l2 = lse[tl * 12 + 8 + j];
    const float mx = fmaxf(l0, fmaxf(l1, l2));
    float w0 = __expf(l0 - mx), w1 = __expf(l1 - mx), w2 = __expf(l2 - mx);
    const float inv = 1.0f / (w0 + w1 + w2);
    w0 *= inv; w1 *= inv; w2 *= inv;
    const u32x4 a = *(const u32x4*)(obg + (size_t)tl * 768 + j * 64 + d8 * 8);
    const u32x4 b = *(const u32x4*)(obg + (size_t)tl * 768 + (4 + j) * 64 + d8 * 8);
    const u32x4 d = *(const u32x4*)(obg + (size_t)tl * 768 + (8 + j) * 64 + d8 * 8);
    u32x4 r;
#pragma unroll
    for (int e = 0; e < 4; ++e) {
      const float lo = w0 * __uint_as_float(a[e] << 16) + w1 * __uint_as_float(b[e] << 16) + w2 * __uint_as_float(d[e] << 16);
      const float hi = w0 * __uint_as_float(a[e] & 0xffff0000u) + w1 * __uint_as_float(b[e] & 0xffff0000u) + w2 * __uint_as_float(d[e] & 0xffff0000u);
      r[e] = pk2(lo, hi);
    }
    *(u32x4*)(ob + (size_t)tl * 256 + j * 64 + d8 * 8) = r;
  }
}

DI void phase_merge(const Ctx& c) {
  const bf16_t* xb = wsb(c, OFF_XB);
  const float* ss = ss_site(c, c.layer, 1);
  const float* bgate = inl(c, 21, 3072);
  bf16_t* mrg = wsb(c, OFF_MRG);
  float* cl = (float*)c.lds; float* rr = (float*)(c.lds + OFF_RR);
  const int tid = tid_(), lane = tid & 63, w = tid >> 6, wm = w >> 1, wn = w & 1, h = lane >> 5, cc = lane & 31;
  for (int t = blockIdx.x; t < 128 * 16; t += gridDim.x) {
    const int mt = t >> 4, nt = t & 15;
    __syncthreads();
    if (tid < 128) rr[tid] = rsqrtf(ss[mt * 128 + tid] * (1.0f / DM) + EPS);
    f32x16 macc[2][1]; zero_acc<1>(macc);
#pragma unroll 1
    for (int k = 0; k < 3; ++k) {
      f32x16 gacc[2][1]; zero_acc<1>(gacc);
      gemm_mainloop<1>(xb + (size_t)mt * 128 * DM, DM, wgt(c, W_GATE) + (size_t)(k * 1024 + nt * 64) * DM, DM, DM, gacc, c.lds);
      const float bv = bgate[k * 1024 + nt * 64 + wn * 32 + cc];
#pragma unroll
      for (int i = 0; i < 2; ++i)
#pragma unroll
        for (int r = 0; r < 16; ++r) {
          const float rv = rr[wm * 64 + i * 32 + (r & 3) + 8 * (r >> 2) + 4 * h];
          gacc[i][0][r] = sigmoidf_(gacc[i][0][r] * rv + bv);
        }
      f32x16 acc[2][1]; zero_acc<1>(acc);
      const int Kk = (k == 1) ? 256 : 512;
      const bf16_t* Ao = wsb(c, k == 0 ? OFF_OA : (k == 1 ? OFF_OB : OFF_OC));
      const bf16_t* Wo = wgt(c, k == 0 ? W_OA : (k == 1 ? W_OB : W_OC));
      gemm_mainloop<1>(Ao + (size_t)mt * 128 * Kk, Kk, Wo + (size_t)nt * 64 * Kk, Kk, Kk, acc, c.lds);
#pragma unroll
      for (int i = 0; i < 2; ++i)
#pragma unroll
        for (int r = 0; r < 16; ++r) macc[i][0][r] += gacc[i][0][r] * acc[i][0][r];
    }
    acc_to_lds<1>(macc, cl);
    __syncthreads();
    const int c4 = (tid & 15) * 4, r0 = tid >> 4;
#pragma unroll 4
    for (int it = 0; it < 8; ++it) {
      const int row = r0 + 16 * it;
      const f32x4 v = *(const f32x4*)(cl + row * CLD + c4);
      u32x2 p; p.x = pk2(v[0], v[1]); p.y = pk2(v[2], v[3]);
      *(u32x2*)(mrg + (size_t)(mt * 128 + row) * DM + nt * 64 + c4) = p;
    }
    __syncthreads();
  }
}

DI void phase_ple(const Ctx& c) {
  const bf16_t* xb = wsb(c, OFF_XB);
  const float* ss = ss_site(c, c.layer, 3);
  float* ssn = ss_site(c, c.layer + 1, 0);
  const bf16_t* peb = wsb(c, OFF_PEB) + (size_t)c.layer * TC * 256;
  float* cl = (float*)c.lds; float* rr = (float*)(c.lds + OFF_RR);
  const int tid = tid_(), lane = tid & 63, w = tid >> 6, wm = w >> 1, h = lane >> 5;
  for (int t = blockIdx.x; t < 128 * 8; t += gridDim.x) {
    const int mt = t >> 3, nt = t & 7;
    if (tid < 128) rr[tid] = rsqrtf(ss[mt * 128 + tid] * (1.0f / DM) + EPS);
    f32x16 g[2][2]; zero_acc<2>(g);
    gemm_mainloop<2>(xb + (size_t)mt * 128 * DM, DM, wgt(c, W_PG) + (size_t)nt * 128 * DM, DM, DM, g, c.lds);
#pragma unroll
    for (int i = 0; i < 2; ++i)
#pragma unroll
      for (int r = 0; r < 16; ++r) {
        const float rv = rr[wm * 64 + i * 32 + (r & 3) + 8 * (r >> 2) + 4 * h];
        g[i][0][r] = sigmoidf_(g[i][0][r] * rv);
        g[i][1][r] = sigmoidf_(g[i][1][r] * rv);
      }
    f32x16 acc[2][2]; zero_acc<2>(acc);
    gemm_mainloop<2>(peb + (size_t)mt * 128 * 256, 256, wgt(c, W_PLE) + (size_t)nt * 128 * 256, 256, 256, acc, c.lds);
#pragma unroll
    for (int i = 0; i < 2; ++i)
#pragma unroll
      for (int j = 0; j < 2; ++j)
#pragma unroll
        for (int r = 0; r < 16; ++r) acc[i][j][r] *= g[i][j][r];
    acc_to_lds<2>(acc, cl);
    __syncthreads();
    resid_epilogue(c.x, wsb(c, OFF_XB), ssn, mt, nt, cl, 1.0f);
    __syncthreads();
  }
}

DI void phase_prologue(const Params& p, char* lds) {
  float* tl = (float*)lds;
  bf16_t* W = (bf16_t*)(p.ws + OFF_W);
  int rot = 0;
  for (int L = 0; L < 2; ++L) {
    bf16_t* wl = W + (size_t)L * W_LAYER;
    transpose_mat(p.in[5] + (size_t)L * 1024 * 5632, 5632, wl + W_FFN1_IN, 5632, 1024, p.in[4] + L * 1024, 1, tl, rot); rot += 88 * 16;
    transpose_mat(p.in[6] + (size_t)L * 2816 * 1024, 1024, wl + W_FFN1_OUT, 1024, 2816, nullptr, 0, tl, rot); rot += 16 * 44;
    transpose_mat(p.in[8] + (size_t)L * 1024 * 3488, 3488, wl + W_IN, 3584, 1024, p.in[7] + L * 1024, 2, tl, rot); rot += 56 * 16;
    transpose_mat(p.in[20] + (size_t)L * 1024 * 3072, 3072, wl + W_GATE, 3072, 1024, p.in[7] + L * 1024, 0, tl, rot); rot += 48 * 16;
    transpose_mat(p.in[11] + (size_t)L * 256 * 768, 768, wl + W_UQ, 768, 256, p.in[9] + L * 256, 3, tl, rot); rot += 12 * 4;
    transpose_mat(p.in[12] + (size_t)L * 128 * 1024, 1024, wl + W_UKV, 1024, 128, p.in[10] + L * 128, 4, tl, rot); rot += 16 * 2;
    transpose_mat(p.in[22] + (size_t)L * 512 * 1024, 1024, wl + W_OA, 1024, 512, nullptr, 0, tl, rot); rot += 16 * 8;
    transpose_mat(p.in[23] + (size_t)L * 256 * 1024, 1024, wl + W_OB, 1024, 256, nullptr, 0, tl, rot); rot += 16 * 4;
    transpose_mat(p.in[24] + (size_t)L * 512 * 1024, 1024, wl + W_OC, 1024, 512, nullptr, 0, tl, rot); rot += 16 * 8;
    transpose_mat(p.in[25] + (size_t)L * 1024 * 1024, 1024, wl + W_OUT, 1024, 1024, nullptr, 0, tl, rot); rot += 16 * 16;
    transpose_mat(p.in[27] + (size_t)L * 1024 * 5632, 5632, wl + W_FFN2_IN, 5632, 1024, p.in[26] + L * 1024, 1, tl, rot); rot += 88 * 16;
    transpose_mat(p.in[28] + (size_t)L * 2816 * 1024, 1024, wl + W_FFN2_OUT, 1024, 2816, nullptr, 0, tl, rot); rot += 16 * 44;
    transpose_mat(p.in[30] + (size_t)L * 1024 * 1024, 1024, wl + W_PG, 1024, 1024, p.in[29] + L * 1024, 0, tl, rot); rot += 16 * 16;
    transpose_mat(p.in[31] + (size_t)L * 256 * 1024, 1024, wl + W_PLE, 1024, 256, nullptr, 0, tl, rot); rot += 16 * 4;
  }
  const int gtid = blockIdx.x * NTHREADS + tid_(), gn = gridDim.x * NTHREADS;
  f32x2* rope = (f32x2*)(p.ws + OFF_ROPE);
  for (int idx = gtid; idx < 16384 * 16; idx += gn) {
    const int pos = idx >> 4, i = idx & 15;
    const float freq = (float)pow(10000.0, -(double)i / 16.0);
    const float ang = (float)pos * freq;
    f32x2 cs; cs.x = (float)cos((double)ang); cs.y = (float)sin((double)ang);
    rope[idx] = cs;
  }
  float* bias = (float*)(p.ws + OFF_BIAS);
  for (int idx = gtid; idx < 12 * 129; idx += gn) {
    const int hb = idx / 129, jj = idx - hb * 129;
    const int dil = 1 << (2 * (hb >> 2));
    const int rel = (jj - 64) * dil;
    const int n = rel < 0 ? -rel : rel;
    int b;
    if (n < 8) b = n;
    else { int lg = 8 + (int)(log((double)n / 8.0) / log(128.0) * 8.0); if (lg > 15) lg = 15; b = lg; }
    if (rel > 0) b += 16;
    bias[hb * 132 + jj] = p.in[17][b * 12 + hb] * LOG2E;
  }
}

DI void phase_init(const Ctx& c) {
  const int tid = tid_(), lane = tid & 63;
  const int gw = blockIdx.x * 4 + (tid >> 6), nw = gridDim.x * 4;
  bf16_t* xb = wsb(c, OFF_XB);
  float* ss0 = ss_site(c, 0, 0);
  for (int row = gw; row < TC; row += nw) {
    float s = 0.f;
#pragma unroll
    for (int i = 0; i < 4; ++i) {
      const size_t gi = (size_t)row * DM + i * 256 + lane * 4;
      const f32x4 v = *(const f32x4*)(c.xin + gi);
      *(f32x4*)(c.x + gi) = v;
      u32x2 p; p.x = pk2(v[0], v[1]); p.y = pk2(v[2], v[3]);
      *(u32x2*)(xb + gi) = p;
      s += v[0] * v[0] + v[1] * v[1] + v[2] * v[2] + v[3] * v[3];
    }
#pragma unroll
    for (int o = 32; o >= 1; o >>= 1) s += __shfl_xor(s, o);
    if (lane == 0) ss0[row] = s;
  }
  const int gtid = blockIdx.x * NTHREADS + tid, gn = gridDim.x * NTHREADS;
  float* ssall = (float*)(c.ws + OFF_SS);
  for (int idx = gtid + TC; idx < 3 * 6 * TC; idx += gn) ssall[idx] = 0.f;
  bf16_t* peb = wsb(c, OFF_PEB);
  for (int idx = gtid; idx < 2 * TC * 64; idx += gn) {
    const int L = idx / (TC * 64), r = idx - L * (TC * 64);
    const f32x4 v = *(const f32x4*)(c.pe0 + (size_t)L * c.pe_ls + (size_t)r * 4);
    u32x2 p; p.x = pk2(v[0], v[1]); p.y = pk2(v[2], v[3]);
    *(u32x2*)(peb + (size_t)idx * 4) = p;
  }
}

#ifndef ONLY
#define ONLY -1
#endif
#define PH(n) (ONLY < 0 || ONLY == (n))
#ifndef DUP
#define DUP -1
#endif
#if DUP == 200
#define GSYNC() do { xcd_barrier(xb); xcd_barrier(xb); } while (0)
#else
#define GSYNC() xcd_barrier(xb)
#endif
#define REP(n) for (int rep_ = 0; rep_ < ((DUP == (n) || (DUP == 100 && ((n) == 2 || (n) == 10))) ? 2 : 1); ++rep_)
__global__ void __launch_bounds__(NTHREADS, 2) mega_kernel(Params p) {
  extern __shared__ __attribute__((aligned(16))) char lds[];
  cg::grid_group grid = cg::this_grid();
  volatile LAS unsigned* xst = (volatile LAS unsigned*)(lds + OFF_RR + 512);
  if (threadIdx.x == 0) { xst[0] = 0u; xst[1] = 0u; }
  __syncthreads();
  const XcdBarrier xb = xcd_barrier_post((unsigned*)(p.ws + OFF_BAR), xst);
  REP(0) { if (PH(0)) phase_prologue(p, lds); grid.sync(); }
  for (int chunk = 0; chunk < 3; ++chunk) {
    Ctx c;
    c.p = &p; c.chunk = chunk; c.layer = 0; c.ws = p.ws; c.lds = lds;
    c.S = chunk == 0 ? 4096 : 16384; c.sshift = chunk == 0 ? 12 : 14;
    c.x = p.out + (size_t)chunk * TC * DM;
    c.xin = chunk == 0 ? p.in[0] : p.in[1] + (size_t)(chunk - 1) * TC * DM;
    c.pe0 = chunk == 0 ? p.in[2] : p.in[3] + (size_t)(chunk - 1) * TC * 256;
    c.pe_ls = chunk == 0 ? (size_t)TC * 256 : (size_t)2 * TC * 256;
    REP(1) { if (PH(1)) phase_init(c); GSYNC(); }
#pragma unroll 1
    for (int layer = 0; layer < 2; ++layer) {
      c.layer = layer;
      REP(2) { if (PH(2)) phase_ffn_in(c, W_FFN1_IN, 0); GSYNC(); }
      REP(3) { if (PH(3)) phase_resid_gemm(c, wsb(c, OFF_ACT), DFF, W_FFN1_OUT, 0.5f, ss_site(c, layer, 1)); GSYNC(); }
      REP(4) { if (PH(4)) phase_proj(c); GSYNC(); }
      REP(5) { if (PH(5)) phase_mlaup(c); GSYNC(); }
      REP(6) { if (PH(6)) phase_attn(c); GSYNC(); }
      REP(7) { if (PH(7)) phase_combine(c); GSYNC(); }
      REP(8) { if (PH(8)) phase_merge(c); GSYNC(); }
      REP(9) { if (PH(9)) phase_resid_gemm(c, wsb(c, OFF_MRG), DM, W_OUT, 1.0f, ss_site(c, layer, 2)); GSYNC(); }
      REP(10) { if (PH(10)) phase_ffn_in(c, W_FFN2_IN, 2); GSYNC(); }
      REP(11) { if (PH(11)) phase_resid_gemm(c, wsb(c, OFF_ACT), DFF, W_FFN2_OUT, 0.5f, ss_site(c, layer, 3)); GSYNC(); }
      REP(12) { if (PH(12)) phase_ple(c); GSYNC(); }
    }
  }
}

extern "C" void kernel_launch(void* const* d_in, const int* in_sizes, int n_in, void* d_out, int out_size, void* d_ws, size_t ws_size, hipStream_t stream) {
  static int grid_blocks = 0;
  if (!grid_blocks) {
    int dev = 0, cus = 0, per_cu = 0;
    hipGetDevice(&dev);
    hipDeviceGetAttribute(&cus, hipDeviceAttributeMultiprocessorCount, dev);
    hipFuncSetAttribute((const void*)mega_kernel, hipFuncAttributeMaxDynamicSharedMemorySize, LDS_BYTES);
    hipOccupancyMaxActiveBlocksPerMultiprocessor(&per_cu, mega_kernel, NTHREADS, LDS_BYTES);
    if (per_cu > 2) per_cu = 2;
    if (per_cu < 1) per_cu = 1;
    grid_blocks = cus * per_cu;
  }
  Params p{};
  for (int i = 0; i < 32; ++i) p.in[i] = (const float*)d_in[i];
  p.out = (float*)d_out;
  p.ws = (char*)d_ws;
  hipMemsetAsync((char*)d_ws + OFF_BAR, 0, 16384, stream);
  void* args[] = {&p};
  hipError_t e = hipLaunchCooperativeKernel((const void*)mega_kernel, dim3(grid_blocks), dim3(NTHREADS), args, LDS_BYTES, stream);
  if (e != hipSuccess) fprintf(stderr, "cooperative launch failed: %s (grid %d)\n", hipGetErrorString(e), grid_blocks);
}
```

```cpp
#include <hip/hip_runtime.h>
#include <hip/hip_cooperative_groups.h>
#include <stdint.h>
#include <cstdio>
namespace cg = cooperative_groups;

typedef unsigned short bf16_t;
typedef short bf16x8 __attribute__((ext_vector_type(8)));
typedef float f32x16 __attribute__((ext_vector_type(16)));
typedef float f32x4 __attribute__((ext_vector_type(4)));
typedef float f32x2 __attribute__((ext_vector_type(2)));
typedef unsigned u32x4 __attribute__((ext_vector_type(4)));
typedef unsigned u32x2 __attribute__((ext_vector_type(2)));
typedef __bf16 bf16x2_t __attribute__((ext_vector_type(2)));
#define DI __device__ __forceinline__
#define MFMA(a, b, c) __builtin_amdgcn_mfma_f32_32x32x16_bf16((a), (b), (c), 0, 0, 0)

constexpr int TC = 16384;
constexpr int DM = 1024;
constexpr int DFF = 2816;
constexpr float EPS = 1e-6f;
constexpr float LOG2E = 1.4426950408889634f;
constexpr float LN2 = 0.6931471805599453f;
constexpr int NTHREADS = 256;

constexpr size_t W_FFN1_IN = 0;
constexpr size_t W_FFN1_OUT = W_FFN1_IN + (size_t)5632 * 1024;
constexpr size_t W_IN = W_FFN1_OUT + (size_t)1024 * 2816;
constexpr size_t W_GATE = W_IN + (size_t)3584 * 1024;
constexpr size_t W_UQ = W_GATE + (size_t)3072 * 1024;
constexpr size_t W_UKV = W_UQ + (size_t)768 * 256;
constexpr size_t W_OA = W_UKV + (size_t)1024 * 128;
constexpr size_t W_OB = W_OA + (size_t)1024 * 512;
constexpr size_t W_OC = W_OB + (size_t)1024 * 256;
constexpr size_t W_OUT = W_OC + (size_t)1024 * 512;
constexpr size_t W_FFN2_IN = W_OUT + (size_t)1024 * 1024;
constexpr size_t W_FFN2_OUT = W_FFN2_IN + (size_t)5632 * 1024;
constexpr size_t W_PG = W_FFN2_OUT + (size_t)1024 * 2816;
constexpr size_t W_PLE = W_PG + (size_t)1024 * 1024;
constexpr size_t W_LAYER = W_PLE + (size_t)1024 * 256;

constexpr size_t AL(size_t x) { return (x + 255) & ~(size_t)255; }
constexpr size_t OFF_W = 0;
constexpr size_t OFF_BAR = AL(OFF_W + 2 * W_LAYER * 2);
constexpr size_t OFF_ROPE = AL(OFF_BAR + 16384);
constexpr size_t OFF_BIAS = AL(OFF_ROPE + (size_t)16384 * 16 * 8);
constexpr size_t OFF_SS = AL(OFF_BIAS + 12 * 132 * 4);
constexpr size_t OFF_XB = AL(OFF_SS + (size_t)3 * 6 * TC * 4);
constexpr size_t OFF_XB2 = AL(OFF_XB + (size_t)TC * 1024 * 2);
constexpr size_t OFF_PEB = AL(OFF_XB2 + (size_t)TC * 1024 * 2);
constexpr size_t OFF_BIG = AL(OFF_PEB + (size_t)2 * TC * 256 * 2);
constexpr size_t OFF_ACT = OFF_BIG;
constexpr size_t OFF_CQ = OFF_BIG;
constexpr size_t OFF_CKV = AL(OFF_CQ + (size_t)TC * 256 * 2);
constexpr size_t OFF_QA = AL(OFF_CKV + (size_t)TC * 128 * 2);
constexpr size_t OFF_KA = AL(OFF_QA + (size_t)TC * 768 * 2);
constexpr size_t OFF_VTA = AL(OFF_KA + (size_t)TC * 768 * 2);
constexpr size_t OFF_QB = AL(OFF_VTA + (size_t)TC * 512 * 2);
constexpr size_t OFF_KB = AL(OFF_QB + (size_t)TC * 768 * 2);
constexpr size_t OFF_VTB = AL(OFF_KB + (size_t)TC * 768 * 2);
constexpr size_t OFF_QC = AL(OFF_VTB + (size_t)TC * 768 * 2);
constexpr size_t OFF_KC = AL(OFF_QC + (size_t)TC * 512 * 2);
constexpr size_t OFF_VTC = AL(OFF_KC + (size_t)TC * 128 * 2);
constexpr size_t OFF_OA = AL(OFF_VTC + (size_t)TC * 128 * 2);
constexpr size_t OFF_OBG = AL(OFF_OA + (size_t)TC * 512 * 2);
constexpr size_t OFF_LSE = AL(OFF_OBG + (size_t)TC * 768 * 2);
constexpr size_t OFF_OB = AL(OFF_LSE + (size_t)TC * 12 * 4);
constexpr size_t OFF_OC = AL(OFF_OB + (size_t)TC * 256 * 2);
constexpr size_t OFF_MRG = AL(OFF_OC + (size_t)TC * 512 * 2);
constexpr size_t OFF_END = AL(OFF_MRG + (size_t)TC * 1024 * 2);
static_assert(OFF_END < (size_t)500 * 1024 * 1024, "workspace too large");
static_assert(OFF_ACT + (size_t)TC * DFF * 2 <= OFF_END, "act fits");

struct Params {
  const float* in[32];
  float* out;
  char* ws;
};

constexpr int LROW = 144;
constexpr int STAGE_OP = 128 * LROW;
constexpr int STAGE = 2 * STAGE_OP;
constexpr int CLD = 132;
constexpr int OFF_RR = 2 * STAGE;
constexpr int LDS_BYTES = 2 * STAGE + 1024;
static_assert(128 * CLD * 4 <= OFF_RR, "lds");

DI int tid_() { int t = threadIdx.x; asm volatile("" : "+v"(t)); return t; }
DI unsigned pk2(float a, float b) { f32x2 v = {a, b}; bf16x2_t r = __builtin_convertvector(v, bf16x2_t); return __builtin_bit_cast(unsigned, r); }
DI bf16_t f2bf(float a) { return (bf16_t)(pk2(a, 0.f) & 0xffffu); }
DI float bf2f(bf16_t v) { return __uint_as_float(((unsigned)v) << 16); }
DI float sigmoidf_(float x) { return 1.0f / (1.0f + __expf(-x)); }

DI int map_col(int map, int n) {
  switch (map) {
    case 0: return n;
    case 1: { int t = n >> 7, w = n & 127; return w < 64 ? t * 64 + w : DFF + t * 64 + (w - 64); }
    case 2: { int slot = n >> 6, d = n & 63; if (slot < 6) return n; if (slot == 6) return d < 32 ? 384 + d : -1; if (slot < 55) return 416 + (n - 448); return -1; }
    case 3: { if (n < 512) return (n >> 6) * 96 + (n & 63); int i = n - 512; return (i >> 5) * 96 + 64 + (i & 31); }
    default: { if (n < 512) return (n >> 6) * 128 + (n & 63); int i = n - 512; return (i >> 6) * 128 + 64 + (i & 63); }
  }
}

DI void transpose_mat(const float* __restrict__ src, int ld_src, bf16_t* __restrict__ dst, int N, int K, const float* __restrict__ gain, int map, float* lds, int rot) {
  const int ntk = K >> 6, ntn = N >> 6, nt = ntk * ntn;
  const int tid = tid_(), c = tid & 63, rq = tid >> 6;
  int b0 = (int)blockIdx.x - (rot % (int)gridDim.x); if (b0 < 0) b0 += gridDim.x;
  for (int t = b0; t < nt; t += gridDim.x) {
    const int tn = t / ntk, tk = t - tn * ntk;
    const int n0 = tn << 6, k0 = tk << 6;
    const int sc = map_col(map, n0 + c);
#pragma unroll 4
    for (int r = 0; r < 16; ++r) {
      const int kk = r * 4 + rq;
      float v = 0.f;
      if (sc >= 0) { v = src[(size_t)(k0 + kk) * ld_src + sc]; if (gain) v *= gain[k0 + kk]; }
      lds[c * 65 + kk] = v;
    }
    __syncthreads();
#pragma unroll 4
    for (int r = 0; r < 16; ++r) {
      const int nn = r * 4 + rq;
      dst[(size_t)(n0 + nn) * K + k0 + c] = f2bf(lds[nn * 65 + c]);
    }
    __syncthreads();
  }
}

template <int NJ> DI void zero_acc(f32x16 (&acc)[2][NJ]) {
#pragma unroll
  for (int i = 0; i < 2; ++i)
#pragma unroll
    for (int j = 0; j < NJ; ++j)
#pragma unroll
      for (int r = 0; r < 16; ++r) acc[i][j][r] = 0.f;
}

template <int NJ> DI void gemm_mainloop(const bf16_t* __restrict__ A, int lda, const bf16_t* __restrict__ Bt, int ldb, int K, f32x16 (&acc)[2][NJ], char* lds) {
  const int tid = tid_(), lane = tid & 63, w = tid >> 6, wm = w >> 1, wn = w & 1;
  const int lr = tid >> 3, lc = tid & 7;
  const bf16_t* ap = A + (size_t)lr * lda + lc * 8;
  const bf16_t* bp = Bt + (size_t)lr * ldb + lc * 8;
  const size_t astep = (size_t)32 * lda, bstep = (size_t)32 * ldb;
  constexpr int NB = 2 * NJ;
  u32x4 ra0[4], rb0[NB], ra1[4], rb1[NB];
  const int wofs = lr * LROW + lc * 16;
  const int a_rd = (wm * 64 + (lane & 31)) * LROW + (lane >> 5) * 16;
  const int b_rd = STAGE_OP + (wn * 32 * NJ + (lane & 31)) * LROW + (lane >> 5) * 16;
#define GL_(RA, RB) { _Pragma("unroll") for (int i = 0; i < 4; ++i) RA[i] = *(const u32x4*)(ap + i * astep); \
                      _Pragma("unroll") for (int i = 0; i < NB; ++i) RB[i] = *(const u32x4*)(bp + i * bstep); ap += 64; bp += 64; }
#define LS_(RA, RB, ST) { char* sn_ = lds + (ST) * STAGE; \
                      _Pragma("unroll") for (int i = 0; i < 4; ++i) *(u32x4*)(sn_ + wofs + i * 32 * LROW) = RA[i]; \
                      _Pragma("unroll") for (int i = 0; i < NB; ++i) *(u32x4*)(sn_ + STAGE_OP + wofs + i * 32 * LROW) = RB[i]; }
#define MM_(ST) { const char* st_ = lds + (ST) * STAGE; \
    _Pragma("unroll") for (int ks = 0; ks < 4; ++ks) { \
      const bf16x8 a0 = *(const bf16x8*)(st_ + a_rd + ks * 32); \
      const bf16x8 a1 = *(const bf16x8*)(st_ + a_rd + 32 * LROW + ks * 32); \
      _Pragma("unroll") for (int j = 0; j < NJ; ++j) { \
        const bf16x8 b = *(const bf16x8*)(st_ + b_rd + j * 32 * LROW + ks * 32); \
        acc[0][j] = MFMA(a0, b, acc[0][j]); acc[1][j] = MFMA(a1, b, acc[1][j]); } } }
  GL_(ra0, rb0);
  GL_(ra1, rb1);
  LS_(ra0, rb0, 0);
  __syncthreads();
  const int nk = K >> 6;
  for (int kt = 0; kt < nk; kt += 2) {
    if (kt + 2 < nk) GL_(ra0, rb0);
    MM_(0);
    LS_(ra1, rb1, 1);
    __syncthreads();
    if (kt + 3 < nk) GL_(ra1, rb1);
    MM_(1);
    if (kt + 2 < nk) LS_(ra0, rb0, 0);
    __syncthreads();
  }
#undef GL_
#undef LS_
#undef MM_
}

template <int NJ> DI void acc_to_lds(const f32x16 (&acc)[2][NJ], float* cl) {
  const int tid = tid_(), lane = tid & 63, w = tid >> 6, wm = w >> 1, wn = w & 1, h = lane >> 5, c = lane & 31;
#pragma unroll
  for (int i = 0; i < 2; ++i)
#pragma unroll
    for (int j = 0; j < NJ; ++j)
#pragma unroll
      for (int r = 0; r < 16; ++r) {
        const int row = wm * 64 + i * 32 + (r & 3) + 8 * (r >> 2) + 4 * h;
        cl[row * CLD + wn * 32 * NJ + j * 32 + c] = acc[i][j][r];
      }
}

template <int NJ> DI void resid_epilogue(float* __restrict__ x, bf16_t* __restrict__ xb, float* __restrict__ ssn, int mt, int nt, const float* cl, float scale) {
  constexpr int LPR = 16 * NJ, RPP = 256 / LPR, NP = 128 / RPP;
  const int tid = tid_(), c4 = (tid & (LPR - 1)) * 4, r0 = tid / LPR;
#pragma unroll 4
  for (int it = 0; it < NP; ++it) {
    const int row = r0 + RPP * it;
    const f32x4 c = *(const f32x4*)(cl + row * CLD + c4);
    const size_t gi = (size_t)(mt * 128 + row) * DM + nt * (64 * NJ) + c4;
    f32x4 xv = *(const f32x4*)(x + gi);
    xv = xv + scale * c;
    *(f32x4*)(x + gi) = xv;
    u32x2 p; p.x = pk2(xv[0], xv[1]); p.y = pk2(xv[2], xv[3]);
    *(u32x2*)(xb + gi) = p;
    float s_ = xv[0] * xv[0] + xv[1] * xv[1] + xv[2] * xv[2] + xv[3] * xv[3];
    if (NJ == 2) s_ += __shfl_xor(s_, 16);
    s_ += __shfl_xor(s_, 8); s_ += __shfl_xor(s_, 4); s_ += __shfl_xor(s_, 2); s_ += __shfl_xor(s_, 1);
    if ((tid & (LPR - 1)) == 0) atomicAdd(ssn + mt * 128 + row, s_);
  }
}

#define XB_TMO      128
#define XB_XCNT(j)  (256  + 64 * (j))
#define XB_XSUB(j)  (1280 + 64 * (j))
#define XB_XGEN(j)  (2304 + 64 * (j))
#define XB_TOP      3328
#define XB_TOPGEN   3392
#define XCD_BAR_WORDS 3456
#define XB_SPIN_CAP (1u << 22)
#define LAS __attribute__((address_space(3)))
DI unsigned xb_ld(unsigned* p)              { return __hip_atomic_load(p, __ATOMIC_RELAXED, __HIP_MEMORY_SCOPE_AGENT); }
DI unsigned xb_add(unsigned* p, unsigned v) { return __hip_atomic_fetch_add(p, v, __ATOMIC_RELAXED, __HIP_MEMORY_SCOPE_AGENT); }
DI unsigned xb_xcc_id() { return (unsigned)__builtin_amdgcn_s_getreg((3 << 11) | 20) & 0xFu; }
#define XB_SPIN(cond, bar) do { unsigned _sp = 0; while (cond) { __builtin_amdgcn_s_sleep(1); \
    if ((++_sp & 255u) == 0u) { if (xb_ld(&(bar)[XB_TMO])) break; if (_sp > XB_SPIN_CAP) { atomicAdd(&(bar)[XB_TMO], 1u); break; } } } } while (0)
struct XcdBarrier { unsigned* bar; unsigned x; volatile LAS unsigned* st; };
DI XcdBarrier xcd_barrier_post(unsigned* bar, volatile LAS unsigned* st) {
  XcdBarrier b; b.bar = bar; b.x = xb_xcc_id(); b.st = st;
  if (threadIdx.x == 0) (void)xb_add(&bar[XB_XCNT(b.x)], 1u);
  return b;
}
DI void xcd_barrier_complete(unsigned* bar, unsigned x, unsigned& nloc, unsigned& nx) {
  const unsigned G = gridDim.x * gridDim.y * gridDim.z;
  unsigned sum, cnt, mine, sp = 0u;
  for (;;) {
    sum = 0u; cnt = 0u; mine = 0u;
#pragma unroll
    for (unsigned j = 0; j < 16; ++j) { const unsigned c = xb_ld(&bar[XB_XCNT(j)]); sum += c; cnt += (c > 0u) ? 1u : 0u; mine = (j == x) ? c : mine; }
    if (sum == G) break;
    __builtin_amdgcn_s_sleep(1);
    if ((++sp & 255u) == 0u) { if (xb_ld(&bar[XB_TMO])) break; if (sp > XB_SPIN_CAP) { atomicAdd(&bar[XB_TMO], 1u); break; } }
  }
  nloc = mine > 0u ? mine : 1u; nx = cnt > 0u ? cnt : 1u;
}
DI void xcd_barrier(const XcdBarrier& b) {
  asm volatile("s_waitcnt vmcnt(0)" ::: "memory");
  __syncthreads();
  if (threadIdx.x == 0) {
    unsigned* bar = b.bar;
    __builtin_amdgcn_s_waitcnt(0);
    unsigned nloc = b.st[0], nx = b.st[1];
    if (nloc == 0u) { xcd_barrier_complete(bar, b.x, nloc, nx); b.st[0] = nloc; b.st[1] = nx; }
    const unsigned old = xb_add(&bar[XB_XSUB(b.x)], 1u);
    const unsigned gen = old / nloc;
    if (old + 1u == (gen + 1u) * nloc) {
      __builtin_amdgcn_fence(__ATOMIC_RELEASE, "agent");
      asm volatile("s_waitcnt vmcnt(0)" ::: "memory");
      const unsigned og = xb_add(&bar[XB_TOP], 1u);
      const unsigned tg = og / nx;
      if (og + 1u == (tg + 1u) * nx) xb_add(&bar[XB_TOPGEN], 1u);
      else XB_SPIN(xb_ld(&bar[XB_TOPGEN]) == tg, bar);
      __builtin_amdgcn_fence(__ATOMIC_ACQUIRE, "agent");
      xb_add(&bar[XB_XGEN(b.x)], 1u);
      asm volatile("s_waitcnt vmcnt(0)" ::: "memory");
    } else {
      XB_SPIN(xb_ld(&bar[XB_XGEN(b.x)]) == gen, bar);
      __builtin_amdgcn_fence(__ATOMIC_ACQUIRE, "agent");
      asm volatile("s_waitcnt vmcnt(0)" ::: "memory");
    }
  }
  __syncthreads();
}

struct Ctx {
  const Params* p;
  int chunk, layer;
  int S, sshift;
  float* x;
  const float* xin;
  const float* pe0; size_t pe_ls;
  char* ws;
  char* lds;
};
DI bf16_t* wsb(const Ctx& c, size_t off) { return (bf16_t*)(c.ws + off); }
DI float* ss_site(const Ctx& c, int layer, int site) { return (float*)(c.ws + OFF_SS) + ((size_t)layer * 6 + site) * TC; }
DI const bf16_t* wgt(const Ctx& c, size_t off) { return (const bf16_t*)(c.ws + OFF_W) + (size_t)c.layer * W_LAYER + off; }
DI const float* inl(const Ctx& c, int idx, size_t per_layer) { return c.p->in[idx] + (size_t)c.layer * per_layer; }

DI void phase_ffn_in(const Ctx& c, const bf16_t* A, size_t woff, int site) {
  const bf16_t* Bt = wgt(c, woff);
  bf16_t* act = wsb(c, OFF_ACT);
  const float* ss = ss_site(c, c.layer, site);
  float* cl = (float*)c.lds; float* rr = (float*)(c.lds + OFF_RR);
  const int tid = tid_();
  const int xcd_ = blockIdx.x & 7, slot_ = blockIdx.x >> 3, nslot_ = gridDim.x >> 3;
  for (int j_ = slot_; j_ < 16 * 44; j_ += nslot_) {
    const int mt = xcd_ * 16 + (j_ & 15), nt = j_ >> 4;
    f32x16 acc[2][2]; zero_acc<2>(acc);
    gemm_mainloop<2>(A + (size_t)mt * 128 * DM, DM, Bt + (size_t)nt * 128 * DM, DM, DM, acc, c.lds);
    acc_to_lds<2>(acc, cl);
    if (tid < 128) rr[tid] = rsqrtf(ss[mt * 128 + tid] * (1.0f / DM) + EPS);
    __syncthreads();
    const int c4 = (tid & 15) * 4, r0 = tid >> 4;
#pragma unroll 2
    for (int it = 0; it < 8; ++it) {
      const int row = r0 + 16 * it;
      const float r = rr[row];
      const f32x4 a = *(const f32x4*)(cl + row * CLD + c4);
      const f32x4 b = *(const f32x4*)(cl + row * CLD + 64 + c4);
      float o[4];
#pragma unroll
      for (int e = 0; e < 4; ++e) { const float av = a[e] * r, bv = b[e] * r; o[e] = av * sigmoidf_(av) * bv; }
      u32x2 pq; pq.x = pk2(o[0], o[1]); pq.y = pk2(o[2], o[3]);
      *(u32x2*)(act + (size_t)(mt * 128 + row) * DFF + nt * 64 + c4) = pq;
    }
    __syncthreads();
  }
}

DI void phase_resid_gemm(const Ctx& c, const bf16_t* A, int K, size_t woff, float scale, float* ssn) {
  const bf16_t* Bt = wgt(c, woff);
  bf16_t* xb = wsb(c, OFF_XB);
  float* cl = (float*)c.lds;
  const int xcd_ = blockIdx.x & 7, slot_ = blockIdx.x >> 3, nslot_ = gridDim.x >> 3;
  for (int j_ = slot_; j_ < 16 * 8; j_ += nslot_) {
    const int mt = xcd_ * 16 + (j_ & 15), nt = j_ >> 4;
    f32x16 acc[2][2]; zero_acc<2>(acc);
    gemm_mainloop<2>(A + (size_t)mt * 128 * K, K, Bt + (size_t)nt * 128 * K, K, K, acc, c.lds);
    acc_to_lds<2>(acc, cl);
    __syncthreads();
    resid_epilogue<2>(c.x, xb, ssn, mt, nt, cl, scale);
    __syncthreads();
  }
}

DI void load_slot(const float* cl, int row, int col0, float (&v)[64]) {
#pragma unroll
  for (int q = 0; q < 16; ++q) { const f32x4 t = *(const f32x4*)(cl + row * CLD + col0 + q * 4); v[4 * q] = t[0]; v[4 * q + 1] = t[1]; v[4 * q + 2] = t[2]; v[4 * q + 3] = t[3]; }
}
template <int N> DI void store_bf16(bf16_t* dst, const float* v) {
#pragma unroll
  for (int q = 0; q < N / 8; ++q) { u32x4 p; p.x = pk2(v[8 * q], v[8 * q + 1]); p.y = pk2(v[8 * q + 2], v[8 * q + 3]); p.z = pk2(v[8 * q + 4], v[8 * q + 5]); p.w = pk2(v[8 * q + 6], v[8 * q + 7]); *(u32x4*)(dst + 8 * q) = p; }
}
template <int N> DI void rmsnorm_inplace(float* v, const float* __restrict__ g) {
  float s = 0.f;
#pragma unroll
  for (int i = 0; i < N; ++i) s += v[i] * v[i];
  const float r = rsqrtf(s * (1.0f / N) + EPS);
#pragma unroll
  for (int i = 0; i < N; ++i) v[i] = v[i] * r * g[i];
}
DI void rope32(float* v, const f32x2* __restrict__ tab  ) {
#pragma unroll
  for (int i = 0; i < 16; ++i) { const f32x2 cs = tab[i]; const float x1 = v[i], x2 = v[i + 16]; v[i] = x1 * cs.x - x2 * cs.y; v[i + 16] = x1 * cs.y + x2 * cs.x; }
}
DI void vt_write(const float* cl, const float* rr, int col0, int u, bf16_t* dst_row  , int dsh, int L, int pos0) {
  const int d = u & 63, th = u >> 6;
  float v[64];
#pragma unroll
  for (int i = 0; i < 64; ++i) v[i] = cl[(th * 64 + i) * CLD + col0 + d] * rr[th * 64 + i];
  const int p0 = pos0 + th * 64;
  if (dsh == 0) {
    store_bf16<64>(dst_row + p0, v);
  } else if (dsh == 2) {
#pragma unroll
    for (int rr_ = 0; rr_ < 4; ++rr_) {
      float t[16];
#pragma unroll
      for (int a = 0; a < 16; ++a) t[a] = v[4 * a + rr_];
      store_bf16<16>(dst_row + rr_ * L + (p0 >> 2), t);
    }
  } else {
#pragma unroll
    for (int rr_ = 0; rr_ < 16; ++rr_) {
      u32x2 p; p.x = pk2(v[rr_], v[16 + rr_]); p.y = pk2(v[32 + rr_], v[48 + rr_]);
      *(u32x2*)(dst_row + rr_ * L + (p0 >> 4)) = p;
    }
  }
}

DI void phase_proj(const Ctx& c) {
  const bf16_t* A = wsb(c, OFF_XB);
  const bf16_t* Bt = wgt(c, W_IN);
  const float* ss = ss_site(c, c.layer, 1);
  float* ss_cq = ss_site(c, c.layer, 4);
  float* ss_ckv = ss_site(c, c.layer, 5);
  float* cl = (float*)c.lds; float* rr = (float*)(c.lds + OFF_RR);
  const f32x2* rope = (const f32x2*)(c.ws + OFF_ROPE);
  const int tid0 = tid_();
  const int S = c.S, sshift = c.sshift;
  const int xcd_ = blockIdx.x & 7, slot_ = blockIdx.x >> 3, nslot_ = gridDim.x >> 3;
  for (int j_ = slot_; j_ < 16 * 28; j_ += nslot_) {
    const int mt = xcd_ * 16 + (j_ & 15), nt = j_ >> 4;
    f32x16 acc[2][2]; zero_acc<2>(acc);
    gemm_mainloop<2>(A + (size_t)mt * 128 * DM, DM, Bt + (size_t)nt * 128 * DM, DM, DM, acc, c.lds);
    acc_to_lds<2>(acc, cl);
    const int tid = tid_(), half = __builtin_amdgcn_readfirstlane(tid >> 7), u = tid & 127;
    if (tid < 128) rr[tid] = rsqrtf(ss[mt * 128 + tid] * (1.0f / DM) + EPS);
    __syncthreads();
    const int slot = nt * 2 + half, col0 = half * 64;
    const int tl0 = mt * 128, seq = tl0 >> sshift, pos0 = tl0 & (S - 1);
    const bool is_vb = (slot >= 31 && slot < 43), is_vc = (slot == 53 || slot == 54);
    if (is_vb) {
      const int hb = slot - 31, dsh = 2 * (hb >> 2);
      bf16_t* dst = wsb(c, OFF_VTB) + ((size_t)(seq * 12 + hb) * 64 + (u & 63)) * S;
      vt_write(cl, rr, col0, u, dst, dsh, S >> dsh, pos0);
    } else if (is_vc) {
      const int hv = slot - 53;
      bf16_t* dst = wsb(c, OFF_VTC) + ((size_t)(seq * 2 + hv) * 64 + (u & 63)) * S;
      vt_write(cl, rr, col0, u, dst, 0, S, pos0);
    } else if (slot < 55) {
      const int row = u, tl = tl0 + row, pos = pos0 + row;
      const float r = rr[row];
      float v[64];
      load_slot(cl, row, col0, v);
#pragma unroll
      for (int i = 0; i < 64; ++i) v[i] *= r;
      if (slot < 6) {
        float s = 0.f;
#pragma unroll
        for (int i = 0; i < 64; ++i) s += v[i] * v[i];
        if (slot < 4) { store_bf16<64>(wsb(c, OFF_CQ) + (size_t)tl * 256 + slot * 64, v); atomicAdd(ss_cq + tl, s); }
        else { store_bf16<64>(wsb(c, OFF_CKV) + (size_t)tl * 128 + (slot - 4) * 64, v); atomicAdd(ss_ckv + tl, s); }
      } else if (slot == 6) {
        rmsnorm_inplace<32>(v, inl(c, 14, 96) + 64);
        rope32(v, rope + (size_t)pos * 16);
        bf16_t* dst = wsb(c, OFF_KA) + ((size_t)(seq * 8) * S + pos) * 96 + 64;
#pragma unroll
        for (int hh = 0; hh < 8; ++hh) store_bf16<32>(dst + (size_t)hh * S * 96, v);
      } else if (slot < 31) {
        const bool isq = slot < 19;
        const int hb = isq ? slot - 7 : slot - 19, dsh = 2 * (hb >> 2), L = S >> dsh;
        rmsnorm_inplace<64>(v, inl(c, isq ? 15 : 16, 64));
        const int srow = (pos & ((1 << dsh) - 1)) * L + (pos >> dsh);
        bf16_t* dst = wsb(c, isq ? OFF_QB : OFF_KB) + ((size_t)(seq * 12 + hb) * S + srow) * 64;
        store_bf16<64>(dst, v);
      } else {
        const bool isq = slot < 51;
        rmsnorm_inplace<64>(v, inl(c, isq ? 18 : 19, 64));
        bf16_t* dst = isq ? wsb(c, OFF_QC) + ((size_t)(seq * 8 + (slot - 43)) * S + pos) * 64
                          : wsb(c, OFF_KC) + ((size_t)(seq * 2 + (slot - 51)) * S + pos) * 64;
        asm volatile("" ::: "memory");
        rope32(v, rope + (size_t)(pos >> 6) * 16);
        store_bf16<32>(dst, v);
        asm volatile("" ::: "memory");
        rope32(v + 32, rope + (size_t)(pos & 63) * 16);
        store_bf16<32>(dst + 32, v + 32);
      }
    }
    __syncthreads();
  }
}

DI void phase_mlaup(const Ctx& c) {
  const float* ss_cq = ss_site(c, c.layer, 4);
  const float* ss_ckv = ss_site(c, c.layer, 5);
  float* cl = (float*)c.lds; float* rr = (float*)(c.lds + OFF_RR);
  const f32x2* rope = (const f32x2*)(c.ws + OFF_ROPE);
  const int tid0 = tid_();
  const int S = c.S, sshift = c.sshift;
  const int xcd_ = blockIdx.x & 7, slot_ = blockIdx.x >> 3, nslot_ = gridDim.x >> 3;
  for (int j_ = slot_; j_ < 16 * 14; j_ += nslot_) {
    const int mt = xcd_ * 16 + (j_ & 15), nt = j_ >> 4;
    const bool isq = nt < 6;
    f32x16 acc[2][2]; zero_acc<2>(acc);
    if (isq) gemm_mainloop<2>(wsb(c, OFF_CQ) + (size_t)mt * 128 * 256, 256, wgt(c, W_UQ) + (size_t)nt * 128 * 256, 256, 256, acc, c.lds);
    else gemm_mainloop<2>(wsb(c, OFF_CKV) + (size_t)mt * 128 * 128, 128, wgt(c, W_UKV) + (size_t)(nt - 6) * 128 * 128, 128, 128, acc, c.lds);
    acc_to_lds<2>(acc, cl);
    const int tid = tid_(), half = __builtin_amdgcn_readfirstlane(tid >> 7), u = tid & 127;
    if (tid < 128) rr[tid] = isq ? rsqrtf(ss_cq[mt * 128 + tid] * (1.0f / 256) + EPS) : rsqrtf(ss_ckv[mt * 128 + tid] * (1.0f / 128) + EPS);
    __syncthreads();
    const int col0 = half * 64;
    const int tl0 = mt * 128, seq = tl0 >> sshift, pos0 = tl0 & (S - 1);
    if (!isq && nt >= 10) {
      const int hv = (nt - 10) * 2 + half;
      bf16_t* dst = wsb(c, OFF_VTA) + ((size_t)(seq * 8 + hv) * 64 + (u & 63)) * S;
      vt_write(cl, rr, col0, u, dst, 0, S, pos0);
    } else {
      const int row = u, pos = pos0 + row;
      const float r = rr[row];
      float v[64];
      load_slot(cl, row, col0, v);
#pragma unroll
      for (int i = 0; i < 64; ++i) v[i] *= r;
      if (isq && nt < 4) {
        const int hh = nt * 2 + half;
        rmsnorm_inplace<64>(v, inl(c, 13, 96));
        store_bf16<64>(wsb(c, OFF_QA) + ((size_t)(seq * 8 + hh) * S + pos) * 96, v);
      } else if (isq) {
        const int h0 = ((nt - 4) * 2 + half) * 2;
        rmsnorm_inplace<32>(v, inl(c, 13, 96) + 64);
        rmsnorm_inplace<32>(v + 32, inl(c, 13, 96) + 64);
        rope32(v, rope + (size_t)pos * 16);
        rope32(v + 32, rope + (size_t)pos * 16);
        store_bf16<32>(wsb(c, OFF_QA) + ((size_t)(seq * 8 + h0) * S + pos) * 96 + 64, v);
        store_bf16<32>(wsb(c, OFF_QA) + ((size_t)(seq * 8 + h0 + 1) * S + pos) * 96 + 64, v + 32);
      } else {
        const int hh = (nt - 6) * 2 + half;
        rmsnorm_inplace<64>(v, inl(c, 14, 96));
        store_bf16<64>(wsb(c, OFF_KA) + ((size_t)(seq * 8 + hh) * S + pos) * 96, v);
      }
    }
    __syncthreads();
  }
}

template <int DQK, bool BAND, int QT>
DI void attn_item(const bf16_t* __restrict__ Q, const bf16_t* __restrict__ Kp, const bf16_t* __restrict__ Vt, int ldv,
                  int kbeg, int kend, int q0, const float* bias_g, float scale_log2,
                  bf16_t* __restrict__ out, size_t out_rs, float* __restrict__ lse, int lse_rs, char* lds) {
  constexpr int KROW = DQK * 2 + 16;
  constexpr int KST = 64 * KROW, VST = 64 * LROW, ST = KST + VST;
  constexpr int NKS = DQK / 16;
  constexpr int KV4 = DQK / 8;
  constexpr int NKL = (64 * KV4) / 256;
  constexpr int WQ = 32 * QT;
  const int tid = tid_(), lane = tid & 63, w = tid >> 6, h = lane >> 5, ql = lane & 31;
  float* bias_l = (float*)(lds + 2 * ST);
  if (BAND) { if (tid < 129) bias_l[tid] = bias_g[tid]; }
  bf16x8 qf[QT][NKS];
#pragma unroll
  for (int qt = 0; qt < QT; ++qt)
#pragma unroll
    for (int ks = 0; ks < NKS; ++ks) qf[qt][ks] = *(const bf16x8*)(Q + (size_t)(w * WQ + qt * 32 + ql) * DQK + ks * 16 + h * 8);
  f32x16 o[2][QT];
#pragma unroll
  for (int a = 0; a < 2; ++a)
#pragma unroll
    for (int b = 0; b < QT; ++b)
#pragma unroll
      for (int r = 0; r < 16; ++r) o[a][b][r] = 0.f;
  float m[QT], l[QT];
#pragma unroll
  for (int qt = 0; qt < QT; ++qt) { m[qt] = -1e30f; l[qt] = 0.f; }
  u32x4 rk[NKL], rv[2];
  const int vrow0 = tid >> 3, vch = tid & 7;
  auto gload = [&](int kt) {
#pragma unroll
    for (int i = 0; i < NKL; ++i) { const int idx = tid + i * 256, kr = idx / KV4, kc = idx - kr * KV4; rk[i] = *(const u32x4*)(Kp + (size_t)(kt + kr) * DQK + kc * 8); }
#pragma unroll
    for (int i = 0; i < 2; ++i) rv[i] = *(const u32x4*)(Vt + (size_t)(vrow0 + 32 * i) * ldv + kt + vch * 8);
  };
  auto lstore = [&](char* st) {
#pragma unroll
    for (int i = 0; i < NKL; ++i) { const int idx = tid + i * 256, kr = idx / KV4, kc = idx - kr * KV4; *(u32x4*)(st + kr * KROW + kc * 16) = rk[i]; }
#pragma unroll
    for (int i = 0; i < 2; ++i) *(u32x4*)(st + KST + (vrow0 + 32 * i) * LROW + vch * 16) = rv[i];
  };
  gload(kbeg);
  lstore(lds);
  __syncthreads();
  const int pr = (ql & ~12) | ((ql & 4) << 1) | ((ql & 8) >> 1);
  const int k_rd = pr * KROW + h * 16;
  const int v_rd = KST + ql * LROW + h * 16;
  const int qw0 = q0 + w * WQ;
  int it = 0;
  for (int kt = kbeg; kt < kend; kt += 64, ++it) {
    const char* st = lds + (it & 1) * ST;
    const bool more = (kt + 64 < kend);
    if (more) gload(kt + 64);
    bool need = true;
    if (BAND) need = (kt + 63 >= qw0 - 64) && (kt <= qw0 + WQ - 1 + 64);
    if (need) {
      f32x16 s[2][QT];
#pragma unroll
      for (int a = 0; a < 2; ++a)
#pragma unroll
        for (int b = 0; b < QT; ++b)
#pragma unroll
          for (int r = 0; r < 16; ++r) s[a][b][r] = 0.f;
#pragma unroll
      for (int ks = 0; ks < NKS; ++ks) {
        const bf16x8 k0 = *(const bf16x8*)(st + k_rd + ks * 32);
        const bf16x8 k1 = *(const bf16x8*)(st + k_rd + 32 * KROW + ks * 32);
#pragma unroll
        for (int qt = 0; qt < QT; ++qt) {
          s[0][qt] = MFMA(k0, qf[qt][ks], s[0][qt]);
          s[1][qt] = MFMA(k1, qf[qt][ks], s[1][qt]);
        }
      }
      bf16x8 pf[QT][4];
#pragma unroll
      for (int qt = 0; qt < QT; ++qt) {
        float mx = -1e30f;
#pragma unroll
        for (int a = 0; a < 2; ++a)
#pragma unroll
          for (int r = 0; r < 16; ++r) {
            float v = s[a][qt][r] * scale_log2;
            if (BAND) {
              const int kidx = kt + 32 * a + (r & 7) + 8 * h + 16 * (r >> 3);
              const int rel = kidx - (qw0 + qt * 32 + ql);
              const bool ok = (rel >= -64) && (rel <= 64);
              const int bi = ok ? rel + 64 : 0;
              v = ok ? v + bias_l[bi] : -1e30f;
            }
            s[a][qt][r] = v;
            mx = fmaxf(mx, v);
          }
        mx = fmaxf(mx, __shfl_xor(mx, 32));
        const float mn = fmaxf(m[qt], mx);
        const float alpha = __builtin_amdgcn_exp2f(m[qt] - mn);
        m[qt] = mn;
        float ls = 0.f;
#pragma unroll
        for (int a = 0; a < 2; ++a) {
#pragma unroll
          for (int r = 0; r < 16; ++r) { const float pv = __builtin_amdgcn_exp2f(s[a][qt][r] - mn); s[a][qt][r] = pv; ls += pv; }
#pragma unroll
          for (int s2 = 0; s2 < 2; ++s2) {
            u32x4 pk;
            pk.x = pk2(s[a][qt][8 * s2 + 0], s[a][qt][8 * s2 + 1]);
            pk.y = pk2(s[a][qt][8 * s2 + 2], s[a][qt][8 * s2 + 3]);
            pk.z = pk2(s[a][qt][8 * s2 + 4], s[a][qt][8 * s2 + 5]);
            pk.w = pk2(s[a][qt][8 * s2 + 6], s[a][qt][8 * s2 + 7]);
            pf[qt][a * 2 + s2] = __builtin_bit_cast(bf16x8, pk);
          }
        }
        l[qt] = l[qt] * alpha + ls;
#pragma unroll
        for (int r = 0; r < 16; ++r) { o[0][qt][r] *= alpha; o[1][qt][r] *= alpha; }
      }
#pragma unroll
      for (int ks = 0; ks < 4; ++ks) {
        const bf16x8 v0 = *(const bf16x8*)(st + v_rd + ks * 32);
        const bf16x8 v1 = *(const bf16x8*)(st + v_rd + 32 * LROW + ks * 32);
#pragma unroll
        for (int qt = 0; qt < QT; ++qt) {
          o[0][qt] = MFMA(v0, pf[qt][ks], o[0][qt]);
          o[1][qt] = MFMA(v1, pf[qt][ks], o[1][qt]);
        }
      }
    }
    if (more) lstore(lds + ((it + 1) & 1) * ST);
    __syncthreads();
  }
#pragma unroll
  for (int qt = 0; qt < QT; ++qt) {
    const float lt = l[qt] + __shfl_xor(l[qt], 32);
    const float inv = 1.0f / lt;
    const int qi = w * WQ + qt * 32 + ql;
    bf16_t* orow = out + (size_t)qi * out_rs;
#pragma unroll
    for (int dt = 0; dt < 2; ++dt)
#pragma unroll
      for (int g = 0; g < 4; ++g) {
        u32x2 p; p.x = pk2(o[dt][qt][4 * g] * inv, o[dt][qt][4 * g + 1] * inv); p.y = pk2(o[dt][qt][4 * g + 2] * inv, o[dt][qt][4 * g + 3] * inv);
        *(u32x2*)(orow + dt * 32 + 8 * g + 4 * h) = p;
      }
    if (BAND) { if (h == 0) lse[(size_t)qi * lse_rs] = m[qt] * LN2 + __logf(lt); }
  }
}

constexpr int AQT = 1;
constexpr int QBLK = 128 * AQT;
DI void phase_attn(const Ctx& c) {
  const int S = c.S, nseq = TC / S, nqb = S / QBLK;
  const int n_mla = nseq * 8 * nqb, n_gqa = n_mla, n_dil = nseq * 12 * nqb;
  const float* bias = (const float*)(c.ws + OFF_BIAS);
  for (int item = blockIdx.x; item < n_mla + n_gqa + n_dil; item += gridDim.x) {
    if (item < n_mla) {
      const int hh = item & 7, rest = item >> 3, seq = rest / nqb, qb = rest - seq * nqb;
      const size_t hs = (size_t)(seq * 8 + hh) * S;
      attn_item<96, false, AQT>(wsb(c, OFF_QA) + (hs + qb * QBLK) * 96, wsb(c, OFF_KA) + hs * 96, wsb(c, OFF_VTA) + hs * 64, S,
                           0, S, 0, nullptr, 0.10206207261596577f * LOG2E,
                           wsb(c, OFF_OA) + ((size_t)seq * S + qb * QBLK) * 512 + hh * 64, 512, nullptr, 0, c.lds);
    } else if (item < n_mla + n_gqa) {
      const int i2 = item - n_mla;
      const int hq = i2 & 7, rest = i2 >> 3, seq = rest / nqb, qb = rest - seq * nqb;
      const size_t hs = (size_t)(seq * 8 + hq) * S, ks = (size_t)(seq * 2 + (hq >> 2)) * S;
      attn_item<64, false, AQT>(wsb(c, OFF_QC) + (hs + qb * QBLK) * 64, wsb(c, OFF_KC) + ks * 64, wsb(c, OFF_VTC) + ks * 64, S,
                           0, S, 0, nullptr, 0.125f * LOG2E,
                           wsb(c, OFF_OC) + ((size_t)seq * S + qb * QBLK) * 512 + hq * 64, 512, nullptr, 0, c.lds);
    } else {
      const int i2 = item - n_mla - n_gqa;
      const int hb = i2 % 12, rest = i2 / 12, seq = rest / nqb, blk = rest - seq * nqb;
      const int dsh = 2 * (hb >> 2), L = S >> dsh, dil = 1 << dsh;
      const int srow0 = blk * QBLK, rr = srow0 / L, l0 = srow0 - rr * L;
      const size_t hs = (size_t)(seq * 12 + hb) * S;
      int kb = l0 - 64; if (kb < 0) kb = 0;
      int ke = l0 + QBLK + 64; if (ke > L) ke = L;
      const size_t tok0 = (size_t)seq * S + (size_t)l0 * dil + rr;
      attn_item<64, true, AQT>(wsb(c, OFF_QB) + (hs + srow0) * 64, wsb(c, OFF_KB) + (hs + (size_t)rr * L) * 64, wsb(c, OFF_VTB) + hs * 64 + (size_t)rr * L, S,
                          kb, ke, l0, bias + hb * 132, 0.125f * LOG2E,
                          wsb(c, OFF_OBG) + tok0 * 768 + hb * 64, (size_t)dil * 768, (float*)(c.ws + OFF_LSE) + tok0 * 12 + hb, dil * 12, c.lds);
    }
    __syncthreads();
  }
}

DI void phase_combine(const Ctx& c) {
  const bf16_t* obg = wsb(c, OFF_OBG);
  const float* lse = (const float*)(c.ws + OFF_LSE);
  bf16_t* ob = wsb(c, OFF_OB);
  const int total = TC * 4 * 8;
  for (int idx = blockIdx.x * NTHREADS + tid_(); idx < total; idx += gridDim.x * NTHREADS) {
    const int d8 = idx & 7, j = (idx >> 3) & 3, tl = idx >> 5;
    const float l0 = lse[tl * 12 + j], l1 = lse[tl * 12 + 4 + j], l2 = lse[tl * 12 + 8 + j];
    const float mx = fmaxf(l0, fmaxf(l1, l2));
    float w0 = __expf(l0 - mx), w1 = __expf(l1 - mx), w2 = __expf(l2 - mx);
    const float inv = 1.0f / (w0 + w1 + w2);
    w0 *= inv; w1 *= inv; w2 *= inv;
    const u32x4 a = *(const u32x4*)(obg + (size_t)tl * 768 + j * 64 + d8 * 8);
    const u32x4 b = *(const u32x4*)(obg + (size_t)tl * 768 + (4 + j) * 64 + d8 * 8);
    const u32x4 d = *(const u32x4*)(obg + (size_t)tl * 768 + (8 + j) * 64 + d8 * 8);
    u32x4 r;
#pragma unroll
    for (int e = 0; e < 4; ++e) {
      const float lo = w0 * __uint_as_float(a[e] << 16) + w1 * __uint_as_float(b[e] << 16) + w2 * __uint_as_float(d[e] << 16);
      const float hi = w0 * __uint_as_float(a[e] & 0xffff0000u) + w1 * __uint_as_float(b[e] & 0xffff0000u) + w2 * __uint_as_float(d[e] & 0xffff0000u);
      r[e] = pk2(lo, hi);
    }
    *(u32x4*)(ob + (size_t)tl * 256 + j * 64 + d8 * 8) = r;
  }
}

DI void phase_merge(const Ctx& c) {
  const bf16_t* xb = wsb(c, OFF_XB);
  const float* ss = ss_site(c, c.layer, 1);
  const float* bgate = inl(c, 21, 3072);
  bf16_t* mrg = wsb(c, OFF_MRG);
  float* cl = (float*)c.lds; float* rr = (float*)(c.lds + OFF_RR);
  const int tid = tid_(), lane = tid & 63, w = tid >> 6, wm = w >> 1, wn = w & 1, h = lane >> 5, cc = lane & 31;
  const int xcd_ = blockIdx.x & 7, slot_ = blockIdx.x >> 3, nslot_ = gridDim.x >> 3;
  for (int j_ = slot_; j_ < 16 * 16; j_ += nslot_) {
    const int mt = xcd_ * 16 + (j_ & 15), nt = j_ >> 4;
    __syncthreads();
    if (tid < 128) rr[tid] = rsqrtf(ss[mt * 128 + tid] * (1.0f / DM) + EPS);
    f32x16 macc[2][1]; zero_acc<1>(macc);
#pragma unroll 1
    for (int k = 0; k < 3; ++k) {
      f32x16 gacc[2][1]; zero_acc<1>(gacc);
      gemm_mainloop<1>(xb + (size_t)mt * 128 * DM, DM, wgt(c, W_GATE) + (size_t)(k * 1024 + nt * 64) * DM, DM, DM, gacc, c.lds);
      const float bv = bgate[k * 1024 + nt * 64 + wn * 32 + cc];
#pragma unroll
      for (int i = 0; i < 2; ++i)
#pragma unroll
        for (int r = 0; r < 16; ++r) {
          const float rv = rr[wm * 64 + i * 32 + (r & 3) + 8 * (r >> 2) + 4 * h];
          gacc[i][0][r] = sigmoidf_(gacc[i][0][r] * rv + bv);
        }
      f32x16 acc[2][1]; zero_acc<1>(acc);
      const int Kk = (k == 1) ? 256 : 512;
      const bf16_t* Ao = wsb(c, k == 0 ? OFF_OA : (k == 1 ? OFF_OB : OFF_OC));
      const bf16_t* Wo = wgt(c, k == 0 ? W_OA : (k == 1 ? W_OB : W_OC));
      gemm_mainloop<1>(Ao + (size_t)mt * 128 * Kk, Kk, Wo + (size_t)nt * 64 * Kk, Kk, Kk, acc, c.lds);
#pragma unroll
      for (int i = 0; i < 2; ++i)
#pragma unroll
        for (int r = 0; r < 16; ++r) macc[i][0][r] += gacc[i][0][r] * acc[i][0][r];
    }
    acc_to_lds<1>(macc, cl);
    __syncthreads();
    const int c4 = (tid & 15) * 4, r0 = tid >> 4;
#pragma unroll 4
    for (int it = 0; it < 8; ++it) {
      const int row = r0 + 16 * it;
      const f32x4 v = *(const f32x4*)(cl + row * CLD + c4);
      u32x2 p; p.x = pk2(v[0], v[1]); p.y = pk2(v[2], v[3]);
      *(u32x2*)(mrg + (size_t)(mt * 128 + row) * DM + nt * 64 + c4) = p;
    }
    __syncthreads();
  }
}

DI void phase_ple(const Ctx& c) {
  const bf16_t* xb = wsb(c, OFF_XB);
  const float* ss = ss_site(c, c.layer, 3);
  float* ssn = ss_site(c, c.layer + 1, 0);
  const bf16_t* peb = wsb(c, OFF_PEB) + (size_t)c.layer * TC * 256;
  float* cl = (float*)c.lds; float* rr = (float*)(c.lds + OFF_RR);
  const int tid = tid_(), lane = tid & 63, w = tid >> 6, wm = w >> 1, h = lane >> 5;
  const int xcd_ = blockIdx.x & 7, slot_ = blockIdx.x >> 3, nslot_ = gridDim.x >> 3;
  for (int j_ = slot_; j_ < 16 * 16; j_ += nslot_) {
    const int mt = xcd_ * 16 + (j_ & 15), nt = j_ >> 4;
    if (tid < 128) rr[tid] = rsqrtf(ss[mt * 128 + tid] * (1.0f / DM) + EPS);
    f32x16 g[2][1]; zero_acc<1>(g);
    gemm_mainloop<1>(xb + (size_t)mt * 128 * DM, DM, wgt(c, W_PG) + (size_t)nt * 64 * DM, DM, DM, g, c.lds);
#pragma unroll
    for (int i = 0; i < 2; ++i)
#pragma unroll
      for (int r = 0; r < 16; ++r) {
        const float rv = rr[wm * 64 + i * 32 + (r & 3) + 8 * (r >> 2) + 4 * h];
        g[i][0][r] = sigmoidf_(g[i][0][r] * rv);
      }
    f32x16 acc[2][1]; zero_acc<1>(acc);
    gemm_mainloop<1>(peb + (size_t)mt * 128 * 256, 256, wgt(c, W_PLE) + (size_t)nt * 64 * 256, 256, 256, acc, c.lds);
#pragma unroll
    for (int i = 0; i < 2; ++i)
#pragma unroll
      for (int r = 0; r < 16; ++r) acc[i][0][r] *= g[i][0][r];
    acc_to_lds<1>(acc, cl);
    __syncthreads();
    resid_epilogue<1>(c.x, wsb(c, OFF_XB2), ssn, mt, nt, cl, 1.0f);
    __syncthreads();
  }
}

DI void phase_prologue(const Params& p, char* lds) {
  float* tl = (float*)lds;
  bf16_t* W = (bf16_t*)(p.ws + OFF_W);
  int rot = 0;
  for (int L = 0; L < 2; ++L) {
    bf16_t* wl = W + (size_t)L * W_LAYER;
    transpose_mat(p.in[5] + (size_t)L * 1024 * 5632, 5632, wl + W_FFN1_IN, 5632, 1024, p.in[4] + L * 1024, 1, tl, rot); rot += 88 * 16;
    transpose_mat(p.in[6] + (size_t)L * 2816 * 1024, 1024, wl + W_FFN1_OUT, 1024, 2816, nullptr, 0, tl, rot); rot += 16 * 44;
    transpose_mat(p.in[8] + (size_t)L * 1024 * 3488, 3488, wl + W_IN, 3584, 1024, p.in[7] + L * 1024, 2, tl, rot); rot += 56 * 16;
    transpose_mat(p.in[20] + (size_t)L * 1024 * 3072, 3072, wl + W_GATE, 3072, 1024, p.in[7] + L * 1024, 0, tl, rot); rot += 48 * 16;
    transpose_mat(p.in[11] + (size_t)L * 256 * 768, 768, wl + W_UQ, 768, 256, p.in[9] + L * 256, 3, tl, rot); rot += 12 * 4;
    transpose_mat(p.in[12] + (size_t)L * 128 * 1024, 1024, wl + W_UKV, 1024, 128, p.in[10] + L * 128, 4, tl, rot); rot += 16 * 2;
    transpose_mat(p.in[22] + (size_t)L * 512 * 1024, 1024, wl + W_OA, 1024, 512, nullptr, 0, tl, rot); rot += 16 * 8;
    transpose_mat(p.in[23] + (size_t)L * 256 * 1024, 1024, wl + W_OB, 1024, 256, nullptr, 0, tl, rot); rot += 16 * 4;
    transpose_mat(p.in[24] + (size_t)L * 512 * 1024, 1024, wl + W_OC, 1024, 512, nullptr, 0, tl, rot); rot += 16 * 8;
    transpose_mat(p.in[25] + (size_t)L * 1024 * 1024, 1024, wl + W_OUT, 1024, 1024, nullptr, 0, tl, rot); rot += 16 * 16;
    transpose_mat(p.in[27] + (size_t)L * 1024 * 5632, 5632, wl + W_FFN2_IN, 5632, 1024, p.in[26] + L * 1024, 1, tl, rot); rot += 88 * 16;
    transpose_mat(p.in[28] + (size_t)L * 2816 * 1024, 1024, wl + W_FFN2_OUT, 1024, 2816, nullptr, 0, tl, rot); rot += 16 * 44;
    transpose_mat(p.in[30] + (size_t)L * 1024 * 1024, 1024, wl + W_PG, 1024, 1024, p.in[29] + L * 1024, 0, tl, rot); rot += 16 * 16;
    transpose_mat(p.in[31] + (size_t)L * 256 * 1024, 1024, wl + W_PLE, 1024, 256, nullptr, 0, tl, rot); rot += 16 * 4;
  }
  const int gtid = blockIdx.x * NTHREADS + tid_(), gn = gridDim.x * NTHREADS;
  f32x2* rope = (f32x2*)(p.ws + OFF_ROPE);
  for (int idx = gtid; idx < 16384 * 16; idx += gn) {
    const int pos = idx >> 4, i = idx & 15;
    const float freq = (float)pow(10000.0, -(double)i / 16.0);
    const float ang = (float)pos * freq;
    f32x2 cs; cs.x = (float)cos((double)ang); cs.y = (float)sin((double)ang);
    rope[idx] = cs;
  }
  float* bias = (float*)(p.ws + OFF_BIAS);
  for (int idx = gtid; idx < 12 * 129; idx += gn) {
    const int hb = idx / 129, jj = idx - hb * 129;
    const int dil = 1 << (2 * (hb >> 2));
    const int rel = (jj - 64) * dil;
    const int n = rel < 0 ? -rel : rel;
    int b;
    if (n < 8) b = n;
    else { int lg = 8 + (int)(log((double)n / 8.0) / log(128.0) * 8.0); if (lg > 15) lg = 15; b = lg; }
    if (rel > 0) b += 16;
    bias[hb * 132 + jj] = p.in[17][b * 12 + hb] * LOG2E;
  }
}

DI void phase_init(const Ctx& c) {
  const int tid = tid_(), lane = tid & 63;
  const int gw = blockIdx.x * 4 + (tid >> 6), nw = gridDim.x * 4;
  bf16_t* xb = wsb(c, OFF_XB);
  float* ss0 = ss_site(c, 0, 0);
  for (int row = gw; row < TC; row += nw) {
    float s = 0.f;
#pragma unroll
    for (int i = 0; i < 4; ++i) {
      const size_t gi = (size_t)row * DM + i * 256 + lane * 4;
      const f32x4 v = *(const f32x4*)(c.xin + gi);
      *(f32x4*)(c.x + gi) = v;
      u32x2 p; p.x = pk2(v[0], v[1]); p.y = pk2(v[2], v[3]);
      *(u32x2*)(xb + gi) = p;
      s += v[0] * v[0] + v[1] * v[1] + v[2] * v[2] + v[3] * v[3];
    }
#pragma unroll
    for (int o = 32; o >= 1; o >>= 1) s += __shfl_xor(s, o);
    if (lane == 0) ss0[row] = s;
  }
  const int gtid = blockIdx.x * NTHREADS + tid, gn = gridDim.x * NTHREADS;
  float* ssall = (float*)(c.ws + OFF_SS);
  for (int idx = gtid + TC; idx < 3 * 6 * TC; idx += gn) ssall[idx] = 0.f;
  bf16_t* peb = wsb(c, OFF_PEB);
  for (int idx = gtid; idx < 2 * TC * 64; idx += gn) {
    const int L = idx / (TC * 64), r = idx - L * (TC * 64);
    const f32x4 v = *(const f32x4*)(c.pe0 + (size_t)L * c.pe_ls + (size_t)r * 4);
    u32x2 p; p.x = pk2(v[0], v[1]); p.y = pk2(v[2], v[3]);
    *(u32x2*)(peb + (size_t)idx * 4) = p;
  }
}

#ifndef ONLY
#define ONLY -1
#endif
#define PH(n) (ONLY < 0 || ONLY == (n))
#ifndef DUP
#define DUP -1
#endif
#if DUP == 200
#define GSYNC() do { xcd_barrier(xb); xcd_barrier(xb); } while (0)
#else
#define GSYNC() xcd_barrier(xb)
#endif
#define REP(n) for (int rep_ = 0; rep_ < ((DUP == (n) || (DUP == 100 && ((n) == 2 || (n) == 10))) ? 2 : 1); ++rep_)
__global__ void __launch_bounds__(NTHREADS, 2) mega_kernel(Params p) {
  extern __shared__ __attribute__((aligned(16))) char lds[];
  cg::grid_group grid = cg::this_grid();
  volatile LAS unsigned* xst = (volatile LAS unsigned*)(lds + OFF_RR + 512);
  if (threadIdx.x == 0) { xst[0] = 0u; xst[1] = 0u; }
  __syncthreads();
  const XcdBarrier xb = xcd_barrier_post((unsigned*)(p.ws + OFF_BAR), xst);
  REP(0) { if (PH(0)) phase_prologue(p, lds); grid.sync(); }
  for (int chunk = 0; chunk < 3; ++chunk) {
    Ctx c;
    c.p = &p; c.chunk = chunk; c.layer = 0; c.ws = p.ws; c.lds = lds;
    c.S = chunk == 0 ? 4096 : 16384; c.sshift = chunk == 0 ? 12 : 14;
    c.x = p.out + (size_t)chunk * TC * DM;
    c.xin = chunk == 0 ? p.in[0] : p.in[1] + (size_t)(chunk - 1) * TC * DM;
    c.pe0 = chunk == 0 ? p.in[2] : p.in[3] + (size_t)(chunk - 1) * TC * 256;
    c.pe_ls = chunk == 0 ? (size_t)TC * 256 : (size_t)2 * TC * 256;
    REP(1) { if (PH(1)) phase_init(c); GSYNC(); }
#pragma unroll 1
    for (int layer = 0; layer < 2; ++layer) {
      c.layer = layer;
      REP(2) { if (PH(2)) phase_ffn_in(c, wsb(c, layer == 0 ? OFF_XB : OFF_XB2), W_FFN1_IN, 0); GSYNC(); }
      REP(3) { if (PH(3)) phase_resid_gemm(c, wsb(c, OFF_ACT), DFF, W_FFN1_OUT, 0.5f, ss_site(c, layer, 1)); GSYNC(); }
      REP(4) { if (PH(4)) phase_proj(c); GSYNC(); }
      REP(5) { if (PH(5)) phase_mlaup(c); GSYNC(); }
      REP(6) { if (PH(6)) phase_attn(c); GSYNC(); }
      REP(7) { if (PH(7)) phase_combine(c); GSYNC(); }
      REP(8) { if (PH(8)) phase_merge(c); GSYNC(); }
      REP(9) { if (PH(9)) phase_resid_gemm(c, wsb(c, OFF_MRG), DM, W_OUT, 1.0f, ss_site(c, layer, 2)); GSYNC(); }
      REP(10) { if (PH(10)) phase_ffn_in(c, wsb(c, OFF_XB), W_FFN2_IN, 2); GSYNC(); }
      REP(11) { if (PH(11)) phase_resid_gemm(c, wsb(c, OFF_ACT), DFF, W_FFN2_OUT, 0.5f, ss_site(c, layer, 3)); GSYNC(); }
      REP(12) { if (PH(12)) phase_ple(c); GSYNC(); }
    }
  }
}

extern "C" void kernel_launch(void* const* d_in, const int* in_sizes, int n_in, void* d_out, int out_size, void* d_ws, size_t ws_size, hipStream_t stream) {
  static int grid_blocks = 0;
  if (!grid_blocks) {
    int dev = 0, cus = 0, per_cu = 0;
    hipGetDevice(&dev);
    hipDeviceGetAttribute(&cus, hipDeviceAttributeMultiprocessorCount, dev);
    hipFuncSetAttribute((const void*)mega_kernel, hipFuncAttributeMaxDynamicSharedMemorySize, LDS_BYTES);
    hipOccupancyMaxActiveBlocksPerMultiprocessor(&per_cu, mega_kernel, NTHREADS, LDS_BYTES);
    if (per_cu > 2) per_cu = 2;
    if (per_cu < 1) per_cu = 1;
    grid_blocks = cus * per_cu;
  }
  Params p{};
  for (int i = 0; i < 32; ++i) p.in[i] = (const float*)d_in[i];
  p.out = (float*)d_out;
  p.ws = (char*)d_ws;
  hipMemsetAsync((char*)d_ws + OFF_BAR, 0, 16384, stream);
  void* args[] = {&p};
  hipError_t e = hipLaunchCooperativeKernel((const void*)mega_kernel, dim3(grid_blocks), dim3(NTHREADS), args, LDS_BYTES, stream);
  if (e != hipSuccess) fprintf(stderr, "cooperative launch failed: %s (grid %d)\n", hipGetErrorString(e), grid_blocks);
}
```

```cpp
#include <hip/hip_runtime.h>
#include <hip/hip_cooperative_groups.h>
#include <stdint.h>
#include <cstdio>
namespace cg = cooperative_groups;

typedef unsigned short bf16_t;
typedef short bf16x8 __attribute__((ext_vector_type(8)));
typedef float f32x16 __attribute__((ext_vector_type(16)));
typedef float f32x4 __attribute__((ext_vector_type(4)));
typedef float f32x2 __attribute__((ext_vector_type(2)));
typedef unsigned u32x4 __attribute__((ext_vector_type(4)));
typedef unsigned u32x2 __attribute__((ext_vector_type(2)));
typedef __bf16 bf16x2_t __attribute__((ext_vector_type(2)));
#define DI __device__ __forceinline__
#define MFMA(a, b, c) __builtin_amdgcn_mfma_f32_32x32x16_bf16((a), (b), (c), 0, 0, 0)

constexpr int TC = 16384;
constexpr int DM = 1024;
constexpr int DFF = 2816;
constexpr float EPS = 1e-6f;
constexpr float LOG2E = 1.4426950408889634f;
constexpr float LN2 = 0.6931471805599453f;
constexpr int NTHREADS = 256;

constexpr size_t W_FFN1_IN = 0;
constexpr size_t W_FFN1_OUT = W_FFN1_IN + (size_t)5632 * 1024;
constexpr size_t W_IN = W_FFN1_OUT + (size_t)1024 * 2816;
constexpr size_t W_GATE = W_IN + (size_t)3584 * 1024;
constexpr size_t W_UQ = W_GATE + (size_t)3072 * 1024;
constexpr size_t W_UKV = W_UQ + (size_t)768 * 256;
constexpr size_t W_OA = W_UKV + (size_t)1024 * 128;
constexpr size_t W_OB = W_OA + (size_t)1024 * 512;
constexpr size_t W_OC = W_OB + (size_t)1024 * 256;
constexpr size_t W_OUT = W_OC + (size_t)1024 * 512;
constexpr size_t W_FFN2_IN = W_OUT + (size_t)1024 * 1024;
constexpr size_t W_FFN2_OUT = W_FFN2_IN + (size_t)5632 * 1024;
constexpr size_t W_PG = W_FFN2_OUT + (size_t)1024 * 2816;
constexpr size_t W_PLE = W_PG + (size_t)1024 * 1024;
constexpr size_t W_LAYER = W_PLE + (size_t)1024 * 256;

constexpr size_t AL(size_t x) { return (x + 255) & ~(size_t)255; }
constexpr size_t OFF_W = 0;
constexpr size_t OFF_BAR = AL(OFF_W + 2 * W_LAYER * 2);
constexpr size_t OFF_ROPE = AL(OFF_BAR + 16384);
constexpr size_t OFF_BIAS = AL(OFF_ROPE + (size_t)16384 * 16 * 8);
constexpr size_t OFF_SS = AL(OFF_BIAS + 12 * 132 * 4);
constexpr size_t OFF_XB = AL(OFF_SS + (size_t)3 * 6 * TC * 4);
constexpr size_t OFF_XB2 = AL(OFF_XB + (size_t)TC * 1024 * 2);
constexpr size_t OFF_PEB = AL(OFF_XB2 + (size_t)TC * 1024 * 2);
constexpr size_t OFF_BIG = AL(OFF_PEB + (size_t)2 * TC * 256 * 2);
constexpr size_t OFF_ACT = OFF_BIG;
constexpr size_t OFF_CQ = OFF_BIG;
constexpr size_t OFF_CKV = AL(OFF_CQ + (size_t)TC * 256 * 2);
constexpr size_t OFF_QA = AL(OFF_CKV + (size_t)TC * 128 * 2);
constexpr size_t OFF_KA = AL(OFF_QA + (size_t)TC * 768 * 2);
constexpr size_t OFF_VTA = AL(OFF_KA + (size_t)TC * 768 * 2);
constexpr size_t OFF_QB = AL(OFF_VTA + (size_t)TC * 512 * 2);
constexpr size_t OFF_KB = AL(OFF_QB + (size_t)TC * 768 * 2);
constexpr size_t OFF_VTB = AL(OFF_KB + (size_t)TC * 768 * 2);
constexpr size_t OFF_QC = AL(OFF_VTB + (size_t)TC * 768 * 2);
constexpr size_t OFF_KC = AL(OFF_QC + (size_t)TC * 512 * 2);
constexpr size_t OFF_VTC = AL(OFF_KC + (size_t)TC * 128 * 2);
constexpr size_t OFF_OA = AL(OFF_VTC + (size_t)TC * 128 * 2);
constexpr size_t OFF_OBG = AL(OFF_OA + (size_t)TC * 512 * 2);
constexpr size_t OFF_LSE = AL(OFF_OBG + (size_t)TC * 768 * 2);
constexpr size_t OFF_OB = AL(OFF_LSE + (size_t)TC * 12 * 4);
constexpr size_t OFF_OC = AL(OFF_OB + (size_t)TC * 256 * 2);
constexpr size_t OFF_MRG = AL(OFF_OC + (size_t)TC * 512 * 2);
constexpr size_t OFF_END = AL(OFF_MRG + (size_t)TC * 1024 * 2);
static_assert(OFF_END < (size_t)500 * 1024 * 1024, "workspace too large");
static_assert(OFF_ACT + (size_t)TC * DFF * 2 <= OFF_END, "act fits");

struct Params {
  const float* in[32];
  float* out;
  char* ws;
};

constexpr int LROW = 144;
constexpr int STAGE_OP = 128 * LROW;
constexpr int STAGE = 2 * STAGE_OP;
constexpr int CLD = 132;
constexpr int OFF_RR = 2 * STAGE;
constexpr int LDS_BYTES = 2 * STAGE + 1024;
static_assert(128 * CLD * 4 <= OFF_RR, "lds");

DI int tid_() { int t = threadIdx.x; asm volatile("" : "+v"(t)); return t; }
DI unsigned pk2(float a, float b) { f32x2 v = {a, b}; bf16x2_t r = __builtin_convertvector(v, bf16x2_t); return __builtin_bit_cast(unsigned, r); }
DI bf16_t f2bf(float a) { return (bf16_t)(pk2(a, 0.f) & 0xffffu); }
DI float bf2f(bf16_t v) { return __uint_as_float(((unsigned)v) << 16); }
DI float sigmoidf_(float x) { return 1.0f / (1.0f + __expf(-x)); }

DI int map_col(int map, int n) {
  switch (map) {
    case 0: return n;
    case 1: { int t = n >> 7, w = n & 127; return w < 64 ? t * 64 + w : DFF + t * 64 + (w - 64); }
    case 2: { int slot = n >> 6, d = n & 63; if (slot < 6) return n; if (slot == 6) return d < 32 ? 384 + d : -1; if (slot < 55) return 416 + (n - 448); return -1; }
    case 3: { if (n < 512) return (n >> 6) * 96 + (n & 63); int i = n - 512; return (i >> 5) * 96 + 64 + (i & 31); }
    default: { if (n < 512) return (n >> 6) * 128 + (n & 63); int i = n - 512; return (i >> 6) * 128 + 64 + (i & 63); }
  }
}

DI void transpose_mat(const float* __restrict__ src, int ld_src, bf16_t* __restrict__ dst, int N, int K, const float* __restrict__ gain, int map, float* lds, int rot) {
  const int ntk = K >> 6, ntn = N >> 6, nt = ntk * ntn;
  const int tid = tid_(), c = tid & 63, rq = tid >> 6;
  int b0 = (int)blockIdx.x - (rot % (int)gridDim.x); if (b0 < 0) b0 += gridDim.x;
  for (int t = b0; t < nt; t += gridDim.x) {
    const int tn = t / ntk, tk = t - tn * ntk;
    const int n0 = tn << 6, k0 = tk << 6;
    const int sc = map_col(map, n0 + c);
#pragma unroll 4
    for (int r = 0; r < 16; ++r) {
      const int kk = r * 4 + rq;
      float v = 0.f;
      if (sc >= 0) { v = src[(size_t)(k0 + kk) * ld_src + sc]; if (gain) v *= gain[k0 + kk]; }
      lds[c * 65 + kk] = v;
    }
    __syncthreads();
#pragma unroll 4
    for (int r = 0; r < 16; ++r) {
      const int nn = r * 4 + rq;
      dst[(size_t)(n0 + nn) * K + k0 + c] = f2bf(lds[nn * 65 + c]);
    }
    __syncthreads();
  }
}

template <int NJ> DI void zero_acc(f32x16 (&acc)[2][NJ]) {
#pragma unroll
  for (int i = 0; i < 2; ++i)
#pragma unroll
    for (int j = 0; j < NJ; ++j)
#pragma unroll
      for (int r = 0; r < 16; ++r) acc[i][j][r] = 0.f;
}

template <int NJ> DI void gemm_mainloop(const bf16_t* __restrict__ A, int lda, const bf16_t* __restrict__ Bt, int ldb, int K, f32x16 (&acc)[2][NJ], char* lds) {
  const int tid = tid_(), lane = tid & 63, w = tid >> 6, wm = w >> 1, wn = w & 1;
  const int lr = tid >> 3, lc = tid & 7;
  const bf16_t* ap = A + (size_t)lr * lda + lc * 8;
  const bf16_t* bp = Bt + (size_t)lr * ldb + lc * 8;
  const size_t astep = (size_t)32 * lda, bstep = (size_t)32 * ldb;
  constexpr int NB = 2 * NJ;
  u32x4 ra0[4], rb0[NB], ra1[4], rb1[NB];
  const int wofs = lr * LROW + lc * 16;
  const int a_rd = (wm * 64 + (lane & 31)) * LROW + (lane >> 5) * 16;
  const int b_rd = STAGE_OP + (wn * 32 * NJ + (lane & 31)) * LROW + (lane >> 5) * 16;
#define GL1_(RA, RB, i) { RA[i] = *(const u32x4*)(ap + (i) * astep); if ((i) < NB) RB[(i) < NB ? (i) : 0] = *(const u32x4*)(bp + (i) * bstep); }
#define LS1_(RA, RB, ST, i) { char* sn_ = lds + (ST) * STAGE; *(u32x4*)(sn_ + wofs + (i) * 32 * LROW) = RA[i]; \
                              if ((i) < NB) *(u32x4*)(sn_ + STAGE_OP + wofs + (i) * 32 * LROW) = RB[(i) < NB ? (i) : 0]; }
#define RF_(ks) { fa0 = *(const bf16x8*)(st_ + a_rd + (ks) * 32); fa1 = *(const bf16x8*)(st_ + a_rd + 32 * LROW + (ks) * 32); \
      _Pragma("unroll") for (int j = 0; j < NJ; ++j) fb[j] = *(const bf16x8*)(st_ + b_rd + j * 32 * LROW + (ks) * 32); }
#define STEP_(ST, DOL, RAL, RBL, DOS, RAS, RBS) { const char* st_ = lds + (ST) * STAGE; \
    bf16x8 fa0, fa1, fb[NJ]; RF_(0); \
    _Pragma("unroll") for (int ks = 0; ks < 4; ++ks) { \
      if (DOL) GL1_(RAL, RBL, ks); \
      const bf16x8 ca0 = fa0, ca1 = fa1; bf16x8 cb[NJ]; \
      _Pragma("unroll") for (int j = 0; j < NJ; ++j) cb[j] = fb[j]; \
      if (ks < 3) RF_(ks + 1); \
      _Pragma("unroll") for (int j = 0; j < NJ; ++j) { acc[0][j] = MFMA(ca0, cb[j], acc[0][j]); acc[1][j] = MFMA(ca1, cb[j], acc[1][j]); } \
      if (DOS) LS1_(RAS, RBS, 1 - (ST), ks); \
      __builtin_amdgcn_sched_barrier(0); } \
    if (DOL) { ap += 64; bp += 64; } }
#pragma unroll
  for (int i = 0; i < 4; ++i) GL1_(ra0, rb0, i);
  ap += 64; bp += 64;
#pragma unroll
  for (int i = 0; i < 4; ++i) GL1_(ra1, rb1, i);
  ap += 64; bp += 64;
#pragma unroll
  for (int i = 0; i < 4; ++i) LS1_(ra0, rb0, 0, i);
  __syncthreads();
  const int nk = K >> 6;
  for (int kt = 0; kt < nk; kt += 2) {
    const bool l0 = (kt + 2 < nk), l1 = (kt + 3 < nk);
    STEP_(0, l0, ra0, rb0, true, ra1, rb1);
    __syncthreads();
    STEP_(1, l1, ra1, rb1, l0, ra0, rb0);
    __syncthreads();
  }
#undef GL1_
#undef LS1_
#undef STEP_
#undef RF_
}

template <int NJ> DI void acc_to_lds(const f32x16 (&acc)[2][NJ], float* cl) {
  const int tid = tid_(), lane = tid & 63, w = tid >> 6, wm = w >> 1, wn = w & 1, h = lane >> 5, c = lane & 31;
#pragma unroll
  for (int i = 0; i < 2; ++i)
#pragma unroll
    for (int j = 0; j < NJ; ++j)
#pragma unroll
      for (int r = 0; r < 16; ++r) {
        const int row = wm * 64 + i * 32 + (r & 3) + 8 * (r >> 2) + 4 * h;
        cl[row * CLD + wn * 32 * NJ + j * 32 + c] = acc[i][j][r];
      }
}

template <int NJ> DI void resid_epilogue(float* __restrict__ x, bf16_t* __restrict__ xb, float* __restrict__ ssn, int mt, int nt, const float* cl, float scale) {
  constexpr int LPR = 16 * NJ, RPP = 256 / LPR, NP = 128 / RPP;
  const int tid = tid_(), c4 = (tid & (LPR - 1)) * 4, r0 = tid / LPR;
#pragma unroll 4
  for (int it = 0; it < NP; ++it) {
    const int row = r0 + RPP * it;
    const f32x4 c = *(const f32x4*)(cl + row * CLD + c4);
    const size_t gi = (size_t)(mt * 128 + row) * DM + nt * (64 * NJ) + c4;
    f32x4 xv = *(const f32x4*)(x + gi);
    xv = xv + scale * c;
    *(f32x4*)(x + gi) = xv;
    u32x2 p; p.x = pk2(xv[0], xv[1]); p.y = pk2(xv[2], xv[3]);
    *(u32x2*)(xb + gi) = p;
    float s_ = xv[0] * xv[0] + xv[1] * xv[1] + xv[2] * xv[2] + xv[3] * xv[3];
    if (NJ == 2) s_ += __shfl_xor(s_, 16);
    s_ += __shfl_xor(s_, 8); s_ += __shfl_xor(s_, 4); s_ += __shfl_xor(s_, 2); s_ += __shfl_xor(s_, 1);
    if ((tid & (LPR - 1)) == 0) atomicAdd(ssn + mt * 128 + row, s_);
  }
}

#define XB_TMO      128
#define XB_XCNT(j)  (256  + 64 * (j))
#define XB_XSUB(j)  (1280 + 64 * (j))
#define XB_XGEN(j)  (2304 + 64 * (j))
#define XB_TOP      3328
#define XB_TOPGEN   3392
#define XCD_BAR_WORDS 3456
#define XB_SPIN_CAP (1u << 22)
#define LAS __attribute__((address_space(3)))
DI unsigned xb_ld(unsigned* p)              { return __hip_atomic_load(p, __ATOMIC_RELAXED, __HIP_MEMORY_SCOPE_AGENT); }
DI unsigned xb_add(unsigned* p, unsigned v) { return __hip_atomic_fetch_add(p, v, __ATOMIC_RELAXED, __HIP_MEMORY_SCOPE_AGENT); }
DI unsigned xb_xcc_id() { return (unsigned)__builtin_amdgcn_s_getreg((3 << 11) | 20) & 0xFu; }
#define XB_SPIN(cond, bar) do { unsigned _sp = 0; while (cond) { __builtin_amdgcn_s_sleep(1); \
    if ((++_sp & 255u) == 0u) { if (xb_ld(&(bar)[XB_TMO])) break; if (_sp > XB_SPIN_CAP) { atomicAdd(&(bar)[XB_TMO], 1u); break; } } } } while (0)
struct XcdBarrier { unsigned* bar; unsigned x; volatile LAS unsigned* st; };
DI XcdBarrier xcd_barrier_post(unsigned* bar, volatile LAS unsigned* st) {
  XcdBarrier b; b.bar = bar; b.x = xb_xcc_id(); b.st = st;
  if (threadIdx.x == 0) (void)xb_add(&bar[XB_XCNT(b.x)], 1u);
  return b;
}
DI void xcd_barrier_complete(unsigned* bar, unsigned x, unsigned& nloc, unsigned& nx) {
  const unsigned G = gridDim.x * gridDim.y * gridDim.z;
  unsigned sum, cnt, mine, sp = 0u;
  for (;;) {
    sum = 0u; cnt = 0u; mine = 0u;
#pragma unroll
    for (unsigned j = 0; j < 16; ++j) { const unsigned c = xb_ld(&bar[XB_XCNT(j)]); sum += c; cnt += (c > 0u) ? 1u : 0u; mine = (j == x) ? c : mine; }
    if (sum == G) break;
    __builtin_amdgcn_s_sleep(1);
    if ((++sp & 255u) == 0u) { if (xb_ld(&bar[XB_TMO])) break; if (sp > XB_SPIN_CAP) { atomicAdd(&bar[XB_TMO], 1u); break; } }
  }
  nloc = mine > 0u ? mine : 1u; nx = cnt > 0u ? cnt : 1u;
}
DI void xcd_barrier(const XcdBarrier& b) {
  asm volatile("s_waitcnt vmcnt(0)" ::: "memory");
  __syncthreads();
  if (threadIdx.x == 0) {
    unsigned* bar = b.bar;
    __builtin_amdgcn_s_waitcnt(0);
    unsigned nloc = b.st[0], nx = b.st[1];
    if (nloc == 0u) { xcd_barrier_complete(bar, b.x, nloc, nx); b.st[0] = nloc; b.st[1] = nx; }
    const unsigned old = xb_add(&bar[XB_XSUB(b.x)], 1u);
    const unsigned gen = old / nloc;
    if (old + 1u == (gen + 1u) * nloc) {
      __builtin_amdgcn_fence(__ATOMIC_RELEASE, "agent");
      asm volatile("s_waitcnt vmcnt(0)" ::: "memory");
      const unsigned og = xb_add(&bar[XB_TOP], 1u);
      const unsigned tg = og / nx;
      if (og + 1u == (tg + 1u) * nx) xb_add(&bar[XB_TOPGEN], 1u);
      else XB_SPIN(xb_ld(&bar[XB_TOPGEN]) == tg, bar);
      __builtin_amdgcn_fence(__ATOMIC_ACQUIRE, "agent");
      xb_add(&bar[XB_XGEN(b.x)], 1u);
      asm volatile("s_waitcnt vmcnt(0)" ::: "memory");
    } else {
      XB_SPIN(xb_ld(&bar[XB_XGEN(b.x)]) == gen, bar);
      __builtin_amdgcn_fence(__ATOMIC_ACQUIRE, "agent");
      asm volatile("s_waitcnt vmcnt(0)" ::: "memory");
    }
  }
  __syncthreads();
}

struct Ctx {
  const Params* p;
  int chunk, layer;
  int S, sshift;
  float* x;
  const float* xin;
  const float* pe0; size_t pe_ls;
  char* ws;
  char* lds;
};
DI bf16_t* wsb(const Ctx& c, size_t off) { return (bf16_t*)(c.ws + off); }
DI float* ss_site(const Ctx& c, int layer, int site) { return (float*)(c.ws + OFF_SS) + ((size_t)layer * 6 + site) * TC; }
DI const bf16_t* wgt(const Ctx& c, size_t off) { return (const bf16_t*)(c.ws + OFF_W) + (size_t)c.layer * W_LAYER + off; }
DI const float* inl(const Ctx& c, int idx, size_t per_layer) { return c.p->in[idx] + (size_t)c.layer * per_layer; }

DI void phase_ffn_in(const Ctx& c, const bf16_t* A, size_t woff, int site) {
  const bf16_t* Bt = wgt(c, woff);
  bf16_t* act = wsb(c, OFF_ACT);
  const float* ss = ss_site(c, c.layer, site);
  float* cl = (float*)c.lds; float* rr = (float*)(c.lds + OFF_RR);
  const int tid = tid_();
  const int xcd_ = blockIdx.x & 7, slot_ = blockIdx.x >> 3, nslot_ = gridDim.x >> 3;
  for (int j_ = slot_; j_ < 16 * 44; j_ += nslot_) {
    const int mt = xcd_ * 16 + (j_ & 15), nt = j_ >> 4;
    f32x16 acc[2][2]; zero_acc<2>(acc);
    gemm_mainloop<2>(A + (size_t)mt * 128 * DM, DM, Bt + (size_t)nt * 128 * DM, DM, DM, acc, c.lds);
    acc_to_lds<2>(acc, cl);
    if (tid < 128) rr[tid] = rsqrtf(ss[mt * 128 + tid] * (1.0f / DM) + EPS);
    __syncthreads();
    const int c4 = (tid & 15) * 4, r0 = tid >> 4;
#pragma unroll 2
    for (int it = 0; it < 8; ++it) {
      const int row = r0 + 16 * it;
      const float r = rr[row];
      const f32x4 a = *(const f32x4*)(cl + row * CLD + c4);
      const f32x4 b = *(const f32x4*)(cl + row * CLD + 64 + c4);
      float o[4];
#pragma unroll
      for (int e = 0; e < 4; ++e) { const float av = a[e] * r, bv = b[e] * r; o[e] = av * sigmoidf_(av) * bv; }
      u32x2 pq; pq.x = pk2(o[0], o[1]); pq.y = pk2(o[2], o[3]);
      *(u32x2*)(act + (size_t)(mt * 128 + row) * DFF + nt * 64 + c4) = pq;
    }
    __syncthreads();
  }
}

DI void phase_resid_gemm(const Ctx& c, const bf16_t* A, int K, size_t woff, float scale, float* ssn) {
  const bf16_t* Bt = wgt(c, woff);
  bf16_t* xb = wsb(c, OFF_XB);
  float* cl = (float*)c.lds;
  const int xcd_ = blockIdx.x & 7, slot_ = blockIdx.x >> 3, nslot_ = gridDim.x >> 3;
  for (int j_ = slot_; j_ < 16 * 8; j_ += nslot_) {
    const int mt = xcd_ * 16 + (j_ & 15), nt = j_ >> 4;
    f32x16 acc[2][2]; zero_acc<2>(acc);
    gemm_mainloop<2>(A + (size_t)mt * 128 * K, K, Bt + (size_t)nt * 128 * K, K, K, acc, c.lds);
    acc_to_lds<2>(acc, cl);
    __syncthreads();
    resid_epilogue<2>(c.x, xb, ssn, mt, nt, cl, scale);
    __syncthreads();
  }
}

DI void load_slot(const float* cl, int row, int col0, float (&v)[64]) {
#pragma unroll
  for (int q = 0; q < 16; ++q) { const f32x4 t = *(const f32x4*)(cl + row * CLD + col0 + q * 4); v[4 * q] = t[0]; v[4 * q + 1] = t[1]; v[4 * q + 2] = t[2]; v[4 * q + 3] = t[3]; }
}
template <int N> DI void store_bf16(bf16_t* dst, const float* v) {
#pragma unroll
  for (int q = 0; q < N / 8; ++q) { u32x4 p; p.x = pk2(v[8 * q], v[8 * q + 1]); p.y = pk2(v[8 * q + 2], v[8 * q + 3]); p.z = pk2(v[8 * q + 4], v[8 * q + 5]); p.w = pk2(v[8 * q + 6], v[8 * q + 7]); *(u32x4*)(dst + 8 * q) = p; }
}
template <int N> DI void rmsnorm_inplace(float* v, const float* __restrict__ g) {
  float s = 0.f;
#pragma unroll
  for (int i = 0; i < N; ++i) s += v[i] * v[i];
  const float r = rsqrtf(s * (1.0f / N) + EPS);
#pragma unroll
  for (int i = 0; i < N; ++i) v[i] = v[i] * r * g[i];
}
DI void rope32(float* v, const f32x2* __restrict__ tab  ) {
#pragma unroll
  for (int i = 0; i < 16; ++i) { const f32x2 cs = tab[i]; const float x1 = v[i], x2 = v[i + 16]; v[i] = x1 * cs.x - x2 * cs.y; v[i + 16] = x1 * cs.y + x2 * cs.x; }
}
DI void vt_write(const float* cl, const float* rr, int col0, int u, bf16_t* dst_row  , int dsh, int L, int pos0) {
  const int d = u & 63, th = u >> 6;
  float v[64];
#pragma unroll
  for (int i = 0; i < 64; ++i) v[i] = cl[(th * 64 + i) * CLD + col0 + d] * rr[th * 64 + i];
  const int p0 = pos0 + th * 64;
  if (dsh == 0) {
    store_bf16<64>(dst_row + p0, v);
  } else if (dsh == 2) {
#pragma unroll
    for (int rr_ = 0; rr_ < 4; ++rr_) {
      float t[16];
#pragma unroll
      for (int a = 0; a < 16; ++a) t[a] = v[4 * a + rr_];
      store_bf16<16>(dst_row + rr_ * L + (p0 >> 2), t);
    }
  } else {
#pragma unroll
    for (int rr_ = 0; rr_ < 16; ++rr_) {
      u32x2 p; p.x = pk2(v[rr_], v[16 + rr_]); p.y = pk2(v[32 + rr_], v[48 + rr_]);
      *(u32x2*)(dst_row + rr_ * L + (p0 >> 4)) = p;
    }
  }
}

DI void phase_proj(const Ctx& c) {
  const bf16_t* A = wsb(c, OFF_XB);
  const bf16_t* Bt = wgt(c, W_IN);
  const float* ss = ss_site(c, c.layer, 1);
  float* ss_cq = ss_site(c, c.layer, 4);
  float* ss_ckv = ss_site(c, c.layer, 5);
  float* cl = (float*)c.lds; float* rr = (float*)(c.lds + OFF_RR);
  const f32x2* rope = (const f32x2*)(c.ws + OFF_ROPE);
  const int tid0 = tid_();
  const int S = c.S, sshift = c.sshift;
  const int xcd_ = blockIdx.x & 7, slot_ = blockIdx.x >> 3, nslot_ = gridDim.x >> 3;
  for (int j_ = slot_; j_ < 16 * 28; j_ += nslot_) {
    const int mt = xcd_ * 16 + (j_ & 15), nt = j_ >> 4;
    f32x16 acc[2][2]; zero_acc<2>(acc);
    gemm_mainloop<2>(A + (size_t)mt * 128 * DM, DM, Bt + (size_t)nt * 128 * DM, DM, DM, acc, c.lds);
    acc_to_lds<2>(acc, cl);
    const int tid = tid_(), half = __builtin_amdgcn_readfirstlane(tid >> 7), u = tid & 127;
    if (tid < 128) rr[tid] = rsqrtf(ss[mt * 128 + tid] * (1.0f / DM) + EPS);
    __syncthreads();
    const int slot = nt * 2 + half, col0 = half * 64;
    const int tl0 = mt * 128, seq = tl0 >> sshift, pos0 = tl0 & (S - 1);
    const bool is_vb = (slot >= 31 && slot < 43), is_vc = (slot == 53 || slot == 54);
    if (is_vb) {
      const int hb = slot - 31, dsh = 2 * (hb >> 2);
      bf16_t* dst = wsb(c, OFF_VTB) + ((size_t)(seq * 12 + hb) * 64 + (u & 63)) * S;
      vt_write(cl, rr, col0, u, dst, dsh, S >> dsh, pos0);
    } else if (is_vc) {
      const int hv = slot - 53;
      bf16_t* dst = wsb(c, OFF_VTC) + ((size_t)(seq * 2 + hv) * 64 + (u & 63)) * S;
      vt_write(cl, rr, col0, u, dst, 0, S, pos0);
    } else if (slot < 55) {
      const int row = u, tl = tl0 + row, pos = pos0 + row;
      const float r = rr[row];
      float v[64];
      load_slot(cl, row, col0, v);
#pragma unroll
      for (int i = 0; i < 64; ++i) v[i] *= r;
      if (slot < 6) {
        float s = 0.f;
#pragma unroll
        for (int i = 0; i < 64; ++i) s += v[i] * v[i];
        if (slot < 4) { store_bf16<64>(wsb(c, OFF_CQ) + (size_t)tl * 256 + slot * 64, v); atomicAdd(ss_cq + tl, s); }
        else { store_bf16<64>(wsb(c, OFF_CKV) + (size_t)tl * 128 + (slot - 4) * 64, v); atomicAdd(ss_ckv + tl, s); }
      } else if (slot == 6) {
        rmsnorm_inplace<32>(v, inl(c, 14, 96) + 64);
        rope32(v, rope + (size_t)pos * 16);
        bf16_t* dst = wsb(c, OFF_KA) + ((size_t)(seq * 8) * S + pos) * 96 + 64;
#pragma unroll
        for (int hh = 0; hh < 8; ++hh) store_bf16<32>(dst + (size_t)hh * S * 96, v);
      } else if (slot < 31) {
        const bool isq = slot < 19;
        const int hb = isq ? slot - 7 : slot - 19, dsh = 2 * (hb >> 2), L = S >> dsh;
        rmsnorm_inplace<64>(v, inl(c, isq ? 15 : 16, 64));
        const int srow = (pos & ((1 << dsh) - 1)) * L + (pos >> dsh);
        bf16_t* dst = wsb(c, isq ? OFF_QB : OFF_KB) + ((size_t)(seq * 12 + hb) * S + srow) * 64;
        store_bf16<64>(dst, v);
      } else {
        const bool isq = slot < 51;
        rmsnorm_inplace<64>(v, inl(c, isq ? 18 : 19, 64));
        bf16_t* dst = isq ? wsb(c, OFF_QC) + ((size_t)(seq * 8 + (slot - 43)) * S + pos) * 64
                          : wsb(c, OFF_KC) + ((size_t)(seq * 2 + (slot - 51)) * S + pos) * 64;
        asm volatile("" ::: "memory");
        rope32(v, rope + (size_t)(pos >> 6) * 16);
        store_bf16<32>(dst, v);
        asm volatile("" ::: "memory");
        rope32(v + 32, rope + (size_t)(pos & 63) * 16);
        store_bf16<32>(dst + 32, v + 32);
      }
    }
    __syncthreads();
  }
}

DI void phase_mlaup(const Ctx& c) {
  const float* ss_cq = ss_site(c, c.layer, 4);
  const float* ss_ckv = ss_site(c, c.layer, 5);
  float* cl = (float*)c.lds; float* rr = (float*)(c.lds + OFF_RR);
  const f32x2* rope = (const f32x2*)(c.ws + OFF_ROPE);
  const int tid0 = tid_();
  const int S = c.S, sshift = c.sshift;
  const int xcd_ = blockIdx.x & 7, slot_ = blockIdx.x >> 3, nslot_ = gridDim.x >> 3;
  for (int j_ = slot_; j_ < 16 * 14; j_ += nslot_) {
    const int mt = xcd_ * 16 + (j_ & 15), nt = j_ >> 4;
    const bool isq = nt < 6;
    f32x16 acc[2][2]; zero_acc<2>(acc);
    if (isq) gemm_mainloop<2>(wsb(c, OFF_CQ) + (size_t)mt * 128 * 256, 256, wgt(c, W_UQ) + (size_t)nt * 128 * 256, 256, 256, acc, c.lds);
    else gemm_mainloop<2>(wsb(c, OFF_CKV) + (size_t)mt * 128 * 128, 128, wgt(c, W_UKV) + (size_t)(nt - 6) * 128 * 128, 128, 128, acc, c.lds);
    acc_to_lds<2>(acc, cl);
    const int tid = tid_(), half = __builtin_amdgcn_readfirstlane(tid >> 7), u = tid & 127;
    if (tid < 128) rr[tid] = isq ? rsqrtf(ss_cq[mt * 128 + tid] * (1.0f / 256) + EPS) : rsqrtf(ss_ckv[mt * 128 + tid] * (1.0f / 128) + EPS);
    __syncthreads();
    const int col0 = half * 64;
    const int tl0 = mt * 128, seq = tl0 >> sshift, pos0 = tl0 & (S - 1);
    if (!isq && nt >= 10) {
      const int hv = (nt - 10) * 2 + half;
      bf16_t* dst = wsb(c, OFF_VTA) + ((size_t)(seq * 8 + hv) * 64 + (u & 63)) * S;
      vt_write(cl, rr, col0, u, dst, 0, S, pos0);
    } else {
      const int row = u, pos = pos0 + row;
      const float r = rr[row];
      float v[64];
      load_slot(cl, row, col0, v);
#pragma unroll
      for (int i = 0; i < 64; ++i) v[i] *= r;
      if (isq && nt < 4) {
        const int hh = nt * 2 + half;
        rmsnorm_inplace<64>(v, inl(c, 13, 96));
        store_bf16<64>(wsb(c, OFF_QA) + ((size_t)(seq * 8 + hh) * S + pos) * 96, v);
      } else if (isq) {
        const int h0 = ((nt - 4) * 2 + half) * 2;
        rmsnorm_inplace<32>(v, inl(c, 13, 96) + 64);
        rmsnorm_inplace<32>(v + 32, inl(c, 13, 96) + 64);
        rope32(v, rope + (size_t)pos * 16);
        rope32(v + 32, rope + (size_t)pos * 16);
        store_bf16<32>(wsb(c, OFF_QA) + ((size_t)(seq * 8 + h0) * S + pos) * 96 + 64, v);
        store_bf16<32>(wsb(c, OFF_QA) + ((size_t)(seq * 8 + h0 + 1) * S + pos) * 96 + 64, v + 32);
      } else {
        const int hh = (nt - 6) * 2 + half;
        rmsnorm_inplace<64>(v, inl(c, 14, 96));
        store_bf16<64>(wsb(c, OFF_KA) + ((size_t)(seq * 8 + hh) * S + pos) * 96, v);
      }
    }
    __syncthreads();
  }
}

template <int DQK, bool BAND, int QT>
DI void attn_item(const bf16_t* __restrict__ Q, const bf16_t* __restrict__ Kp, const bf16_t* __restrict__ Vt, int ldv,
                  int kbeg, int kend, int q0, const float* bias_g, float scale_log2,
                  bf16_t* __restrict__ out, size_t out_rs, float* __restrict__ lse, int lse_rs, char* lds) {
  constexpr int KROW = DQK * 2 + 16;
  constexpr int KST = 64 * KROW, VST = 64 * LROW, ST = KST + VST;
  constexpr int NKS = DQK / 16;
  constexpr int KV4 = DQK / 8;
  constexpr int NKL = (64 * KV4) / 256;
  constexpr int WQ = 32 * QT;
  const int tid = tid_(), lane = tid & 63, w = tid >> 6, h = lane >> 5, ql = lane & 31;
  float* bias_l = (float*)(lds + 2 * ST);
  if (BAND) { if (tid < 129) bias_l[tid] = bias_g[tid]; }
  bf16x8 qf[QT][NKS];
#pragma unroll
  for (int qt = 0; qt < QT; ++qt)
#pragma unroll
    for (int ks = 0; ks < NKS; ++ks) qf[qt][ks] = *(const bf16x8*)(Q + (size_t)(w * WQ + qt * 32 + ql) * DQK + ks * 16 + h * 8);
  f32x16 o[2][QT];
#pragma unroll
  for (int a = 0; a < 2; ++a)
#pragma unroll
    for (int b = 0; b < QT; ++b)
#pragma unroll
      for (int r = 0; r < 16; ++r) o[a][b][r] = 0.f;
  float m[QT], l[QT];
#pragma unroll
  for (int qt = 0; qt < QT; ++qt) { m[qt] = -1e30f; l[qt] = 0.f; }
  u32x4 rk[NKL], rv[2];
  const int vrow0 = tid >> 3, vch = tid & 7;
  auto gload = [&](int kt) {
#pragma unroll
    for (int i = 0; i < NKL; ++i) { const int idx = tid + i * 256, kr = idx / KV4, kc = idx - kr * KV4; rk[i] = *(const u32x4*)(Kp + (size_t)(kt + kr) * DQK + kc * 8); }
#pragma unroll
    for (int i = 0; i < 2; ++i) rv[i] = *(const u32x4*)(Vt + (size_t)(vrow0 + 32 * i) * ldv + kt + vch * 8);
  };
  auto lstore = [&](char* st) {
#pragma unroll
    for (int i = 0; i < NKL; ++i) { const int idx = tid + i * 256, kr = idx / KV4, kc = idx - kr * KV4; *(u32x4*)(st + kr * KROW + kc * 16) = rk[i]; }
#pragma unroll
    for (int i = 0; i < 2; ++i) *(u32x4*)(st + KST + (vrow0 + 32 * i) * LROW + vch * 16) = rv[i];
  };
  gload(kbeg);
  lstore(lds);
  __syncthreads();
  const int pr = (ql & ~12) | ((ql & 4) << 1) | ((ql & 8) >> 1);
  const int k_rd = pr * KROW + h * 16;
  const int v_rd = KST + ql * LROW + h * 16;
  const int qw0 = q0 + w * WQ;
  int it = 0;
  for (int kt = kbeg; kt < kend; kt += 64, ++it) {
    const char* st = lds + (it & 1) * ST;
    const bool more = (kt + 64 < kend);
    if (more) gload(kt + 64);
    bool need = true;
    if (BAND) need = (kt + 63 >= qw0 - 64) && (kt <= qw0 + WQ - 1 + 64);
    if (need) {
      f32x16 s[2][QT];
#pragma unroll
      for (int a = 0; a < 2; ++a)
#pragma unroll
        for (int b = 0; b < QT; ++b)
#pragma unroll
          for (int r = 0; r < 16; ++r) s[a][b][r] = 0.f;
#pragma unroll
      for (int ks = 0; ks < NKS; ++ks) {
        const bf16x8 k0 = *(const bf16x8*)(st + k_rd + ks * 32);
        const bf16x8 k1 = *(const bf16x8*)(st + k_rd + 32 * KROW + ks * 32);
#pragma unroll
        for (int qt = 0; qt < QT; ++qt) {
          s[0][qt] = MFMA(k0, qf[qt][ks], s[0][qt]);
          s[1][qt] = MFMA(k1, qf[qt][ks], s[1][qt]);
        }
      }
      bf16x8 pf[QT][4];
#pragma unroll
      for (int qt = 0; qt < QT; ++qt) {
        float mx = -1e30f;
#pragma unroll
        for (int a = 0; a < 2; ++a)
#pragma unroll
          for (int r = 0; r < 16; ++r) {
            float v = s[a][qt][r] * scale_log2;
            if (BAND) {
              const int kidx = kt + 32 * a + (r & 7) + 8 * h + 16 * (r >> 3);
              const int rel = kidx - (qw0 + qt * 32 + ql);
              const bool ok = (rel >= -64) && (rel <= 64);
              const int bi = ok ? rel + 64 : 0;
              v = ok ? v + bias_l[bi] : -1e30f;
            }
            s[a][qt][r] = v;
            mx = fmaxf(mx, v);
          }
        mx = fmaxf(mx, __shfl_xor(mx, 32));
        const float mn = fmaxf(m[qt], mx);
        const float alpha = __builtin_amdgcn_exp2f(m[qt] - mn);
        m[qt] = mn;
        float ls = 0.f;
#pragma unroll
        for (int a = 0; a < 2; ++a) {
#pragma unroll
          for (int r = 0; r < 16; ++r) { const float pv = __builtin_amdgcn_exp2f(s[a][qt][r] - mn); s[a][qt][r] = pv; ls += pv; }
#pragma unroll
          for (int s2 = 0; s2 < 2; ++s2) {
            u32x4 pk;
            pk.x = pk2(s[a][qt][8 * s2 + 0], s[a][qt][8 * s2 + 1]);
            pk.y = pk2(s[a][qt][8 * s2 + 2], s[a][qt][8 * s2 + 3]);
            pk.z = pk2(s[a][qt][8 * s2 + 4], s[a][qt][8 * s2 + 5]);
            pk.w = pk2(s[a][qt][8 * s2 + 6], s[a][qt][8 * s2 + 7]);
            pf[qt][a * 2 + s2] = __builtin_bit_cast(bf16x8, pk);
          }
        }
        l[qt] = l[qt] * alpha + ls;
#pragma unroll
        for (int r = 0; r < 16; ++r) { o[0][qt][r] *= alpha; o[1][qt][r] *= alpha; }
      }
#pragma unroll
      for (int ks = 0; ks < 4; ++ks) {
        const bf16x8 v0 = *(const bf16x8*)(st + v_rd + ks * 32);
        const bf16x8 v1 = *(const bf16x8*)(st + v_rd + 32 * LROW + ks * 32);
#pragma unroll
        for (int qt = 0; qt < QT; ++qt) {
          o[0][qt] = MFMA(v0, pf[qt][ks], o[0][qt]);
          o[1][qt] = MFMA(v1, pf[qt][ks], o[1][qt]);
        }
      }
    }
    if (more) lstore(lds + ((it + 1) & 1) * ST);
    __syncthreads();
  }
#pragma unroll
  for (int qt = 0; qt < QT; ++qt) {
    const float lt = l[qt] + __shfl_xor(l[qt], 32);
    const float inv = 1.0f / lt;
    const int qi = w * WQ + qt * 32 + ql;
    bf16_t* orow = out + (size_t)qi * out_rs;
#pragma unroll
    for (int dt = 0; dt < 2; ++dt)
#pragma unroll
      for (int g = 0; g < 4; ++g) {
        u32x2 p; p.x = pk2(o[dt][qt][4 * g] * inv, o[dt][qt][4 * g + 1] * inv); p.y = pk2(o[dt][qt][4 * g + 2] * inv, o[dt][qt][4 * g + 3] * inv);
        *(u32x2*)(orow + dt * 32 + 8 * g + 4 * h) = p;
      }
    if (BAND) { if (h == 0) lse[(size_t)qi * lse_rs] = m[qt] * LN2 + __logf(lt); }
  }
}

constexpr int AQT = 1;
constexpr int QBLK = 128 * AQT;
DI void phase_attn(const Ctx& c) {
  const int S = c.S, nseq = TC / S, nqb = S / QBLK;
  const int n_mla = nseq * 8 * nqb, n_gqa = n_mla, n_dil = nseq * 12 * nqb;
  const float* bias = (const float*)(c.ws + OFF_BIAS);
  for (int item = blockIdx.x; item < n_mla + n_gqa + n_dil; item += gridDim.x) {
    if (item < n_mla) {
      const int hh = item & 7, rest = item >> 3, seq = rest / nqb, qb = rest - seq * nqb;
      const size_t hs = (size_t)(seq * 8 + hh) * S;
      attn_item<96, false, AQT>(wsb(c, OFF_QA) + (hs + qb * QBLK) * 96, wsb(c, OFF_KA) + hs * 96, wsb(c, OFF_VTA) + hs * 64, S,
                           0, S, 0, nullptr, 0.10206207261596577f * LOG2E,
                           wsb(c, OFF_OA) + ((size_t)seq * S + qb * QBLK) * 512 + hh * 64, 512, nullptr, 0, c.lds);
    } else if (item < n_mla + n_gqa) {
      const int i2 = item - n_mla;
      const int hq = i2 & 7, rest = i2 >> 3, seq = rest / nqb, qb = rest - seq * nqb;
      const size_t hs = (size_t)(seq * 8 + hq) * S, ks = (size_t)(seq * 2 + (hq >> 2)) * S;
      attn_item<64, false, AQT>(wsb(c, OFF_QC) + (hs + qb * QBLK) * 64, wsb(c, OFF_KC) + ks * 64, wsb(c, OFF_VTC) + ks * 64, S,
                           0, S, 0, nullptr, 0.125f * LOG2E,
                           wsb(c, OFF_OC) + ((size_t)seq * S + qb * QBLK) * 512 + hq * 64, 512, nullptr, 0, c.lds);
    } else {
      const int i2 = item - n_mla - n_gqa;
      const int hb = i2 % 12, rest = i2 / 12, seq = rest / nqb, blk = rest - seq * nqb;
      const int dsh = 2 * (hb >> 2), L = S >> dsh, dil = 1 << dsh;
      const int srow0 = blk * QBLK, rr = srow0 / L, l0 = srow0 - rr * L;
      const size_t hs = (size_t)(seq * 12 + hb) * S;
      int kb = l0 - 64; if (kb < 0) kb = 0;
      int ke = l0 + QBLK + 64; if (ke > L) ke = L;
      const size_t tok0 = (size_t)seq * S + (size_t)l0 * dil + rr;
      attn_item<64, true, AQT>(wsb(c, OFF_QB) + (hs + srow0) * 64, wsb(c, OFF_KB) + (hs + (size_t)rr * L) * 64, wsb(c, OFF_VTB) + hs * 64 + (size_t)rr * L, S,
                          kb, ke, l0, bias + hb * 132, 0.125f * LOG2E,
                          wsb(c, OFF_OBG) + tok0 * 768 + hb * 64, (size_t)dil * 768, (float*)(c.ws + OFF_LSE) + tok0 * 12 + hb, dil * 12, c.lds);
    }
    __syncthreads();
  }
}

DI void phase_combine(const Ctx& c) {
  const bf16_t* obg = wsb(c, OFF_OBG);
  const float* lse = (const float*)(c.ws + OFF_LSE);
  bf16_t* ob = wsb(c, OFF_OB);
  const int total = TC * 4 * 8;
  for (int idx = blockIdx.x * NTHREADS + tid_(); idx < total; idx += gridDim.x * NTHREADS) {
    const int d8 = idx & 7, j = (idx >> 3) & 3, tl = idx >> 5;
    const float l0 = lse[tl * 12 + j], l1 = lse[tl * 12 + 4 + j], l2 = lse[tl * 12 + 8 + j];
    const float mx = fmaxf(l0, fmaxf(l1, l2));
    float w0 = __expf(l0 - mx), w1 = __expf(l1 - mx), w2 = __expf(l2 - mx);
    const float inv = 1.0f / (w0 + w1 + w2);
    w0 *= inv; w1 *= inv; w2 *= inv;
    const u32x4 a = *(const u32x4*)(obg + (size_t)tl * 768 + j * 64 + d8 * 8);
    const u32x4 b = *(const u32x4*)(obg + (size_t)tl * 768 + (4 + j) * 64 + d8 * 8);
    const u32x4 d = *(const u32x4*)(obg + (size_t)tl * 768 + (8 + j) * 64 + d8 * 8);
    u32x4 r;
#pragma unroll
    for (int e = 0; e < 4; ++e) {
      const float lo = w0 * __uint_as_float(a[e] << 16) + w1 * __uint_as_float(b[e] << 16) + w2 * __uint_as_float(d[e] << 16);
      const float hi = w0 * __uint_as_float(a[e] & 0xffff0000u) + w1 * __uint_as_float(b[e] & 0xffff0000u) + w2 * __uint_as_float(d[e] & 0xffff0000u);
      r[e] = pk2(lo, hi);
    }
    *(u32x4*)(ob + (size_t)tl * 256 + j * 64 + d8 * 8) = r;
  }
}

DI void phase_merge(const Ctx& c) {
  const bf16_t* xb = wsb(c, OFF_XB);
  const float* ss = ss_site(c, c.layer, 1);
  const float* bgate = inl(c, 21, 3072);
  bf16_t* mrg = wsb(c, OFF_MRG);
  float* cl = (float*)c.lds; float* rr = (float*)(c.lds + OFF_RR);
  const int tid = tid_(), lane = tid & 63, w = tid >> 6, wm = w >> 1, wn = w & 1, h = lane >> 5, cc = lane & 31;
  const int xcd_ = blockIdx.x & 7, slot_ = blockIdx.x >> 3, nslot_ = gridDim.x >> 3;
  for (int j_ = slot_; j_ < 16 * 16; j_ += nslot_) {
    const int mt = xcd_ * 16 + (j_ & 15), nt = j_ >> 4;
    __syncthreads();
    if (tid < 128) rr[tid] = rsqrtf(ss[mt * 128 + tid] * (1.0f / DM) + EPS);
    f32x16 macc[2][1]; zero_acc<1>(macc);
#pragma unroll 1
    for (int k = 0; k < 3; ++k) {
      f32x16 gacc[2][1]; zero_acc<1>(gacc);
      gemm_mainloop<1>(xb + (size_t)mt * 128 * DM, DM, wgt(c, W_GATE) + (size_t)(k * 1024 + nt * 64) * DM, DM, DM, gacc, c.lds);
      const float bv = bgate[k * 1024 + nt * 64 + wn * 32 + cc];
#pragma unroll
      for (int i = 0; i < 2; ++i)
#pragma unroll
        for (int r = 0; r < 16; ++r) {
          const float rv = rr[wm * 64 + i * 32 + (r & 3) + 8 * (r >> 2) + 4 * h];
          gacc[i][0][r] = sigmoidf_(gacc[i][0][r] * rv + bv);
        }
      f32x16 acc[2][1]; zero_acc<1>(acc);
      const int Kk = (k == 1) ? 256 : 512;
      const bf16_t* Ao = wsb(c, k == 0 ? OFF_OA : (k == 1 ? OFF_OB : OFF_OC));
      const bf16_t* Wo = wgt(c, k == 0 ? W_OA : (k == 1 ? W_OB : W_OC));
      gemm_mainloop<1>(Ao + (size_t)mt * 128 * Kk, Kk, Wo + (size_t)nt * 64 * Kk, Kk, Kk, acc, c.lds);
#pragma unroll
      for (int i = 0; i < 2; ++i)
#pragma unroll
        for (int r = 0; r < 16; ++r) macc[i][0][r] += gacc[i][0][r] * acc[i][0][r];
    }
    acc_to_lds<1>(macc, cl);
    __syncthreads();
    const int c4 = (tid & 15) * 4, r0 = tid >> 4;
#pragma unroll 4
    for (int it = 0; it < 8; ++it) {
      const int row = r0 + 16 * it;
      const f32x4 v = *(const f32x4*)(cl + row * CLD + c4);
      u32x2 p; p.x = pk2(v[0], v[1]); p.y = pk2(v[2], v[3]);
      *(u32x2*)(mrg + (size_t)(mt * 128 + row) * DM + nt * 64 + c4) = p;
    }
    __syncthreads();
  }
}

DI void phase_ple(const Ctx& c) {
  const bf16_t* xb = wsb(c, OFF_XB);
  const float* ss = ss_site(c, c.layer, 3);
  float* ssn = ss_site(c, c.layer + 1, 0);
  const bf16_t* peb = wsb(c, OFF_PEB) + (size_t)c.layer * TC * 256;
  float* cl = (float*)c.lds; float* rr = (float*)(c.lds + OFF_RR);
  const int tid = tid_(), lane = tid & 63, w = tid >> 6, wm = w >> 1, h = lane >> 5;
  const int xcd_ = blockIdx.x & 7, slot_ = blockIdx.x >> 3, nslot_ = gridDim.x >> 3;
  for (int j_ = slot_; j_ < 16 * 16; j_ += nslot_) {
    const int mt = xcd_ * 16 + (j_ & 15), nt = j_ >> 4;
    if (tid < 128) rr[tid] = rsqrtf(ss[mt * 128 + tid] * (1.0f / DM) + EPS);
    f32x16 g[2][1]; zero_acc<1>(g);
    gemm_mainloop<1>(xb + (size_t)mt * 128 * DM, DM, wgt(c, W_PG) + (size_t)nt * 64 * DM, DM, DM, g, c.lds);
#pragma unroll
    for (int i = 0; i < 2; ++i)
#pragma unroll
      for (int r = 0; r < 16; ++r) {
        const float rv = rr[wm * 64 + i * 32 + (r & 3) + 8 * (r >> 2) + 4 * h];
        g[i][0][r] = sigmoidf_(g[i][0][r] * rv);
      }
    f32x16 acc[2][1]; zero_acc<1>(acc);
    gemm_mainloop<1>(peb + (size_t)mt * 128 * 256, 256, wgt(c, W_PLE) + (size_t)nt * 64 * 256, 256, 256, acc, c.lds);
#pragma unroll
    for (int i = 0; i < 2; ++i)
#pragma unroll
      for (int r = 0; r < 16; ++r) acc[i][0][r] *= g[i][0][r];
    acc_to_lds<1>(acc, cl);
    __syncthreads();
    resid_epilogue<1>(c.x, wsb(c, OFF_XB2), ssn, mt, nt, cl, 1.0f);
    __syncthreads();
  }
}

DI void phase_prologue(const Params& p, char* lds) {
  float* tl = (float*)lds;
  bf16_t* W = (bf16_t*)(p.ws + OFF_W);
  int rot = 0;
  for (int L = 0; L < 2; ++L) {
    bf16_t* wl = W + (size_t)L * W_LAYER;
    transpose_mat(p.in[5] + (size_t)L * 1024 * 5632, 5632, wl + W_FFN1_IN, 5632, 1024, p.in[4] + L * 1024, 1, tl, rot); rot += 88 * 16;
    transpose_mat(p.in[6] + (size_t)L * 2816 * 1024, 1024, wl + W_FFN1_OUT, 1024, 2816, nullptr, 0, tl, rot); rot += 16 * 44;
    transpose_mat(p.in[8] + (size_t)L * 1024 * 3488, 3488, wl + W_IN, 3584, 1024, p.in[7] + L * 1024, 2, tl, rot); rot += 56 * 16;
    transpose_mat(p.in[20] + (size_t)L * 1024 * 3072, 3072, wl + W_GATE, 3072, 1024, p.in[7] + L * 1024, 0, tl, rot); rot += 48 * 16;
    transpose_mat(p.in[11] + (size_t)L * 256 * 768, 768, wl + W_UQ, 768, 256, p.in[9] + L * 256, 3, tl, rot); rot += 12 * 4;
    transpose_mat(p.in[12] + (size_t)L * 128 * 1024, 1024, wl + W_UKV, 1024, 128, p.in[10] + L * 128, 4, tl, rot); rot += 16 * 2;
    transpose_mat(p.in[22] + (size_t)L * 512 * 1024, 1024, wl + W_OA, 1024, 512, nullptr, 0, tl, rot); rot += 16 * 8;
    transpose_mat(p.in[23] + (size_t)L * 256 * 1024, 1024, wl + W_OB, 1024, 256, nullptr, 0, tl, rot); rot += 16 * 4;
    transpose_mat(p.in[24] + (size_t)L * 512 * 1024, 1024, wl + W_OC, 1024, 512, nullptr, 0, tl, rot); rot += 16 * 8;
    transpose_mat(p.in[25] + (size_t)L * 1024 * 1024, 1024, wl + W_OUT, 1024, 1024, nullptr, 0, tl, rot); rot += 16 * 16;
    transpose_mat(p.in[27] + (size_t)L * 1024 * 5632, 5632, wl + W_FFN2_IN, 5632, 1024, p.in[26] + L * 1024, 1, tl, rot); rot += 88 * 16;
    transpose_mat(p.in[28] + (size_t)L * 2816 * 1024, 1024, wl + W_FFN2_OUT, 1024, 2816, nullptr, 0, tl, rot); rot += 16 * 44;
    transpose_mat(p.in[30] + (size_t)L * 1024 * 1024, 1024, wl + W_PG, 1024, 1024, p.in[29] + L * 1024, 0, tl, rot); rot += 16 * 16;
    transpose_mat(p.in[31] + (size_t)L * 256 * 1024, 1024, wl + W_PLE, 1024, 256, nullptr, 0, tl, rot); rot += 16 * 4;
  }
  const int gtid = blockIdx.x * NTHREADS + tid_(), gn = gridDim.x * NTHREADS;
  f32x2* rope = (f32x2*)(p.ws + OFF_ROPE);
  for (int idx = gtid; idx < 16384 * 16; idx += gn) {
    const int pos = idx >> 4, i = idx & 15;
    const float freq = (float)pow(10000.0, -(double)i / 16.0);
    const float ang = (float)pos * freq;
    f32x2 cs; cs.x = (float)cos((double)ang); cs.y = (float)sin((double)ang);
    rope[idx] = cs;
  }
  float* bias = (float*)(p.ws + OFF_BIAS);
  for (int idx = gtid; idx < 12 * 129; idx += gn) {
    const int hb = idx / 129, jj = idx - hb * 129;
    const int dil = 1 << (2 * (hb >> 2));
    const int rel = (jj - 64) * dil;
    const int n = rel < 0 ? -rel : rel;
    int b;
    if (n < 8) b = n;
    else { int lg = 8 + (int)(log((double)n / 8.0) / log(128.0) * 8.0); if (lg > 15) lg = 15; b = lg; }
    if (rel > 0) b += 16;
    bias[hb * 132 + jj] = p.in[17][b * 12 + hb] * LOG2E;
  }
}

DI void phase_init(const Ctx& c) {
  const int tid = tid_(), lane = tid & 63;
  const int gw = blockIdx.x * 4 + (tid >> 6), nw = gridDim.x * 4;
  bf16_t* xb = wsb(c, OFF_XB);
  float* ss0 = ss_site(c, 0, 0);
  for (int row = gw; row < TC; row += nw) {
    float s = 0.f;
#pragma unroll
    for (int i = 0; i < 4; ++i) {
      const size_t gi = (size_t)row * DM + i * 256 + lane * 4;
      const f32x4 v = *(const f32x4*)(c.xin + gi);
      *(f32x4*)(c.x + gi) = v;
      u32x2 p; p.x = pk2(v[0], v[1]); p.y = pk2(v[2], v[3]);
      *(u32x2*)(xb + gi) = p;
      s += v[0] * v[0] + v[1] * v[1] + v[2] * v[2] + v[3] * v[3];
    }
#pragma unroll
    for (int o = 32; o >= 1; o >>= 1) s += __shfl_xor(s, o);
    if (lane == 0) ss0[row] = s;
  }
  const int gtid = blockIdx.x * NTHREADS + tid, gn = gridDim.x * NTHREADS;
  float* ssall = (float*)(c.ws + OFF_SS);
  for (int idx = gtid + TC; idx < 3 * 6 * TC; idx += gn) ssall[idx] = 0.f;
  bf16_t* peb = wsb(c, OFF_PEB);
  for (int idx = gtid; idx < 2 * TC * 64; idx += gn) {
    const int L = idx / (TC * 64), r = idx - L * (TC * 64);
    const f32x4 v = *(const f32x4*)(c.pe0 + (size_t)L * c.pe_ls + (size_t)r * 4);
    u32x2 p; p.x = pk2(v[0], v[1]); p.y = pk2(v[2], v[3]);
    *(u32x2*)(peb + (size_t)idx * 4) = p;
  }
}

#ifndef ONLY
#define ONLY -1
#endif
#define PH(n) (ONLY < 0 || ONLY == (n))
#ifndef DUP
#define DUP -1
#endif
#if DUP == 200
#define GSYNC() do { xcd_barrier(xb); xcd_barrier(xb); } while (0)
#else
#define GSYNC() xcd_barrier(xb)
#endif
#define REP(n) for (int rep_ = 0; rep_ < ((DUP == (n) || (DUP == 100 && ((n) == 2 || (n) == 10))) ? 2 : 1); ++rep_)
__global__ void __launch_bounds__(NTHREADS, 2) mega_kernel(Params p) {
  extern __shared__ __attribute__((aligned(16))) char lds[];
  cg::grid_group grid = cg::this_grid();
  volatile LAS unsigned* xst = (volatile LAS unsigned*)(lds + OFF_RR + 512);
  if (threadIdx.x == 0) { xst[0] = 0u; xst[1] = 0u; }
  __syncthreads();
  const XcdBarrier xb = xcd_barrier_post((unsigned*)(p.ws + OFF_BAR), xst);
  REP(0) { if (PH(0)) phase_prologue(p, lds); grid.sync(); }
  for (int chunk = 0; chunk < 3; ++chunk) {
    Ctx c;
    c.p = &p; c.chunk = chunk; c.layer = 0; c.ws = p.ws; c.lds = lds;
    c.S = chunk == 0 ? 4096 : 16384; c.sshift = chunk == 0 ? 12 : 14;
    c.x = p.out + (size_t)chunk * TC * DM;
    c.xin = chunk == 0 ? p.in[0] : p.in[1] + (size_t)(chunk - 1) * TC * DM;
    c.pe0 = chunk == 0 ? p.in[2] : p.in[3] + (size_t)(chunk - 1) * TC * 256;
    c.pe_ls = chunk == 0 ? (size_t)TC * 256 : (size_t)2 * TC * 256;
    REP(1) { if (PH(1)) phase_init(c); GSYNC(); }
#pragma unroll 1
    for (int layer = 0; layer < 2; ++layer) {
      c.layer = layer;
      REP(2) { if (PH(2)) phase_ffn_in(c, wsb(c, layer == 0 ? OFF_XB : OFF_XB2), W_FFN1_IN, 0); GSYNC(); }
      REP(3) { if (PH(3)) phase_resid_gemm(c, wsb(c, OFF_ACT), DFF, W_FFN1_OUT, 0.5f, ss_site(c, layer, 1)); GSYNC(); }
      REP(4) { if (PH(4)) phase_proj(c); GSYNC(); }
      REP(5) { if (PH(5)) phase_mlaup(c); GSYNC(); }
      REP(6) { if (PH(6)) phase_attn(c); GSYNC(); }
      REP(7) { if (PH(7)) phase_combine(c); GSYNC(); }
      REP(8) { if (PH(8)) phase_merge(c); GSYNC(); }
      REP(9) { if (PH(9)) phase_resid_gemm(c, wsb(c, OFF_MRG), DM, W_OUT, 1.0f, ss_site(c, layer, 2)); GSYNC(); }
      REP(10) { if (PH(10)) phase_ffn_in(c, wsb(c, OFF_XB), W_FFN2_IN, 2); GSYNC(); }
      REP(11) { if (PH(11)) phase_resid_gemm(c, wsb(c, OFF_ACT), DFF, W_FFN2_OUT, 0.5f, ss_site(c, layer, 3)); GSYNC(); }
      REP(12) { if (PH(12)) phase_ple(c); GSYNC(); }
    }
  }
}

extern "C" void kernel_launch(void* const* d_in, const int* in_sizes, int n_in, void* d_out, int out_size, void* d_ws, size_t ws_size, hipStream_t stream) {
  static int grid_blocks = 0;
  if (!grid_blocks) {
    int dev = 0, cus = 0, per_cu = 0;
    hipGetDevice(&dev);
    hipDeviceGetAttribute(&cus, hipDeviceAttributeMultiprocessorCount, dev);
    hipFuncSetAttribute((const void*)mega_kernel, hipFuncAttributeMaxDynamicSharedMemorySize, LDS_BYTES);
    hipOccupancyMaxActiveBlocksPerMultiprocessor(&per_cu, mega_kernel, NTHREADS, LDS_BYTES);
    if (per_cu > 2) per_cu = 2;
    if (per_cu < 1) per_cu = 1;
    grid_blocks = cus * per_cu;
  }
  Params p{};
  for (int i = 0; i < 32; ++i) p.in[i] = (const float*)d_in[i];
  p.out = (float*)d_out;
  p.ws = (char*)d_ws;
  hipMemsetAsync((char*)d_ws + OFF_BAR, 0, 16384, stream);
  void* args[] = {&p};
  hipError_t e = hipLaunchCooperativeKernel((const void*)mega_kernel, dim3(grid_blocks), dim3(NTHREADS), args, LDS_BYTES, stream);
  if (e != hipSuccess) fprintf(stderr, "cooperative launch failed: %s (grid %d)\n", hipGetErrorString(e), grid_blocks);
}
```

```cpp
#include <hip/hip_runtime.h>
#include <hip/hip_cooperative_groups.h>
#include <stdint.h>
#include <cstdio>
namespace cg = cooperative_groups;

typedef unsigned short bf16_t;
typedef short bf16x8 __attribute__((ext_vector_type(8)));
typedef float f32x16 __attribute__((ext_vector_type(16)));
typedef float f32x4 __attribute__((ext_vector_type(4)));
typedef float f32x2 __attribute__((ext_vector_type(2)));
typedef unsigned u32x4 __attribute__((ext_vector_type(4)));
typedef unsigned u32x2 __attribute__((ext_vector_type(2)));
typedef __bf16 bf16x2_t __attribute__((ext_vector_type(2)));
#define DI __device__ __forceinline__
#define MFMA(a, b, c) __builtin_amdgcn_mfma_f32_32x32x16_bf16((a), (b), (c), 0, 0, 0)

constexpr int TC = 16384;
constexpr int DM = 1024;
constexpr int DFF = 2816;
constexpr float EPS = 1e-6f;
constexpr float LOG2E = 1.4426950408889634f;
constexpr float LN2 = 0.6931471805599453f;
constexpr int NTHREADS = 256;
constexpr int PADK = 64;
constexpr int LDX = DM + PADK;
constexpr int LDACT = DFF + PADK;
constexpr int LDCQ = 256 + PADK, LDCKV = 128 + PADK, LDO = 512 + PADK, LDOB = 256 + PADK, LDPE = 256 + PADK;

constexpr size_t W_FFN1_IN = 0;
constexpr size_t W_FFN1_OUT = W_FFN1_IN + (size_t)5632 * LDX;
constexpr size_t W_IN = W_FFN1_OUT + (size_t)1024 * LDACT;
constexpr size_t W_GATE = W_IN + (size_t)3584 * LDX;
constexpr size_t W_UQ = W_GATE + (size_t)3072 * LDX;
constexpr size_t W_UKV = W_UQ + (size_t)768 * LDCQ;
constexpr size_t W_OA = W_UKV + (size_t)1024 * LDCKV;
constexpr size_t W_OB = W_OA + (size_t)1024 * LDO;
constexpr size_t W_OC = W_OB + (size_t)1024 * LDOB;
constexpr size_t W_OUT = W_OC + (size_t)1024 * LDO;
constexpr size_t W_FFN2_IN = W_OUT + (size_t)1024 * LDX;
constexpr size_t W_FFN2_OUT = W_FFN2_IN + (size_t)5632 * LDX;
constexpr size_t W_PG = W_FFN2_OUT + (size_t)1024 * LDACT;
constexpr size_t W_PLE = W_PG + (size_t)1024 * LDX;
constexpr size_t W_LAYER = W_PLE + (size_t)1024 * LDPE;

constexpr size_t AL(size_t x) { return (x + 255) & ~(size_t)255; }
constexpr size_t OFF_W = 0;
constexpr size_t OFF_BAR = AL(OFF_W + 2 * W_LAYER * 2);
constexpr size_t OFF_ROPE = AL(OFF_BAR + 16384);
constexpr size_t OFF_BIAS = AL(OFF_ROPE + (size_t)16384 * 16 * 8);
constexpr size_t OFF_SS = AL(OFF_BIAS + 12 * 132 * 4);
constexpr size_t OFF_XB = AL(OFF_SS + (size_t)3 * 6 * TC * 4);
constexpr size_t OFF_XB2 = AL(OFF_XB + (size_t)TC * LDX * 2);
constexpr size_t OFF_PEB = AL(OFF_XB2 + (size_t)TC * LDX * 2);
constexpr size_t OFF_BIG = AL(OFF_PEB + (size_t)2 * TC * LDPE * 2);
constexpr size_t OFF_ACT = OFF_BIG;
constexpr size_t OFF_CQ = OFF_BIG;
constexpr size_t OFF_CKV = AL(OFF_CQ + (size_t)TC * LDCQ * 2);
constexpr size_t OFF_QA = AL(OFF_CKV + (size_t)TC * LDCKV * 2);
constexpr size_t OFF_KA = AL(OFF_QA + (size_t)TC * 768 * 2);
constexpr size_t OFF_VTA = AL(OFF_KA + (size_t)TC * 768 * 2);
constexpr size_t OFF_QB = AL(OFF_VTA + (size_t)(TC + 256) * 512 * 2);
constexpr size_t OFF_KB = AL(OFF_QB + (size_t)TC * 768 * 2);
constexpr size_t OFF_VTB = AL(OFF_KB + (size_t)TC * 768 * 2);
constexpr size_t OFF_QC = AL(OFF_VTB + (size_t)(TC + 256) * 768 * 2);
constexpr size_t OFF_KC = AL(OFF_QC + (size_t)TC * 512 * 2);
constexpr size_t OFF_VTC = AL(OFF_KC + (size_t)TC * 128 * 2);
constexpr size_t OFF_OA = AL(OFF_VTC + (size_t)(TC + 256) * 128 * 2);
constexpr size_t OFF_OBG = AL(OFF_OA + (size_t)TC * LDO * 2);
constexpr size_t OFF_LSE = AL(OFF_OBG + (size_t)TC * 768 * 2);
constexpr size_t OFF_OB = AL(OFF_LSE + (size_t)TC * 12 * 4);
constexpr size_t OFF_OC = AL(OFF_OB + (size_t)TC * LDOB * 2);
constexpr size_t OFF_MRG = AL(OFF_OC + (size_t)TC * LDO * 2);
constexpr size_t OFF_END = AL(OFF_MRG + (size_t)TC * LDX * 2);
static_assert(OFF_END < (size_t)508 * 1024 * 1024, "workspace too large");
static_assert(OFF_ACT + (size_t)TC * LDACT * 2 <= OFF_END, "act fits");

struct Params {
  const float* in[32];
  float* out;
  char* ws;
};

constexpr int LROW = 144;
constexpr int STAGE_OP = 128 * LROW;
constexpr int STAGE = 2 * STAGE_OP;
constexpr int CLD = 132;
constexpr int OFF_RR = 2 * STAGE;
constexpr int LDS_BYTES = 2 * STAGE + 1024;
static_assert(128 * CLD * 4 <= OFF_RR, "lds");

DI int tid_() { int t = threadIdx.x; asm volatile("" : "+v"(t)); return t; }
DI unsigned pk2(float a, float b) { f32x2 v = {a, b}; bf16x2_t r = __builtin_convertvector(v, bf16x2_t); return __builtin_bit_cast(unsigned, r); }
DI bf16_t f2bf(float a) { return (bf16_t)(pk2(a, 0.f) & 0xffffu); }
DI float bf2f(bf16_t v) { return __uint_as_float(((unsigned)v) << 16); }
DI float sigmoidf_(float x) { return 1.0f / (1.0f + __expf(-x)); }

DI int map_col(int map, int n) {
  switch (map) {
    case 0: return n;
    case 1: { int t = n >> 7, w = n & 127; return w < 64 ? t * 64 + w : DFF + t * 64 + (w - 64); }
    case 2: { int slot = n >> 6, d = n & 63; if (slot < 6) return n; if (slot == 6) return d < 32 ? 384 + d : -1; if (slot < 55) return 416 + (n - 448); return -1; }
    case 3: { if (n < 512) return (n >> 6) * 96 + (n & 63); int i = n - 512; return (i >> 5) * 96 + 64 + (i & 31); }
    default: { if (n < 512) return (n >> 6) * 128 + (n & 63); int i = n - 512; return (i >> 6) * 128 + 64 + (i & 63); }
  }
}

DI void transpose_mat(const float* __restrict__ src, int ld_src, bf16_t* __restrict__ dst, int N, int K, const float* __restrict__ gain, int map, float* lds, int rot) {
  const int ntk = K >> 6, ntn = N >> 6, nt = ntk * ntn;
  const int tid = tid_(), c = tid & 63, rq = tid >> 6;
  int b0 = (int)blockIdx.x - (rot % (int)gridDim.x); if (b0 < 0) b0 += gridDim.x;
  for (int t = b0; t < nt; t += gridDim.x) {
    const int tn = t / ntk, tk = t - tn * ntk;
    const int n0 = tn << 6, k0 = tk << 6;
    const int sc = map_col(map, n0 + c);
#pragma unroll 4
    for (int r = 0; r < 16; ++r) {
      const int kk = r * 4 + rq;
      float v = 0.f;
      if (sc >= 0) { v = src[(size_t)(k0 + kk) * ld_src + sc]; if (gain) v *= gain[k0 + kk]; }
      lds[c * 65 + kk] = v;
    }
    __syncthreads();
#pragma unroll 4
    for (int r = 0; r < 16; ++r) {
      const int nn = r * 4 + rq;
      dst[(size_t)(n0 + nn) * (K + PADK) + k0 + c] = f2bf(lds[nn * 65 + c]);
    }
    __syncthreads();
  }
}

template <int NJ> DI void zero_acc(f32x16 (&acc)[2][NJ]) {
#pragma unroll
  for (int i = 0; i < 2; ++i)
#pragma unroll
    for (int j = 0; j < NJ; ++j)
#pragma unroll
      for (int r = 0; r < 16; ++r) acc[i][j][r] = 0.f;
}

template <int NJ> DI void gemm_mainloop(const bf16_t* __restrict__ A, int lda, const bf16_t* __restrict__ Bt, int ldb, int K, f32x16 (&acc)[2][NJ], char* lds) {
  const int tid = tid_(), lane = tid & 63, w = tid >> 6, wm = w >> 1, wn = w & 1;
  const int lr = tid >> 3, lc = tid & 7;
  const bf16_t* ap = A + (size_t)lr * lda + lc * 8;
  const bf16_t* bp = Bt + (size_t)lr * ldb + lc * 8;
  const size_t astep = (size_t)32 * lda, bstep = (size_t)32 * ldb;
  constexpr int NB = 2 * NJ;
  u32x4 ra0[4], rb0[NB], ra1[4], rb1[NB];
  const int wofs = lr * LROW + lc * 16;
  const int a_rd = (wm * 64 + (lane & 31)) * LROW + (lane >> 5) * 16;
  const int b_rd = STAGE_OP + (wn * 32 * NJ + (lane & 31)) * LROW + (lane >> 5) * 16;
#define GL1_(RA, RB, i) { RA[i] = *(const u32x4*)(ap + (i) * astep); if ((i) < NB) RB[(i) < NB ? (i) : 0] = *(const u32x4*)(bp + (i) * bstep); }
#define LS1_(RA, RB, ST, i) { char* sn_ = lds + (ST) * STAGE; *(u32x4*)(sn_ + wofs + (i) * 32 * LROW) = RA[i]; \
                              if ((i) < NB) *(u32x4*)(sn_ + STAGE_OP + wofs + (i) * 32 * LROW) = RB[(i) < NB ? (i) : 0]; }
#define RF_(ks) { fa0 = *(const bf16x8*)(st_ + a_rd + (ks) * 32); fa1 = *(const bf16x8*)(st_ + a_rd + 32 * LROW + (ks) * 32); \
      _Pragma("unroll") for (int j = 0; j < NJ; ++j) fb[j] = *(const bf16x8*)(st_ + b_rd + j * 32 * LROW + (ks) * 32); }
#define STEP_(ST, DOL, RAL, RBL, DOS, RAS, RBS) { const char* st_ = lds + (ST) * STAGE; \
    bf16x8 fa0, fa1, fb[NJ]; RF_(0); \
    _Pragma("unroll") for (int ks = 0; ks < 4; ++ks) { \
      if (DOL) GL1_(RAL, RBL, ks); \
      const bf16x8 ca0 = fa0, ca1 = fa1; bf16x8 cb[NJ]; \
      _Pragma("unroll") for (int j = 0; j < NJ; ++j) cb[j] = fb[j]; \
      if (ks < 3) RF_(ks + 1); \
      _Pragma("unroll") for (int j = 0; j < NJ; ++j) { acc[0][j] = MFMA(ca0, cb[j], acc[0][j]); acc[1][j] = MFMA(ca1, cb[j], acc[1][j]); } \
      if (DOS) LS1_(RAS, RBS, 1 - (ST), ks); \
      __builtin_amdgcn_sched_barrier(0); } \
    if (DOL) { ap += 64; bp += 64; } }
#pragma unroll
  for (int i = 0; i < 4; ++i) GL1_(ra0, rb0, i);
  ap += 64; bp += 64;
#pragma unroll
  for (int i = 0; i < 4; ++i) GL1_(ra1, rb1, i);
  ap += 64; bp += 64;
#pragma unroll
  for (int i = 0; i < 4; ++i) LS1_(ra0, rb0, 0, i);
  __syncthreads();
  const int nk = K >> 6;
  for (int kt = 0; kt < nk; kt += 2) {
    const bool l0 = (kt + 2 < nk), l1 = (kt + 3 < nk);
    STEP_(0, l0, ra0, rb0, true, ra1, rb1);
    __syncthreads();
    STEP_(1, l1, ra1, rb1, l0, ra0, rb0);
    __syncthreads();
  }
#undef GL1_
#undef LS1_
#undef STEP_
#undef RF_
}

template <int NJ> DI void acc_to_lds(const f32x16 (&acc)[2][NJ], float* cl) {
  const int tid = tid_(), lane = tid & 63, w = tid >> 6, wm = w >> 1, wn = w & 1, h = lane >> 5, c = lane & 31;
#pragma unroll
  for (int i = 0; i < 2; ++i)
#pragma unroll
    for (int j = 0; j < NJ; ++j)
#pragma unroll
      for (int r = 0; r < 16; ++r) {
        const int row = wm * 64 + i * 32 + (r & 3) + 8 * (r >> 2) + 4 * h;
        cl[row * CLD + wn * 32 * NJ + j * 32 + c] = acc[i][j][r];
      }
}

template <int NJ> DI void resid_epilogue(float* __restrict__ x, bf16_t* __restrict__ xb, float* __restrict__ ssn, int mt, int nt, const float* cl, float scale) {
  constexpr int LPR = 16 * NJ, RPP = 256 / LPR, NP = 128 / RPP;
  const int tid = tid_(), c4 = (tid & (LPR - 1)) * 4, r0 = tid / LPR;
#pragma unroll 4
  for (int it = 0; it < NP; ++it) {
    const int row = r0 + RPP * it;
    const f32x4 c = *(const f32x4*)(cl + row * CLD + c4);
    const size_t gi = (size_t)(mt * 128 + row) * DM + nt * (64 * NJ) + c4;
    f32x4 xv = *(const f32x4*)(x + gi);
    xv = xv + scale * c;
    *(f32x4*)(x + gi) = xv;
    u32x2 p; p.x = pk2(xv[0], xv[1]); p.y = pk2(xv[2], xv[3]);
    *(u32x2*)(xb + (size_t)(mt * 128 + row) * LDX + nt * (64 * NJ) + c4) = p;
    float s_ = xv[0] * xv[0] + xv[1] * xv[1] + xv[2] * xv[2] + xv[3] * xv[3];
    if (NJ == 2) s_ += __shfl_xor(s_, 16);
    s_ += __shfl_xor(s_, 8); s_ += __shfl_xor(s_, 4); s_ += __shfl_xor(s_, 2); s_ += __shfl_xor(s_, 1);
    if ((tid & (LPR - 1)) == 0) atomicAdd(ssn + mt * 128 + row, s_);
  }
}

#define XB_TMO      128
#define XB_XCNT(j)  (256  + 64 * (j))
#define XB_XSUB(j)  (1280 + 64 * (j))
#define XB_XGEN(j)  (2304 + 64 * (j))
#define XB_TOP      3328
#define XB_TOPGEN   3392
#define XCD_BAR_WORDS 3456
#define XB_SPIN_CAP (1u << 22)
#define LAS __attribute__((address_space(3)))
DI unsigned xb_ld(unsigned* p)              { return __hip_atomic_load(p, __ATOMIC_RELAXED, __HIP_MEMORY_SCOPE_AGENT); }
DI unsigned xb_add(unsigned* p, unsigned v) { return __hip_atomic_fetch_add(p, v, __ATOMIC_RELAXED, __HIP_MEMORY_SCOPE_AGENT); }
DI unsigned xb_xcc_id() { return (unsigned)__builtin_amdgcn_s_getreg((3 << 11) | 20) & 0xFu; }
#define XB_SPIN(cond, bar) do { unsigned _sp = 0; while (cond) { __builtin_amdgcn_s_sleep(1); \
    if ((++_sp & 255u) == 0u) { if (xb_ld(&(bar)[XB_TMO])) break; if (_sp > XB_SPIN_CAP) { atomicAdd(&(bar)[XB_TMO], 1u); break; } } } } while (0)
struct XcdBarrier { unsigned* bar; unsigned x; volatile LAS unsigned* st; };
DI XcdBarrier xcd_barrier_post(unsigned* bar, volatile LAS unsigned* st) {
  XcdBarrier b; b.bar = bar; b.x = xb_xcc_id(); b.st = st;
  if (threadIdx.x == 0) (void)xb_add(&bar[XB_XCNT(b.x)], 1u);
  return b;
}
DI void xcd_barrier_complete(unsigned* bar, unsigned x, unsigned& nloc, unsigned& nx) {
  const unsigned G = gridDim.x * gridDim.y * gridDim.z;
  unsigned sum, cnt, mine, sp = 0u;
  for (;;) {
    sum = 0u; cnt = 0u; mine = 0u;
#pragma unroll
    for (unsigned j = 0; j < 16; ++j) { const unsigned c = xb_ld(&bar[XB_XCNT(j)]); sum += c; cnt += (c > 0u) ? 1u : 0u; mine = (j == x) ? c : mine; }
    if (sum == G) break;
    __builtin_amdgcn_s_sleep(1);
    if ((++sp & 255u) == 0u) { if (xb_ld(&bar[XB_TMO])) break; if (sp > XB_SPIN_CAP) { atomicAdd(&bar[XB_TMO], 1u); break; } }
  }
  nloc = mine > 0u ? mine : 1u; nx = cnt > 0u ? cnt : 1u;
}
DI void xcd_barrier(const XcdBarrier& b) {
  asm volatile("s_waitcnt vmcnt(0)" ::: "memory");
  __syncthreads();
  if (threadIdx.x == 0) {
    unsigned* bar = b.bar;
    __builtin_amdgcn_s_waitcnt(0);
    unsigned nloc = b.st[0], nx = b.st[1];
    if (nloc == 0u) { xcd_barrier_complete(bar, b.x, nloc, nx); b.st[0] = nloc; b.st[1] = nx; }
    const unsigned old = xb_add(&bar[XB_XSUB(b.x)], 1u);
    const unsigned gen = old / nloc;
    if (old + 1u == (gen + 1u) * nloc) {
      __builtin_amdgcn_fence(__ATOMIC_RELEASE, "agent");
      asm volatile("s_waitcnt vmcnt(0)" ::: "memory");
      const unsigned og = xb_add(&bar[XB_TOP], 1u);
      const unsigned tg = og / nx;
      if (og + 1u == (tg + 1u) * nx) xb_add(&bar[XB_TOPGEN], 1u);
      else XB_SPIN(xb_ld(&bar[XB_TOPGEN]) == tg, bar);
      __builtin_amdgcn_fence(__ATOMIC_ACQUIRE, "agent");
      xb_add(&bar[XB_XGEN(b.x)], 1u);
      asm volatile("s_waitcnt vmcnt(0)" ::: "memory");
    } else {
      XB_SPIN(xb_ld(&bar[XB_XGEN(b.x)]) == gen, bar);
      __builtin_amdgcn_fence(__ATOMIC_ACQUIRE, "agent");
      asm volatile("s_waitcnt vmcnt(0)" ::: "memory");
    }
  }
  __syncthreads();
}

struct Ctx {
  const Params* p;
  int chunk, layer;
  int S, sshift;
  float* x;
  const float* xin;
  const float* pe0; size_t pe_ls;
  char* ws;
  char* lds;
};
DI bf16_t* wsb(const Ctx& c, size_t off) { return (bf16_t*)(c.ws + off); }
DI float* ss_site(const Ctx& c, int layer, int site) { return (float*)(c.ws + OFF_SS) + ((size_t)layer * 6 + site) * TC; }
DI const bf16_t* wgt(const Ctx& c, size_t off) { return (const bf16_t*)(c.ws + OFF_W) + (size_t)c.layer * W_LAYER + off; }
DI const float* inl(const Ctx& c, int idx, size_t per_layer) { return c.p->in[idx] + (size_t)c.layer * per_layer; }

DI void phase_ffn_in(const Ctx& c, const bf16_t* A, size_t woff, int site) {
  const bf16_t* Bt = wgt(c, woff);
  bf16_t* act = wsb(c, OFF_ACT);
  const float* ss = ss_site(c, c.layer, site);
  float* cl = (float*)c.lds; float* rr = (float*)(c.lds + OFF_RR);
  const int tid = tid_();
  const int xcd_ = blockIdx.x & 7, slot_ = blockIdx.x >> 3, nslot_ = gridDim.x >> 3;
  for (int j_ = slot_; j_ < 16 * 44; j_ += nslot_) {
    const int mt = xcd_ * 16 + (j_ & 15), nt = j_ >> 4;
    f32x16 acc[2][2]; zero_acc<2>(acc);
    gemm_mainloop<2>(A + (size_t)mt * 128 * LDX, LDX, Bt + (size_t)nt * 128 * LDX, LDX, DM, acc, c.lds);
    acc_to_lds<2>(acc, cl);
    if (tid < 128) rr[tid] = rsqrtf(ss[mt * 128 + tid] * (1.0f / DM) + EPS);
    __syncthreads();
    const int c4 = (tid & 15) * 4, r0 = tid >> 4;
#pragma unroll 2
    for (int it = 0; it < 8; ++it) {
      const int row = r0 + 16 * it;
      const float r = rr[row];
      const f32x4 a = *(const f32x4*)(cl + row * CLD + c4);
      const f32x4 b = *(const f32x4*)(cl + row * CLD + 64 + c4);
      float o[4];
#pragma unroll
      for (int e = 0; e < 4; ++e) { const float av = a[e] * r, bv = b[e] * r; o[e] = av * sigmoidf_(av) * bv; }
      u32x2 pq; pq.x = pk2(o[0], o[1]); pq.y = pk2(o[2], o[3]);
      *(u32x2*)(act + (size_t)(mt * 128 + row) * LDACT + nt * 64 + c4) = pq;
    }
    __syncthreads();
  }
}

DI void phase_resid_gemm(const Ctx& c, const bf16_t* A, int K, size_t woff, float scale, float* ssn) {
  const bf16_t* Bt = wgt(c, woff);
  bf16_t* xb = wsb(c, OFF_XB);
  float* cl = (float*)c.lds;
  const int xcd_ = blockIdx.x & 7, slot_ = blockIdx.x >> 3, nslot_ = gridDim.x >> 3;
  for (int j_ = slot_; j_ < 16 * 8; j_ += nslot_) {
    const int mt = xcd_ * 16 + (j_ & 15), nt = j_ >> 4;
    f32x16 acc[2][2]; zero_acc<2>(acc);
    gemm_mainloop<2>(A + (size_t)mt * 128 * (K + PADK), K + PADK, Bt + (size_t)nt * 128 * (K + PADK), K + PADK, K, acc, c.lds);
    acc_to_lds<2>(acc, cl);
    __syncthreads();
    resid_epilogue<2>(c.x, xb, ssn, mt, nt, cl, scale);
    __syncthreads();
  }
}

DI void load_slot(const float* cl, int row, int col0, float (&v)[64]) {
#pragma unroll
  for (int q = 0; q < 16; ++q) { const f32x4 t = *(const f32x4*)(cl + row * CLD + col0 + q * 4); v[4 * q] = t[0]; v[4 * q + 1] = t[1]; v[4 * q + 2] = t[2]; v[4 * q + 3] = t[3]; }
}
template <int N> DI void store_bf16(bf16_t* dst, const float* v) {
#pragma unroll
  for (int q = 0; q < N / 8; ++q) { u32x4 p; p.x = pk2(v[8 * q], v[8 * q + 1]); p.y = pk2(v[8 * q + 2], v[8 * q + 3]); p.z = pk2(v[8 * q + 4], v[8 * q + 5]); p.w = pk2(v[8 * q + 6], v[8 * q + 7]); *(u32x4*)(dst + 8 * q) = p; }
}
template <int N> DI void rmsnorm_inplace(float* v, const float* __restrict__ g) {
  float s = 0.f;
#pragma unroll
  for (int i = 0; i < N; ++i) s += v[i] * v[i];
  const float r = rsqrtf(s * (1.0f / N) + EPS);
#pragma unroll
  for (int i = 0; i < N; ++i) v[i] = v[i] * r * g[i];
}
DI void rope32(float* v, const f32x2* __restrict__ tab  ) {
#pragma unroll
  for (int i = 0; i < 16; ++i) { const f32x2 cs = tab[i]; const float x1 = v[i], x2 = v[i + 16]; v[i] = x1 * cs.x - x2 * cs.y; v[i + 16] = x1 * cs.y + x2 * cs.x; }
}
DI void vt_write(const float* cl, const float* rr, int col0, int u, bf16_t* dst_row  , int dsh, int L, int pos0) {
  const int d = u & 63, th = u >> 6;
  float v[64];
#pragma unroll
  for (int i = 0; i < 64; ++i) v[i] = cl[(th * 64 + i) * CLD + col0 + d] * rr[th * 64 + i];
  const int p0 = pos0 + th * 64;
  if (dsh == 0) {
    store_bf16<64>(dst_row + p0, v);
  } else if (dsh == 2) {
#pragma unroll
    for (int rr_ = 0; rr_ < 4; ++rr_) {
      float t[16];
#pragma unroll
      for (int a = 0; a < 16; ++a) t[a] = v[4 * a + rr_];
      store_bf16<16>(dst_row + rr_ * L + (p0 >> 2), t);
    }
  } else {
#pragma unroll
    for (int rr_ = 0; rr_ < 16; ++rr_) {
      u32x2 p; p.x = pk2(v[rr_], v[16 + rr_]); p.y = pk2(v[32 + rr_], v[48 + rr_]);
      *(u32x2*)(dst_row + rr_ * L + (p0 >> 4)) = p;
    }
  }
}

DI void phase_proj(const Ctx& c) {
  const bf16_t* A = wsb(c, OFF_XB);
  const bf16_t* Bt = wgt(c, W_IN);
  const float* ss = ss_site(c, c.layer, 1);
  float* ss_cq = ss_site(c, c.layer, 4);
  float* ss_ckv = ss_site(c, c.layer, 5);
  float* cl = (float*)c.lds; float* rr = (float*)(c.lds + OFF_RR);
  const f32x2* rope = (const f32x2*)(c.ws + OFF_ROPE);
  const int tid0 = tid_();
  const int S = c.S, sshift = c.sshift;
  const int xcd_ = blockIdx.x & 7, slot_ = blockIdx.x >> 3, nslot_ = gridDim.x >> 3;
  for (int j_ = slot_; j_ < 16 * 28; j_ += nslot_) {
    const int mt = xcd_ * 16 + (j_ & 15), nt = j_ >> 4;
    f32x16 acc[2][2]; zero_acc<2>(acc);
    gemm_mainloop<2>(A + (size_t)mt * 128 * LDX, LDX, Bt + (size_t)nt * 128 * LDX, LDX, DM, acc, c.lds);
    acc_to_lds<2>(acc, cl);
    const int tid = tid_(), half = __builtin_amdgcn_readfirstlane(tid >> 7), u = tid & 127;
    if (tid < 128) rr[tid] = rsqrtf(ss[mt * 128 + tid] * (1.0f / DM) + EPS);
    __syncthreads();
    const int slot = nt * 2 + half, col0 = half * 64;
    const int tl0 = mt * 128, seq = tl0 >> sshift, pos0 = tl0 & (S - 1);
    const bool is_vb = (slot >= 31 && slot < 43), is_vc = (slot == 53 || slot == 54);
    if (is_vb) {
      const int hb = slot - 31, dsh = 2 * (hb >> 2);
      bf16_t* dst = wsb(c, OFF_VTB) + ((size_t)(seq * 12 + hb) * 64 + (u & 63)) * (S + 64);
      vt_write(cl, rr, col0, u, dst, dsh, S >> dsh, pos0);
    } else if (is_vc) {
      const int hv = slot - 53;
      bf16_t* dst = wsb(c, OFF_VTC) + ((size_t)(seq * 2 + hv) * 64 + (u & 63)) * (S + 64);
      vt_write(cl, rr, col0, u, dst, 0, S, pos0);
    } else if (slot < 55) {
      const int row = u, tl = tl0 + row, pos = pos0 + row;
      const float r = rr[row];
      float v[64];
      load_slot(cl, row, col0, v);
#pragma unroll
      for (int i = 0; i < 64; ++i) v[i] *= r;
      if (slot < 6) {
        float s = 0.f;
#pragma unroll
        for (int i = 0; i < 64; ++i) s += v[i] * v[i];
        if (slot < 4) { store_bf16<64>(wsb(c, OFF_CQ) + (size_t)tl * LDCQ + slot * 64, v); atomicAdd(ss_cq + tl, s); }
        else { store_bf16<64>(wsb(c, OFF_CKV) + (size_t)tl * LDCKV + (slot - 4) * 64, v); atomicAdd(ss_ckv + tl, s); }
      } else if (slot == 6) {
        rmsnorm_inplace<32>(v, inl(c, 14, 96) + 64);
        rope32(v, rope + (size_t)pos * 16);
        bf16_t* dst = wsb(c, OFF_KA) + ((size_t)(seq * 8) * S + pos) * 96 + 64;
#pragma unroll
        for (int hh = 0; hh < 8; ++hh) store_bf16<32>(dst + (size_t)hh * S * 96, v);
      } else if (slot < 31) {
        const bool isq = slot < 19;
        const int hb = isq ? slot - 7 : slot - 19, dsh = 2 * (hb >> 2), L = S >> dsh;
        rmsnorm_inplace<64>(v, inl(c, isq ? 15 : 16, 64));
        const int srow = (pos & ((1 << dsh) - 1)) * L + (pos >> dsh);
        bf16_t* dst = wsb(c, isq ? OFF_QB : OFF_KB) + ((size_t)(seq * 12 + hb) * S + srow) * 64;
        store_bf16<64>(dst, v);
      } else {
        const bool isq = slot < 51;
        rmsnorm_inplace<64>(v, inl(c, isq ? 18 : 19, 64));
        bf16_t* dst = isq ? wsb(c, OFF_QC) + ((size_t)(seq * 8 + (slot - 43)) * S + pos) * 64
                          : wsb(c, OFF_KC) + ((size_t)(seq * 2 + (slot - 51)) * S + pos) * 64;
        asm volatile("" ::: "memory");
        rope32(v, rope + (size_t)(pos >> 6) * 16);
        store_bf16<32>(dst, v);
        asm volatile("" ::: "memory");
        rope32(v + 32, rope + (size_t)(pos & 63) * 16);
        store_bf16<32>(dst + 32, v + 32);
      }
    }
    __syncthreads();
  }
}

DI void phase_mlaup(const Ctx& c) {
  const float* ss_cq = ss_site(c, c.layer, 4);
  const float* ss_ckv = ss_site(c, c.layer, 5);
  float* cl = (float*)c.lds; float* rr = (float*)(c.lds + OFF_RR);
  const f32x2* rope = (const f32x2*)(c.ws + OFF_ROPE);
  const int tid0 = tid_();
  const int S = c.S, sshift = c.sshift;
  const int xcd_ = blockIdx.x & 7, slot_ = blockIdx.x >> 3, nslot_ = gridDim.x >> 3;
  for (int j_ = slot_; j_ < 16 * 14; j_ += nslot_) {
    const int mt = xcd_ * 16 + (j_ & 15), nt = j_ >> 4;
    const bool isq = nt < 6;
    f32x16 acc[2][2]; zero_acc<2>(acc);
    if (isq) gemm_mainloop<2>(wsb(c, OFF_CQ) + (size_t)mt * 128 * LDCQ, LDCQ, wgt(c, W_UQ) + (size_t)nt * 128 * LDCQ, LDCQ, 256, acc, c.lds);
    else gemm_mainloop<2>(wsb(c, OFF_CKV) + (size_t)mt * 128 * LDCKV, LDCKV, wgt(c, W_UKV) + (size_t)(nt - 6) * 128 * LDCKV, LDCKV, 128, acc, c.lds);
    acc_to_lds<2>(acc, cl);
    const int tid = tid_(), half = __builtin_amdgcn_readfirstlane(tid >> 7), u = tid & 127;
    if (tid < 128) rr[tid] = isq ? rsqrtf(ss_cq[mt * 128 + tid] * (1.0f / 256) + EPS) : rsqrtf(ss_ckv[mt * 128 + tid] * (1.0f / 128) + EPS);
    __syncthreads();
    const int col0 = half * 64;
    const int tl0 = mt * 128, seq = tl0 >> sshift, pos0 = tl0 & (S - 1);
    if (!isq && nt >= 10) {
      const int hv = (nt - 10) * 2 + half;
      bf16_t* dst = wsb(c, OFF_VTA) + ((size_t)(seq * 8 + hv) * 64 + (u & 63)) * (S + 64);
      vt_write(cl, rr, col0, u, dst, 0, S, pos0);
    } else {
      const int row = u, pos = pos0 + row;
      const float r = rr[row];
      float v[64];
      load_slot(cl, row, col0, v);
#pragma unroll
      for (int i = 0; i < 64; ++i) v[i] *= r;
      if (isq && nt < 4) {
        const int hh = nt * 2 + half;
        rmsnorm_inplace<64>(v, inl(c, 13, 96));
        store_bf16<64>(wsb(c, OFF_QA) + ((size_t)(seq * 8 + hh) * S + pos) * 96, v);
      } else if (isq) {
        const int h0 = ((nt - 4) * 2 + half) * 2;
        rmsnorm_inplace<32>(v, inl(c, 13, 96) + 64);
        rmsnorm_inplace<32>(v + 32, inl(c, 13, 96) + 64);
        rope32(v, rope + (size_t)pos * 16);
        rope32(v + 32, rope + (size_t)pos * 16);
        store_bf16<32>(wsb(c, OFF_QA) + ((size_t)(seq * 8 + h0) * S + pos) * 96 + 64, v);
        store_bf16<32>(wsb(c, OFF_QA) + ((size_t)(seq * 8 + h0 + 1) * S + pos) * 96 + 64, v + 32);
      } else {
        const int hh = (nt - 6) * 2 + half;
        rmsnorm_inplace<64>(v, inl(c, 14, 96));
        store_bf16<64>(wsb(c, OFF_KA) + ((size_t)(seq * 8 + hh) * S + pos) * 96, v);
      }
    }
    __syncthreads();
  }
}

template <int DQK, bool BAND, int QT>
DI void attn_item(const bf16_t* __restrict__ Q, const bf16_t* __restrict__ Kp, const bf16_t* __restrict__ Vt, int ldv,
                  int kbeg, int kend, int q0, const float* bias_g, float scale_log2,
                  bf16_t* __restrict__ out, size_t out_rs, float* __restrict__ lse, int lse_rs, char* lds) {
  constexpr int KROW = DQK * 2 + 16;
  constexpr int KST = 64 * KROW, VST = 64 * LROW, ST = KST + VST;
  constexpr int NKS = DQK / 16;
  constexpr int KV4 = DQK / 8;
  constexpr int NKL = (64 * KV4) / 256;
  constexpr int WQ = 32 * QT;
  const int tid = tid_(), lane = tid & 63, w = tid >> 6, h = lane >> 5, ql = lane & 31;
  float* bias_l = (float*)(lds + 2 * ST);
  if (BAND) { if (tid < 129) bias_l[tid] = bias_g[tid]; }
  bf16x8 qf[QT][NKS];
#pragma unroll
  for (int qt = 0; qt < QT; ++qt)
#pragma unroll
    for (int ks = 0; ks < NKS; ++ks) qf[qt][ks] = *(const bf16x8*)(Q + (size_t)(w * WQ + qt * 32 + ql) * DQK + ks * 16 + h * 8);
  f32x16 o[2][QT];
#pragma unroll
  for (int a = 0; a < 2; ++a)
#pragma unroll
    for (int b = 0; b < QT; ++b)
#pragma unroll
      for (int r = 0; r < 16; ++r) o[a][b][r] = 0.f;
  float m[QT], l[QT];
#pragma unroll
  for (int qt = 0; qt < QT; ++qt) { m[qt] = -1e30f; l[qt] = 0.f; }
  u32x4 rk[NKL], rv[2];
  const int vrow0 = tid >> 3, vch = tid & 7;
  auto gload = [&](int kt) {
#pragma unroll
    for (int i = 0; i < NKL; ++i) { const int idx = tid + i * 256, kr = idx / KV4, kc = idx - kr * KV4; rk[i] = *(const u32x4*)(Kp + (size_t)(kt + kr) * DQK + kc * 8); }
#pragma unroll
    for (int i = 0; i < 2; ++i) rv[i] = *(const u32x4*)(Vt + (size_t)(vrow0 + 32 * i) * ldv + kt + vch * 8);
  };
  auto lstore = [&](char* st) {
#pragma unroll
    for (int i = 0; i < NKL; ++i) { const int idx = tid + i * 256, kr = idx / KV4, kc = idx - kr * KV4; *(u32x4*)(st + kr * KROW + kc * 16) = rk[i]; }
#pragma unroll
    for (int i = 0; i < 2; ++i) *(u32x4*)(st + KST + (vrow0 + 32 * i) * LROW + vch * 16) = rv[i];
  };
  gload(kbeg);
  lstore(lds);
  __syncthreads();
  const int pr = (ql & ~12) | ((ql & 4) << 1) | ((ql & 8) >> 1);
  const int k_rd = pr * KROW + h * 16;
  const int v_rd = KST + ql * LROW + h * 16;
  const int qw0 = q0 + w * WQ;
  int it = 0;
  for (int kt = kbeg; kt < kend; kt += 64, ++it) {
    const char* st = lds + (it & 1) * ST;
    const bool more = (kt + 64 < kend);
    if (more) gload(kt + 64);
    bool need = true;
    if (BAND) need = (kt + 63 >= qw0 - 64) && (kt <= qw0 + WQ - 1 + 64);
    if (need) {
      f32x16 s[2][QT];
#pragma unroll
      for (int a = 0; a < 2; ++a)
#pragma unroll
        for (int b = 0; b < QT; ++b)
#pragma unroll
          for (int r = 0; r < 16; ++r) s[a][b][r] = 0.f;
#pragma unroll
      for (int ks = 0; ks < NKS; ++ks) {
        const bf16x8 k0 = *(const bf16x8*)(st + k_rd + ks * 32);
        const bf16x8 k1 = *(const bf16x8*)(st + k_rd + 32 * KROW + ks * 32);
#pragma unroll
        for (int qt = 0; qt < QT; ++qt) {
          s[0][qt] = MFMA(k0, qf[qt][ks], s[0][qt]);
          s[1][qt] = MFMA(k1, qf[qt][ks], s[1][qt]);
        }
      }
      bf16x8 pf[QT][4];
      const float cc = BAND ? 1.0f : scale_log2;
      const float th = BAND ? 8.0f : 8.0f / scale_log2;
#pragma unroll
      for (int qt = 0; qt < QT; ++qt) {
        if (BAND) {
#pragma unroll
          for (int a = 0; a < 2; ++a)
#pragma unroll
            for (int r = 0; r < 16; ++r) {
              const int kidx = kt + 32 * a + (r & 7) + 8 * h + 16 * (r >> 3);
              const int rel = kidx - (qw0 + qt * 32 + ql);
              const bool ok = (rel >= -64) && (rel <= 64);
              const int bi = ok ? rel + 64 : 0;
              s[a][qt][r] = ok ? fmaf(s[a][qt][r], scale_log2, bias_l[bi]) : -1e30f;
            }
        }
        float mx = s[0][qt][0];
#pragma unroll
        for (int r = 1; r < 16; ++r) mx = fmaxf(mx, s[0][qt][r]);
#pragma unroll
        for (int r = 0; r < 16; ++r) mx = fmaxf(mx, s[1][qt][r]);
        mx = fmaxf(mx, __shfl_xor(mx, 32));
        if (__builtin_amdgcn_ballot_w64(mx > m[qt] + th) != 0) {
          const float mn = fmaxf(m[qt], mx);
          const float alpha = __builtin_amdgcn_exp2f((m[qt] - mn) * cc);
          m[qt] = mn;
          l[qt] *= alpha;
#pragma unroll
          for (int r = 0; r < 16; ++r) { o[0][qt][r] *= alpha; o[1][qt][r] *= alpha; }
        }
        const float mc = -m[qt] * cc;
        float ls = 0.f;
#pragma unroll
        for (int a = 0; a < 2; ++a) {
#pragma unroll
          for (int r = 0; r < 16; ++r) { const float pv = __builtin_amdgcn_exp2f(fmaf(s[a][qt][r], cc, mc)); s[a][qt][r] = pv; ls += pv; }
#pragma unroll
          for (int s2 = 0; s2 < 2; ++s2) {
            u32x4 pk;
            pk.x = pk2(s[a][qt][8 * s2 + 0], s[a][qt][8 * s2 + 1]);
            pk.y = pk2(s[a][qt][8 * s2 + 2], s[a][qt][8 * s2 + 3]);
            pk.z = pk2(s[a][qt][8 * s2 + 4], s[a][qt][8 * s2 + 5]);
            pk.w = pk2(s[a][qt][8 * s2 + 6], s[a][qt][8 * s2 + 7]);
            pf[qt][a * 2 + s2] = __builtin_bit_cast(bf16x8, pk);
          }
        }
        l[qt] += ls;
      }
#pragma unroll
      for (int ks = 0; ks < 4; ++ks) {
        const bf16x8 v0 = *(const bf16x8*)(st + v_rd + ks * 32);
        const bf16x8 v1 = *(const bf16x8*)(st + v_rd + 32 * LROW + ks * 32);
#pragma unroll
        for (int qt = 0; qt < QT; ++qt) {
          o[0][qt] = MFMA(v0, pf[qt][ks], o[0][qt]);
          o[1][qt] = MFMA(v1, pf[qt][ks], o[1][qt]);
        }
      }
    }
    if (more) lstore(lds + ((it + 1) & 1) * ST);
    __syncthreads();
  }
#pragma unroll
  for (int qt = 0; qt < QT; ++qt) {
    const float lt = l[qt] + __shfl_xor(l[qt], 32);
    const float inv = 1.0f / lt;
    const int qi = w * WQ + qt * 32 + ql;
    bf16_t* orow = out + (size_t)qi * out_rs;
#pragma unroll
    for (int dt = 0; dt < 2; ++dt)
#pragma unroll
      for (int g = 0; g < 4; ++g) {
        u32x2 p; p.x = pk2(o[dt][qt][4 * g] * inv, o[dt][qt][4 * g + 1] * inv); p.y = pk2(o[dt][qt][4 * g + 2] * inv, o[dt][qt][4 * g + 3] * inv);
        *(u32x2*)(orow + dt * 32 + 8 * g + 4 * h) = p;
      }
    if (BAND) { if (h == 0) lse[(size_t)qi * lse_rs] = m[qt] * LN2 + __logf(lt); }
  }
}

constexpr int AQT = 1;
constexpr int QBLK = 128 * AQT;
DI void phase_attn(const Ctx& c) {
  const int S = c.S, nseq = TC / S, nqb = S / QBLK;
  const int n_mla = nseq * 8 * nqb, n_gqa = n_mla, n_dil = nseq * 12 * nqb;
  const float* bias = (const float*)(c.ws + OFF_BIAS);
  for (int item = blockIdx.x; item < n_mla + n_gqa + n_dil; item += gridDim.x) {
    if (item < n_mla) {
      const int hh = item & 7, rest = item >> 3, seq = rest / nqb, qb = rest - seq * nqb;
      const size_t hs = (size_t)(seq * 8 + hh) * S;
      attn_item<96, false, AQT>(wsb(c, OFF_QA) + (hs + qb * QBLK) * 96, wsb(c, OFF_KA) + hs * 96, wsb(c, OFF_VTA) + (size_t)(seq * 8 + hh) * 64 * (S + 64), S + 64,
                           0, S, 0, nullptr, 0.10206207261596577f * LOG2E,
                           wsb(c, OFF_OA) + ((size_t)seq * S + qb * QBLK) * LDO + hh * 64, LDO, nullptr, 0, c.lds);
    } else if (item < n_mla + n_gqa) {
      const int i2 = item - n_mla;
      const int hq = i2 & 7, rest = i2 >> 3, seq = rest / nqb, qb = rest - seq * nqb;
      const size_t hs = (size_t)(seq * 8 + hq) * S, ks = (size_t)(seq * 2 + (hq >> 2)) * S;
      attn_item<64, false, AQT>(wsb(c, OFF_QC) + (hs + qb * QBLK) * 64, wsb(c, OFF_KC) + ks * 64, wsb(c, OFF_VTC) + (size_t)(seq * 2 + (hq >> 2)) * 64 * (S + 64), S + 64,
                           0, S, 0, nullptr, 0.125f * LOG2E,
                           wsb(c, OFF_OC) + ((size_t)seq * S + qb * QBLK) * LDO + hq * 64, LDO, nullptr, 0, c.lds);
    } else {
      const int i2 = item - n_mla - n_gqa;
      const int hb = i2 % 12, rest = i2 / 12, seq = rest / nqb, blk = rest - seq * nqb;
      const int dsh = 2 * (hb >> 2), L = S >> dsh, dil = 1 << dsh;
      const int srow0 = blk * QBLK, rr = srow0 / L, l0 = srow0 - rr * L;
      const size_t hs = (size_t)(seq * 12 + hb) * S;
      int kb = l0 - 64; if (kb < 0) kb = 0;
      int ke = l0 + QBLK + 64; if (ke > L) ke = L;
      const size_t tok0 = (size_t)seq * S + (size_t)l0 * dil + rr;
      attn_item<64, true, AQT>(wsb(c, OFF_QB) + (hs + srow0) * 64, wsb(c, OFF_KB) + (hs + (size_t)rr * L) * 64, wsb(c, OFF_VTB) + (size_t)(seq * 12 + hb) * 64 * (S + 64) + (size_t)rr * L, S + 64,
                          kb, ke, l0, bias + hb * 132, 0.125f * LOG2E,
                          wsb(c, OFF_OBG) + tok0 * 768 + hb * 64, (size_t)dil * 768, (float*)(c.ws + OFF_LSE) + tok0 * 12 + hb, dil * 12, c.lds);
    }
    __syncthreads();
  }
}

DI void phase_combine(const Ctx& c) {
  const bf16_t* obg = wsb(c, OFF_OBG);
  const float* lse = (const float*)(c.ws + OFF_LSE);
  bf16_t* ob = wsb(c, OFF_OB);
  const int total = TC * 4 * 8;
  for (int idx = blockIdx.x * NTHREADS + tid_(); idx < total; idx += gridDim.x * NTHREADS) {
    const int d8 = idx & 7, j = (idx >> 3) & 3, tl = idx >> 5;
    const float l0 = lse[tl * 12 + j], l1 = lse[tl * 12 + 4 + j], l2 = lse[tl * 12 + 8 + j];
    const float mx = fmaxf(l0, fmaxf(l1, l2));
    float w0 = __expf(l0 - mx), w1 = __expf(l1 - mx), w2 = __expf(l2 - mx);
    const float inv = 1.0f / (w0 + w1 + w2);
    w0 *= inv; w1 *= inv; w2 *= inv;
    const u32x4 a = *(const u32x4*)(obg + (size_t)tl * 768 + j * 64 + d8 * 8);
    const u32x4 b = *(const u32x4*)(obg + (size_t)tl * 768 + (4 + j) * 64 + d8 * 8);
    const u32x4 d = *(const u32x4*)(obg + (size_t)tl * 768 + (8 + j) * 64 + d8 * 8);
    u32x4 r;
#pragma unroll
    for (int e = 0; e < 4; ++e) {
      const float lo = w0 * __uint_as_float(a[e] << 16) + w1 * __uint_as_float(b[e] << 16) + w2 * __uint_as_float(d[e] << 16);
      const float hi = w0 * __uint_as_float(a[e] & 0xffff0000u) + w1 * __uint_as_float(b[e] & 0xffff0000u) + w2 * __uint_as_float(d[e] & 0xffff0000u);
      r[e] = pk2(lo, hi);
    }
    *(u32x4*)(ob + (size_t)tl * LDOB + j * 64 + d8 * 8) = r;
  }
}

DI void phase_merge(const Ctx& c) {
  const bf16_t* xb = wsb(c, OFF_XB);
  const float* ss = ss_site(c, c.layer, 1);
  const float* bgate = inl(c, 21, 3072);
  bf16_t* mrg = wsb(c, OFF_MRG);
  float* cl = (float*)c.lds; float* rr = (float*)(c.lds + OFF_RR);
  const int tid = tid_(), lane = tid & 63, w = tid >> 6, wm = w >> 1, wn = w & 1, h = lane >> 5, cc = lane & 31;
  const int xcd_ = blockIdx.x & 7, slot_ = blockIdx.x >> 3, nslot_ = gridDim.x >> 3;
  for (int j_ = slot_; j_ < 16 * 16; j_ += nslot_) {
    const int mt = xcd_ * 16 + (j_ & 15), nt = j_ >> 4;
    __syncthreads();
    if (tid < 128) rr[tid] = rsqrtf(ss[mt * 128 + tid] * (1.0f / DM) + EPS);
    f32x16 macc[2][1]; zero_acc<1>(macc);
#pragma unroll 1
    for (int k = 0; k < 3; ++k) {
      f32x16 gacc[2][1]; zero_acc<1>(gacc);
      gemm_mainloop<1>(xb + (size_t)mt * 128 * LDX, LDX, wgt(c, W_GATE) + (size_t)(k * 1024 + nt * 64) * LDX, LDX, DM, gacc, c.lds);
      const float bv = bgate[k * 1024 + nt * 64 + wn * 32 + cc];
#pragma unroll
      for (int i = 0; i < 2; ++i)
#pragma unroll
        for (int r = 0; r < 16; ++r) {
          const float rv = rr[wm * 64 + i * 32 + (r & 3) + 8 * (r >> 2) + 4 * h];
          gacc[i][0][r] = sigmoidf_(gacc[i][0][r] * rv + bv);
        }
      f32x16 acc[2][1]; zero_acc<1>(acc);
      const int Kk = (k == 1) ? 256 : 512;
      const bf16_t* Ao = wsb(c, k == 0 ? OFF_OA : (k == 1 ? OFF_OB : OFF_OC));
      const bf16_t* Wo = wgt(c, k == 0 ? W_OA : (k == 1 ? W_OB : W_OC));
      gemm_mainloop<1>(Ao + (size_t)mt * 128 * (Kk + PADK), Kk + PADK, Wo + (size_t)nt * 64 * (Kk + PADK), Kk + PADK, Kk, acc, c.lds);
#pragma unroll
      for (int i = 0; i < 2; ++i)
#pragma unroll
        for (int r = 0; r < 16; ++r) macc[i][0][r] += gacc[i][0][r] * acc[i][0][r];
    }
    acc_to_lds<1>(macc, cl);
    __syncthreads();
    const int c4 = (tid & 15) * 4, r0 = tid >> 4;
#pragma unroll 4
    for (int it = 0; it < 8; ++it) {
      const int row = r0 + 16 * it;
      const f32x4 v = *(const f32x4*)(cl + row * CLD + c4);
      u32x2 p; p.x = pk2(v[0], v[1]); p.y = pk2(v[2], v[3]);
      *(u32x2*)(mrg + (size_t)(mt * 128 + row) * LDX + nt * 64 + c4) = p;
    }
    __syncthreads();
  }
}

DI void phase_ple(const Ctx& c) {
  const bf16_t* xb = wsb(c, OFF_XB);
  const float* ss = ss_site(c, c.layer, 3);
  float* ssn = ss_site(c, c.layer + 1, 0);
  const bf16_t* peb = wsb(c, OFF_PEB) + (size_t)c.layer * TC * LDPE;
  float* cl = (float*)c.lds; float* rr = (float*)(c.lds + OFF_RR);
  const int tid = tid_(), lane = tid & 63, w = tid >> 6, wm = w >> 1, h = lane >> 5;
  const int xcd_ = blockIdx.x & 7, slot_ = blockIdx.x >> 3, nslot_ = gridDim.x >> 3;
  for (int j_ = slot_; j_ < 16 * 16; j_ += nslot_) {
    const int mt = xcd_ * 16 + (j_ & 15), nt = j_ >> 4;
    if (tid < 128) rr[tid] = rsqrtf(ss[mt * 128 + tid] * (1.0f / DM) + EPS);
    f32x16 g[2][1]; zero_acc<1>(g);
    gemm_mainloop<1>(xb + (size_t)mt * 128 * LDX, LDX, wgt(c, W_PG) + (size_t)nt * 64 * LDX, LDX, DM, g, c.lds);
#pragma unroll
    for (int i = 0; i < 2; ++i)
#pragma unroll
      for (int r = 0; r < 16; ++r) {
        const float rv = rr[wm * 64 + i * 32 + (r & 3) + 8 * (r >> 2) + 4 * h];
        g[i][0][r] = sigmoidf_(g[i][0][r] * rv);
      }
    f32x16 acc[2][1]; zero_acc<1>(acc);
    gemm_mainloop<1>(peb + (size_t)mt * 128 * LDPE, LDPE, wgt(c, W_PLE) + (size_t)nt * 64 * LDPE, LDPE, 256, acc, c.lds);
#pragma unroll
    for (int i = 0; i < 2; ++i)
#pragma unroll
      for (int r = 0; r < 16; ++r) acc[i][0][r] *= g[i][0][r];
    acc_to_lds<1>(acc, cl);
    __syncthreads();
    resid_epilogue<1>(c.x, wsb(c, OFF_XB2), ssn, mt, nt, cl, 1.0f);
    __syncthreads();
  }
}

DI void phase_prologue(const Params& p, char* lds) {
  float* tl = (float*)lds;
  bf16_t* W = (bf16_t*)(p.ws + OFF_W);
  int rot = 0;
  for (int L = 0; L < 2; ++L) {
    bf16_t* wl = W + (size_t)L * W_LAYER;
    transpose_mat(p.in[5] + (size_t)L * 1024 * 5632, 5632, wl + W_FFN1_IN, 5632, 1024, p.in[4] + L * 1024, 1, tl, rot); rot += 88 * 16;
    transpose_mat(p.in[6] + (size_t)L * 2816 * 1024, 1024, wl + W_FFN1_OUT, 1024, 2816, nullptr, 0, tl, rot); rot += 16 * 44;
    transpose_mat(p.in[8] + (size_t)L * 1024 * 3488, 3488, wl + W_IN, 3584, 1024, p.in[7] + L * 1024, 2, tl, rot); rot += 56 * 16;
    transpose_mat(p.in[20] + (size_t)L * 1024 * 3072, 3072, wl + W_GATE, 3072, 1024, p.in[7] + L * 1024, 0, tl, rot); rot += 48 * 16;
    transpose_mat(p.in[11] + (size_t)L * 256 * 768, 768, wl + W_UQ, 768, 256, p.in[9] + L * 256, 3, tl, rot); rot += 12 * 4;
    transpose_mat(p.in[12] + (size_t)L * 128 * 1024, 1024, wl + W_UKV, 1024, 128, p.in[10] + L * 128, 4, tl, rot); rot += 16 * 2;
    transpose_mat(p.in[22] + (size_t)L * 512 * 1024, 1024, wl + W_OA, 1024, 512, nullptr, 0, tl, rot); rot += 16 * 8;
    transpose_mat(p.in[23] + (size_t)L * 256 * 1024, 1024, wl + W_OB, 1024, 256, nullptr, 0, tl, rot); rot += 16 * 4;
    transpose_mat(p.in[24] + (size_t)L * 512 * 1024, 1024, wl + W_OC, 1024, 512, nullptr, 0, tl, rot); rot += 16 * 8;
    transpose_mat(p.in[25] + (size_t)L * 1024 * 1024, 1024, wl + W_OUT, 1024, 1024, nullptr, 0, tl, rot); rot += 16 * 16;
    transpose_mat(p.in[27] + (size_t)L * 1024 * 5632, 5632, wl + W_FFN2_IN, 5632, 1024, p.in[26] + L * 1024, 1, tl, rot); rot += 88 * 16;
    transpose_mat(p.in[28] + (size_t)L * 2816 * 1024, 1024, wl + W_FFN2_OUT, 1024, 2816, nullptr, 0, tl, rot); rot += 16 * 44;
    transpose_mat(p.in[30] + (size_t)L * 1024 * 1024, 1024, wl + W_PG, 1024, 1024, p.in[29] + L * 1024, 0, tl, rot); rot += 16 * 16;
    transpose_mat(p.in[31] + (size_t)L * 256 * 1024, 1024, wl + W_PLE, 1024, 256, nullptr, 0, tl, rot); rot += 16 * 4;
  }
  const int gtid = blockIdx.x * NTHREADS + tid_(), gn = gridDim.x * NTHREADS;
  f32x2* rope = (f32x2*)(p.ws + OFF_ROPE);
  for (int idx = gtid; idx < 16384 * 16; idx += gn) {
    const int pos = idx >> 4, i = idx & 15;
    const float freq = (float)pow(10000.0, -(double)i / 16.0);
    const float ang = (float)pos * freq;
    f32x2 cs; cs.x = (float)cos((double)ang); cs.y = (float)sin((double)ang);
    rope[idx] = cs;
  }
  float* bias = (float*)(p.ws + OFF_BIAS);
  for (int idx = gtid; idx < 12 * 129; idx += gn) {
    const int hb = idx / 129, jj = idx - hb * 129;
    const int dil = 1 << (2 * (hb >> 2));
    const int rel = (jj - 64) * dil;
    const int n = rel < 0 ? -rel : rel;
    int b;
    if (n < 8) b = n;
    else { int lg = 8 + (int)(log((double)n / 8.0) / log(128.0) * 8.0); if (lg > 15) lg = 15; b = lg; }
    if (rel > 0) b += 16;
    bias[hb * 132 + jj] = p.in[17][b * 12 + hb] * LOG2E;
  }
}

DI void phase_init(const Ctx& c) {
  const int tid = tid_(), lane = tid & 63;
  const int gw = blockIdx.x * 4 + (tid >> 6), nw = gridDim.x * 4;
  bf16_t* xb = wsb(c, OFF_XB);
  float* ss0 = ss_site(c, 0, 0);
  for (int row = gw; row < TC; row += nw) {
    float s = 0.f;
#pragma unroll
    for (int i = 0; i < 4; ++i) {
      const size_t gi = (size_t)row * DM + i * 256 + lane * 4;
      const f32x4 v = *(const f32x4*)(c.xin + gi);
      *(f32x4*)(c.x + gi) = v;
      u32x2 p; p.x = pk2(v[0], v[1]); p.y = pk2(v[2], v[3]);
      *(u32x2*)(xb + (size_t)row * LDX + i * 256 + lane * 4) = p;
      s += v[0] * v[0] + v[1] * v[1] + v[2] * v[2] + v[3] * v[3];
    }
#pragma unroll
    for (int o = 32; o >= 1; o >>= 1) s += __shfl_xor(s, o);
    if (lane == 0) ss0[row] = s;
  }
  const int gtid = blockIdx.x * NTHREADS + tid, gn = gridDim.x * NTHREADS;
  float* ssall = (float*)(c.ws + OFF_SS);
  for (int idx = gtid + TC; idx < 3 * 6 * TC; idx += gn) ssall[idx] = 0.f;
  bf16_t* peb = wsb(c, OFF_PEB);
  for (int idx = gtid; idx < 2 * TC * 64; idx += gn) {
    const int L = idx / (TC * 64), r = idx - L * (TC * 64);
    const f32x4 v = *(const f32x4*)(c.pe0 + (size_t)L * c.pe_ls + (size_t)r * 4);
    u32x2 p; p.x = pk2(v[0], v[1]); p.y = pk2(v[2], v[3]);
    *(u32x2*)(peb + ((size_t)L * TC + (r >> 6)) * LDPE + (r & 63) * 4) = p;
  }
}

#ifndef ONLY
#define ONLY -1
#endif
#define PH(n) (ONLY < 0 || ONLY == (n))
#ifndef DUP
#define DUP -1
#endif
#if DUP == 200
#define GSYNC() do { xcd_barrier(xb); xcd_barrier(xb); } while (0)
#else
#define GSYNC() xcd_barrier(xb)
#endif
#define REP(n) for (int rep_ = 0; rep_ < ((DUP == (n) || (DUP == 100 && ((n) == 2 || (n) == 10))) ? 2 : 1); ++rep_)
__global__ void __launch_bounds__(NTHREADS, 2) mega_kernel(Params p) {
  extern __shared__ __attribute__((aligned(16))) char lds[];
  cg::grid_group grid = cg::this_grid();
  volatile LAS unsigned* xst = (volatile LAS unsigned*)(lds + OFF_RR + 512);
  if (threadIdx.x == 0) { xst[0] = 0u; xst[1] = 0u; }
  __syncthreads();
  const XcdBarrier xb = xcd_barrier_post((unsigned*)(p.ws + OFF_BAR), xst);
  REP(0) { if (PH(0)) phase_prologue(p, lds); grid.sync(); }
  for (int chunk = 0; chunk < 3; ++chunk) {
    Ctx c;
    c.p = &p; c.chunk = chunk; c.layer = 0; c.ws = p.ws; c.lds = lds;
    c.S = chunk == 0 ? 4096 : 16384; c.sshift = chunk == 0 ? 12 : 14;
    c.x = p.out + (size_t)chunk * TC * DM;
    c.xin = chunk == 0 ? p.in[0] : p.in[1] + (size_t)(chunk - 1) * TC * DM;
    c.pe0 = chunk == 0 ? p.in[2] : p.in[3] + (size_t)(chunk - 1) * TC * 256;
    c.pe_ls = chunk == 0 ? (size_t)TC * 256 : (size_t)2 * TC * 256;
    REP(1) { if (PH(1)) phase_init(c); GSYNC(); }
#pragma unroll 1
    for (int layer = 0; layer < 2; ++layer) {
      c.layer = layer;
      REP(2) { if (PH(2)) phase_ffn_in(c, wsb(c, layer == 0 ? OFF_XB : OFF_XB2), W_FFN1_IN, 0); GSYNC(); }
      REP(3) { if (PH(3)) phase_resid_gemm(c, wsb(c, OFF_ACT), DFF, W_FFN1_OUT, 0.5f, ss_site(c, layer, 1)); GSYNC(); }
      REP(4) { if (PH(4)) phase_proj(c); GSYNC(); }
      REP(5) { if (PH(5)) phase_mlaup(c); GSYNC(); }
      REP(6) { if (PH(6)) phase_attn(c); GSYNC(); }
      REP(7) { if (PH(7)) phase_combine(c); GSYNC(); }
      REP(8) { if (PH(8)) phase_merge(c); GSYNC(); }
      REP(9) { if (PH(9)) phase_resid_gemm(c, wsb(c, OFF_MRG), DM, W_OUT, 1.0f, ss_site(c, layer, 2)); GSYNC(); }
      REP(10) { if (PH(10)) phase_ffn_in(c, wsb(c, OFF_XB), W_FFN2_IN, 2); GSYNC(); }
      REP(11) { if (PH(11)) phase_resid_gemm(c, wsb(c, OFF_ACT), DFF, W_FFN2_OUT, 0.5f, ss_site(c, layer, 3)); GSYNC(); }
      REP(12) { if (PH(12)) phase_ple(c); GSYNC(); }
    }
  }
}

extern "C" void kernel_launch(void* const* d_in, const int* in_sizes, int n_in, void* d_out, int out_size, void* d_ws, size_t ws_size, hipStream_t stream) {
  static int grid_blocks = 0;
  if (!grid_blocks) {
    int dev = 0, cus = 0, per_cu = 0;
    hipGetDevice(&dev);
    hipDeviceGetAttribute(&cus, hipDeviceAttributeMultiprocessorCount, dev);
    hipFuncSetAttribute((const void*)mega_kernel, hipFuncAttributeMaxDynamicSharedMemorySize, LDS_BYTES);
    hipOccupancyMaxActiveBlocksPerMultiprocessor(&per_cu, mega_kernel, NTHREADS, LDS_BYTES);
    if (per_cu > 2) per_cu = 2;
    if (per_cu < 1) per_cu = 1;
    grid_blocks = cus * per_cu;
  }
  Params p{};
  for (int i = 0; i < 32; ++i) p.in[i] = (const float*)d_in[i];
  p.out = (float*)d_out;
  p.ws = (char*)d_ws;
  hipMemsetAsync((char*)d_ws + OFF_BAR, 0, 16384, stream);
  void* args[] = {&p};
  hipError_t e = hipLaunchCooperativeKernel((const void*)mega_kernel, dim3(grid_blocks), dim3(NTHREADS), args, LDS_BYTES, stream);
  if (e != hipSuccess) fprintf(stderr, "cooperative launch failed: %s (grid %d)\n", hipGetErrorString(e), grid_blocks);
}
```

```cpp
#ifndef DUP
#define DUP -1
#endif
#include <hip/hip_runtime.h>
#include <hip/hip_cooperative_groups.h>
#include <stdint.h>
#include <cstdio>
namespace cg = cooperative_groups;

typedef unsigned short bf16_t;
typedef short bf16x8 __attribute__((ext_vector_type(8)));
typedef float f32x16 __attribute__((ext_vector_type(16)));
typedef float f32x4 __attribute__((ext_vector_type(4)));
typedef float f32x2 __attribute__((ext_vector_type(2)));
typedef unsigned u32x4 __attribute__((ext_vector_type(4)));
typedef unsigned u32x2 __attribute__((ext_vector_type(2)));
typedef __bf16 bf16x2_t __attribute__((ext_vector_type(2)));
#define DI __device__ __forceinline__
#define MFMA(a, b, c) __builtin_amdgcn_mfma_f32_32x32x16_bf16((a), (b), (c), 0, 0, 0)

constexpr int TC = 16384;
constexpr int DM = 1024;
constexpr int DFF = 2816;
constexpr float EPS = 1e-6f;
constexpr float LOG2E = 1.4426950408889634f;
constexpr float LN2 = 0.6931471805599453f;
constexpr int NTHREADS = 256;
constexpr int PADK = 64;
constexpr int LDX = DM + PADK;
constexpr int LDACT = DFF + PADK;
constexpr int LDCQ = 256 + PADK, LDCKV = 128 + PADK, LDO = 512 + PADK, LDOB = 256 + PADK, LDPE = 256 + PADK;

constexpr size_t W_FFN1_IN = 0;
constexpr size_t W_FFN1_OUT = W_FFN1_IN + (size_t)5632 * LDX;
constexpr size_t W_IN = W_FFN1_OUT + (size_t)1024 * LDACT;
constexpr size_t W_GATE = W_IN + (size_t)3584 * LDX;
constexpr size_t W_UQ = W_GATE + (size_t)3072 * LDX;
constexpr size_t W_UKV = W_UQ + (size_t)768 * LDCQ;
constexpr size_t W_OA = W_UKV + (size_t)1024 * LDCKV;
constexpr size_t W_OB = W_OA + (size_t)1024 * LDO;
constexpr size_t W_OC = W_OB + (size_t)1024 * LDOB;
constexpr size_t W_OUT = W_OC + (size_t)1024 * LDO;
constexpr size_t W_FFN2_IN = W_OUT + (size_t)1024 * LDX;
constexpr size_t W_FFN2_OUT = W_FFN2_IN + (size_t)5632 * LDX;
constexpr size_t W_PG = W_FFN2_OUT + (size_t)1024 * LDACT;
constexpr size_t W_PLE = W_PG + (size_t)1024 * LDX;
constexpr size_t W_LAYER = W_PLE + (size_t)1024 * LDPE;

constexpr size_t AL(size_t x) { return (x + 255) & ~(size_t)255; }
constexpr size_t OFF_W = 0;
constexpr size_t OFF_BAR = AL(OFF_W + 2 * W_LAYER * 2);
constexpr size_t OFF_ROPE = AL(OFF_BAR + 16384);
constexpr size_t OFF_BIAS = AL(OFF_ROPE + (size_t)16384 * 16 * 8);
constexpr size_t OFF_SS = AL(OFF_BIAS + 12 * 132 * 4);
constexpr size_t OFF_XB = AL(OFF_SS + (size_t)3 * 6 * TC * 4);
constexpr size_t OFF_XB2 = AL(OFF_XB + (size_t)TC * LDX * 2);
constexpr size_t OFF_PEB = AL(OFF_XB2 + (size_t)TC * LDX * 2);
constexpr size_t OFF_BIG = AL(OFF_PEB + (size_t)2 * TC * LDPE * 2);
constexpr size_t OFF_ACT = OFF_BIG;
constexpr size_t OFF_CQ = OFF_BIG;
constexpr size_t OFF_CKV = AL(OFF_CQ + (size_t)TC * LDCQ * 2);
constexpr size_t OFF_QA = AL(OFF_CKV + (size_t)TC * LDCKV * 2);
constexpr size_t OFF_KA = AL(OFF_QA + (size_t)TC * 768 * 2);
constexpr size_t OFF_VTA = AL(OFF_KA + (size_t)TC * 768 * 2);
constexpr size_t OFF_QB = AL(OFF_VTA + (size_t)(TC + 256) * 512 * 2);
constexpr size_t OFF_KB = AL(OFF_QB + (size_t)TC * 768 * 2);
constexpr size_t OFF_VTB = AL(OFF_KB + (size_t)TC * 768 * 2);
constexpr size_t OFF_QC = AL(OFF_VTB + (size_t)(TC + 256) * 768 * 2);
constexpr size_t OFF_KC = AL(OFF_QC + (size_t)TC * 512 * 2);
constexpr size_t OFF_VTC = AL(OFF_KC + (size_t)TC * 128 * 2);
constexpr size_t OFF_OA = AL(OFF_VTC + (size_t)(TC + 256) * 128 * 2);
constexpr size_t OFF_OBG = AL(OFF_OA + (size_t)TC * LDO * 2);
constexpr size_t OFF_LSE = AL(OFF_OBG + (size_t)TC * 768 * 2);
constexpr size_t OFF_OB = AL(OFF_LSE + (size_t)TC * 12 * 4);
constexpr size_t OFF_OC = AL(OFF_OB + (size_t)TC * LDOB * 2);
constexpr size_t OFF_MRG = AL(OFF_OC + (size_t)TC * LDO * 2);
constexpr size_t OFF_END = AL(OFF_MRG + (size_t)TC * LDX * 2);
static_assert(OFF_END < (size_t)508 * 1024 * 1024, "workspace too large");
static_assert(OFF_ACT + (size_t)TC * LDACT * 2 <= OFF_END, "act fits");

struct Params {
  const float* in[32];
  float* out;
  char* ws;
};

constexpr int LROW = 144;
constexpr int STAGE_OP = 128 * LROW;
constexpr int STAGE = 2 * STAGE_OP;
constexpr int CLD = 132;
constexpr int OFF_RR = 2 * STAGE;
constexpr int LDS_BYTES = 2 * STAGE + 1024;
static_assert(128 * CLD * 4 <= OFF_RR, "lds");

DI int tid_() { int t = threadIdx.x; asm volatile("" : "+v"(t)); return t; }
DI unsigned pk2(float a, float b) { f32x2 v = {a, b}; bf16x2_t r = __builtin_convertvector(v, bf16x2_t); return __builtin_bit_cast(unsigned, r); }
DI bf16_t f2bf(float a) { return (bf16_t)(pk2(a, 0.f) & 0xffffu); }
DI float bf2f(bf16_t v) { return __uint_as_float(((unsigned)v) << 16); }
DI float sigmoidf_(float x) { return 1.0f / (1.0f + __expf(-x)); }

DI int map_col(int map, int n) {
  switch (map) {
    case 0: return n;
    case 1: { int t = n >> 7, w = n & 127; return w < 64 ? t * 64 + w : DFF + t * 64 + (w - 64); }
    case 2: { int slot = n >> 6, d = n & 63; if (slot < 6) return n; if (slot == 6) return d < 32 ? 384 + d : -1; if (slot < 55) return 416 + (n - 448); return -1; }
    case 3: { if (n < 512) return (n >> 6) * 96 + (n & 63); int i = n - 512; return (i >> 5) * 96 + 64 + (i & 31); }
    default: { if (n < 512) return (n >> 6) * 128 + (n & 63); int i = n - 512; return (i >> 6) * 128 + 64 + (i & 63); }
  }
}

DI void transpose_mat(const float* __restrict__ src, int ld_src, bf16_t* __restrict__ dst, int N, int K, const float* __restrict__ gain, int map, float* lds, int rot) {
  const int ntk = K >> 6, ntn = N >> 6, nt = ntk * ntn;
  const int tid = tid_(), c = tid & 63, rq = tid >> 6;
  int b0 = (int)blockIdx.x - (rot % (int)gridDim.x); if (b0 < 0) b0 += gridDim.x;
  for (int t = b0; t < nt; t += gridDim.x) {
    const int tn = t / ntk, tk = t - tn * ntk;
    const int n0 = tn << 6, k0 = tk << 6;
    const int sc = map_col(map, n0 + c);
#pragma unroll 4
    for (int r = 0; r < 16; ++r) {
      const int kk = r * 4 + rq;
      float v = 0.f;
      if (sc >= 0) { v = src[(size_t)(k0 + kk) * ld_src + sc]; if (gain) v *= gain[k0 + kk]; }
      lds[c * 65 + kk] = v;
    }
    __syncthreads();
#pragma unroll 4
    for (int r = 0; r < 16; ++r) {
      const int nn = r * 4 + rq;
      dst[(size_t)(n0 + nn) * (K + PADK) + k0 + c] = f2bf(lds[nn * 65 + c]);
    }
    __syncthreads();
  }
}

template <int NJ> DI void zero_acc(f32x16 (&acc)[2][NJ]) {
#pragma unroll
  for (int i = 0; i < 2; ++i)
#pragma unroll
    for (int j = 0; j < NJ; ++j)
#pragma unroll
      for (int r = 0; r < 16; ++r) acc[i][j][r] = 0.f;
}

template <int NJ> DI void gemm_mainloop(const bf16_t* __restrict__ A, int lda, const bf16_t* __restrict__ Bt, int ldb, int K, f32x16 (&acc)[2][NJ], char* lds) {
  const int tid = tid_(), lane = tid & 63, w = tid >> 6, wm = w >> 1, wn = w & 1;
  const int lr = tid >> 3, lc = tid & 7;
  const char* ap = (const char*)A;
  const char* bp = (const char*)Bt;
  const unsigned aoff = (unsigned)(lr * lda + lc * 8) * 2u, boff = (unsigned)(lr * ldb + lc * 8) * 2u;
  const unsigned astep = (unsigned)(32 * lda) * 2u, bstep = (unsigned)(32 * ldb) * 2u;
  constexpr int NB = 2 * NJ;
  u32x4 ra0[4], rb0[NB], ra1[4], rb1[NB];
  const int wofs = lr * LROW + lc * 16;
  const int a_rd = (wm * 64 + (lane & 31)) * LROW + (lane >> 5) * 16;
  const int b_rd = STAGE_OP + (wn * 32 * NJ + (lane & 31)) * LROW + (lane >> 5) * 16;
#define GL1_(RA, RB, i) { RA[i] = *(const u32x4*)(ap + (aoff + (i) * astep)); if ((i) < NB) RB[(i) < NB ? (i) : 0] = *(const u32x4*)(bp + (boff + (i) * bstep)); }
#define LS1_(RA, RB, ST, i) { char* sn_ = lds + (ST) * STAGE; *(u32x4*)(sn_ + wofs + (i) * 32 * LROW) = RA[i]; \
                              if ((i) < NB) *(u32x4*)(sn_ + STAGE_OP + wofs + (i) * 32 * LROW) = RB[(i) < NB ? (i) : 0]; }
#define RF_(ks) { fa0 = *(const bf16x8*)(st_ + a_rd + (ks) * 32); fa1 = *(const bf16x8*)(st_ + a_rd + 32 * LROW + (ks) * 32); \
      _Pragma("unroll") for (int j = 0; j < NJ; ++j) fb[j] = *(const bf16x8*)(st_ + b_rd + j * 32 * LROW + (ks) * 32); }
#define STEP_(ST, DOL, RAL, RBL, DOS, RAS, RBS) { const char* st_ = lds + (ST) * STAGE; \
    bf16x8 fa0, fa1, fb[NJ]; RF_(0); \
    _Pragma("unroll") for (int ks = 0; ks < 4; ++ks) { \
      if (DOL) GL1_(RAL, RBL, ks); \
      const bf16x8 ca0 = fa0, ca1 = fa1; bf16x8 cb[NJ]; \
      _Pragma("unroll") for (int j = 0; j < NJ; ++j) cb[j] = fb[j]; \
      if (ks < 3) RF_(ks + 1); \
      _Pragma("unroll") for (int j = 0; j < NJ; ++j) { acc[0][j] = MFMA(ca0, cb[j], acc[0][j]); acc[1][j] = MFMA(ca1, cb[j], acc[1][j]); } \
      if (DOS) LS1_(RAS, RBS, 1 - (ST), ks); \
      __builtin_amdgcn_sched_barrier(0); } \
    if (DOL) { ap += 128; bp += 128; } }
#pragma unroll
  for (int i = 0; i < 4; ++i) GL1_(ra0, rb0, i);
  ap += 128; bp += 128;
#pragma unroll
  for (int i = 0; i < 4; ++i) GL1_(ra1, rb1, i);
  ap += 128; bp += 128;
#pragma unroll
  for (int i = 0; i < 4; ++i) LS1_(ra0, rb0, 0, i);
  __syncthreads();
  const int nk = K >> 6;
  for (int kt = 0; kt < nk; kt += 2) {
    const bool l0 = (kt + 2 < nk), l1 = (kt + 3 < nk);
    STEP_(0, l0, ra0, rb0, true, ra1, rb1);
    __syncthreads();
    STEP_(1, l1, ra1, rb1, l0, ra0, rb0);
    __syncthreads();
  }
#undef GL1_
#undef LS1_
#undef STEP_
#undef RF_
}

template <int NJ> DI void acc_to_lds(const f32x16 (&acc)[2][NJ], float* cl) {
  const int tid = tid_(), lane = tid & 63, w = tid >> 6, wm = w >> 1, wn = w & 1, h = lane >> 5, c = lane & 31;
#pragma unroll
  for (int i = 0; i < 2; ++i)
#pragma unroll
    for (int j = 0; j < NJ; ++j)
#pragma unroll
      for (int r = 0; r < 16; ++r) {
        const int row = wm * 64 + i * 32 + (r & 3) + 8 * (r >> 2) + 4 * h;
        cl[row * CLD + wn * 32 * NJ + j * 32 + c] = acc[i][j][r];
      }
}

template <int NJ> DI void resid_epilogue(float* __restrict__ x, bf16_t* __restrict__ xb, float* __restrict__ ssn, int mt, int nt, const float* cl, float scale) {
  constexpr int LPR = 16 * NJ, RPP = 256 / LPR, NP = 128 / RPP;
  const int tid = tid_(), c4 = (tid & (LPR - 1)) * 4, r0 = tid / LPR;
#pragma unroll 4
  for (int it = 0; it < NP; ++it) {
    const int row = r0 + RPP * it;
    const f32x4 c = *(const f32x4*)(cl + row * CLD + c4);
    const size_t gi = (size_t)(mt * 128 + row) * DM + nt * (64 * NJ) + c4;
    f32x4 xv = *(const f32x4*)(x + gi);
    xv = xv + scale * c;
    *(f32x4*)(x + gi) = xv;
    u32x2 p; p.x = pk2(xv[0], xv[1]); p.y = pk2(xv[2], xv[3]);
    *(u32x2*)(xb + (size_t)(mt * 128 + row) * LDX + nt * (64 * NJ) + c4) = p;
    float s_ = xv[0] * xv[0] + xv[1] * xv[1] + xv[2] * xv[2] + xv[3] * xv[3];
    if (NJ == 2) s_ += __shfl_xor(s_, 16);
    s_ += __shfl_xor(s_, 8); s_ += __shfl_xor(s_, 4); s_ += __shfl_xor(s_, 2); s_ += __shfl_xor(s_, 1);
    if ((tid & (LPR - 1)) == 0) atomicAdd(ssn + mt * 128 + row, s_);
  }
}

#define XB_TMO      128
#define XB_XCNT(j)  (256  + 64 * (j))
#define XB_XSUB(j)  (1280 + 64 * (j))
#define XB_XGEN(j)  (2304 + 64 * (j))
#define XB_TOP      3328
#define XB_TOPGEN   3392
#define XCD_BAR_WORDS 3456
#define XB_SPIN_CAP (1u << 22)
#define LAS __attribute__((address_space(3)))
DI unsigned xb_ld(unsigned* p)              { return __hip_atomic_load(p, __ATOMIC_RELAXED, __HIP_MEMORY_SCOPE_AGENT); }
DI unsigned xb_add(unsigned* p, unsigned v) { return __hip_atomic_fetch_add(p, v, __ATOMIC_RELAXED, __HIP_MEMORY_SCOPE_AGENT); }
DI unsigned xb_xcc_id() { return (unsigned)__builtin_amdgcn_s_getreg((3 << 11) | 20) & 0xFu; }
#define XB_SPIN(cond, bar) do { unsigned _sp = 0; while (cond) { __builtin_amdgcn_s_sleep(1); \
    if ((++_sp & 255u) == 0u) { if (xb_ld(&(bar)[XB_TMO])) break; if (_sp > XB_SPIN_CAP) { atomicAdd(&(bar)[XB_TMO], 1u); break; } } } } while (0)
struct XcdBarrier { unsigned* bar; unsigned x; volatile LAS unsigned* st; };
DI XcdBarrier xcd_barrier_post(unsigned* bar, volatile LAS unsigned* st) {
  XcdBarrier b; b.bar = bar; b.x = xb_xcc_id(); b.st = st;
  if (threadIdx.x == 0) (void)xb_add(&bar[XB_XCNT(b.x)], 1u);
  return b;
}
DI void xcd_barrier_complete(unsigned* bar, unsigned x, unsigned& nloc, unsigned& nx) {
  const unsigned G = gridDim.x * gridDim.y * gridDim.z;
  unsigned sum, cnt, mine, sp = 0u;
  for (;;) {
    sum = 0u; cnt = 0u; mine = 0u;
#pragma unroll
    for (unsigned j = 0; j < 16; ++j) { const unsigned c = xb_ld(&bar[XB_XCNT(j)]); sum += c; cnt += (c > 0u) ? 1u : 0u; mine = (j == x) ? c : mine; }
    if (sum == G) break;
    __builtin_amdgcn_s_sleep(1);
    if ((++sp & 255u) == 0u) { if (xb_ld(&bar[XB_TMO])) break; if (sp > XB_SPIN_CAP) { atomicAdd(&bar[XB_TMO], 1u); break; } }
  }
  nloc = mine > 0u ? mine : 1u; nx = cnt > 0u ? cnt : 1u;
}
DI void xcd_barrier(const XcdBarrier& b) {
  asm volatile("s_waitcnt vmcnt(0)" ::: "memory");
  __syncthreads();
  if (threadIdx.x == 0) {
    unsigned* bar = b.bar;
    __builtin_amdgcn_s_waitcnt(0);
    unsigned nloc = b.st[0], nx = b.st[1];
    if (nloc == 0u) { xcd_barrier_complete(bar, b.x, nloc, nx); b.st[0] = nloc; b.st[1] = nx; }
    const unsigned old = xb_add(&bar[XB_XSUB(b.x)], 1u);
    const unsigned gen = old / nloc;
    if (old + 1u == (gen + 1u) * nloc) {
      __builtin_amdgcn_fence(__ATOMIC_RELEASE, "agent");
      asm volatile("s_waitcnt vmcnt(0)" ::: "memory");
      const unsigned og = xb_add(&bar[XB_TOP], 1u);
      const unsigned tg = og / nx;
      if (og + 1u == (tg + 1u) * nx) xb_add(&bar[XB_TOPGEN], 1u);
      else XB_SPIN(xb_ld(&bar[XB_TOPGEN]) == tg, bar);
      __builtin_amdgcn_fence(__ATOMIC_ACQUIRE, "agent");
      xb_add(&bar[XB_XGEN(b.x)], 1u);
      asm volatile("s_waitcnt vmcnt(0)" ::: "memory");
    } else {
      XB_SPIN(xb_ld(&bar[XB_XGEN(b.x)]) == gen, bar);
      __builtin_amdgcn_fence(__ATOMIC_ACQUIRE, "agent");
      asm volatile("s_waitcnt vmcnt(0)" ::: "memory");
    }
  }
  __syncthreads();
}

struct Ctx {
  const Params* p;
  int chunk, layer;
  int S, sshift;
  float* x;
  const float* xin;
  const float* pe0; size_t pe_ls;
  char* ws;
  char* lds;
};
DI bf16_t* wsb(const Ctx& c, size_t off) { return (bf16_t*)(c.ws + off); }
DI float* ss_site(const Ctx& c, int layer, int site) { return (float*)(c.ws + OFF_SS) + ((size_t)layer * 6 + site) * TC; }
DI const bf16_t* wgt(const Ctx& c, size_t off) { return (const bf16_t*)(c.ws + OFF_W) + (size_t)c.layer * W_LAYER + off; }
DI const float* inl(const Ctx& c, int idx, size_t per_layer) { return c.p->in[idx] + (size_t)c.layer * per_layer; }

DI void phase_ffn_in(const Ctx& c, const bf16_t* A, size_t woff, int site) {
  const bf16_t* Bt = wgt(c, woff);
  bf16_t* act = wsb(c, OFF_ACT);
  const float* ss = ss_site(c, c.layer, site);
  float* cl = (float*)c.lds; float* rr = (float*)(c.lds + OFF_RR);
  const int tid = tid_();
  const int xcd_ = blockIdx.x & 7, slot_ = blockIdx.x >> 3, nslot_ = gridDim.x >> 3;
  for (int j_ = slot_; j_ < 16 * 44; j_ += nslot_) {
    const int mt = xcd_ * 16 + (j_ & 15), nt = j_ >> 4;
    f32x16 acc[2][2]; zero_acc<2>(acc);
    gemm_mainloop<2>(A + (size_t)mt * 128 * LDX, LDX, Bt + (size_t)nt * 128 * LDX, LDX, DM, acc, c.lds);
    acc_to_lds<2>(acc, cl);
    if (tid < 128) rr[tid] = rsqrtf(ss[mt * 128 + tid] * (1.0f / DM) + EPS);
    __syncthreads();
    const int c4 = (tid & 15) * 4, r0 = tid >> 4;
#pragma unroll 2
    for (int it = 0; it < 8; ++it) {
      const int row = r0 + 16 * it;
      const float r = rr[row];
      const f32x4 a = *(const f32x4*)(cl + row * CLD + c4);
      const f32x4 b = *(const f32x4*)(cl + row * CLD + 64 + c4);
      float o[4];
#pragma unroll
      for (int e = 0; e < 4; ++e) { const float av = a[e] * r, bv = b[e] * r; o[e] = av * sigmoidf_(av) * bv; }
      u32x2 pq; pq.x = pk2(o[0], o[1]); pq.y = pk2(o[2], o[3]);
      *(u32x2*)(act + (size_t)(mt * 128 + row) * LDACT + nt * 64 + c4) = pq;
    }
    __syncthreads();
  }
}

#if DUP == 300
DI void phase_ffn_probe(const Ctx& c, const bf16_t* A, size_t woff, int site) {
  const bf16_t* Bt = wgt(c, woff);
  bf16_t* act = (bf16_t*)(c.ws + OFF_ACT + (size_t)110 * 1024 * 1024);
  const float* ss = ss_site(c, c.layer, site);
  float* cl = (float*)c.lds; float* rr = (float*)(c.lds + OFF_RR);
  const int tid = tid_();
  const int xcd_ = blockIdx.x & 7, slot_ = blockIdx.x >> 3, nslot_ = gridDim.x >> 3;
  for (int j_ = slot_; j_ < 16 * 44; j_ += nslot_) {
    const int mt = xcd_ * 16 + (j_ & 15), nt = j_ >> 4;
    f32x16 acc[2][2]; zero_acc<2>(acc);
    gemm_mainloop<2>(A + (size_t)(mt & 1) * 128 * LDX, LDX, Bt + (size_t)(nt & 1) * 128 * LDX, LDX, DM, acc, c.lds);
    acc_to_lds<2>(acc, cl);
    if (tid < 128) rr[tid] = rsqrtf(ss[mt * 128 + tid] * (1.0f / DM) + EPS);
    __syncthreads();
    const int c4 = (tid & 15) * 4, r0 = tid >> 4;
#pragma unroll 2
    for (int it = 0; it < 8; ++it) {
      const int row = r0 + 16 * it;
      const float r = rr[row];
      const f32x4 a = *(const f32x4*)(cl + row * CLD + c4);
      const f32x4 b = *(const f32x4*)(cl + row * CLD + 64 + c4);
      float o[4];
#pragma unroll
      for (int e = 0; e < 4; ++e) { const float av = a[e] * r, bv = b[e] * r; o[e] = av * sigmoidf_(av) * bv; }
      u32x2 pq; pq.x = pk2(o[0], o[1]); pq.y = pk2(o[2], o[3]);
      *(u32x2*)(act + (size_t)(mt * 128 + row) * LDACT + nt * 64 + c4) = pq;
    }
    __syncthreads();
  }
}
#endif

DI void phase_resid_gemm(const Ctx& c, const bf16_t* A, int K, size_t woff, float scale, float* ssn) {
  const bf16_t* Bt = wgt(c, woff);
  bf16_t* xb = wsb(c, OFF_XB);
  float* cl = (float*)c.lds;
  const int xcd_ = blockIdx.x & 7, slot_ = blockIdx.x >> 3, nslot_ = gridDim.x >> 3;
  for (int j_ = slot_; j_ < 16 * 8; j_ += nslot_) {
    const int mt = xcd_ * 16 + (j_ & 15), nt = j_ >> 4;
    f32x16 acc[2][2]; zero_acc<2>(acc);
    gemm_mainloop<2>(A + (size_t)mt * 128 * (K + PADK), K + PADK, Bt + (size_t)nt * 128 * (K + PADK), K + PADK, K, acc, c.lds);
    acc_to_lds<2>(acc, cl);
    __syncthreads();
    resid_epilogue<2>(c.x, xb, ssn, mt, nt, cl, scale);
    __syncthreads();
  }
}

DI void load_slot(const float* cl, int row, int col0, float (&v)[64]) {
#pragma unroll
  for (int q = 0; q < 16; ++q) { const f32x4 t = *(const f32x4*)(cl + row * CLD + col0 + q * 4); v[4 * q] = t[0]; v[4 * q + 1] = t[1]; v[4 * q + 2] = t[2]; v[4 * q + 3] = t[3]; }
}
template <int N> DI void store_bf16(bf16_t* dst, const float* v) {
#pragma unroll
  for (int q = 0; q < N / 8; ++q) { u32x4 p; p.x = pk2(v[8 * q], v[8 * q + 1]); p.y = pk2(v[8 * q + 2], v[8 * q + 3]); p.z = pk2(v[8 * q + 4], v[8 * q + 5]); p.w = pk2(v[8 * q + 6], v[8 * q + 7]); *(u32x4*)(dst + 8 * q) = p; }
}
template <int N> DI void rmsnorm_inplace(float* v, const float* __restrict__ g) {
  float s = 0.f;
#pragma unroll
  for (int i = 0; i < N; ++i) s += v[i] * v[i];
  const float r = rsqrtf(s * (1.0f / N) + EPS);
#pragma unroll
  for (int i = 0; i < N; ++i) v[i] = v[i] * r * g[i];
}
DI void rope32(float* v, const f32x2* __restrict__ tab  ) {
#pragma unroll
  for (int i = 0; i < 16; ++i) { const f32x2 cs = tab[i]; const float x1 = v[i], x2 = v[i + 16]; v[i] = x1 * cs.x - x2 * cs.y; v[i + 16] = x1 * cs.y + x2 * cs.x; }
}
DI void vt_write(const float* cl, const float* rr, int col0, int u, bf16_t* dst_row  , int dsh, int L, int pos0) {
  const int d = u & 63, th = u >> 6;
  float v[64];
#pragma unroll
  for (int i = 0; i < 64; ++i) v[i] = cl[(th * 64 + i) * CLD + col0 + d] * rr[th * 64 + i];
  const int p0 = pos0 + th * 64;
  if (dsh == 0) {
    store_bf16<64>(dst_row + p0, v);
  } else if (dsh == 2) {
#pragma unroll
    for (int rr_ = 0; rr_ < 4; ++rr_) {
      float t[16];
#pragma unroll
      for (int a = 0; a < 16; ++a) t[a] = v[4 * a + rr_];
      store_bf16<16>(dst_row + rr_ * L + (p0 >> 2), t);
    }
  } else {
#pragma unroll
    for (int rr_ = 0; rr_ < 16; ++rr_) {
      u32x2 p; p.x = pk2(v[rr_], v[16 + rr_]); p.y = pk2(v[32 + rr_], v[48 + rr_]);
      *(u32x2*)(dst_row + rr_ * L + (p0 >> 4)) = p;
    }
  }
}

DI void phase_proj(const Ctx& c) {
  const bf16_t* A = wsb(c, OFF_XB);
  const bf16_t* Bt = wgt(c, W_IN);
  const float* ss = ss_site(c, c.layer, 1);
  float* ss_cq = ss_site(c, c.layer, 4);
  float* ss_ckv = ss_site(c, c.layer, 5);
  float* cl = (float*)c.lds; float* rr = (float*)(c.lds + OFF_RR);
  const f32x2* rope = (const f32x2*)(c.ws + OFF_ROPE);
  const int tid0 = tid_();
  const int S = c.S, sshift = c.sshift;
  const int xcd_ = blockIdx.x & 7, slot_ = blockIdx.x >> 3, nslot_ = gridDim.x >> 3;
  for (int j_ = slot_; j_ < 16 * 28; j_ += nslot_) {
    const int mt = xcd_ * 16 + (j_ & 15), nt = j_ >> 4;
    f32x16 acc[2][2]; zero_acc<2>(acc);
    gemm_mainloop<2>(A + (size_t)mt * 128 * LDX, LDX, Bt + (size_t)nt * 128 * LDX, LDX, DM, acc, c.lds);
    acc_to_lds<2>(acc, cl);
    const int tid = tid_(), half = __builtin_amdgcn_readfirstlane(tid >> 7), u = tid & 127;
    if (tid < 128) rr[tid] = rsqrtf(ss[mt * 128 + tid] * (1.0f / DM) + EPS);
    __syncthreads();
    const int slot = nt * 2 + half, col0 = half * 64;
    const int tl0 = mt * 128, seq = tl0 >> sshift, pos0 = tl0 & (S - 1);
    const bool is_vb = (slot >= 31 && slot < 43), is_vc = (slot == 53 || slot == 54);
    if (is_vb) {
      const int hb = slot - 31, dsh = 2 * (hb >> 2);
      bf16_t* dst = wsb(c, OFF_VTB) + ((size_t)(seq * 12 + hb) * 64 + (u & 63)) * (S + 64);
      vt_write(cl, rr, col0, u, dst, dsh, S >> dsh, pos0);
    } else if (is_vc) {
      const int hv = slot - 53;
      bf16_t* dst = wsb(c, OFF_VTC) + ((size_t)(seq * 2 + hv) * 64 + (u & 63)) * (S + 64);
      vt_write(cl, rr, col0, u, dst, 0, S, pos0);
    } else if (slot < 55) {
      const int row = u, tl = tl0 + row, pos = pos0 + row;
      const float r = rr[row];
      float v[64];
      load_slot(cl, row, col0, v);
#pragma unroll
      for (int i = 0; i < 64; ++i) v[i] *= r;
      if (slot < 6) {
        float s = 0.f;
#pragma unroll
        for (int i = 0; i < 64; ++i) s += v[i] * v[i];
        if (slot < 4) { store_bf16<64>(wsb(c, OFF_CQ) + (size_t)tl * LDCQ + slot * 64, v); atomicAdd(ss_cq + tl, s); }
        else { store_bf16<64>(wsb(c, OFF_CKV) + (size_t)tl * LDCKV + (slot - 4) * 64, v); atomicAdd(ss_ckv + tl, s); }
      } else if (slot == 6) {
        rmsnorm_inplace<32>(v, inl(c, 14, 96) + 64);
        rope32(v, rope + (size_t)pos * 16);
        bf16_t* dst = wsb(c, OFF_KA) + ((size_t)(seq * 8) * S + pos) * 96 + 64;
#pragma unroll
        for (int hh = 0; hh < 8; ++hh) store_bf16<32>(dst + (size_t)hh * S * 96, v);
      } else if (slot < 31) {
        const bool isq = slot < 19;
        const int hb = isq ? slot - 7 : slot - 19, dsh = 2 * (hb >> 2), L = S >> dsh;
        rmsnorm_inplace<64>(v, inl(c, isq ? 15 : 16, 64));
        const int srow = (pos & ((1 << dsh) - 1)) * L + (pos >> dsh);
        bf16_t* dst = wsb(c, isq ? OFF_QB : OFF_KB) + ((size_t)(seq * 12 + hb) * S + srow) * 64;
        store_bf16<64>(dst, v);
      } else {
        const bool isq = slot < 51;
        rmsnorm_inplace<64>(v, inl(c, isq ? 18 : 19, 64));
        bf16_t* dst = isq ? wsb(c, OFF_QC) + ((size_t)(seq * 8 + (slot - 43)) * S + pos) * 64
                          : wsb(c, OFF_KC) + ((size_t)(seq * 2 + (slot - 51)) * S + pos) * 64;
        asm volatile("" ::: "memory");
        rope32(v, rope + (size_t)(pos >> 6) * 16);
        store_bf16<32>(dst, v);
        asm volatile("" ::: "memory");
        rope32(v + 32, rope + (size_t)(pos & 63) * 16);
        store_bf16<32>(dst + 32, v + 32);
      }
    }
    __syncthreads();
  }
}

DI void phase_mlaup(const Ctx& c) {
  const float* ss_cq = ss_site(c, c.layer, 4);
  const float* ss_ckv = ss_site(c, c.layer, 5);
  float* cl = (float*)c.lds; float* rr = (float*)(c.lds + OFF_RR);
  const f32x2* rope = (const f32x2*)(c.ws + OFF_ROPE);
  const int tid0 = tid_();
  const int S = c.S, sshift = c.sshift;
  const int xcd_ = blockIdx.x & 7, slot_ = blockIdx.x >> 3, nslot_ = gridDim.x >> 3;
  for (int j_ = slot_; j_ < 16 * 14; j_ += nslot_) {
    const int mt = xcd_ * 16 + (j_ & 15), nt = j_ >> 4;
    const bool isq = nt < 6;
    f32x16 acc[2][2]; zero_acc<2>(acc);
    if (isq) gemm_mainloop<2>(wsb(c, OFF_CQ) + (size_t)mt * 128 * LDCQ, LDCQ, wgt(c, W_UQ) + (size_t)nt * 128 * LDCQ, LDCQ, 256, acc, c.lds);
    else gemm_mainloop<2>(wsb(c, OFF_CKV) + (size_t)mt * 128 * LDCKV, LDCKV, wgt(c, W_UKV) + (size_t)(nt - 6) * 128 * LDCKV, LDCKV, 128, acc, c.lds);
    acc_to_lds<2>(acc, cl);
    const int tid = tid_(), half = __builtin_amdgcn_readfirstlane(tid >> 7), u = tid & 127;
    if (tid < 128) rr[tid] = isq ? rsqrtf(ss_cq[mt * 128 + tid] * (1.0f / 256) + EPS) : rsqrtf(ss_ckv[mt * 128 + tid] * (1.0f / 128) + EPS);
    __syncthreads();
    const int col0 = half * 64;
    const int tl0 = mt * 128, seq = tl0 >> sshift, pos0 = tl0 & (S - 1);
    if (!isq && nt >= 10) {
      const int hv = (nt - 10) * 2 + half;
      bf16_t* dst = wsb(c, OFF_VTA) + ((size_t)(seq * 8 + hv) * 64 + (u & 63)) * (S + 64);
      vt_write(cl, rr, col0, u, dst, 0, S, pos0);
    } else {
      const int row = u, pos = pos0 + row;
      const float r = rr[row];
      float v[64];
      load_slot(cl, row, col0, v);
#pragma unroll
      for (int i = 0; i < 64; ++i) v[i] *= r;
      if (isq && nt < 4) {
        const int hh = nt * 2 + half;
        rmsnorm_inplace<64>(v, inl(c, 13, 96));
        store_bf16<64>(wsb(c, OFF_QA) + ((size_t)(seq * 8 + hh) * S + pos) * 96, v);
      } else if (isq) {
        const int h0 = ((nt - 4) * 2 + half) * 2;
        rmsnorm_inplace<32>(v, inl(c, 13, 96) + 64);
        rmsnorm_inplace<32>(v + 32, inl(c, 13, 96) + 64);
        rope32(v, rope + (size_t)pos * 16);
        rope32(v + 32, rope + (size_t)pos * 16);
        store_bf16<32>(wsb(c, OFF_QA) + ((size_t)(seq * 8 + h0) * S + pos) * 96 + 64, v);
        store_bf16<32>(wsb(c, OFF_QA) + ((size_t)(seq * 8 + h0 + 1) * S + pos) * 96 + 64, v + 32);
      } else {
        const int hh = (nt - 6) * 2 + half;
        rmsnorm_inplace<64>(v, inl(c, 14, 96));
        store_bf16<64>(wsb(c, OFF_KA) + ((size_t)(seq * 8 + hh) * S + pos) * 96, v);
      }
    }
    __syncthreads();
  }
}

template <int DQK, bool BAND, int QT>
DI void attn_item(const bf16_t* __restrict__ Q, const bf16_t* __restrict__ Kp, const bf16_t* __restrict__ Vt, int ldv,
                  int kbeg, int kend, int q0, const float* bias_g, float scale_log2,
                  bf16_t* __restrict__ out, size_t out_rs, float* __restrict__ lse, int lse_rs, char* lds) {
  constexpr int KROW = DQK * 2 + 16;
  constexpr int KST = 64 * KROW, VST = 64 * LROW, ST = KST + VST;
  constexpr int NKS = DQK / 16;
  constexpr int KV4 = DQK / 8;
  constexpr int NKL = (64 * KV4) / 256;
  constexpr int WQ = 32 * QT;
  const int tid = tid_(), lane = tid & 63, w = tid >> 6, h = lane >> 5, ql = lane & 31;
  float* bias_l = (float*)(lds + 2 * ST);
  if (BAND) { if (tid < 129) bias_l[tid] = bias_g[tid]; }
  bf16x8 qf[QT][NKS];
#pragma unroll
  for (int qt = 0; qt < QT; ++qt)
#pragma unroll
    for (int ks = 0; ks < NKS; ++ks) qf[qt][ks] = *(const bf16x8*)(Q + (size_t)(w * WQ + qt * 32 + ql) * DQK + ks * 16 + h * 8);
  f32x16 o[2][QT];
#pragma unroll
  for (int a = 0; a < 2; ++a)
#pragma unroll
    for (int b = 0; b < QT; ++b)
#pragma unroll
      for (int r = 0; r < 16; ++r) o[a][b][r] = 0.f;
  float m[QT], l[QT];
#pragma unroll
  for (int qt = 0; qt < QT; ++qt) { m[qt] = -1e30f; l[qt] = 0.f; }
  u32x4 rk[NKL], rv[2];
  const int vrow0 = tid >> 3, vch = tid & 7;
  auto gload = [&](int kt) {
#pragma unroll
    for (int i = 0; i < NKL; ++i) { const int idx = tid + i * 256, kr = idx / KV4, kc = idx - kr * KV4; rk[i] = *(const u32x4*)(Kp + (size_t)(kt + kr) * DQK + kc * 8); }
#pragma unroll
    for (int i = 0; i < 2; ++i) rv[i] = *(const u32x4*)(Vt + (size_t)(vrow0 + 32 * i) * ldv + kt + vch * 8);
  };
  auto lstore = [&](char* st) {
#pragma unroll
    for (int i = 0; i < NKL; ++i) { const int idx = tid + i * 256, kr = idx / KV4, kc = idx - kr * KV4; *(u32x4*)(st + kr * KROW + kc * 16) = rk[i]; }
#pragma unroll
    for (int i = 0; i < 2; ++i) *(u32x4*)(st + KST + (vrow0 + 32 * i) * LROW + vch * 16) = rv[i];
  };
  gload(kbeg);
  lstore(lds);
  __syncthreads();
  const int pr = (ql & ~12) | ((ql & 4) << 1) | ((ql & 8) >> 1);
  const int k_rd = pr * KROW + h * 16;
  const int v_rd = KST + ql * LROW + h * 16;
  const int qw0 = q0 + w * WQ;
  int it = 0;
  for (int kt = kbeg; kt < kend; kt += 64, ++it) {
    const char* st = lds + (it & 1) * ST;
    const bool more = (kt + 64 < kend);
    if (more) gload(kt + 64);
    bool need = true;
    if (BAND) need = (kt + 63 >= qw0 - 64) && (kt <= qw0 + WQ - 1 + 64);
    if (need) {
      f32x16 s[2][QT];
#pragma unroll
      for (int a = 0; a < 2; ++a)
#pragma unroll
        for (int b = 0; b < QT; ++b)
#pragma unroll
          for (int r = 0; r < 16; ++r) s[a][b][r] = 0.f;
#pragma unroll
      for (int ks = 0; ks < NKS; ++ks) {
        const bf16x8 k0 = *(const bf16x8*)(st + k_rd + ks * 32);
        const bf16x8 k1 = *(const bf16x8*)(st + k_rd + 32 * KROW + ks * 32);
#pragma unroll
        for (int qt = 0; qt < QT; ++qt) {
          s[0][qt] = MFMA(k0, qf[qt][ks], s[0][qt]);
          s[1][qt] = MFMA(k1, qf[qt][ks], s[1][qt]);
        }
      }
      bf16x8 pf[QT][4];
      const float cc = BAND ? 1.0f : scale_log2;
      const float th = BAND ? 8.0f : 8.0f / scale_log2;
#pragma unroll
      for (int qt = 0; qt < QT; ++qt) {
        if (BAND) {
#pragma unroll
          for (int a = 0; a < 2; ++a)
#pragma unroll
            for (int r = 0; r < 16; ++r) {
              const int kidx = kt + 32 * a + (r & 7) + 8 * h + 16 * (r >> 3);
              const int rel = kidx - (qw0 + qt * 32 + ql);
              const bool ok = (rel >= -64) && (rel <= 64);
              const int bi = ok ? rel + 64 : 0;
              s[a][qt][r] = ok ? fmaf(s[a][qt][r], scale_log2, bias_l[bi]) : -1e30f;
            }
        }
        float mx = s[0][qt][0];
#pragma unroll
        for (int r = 1; r < 16; ++r) mx = fmaxf(mx, s[0][qt][r]);
#pragma unroll
        for (int r = 0; r < 16; ++r) mx = fmaxf(mx, s[1][qt][r]);
        mx = fmaxf(mx, __shfl_xor(mx, 32));
        if (__builtin_amdgcn_ballot_w64(mx > m[qt] + th) != 0) {
          const float mn = fmaxf(m[qt], mx);
          const float alpha = __builtin_amdgcn_exp2f((m[qt] - mn) * cc);
          m[qt] = mn;
          l[qt] *= alpha;
#pragma unroll
          for (int r = 0; r < 16; ++r) { o[0][qt][r] *= alpha; o[1][qt][r] *= alpha; }
        }
        const float mc = -m[qt] * cc;
        float ls = 0.f;
#pragma unroll
        for (int a = 0; a < 2; ++a) {
#pragma unroll
          for (int r = 0; r < 16; ++r) { const float pv = __builtin_amdgcn_exp2f(fmaf(s[a][qt][r], cc, mc)); s[a][qt][r] = pv; ls += pv; }
#pragma unroll
          for (int s2 = 0; s2 < 2; ++s2) {
            u32x4 pk;
            pk.x = pk2(s[a][qt][8 * s2 + 0], s[a][qt][8 * s2 + 1]);
            pk.y = pk2(s[a][qt][8 * s2 + 2], s[a][qt][8 * s2 + 3]);
            pk.z = pk2(s[a][qt][8 * s2 + 4], s[a][qt][8 * s2 + 5]);
            pk.w = pk2(s[a][qt][8 * s2 + 6], s[a][qt][8 * s2 + 7]);
            pf[qt][a * 2 + s2] = __builtin_bit_cast(bf16x8, pk);
          }
        }
        l[qt] += ls;
      }
      if (more) lstore(lds + ((it + 1) & 1) * ST);
#pragma unroll
      for (int ks = 0; ks < 4; ++ks) {
        const bf16x8 v0 = *(const bf16x8*)(st + v_rd + ks * 32);
        const bf16x8 v1 = *(const bf16x8*)(st + v_rd + 32 * LROW + ks * 32);
#pragma unroll
        for (int qt = 0; qt < QT; ++qt) {
          o[0][qt] = MFMA(v0, pf[qt][ks], o[0][qt]);
          o[1][qt] = MFMA(v1, pf[qt][ks], o[1][qt]);
        }
      }
    } else {
      if (more) lstore(lds + ((it + 1) & 1) * ST);
    }
    __syncthreads();
  }
#pragma unroll
  for (int qt = 0; qt < QT; ++qt) {
    const float lt = l[qt] + __shfl_xor(l[qt], 32);
    const float inv = 1.0f / lt;
    const int qi = w * WQ + qt * 32 + ql;
    bf16_t* orow = out + (size_t)qi * out_rs;
#pragma unroll
    for (int dt = 0; dt < 2; ++dt)
#pragma unroll
      for (int g = 0; g < 4; ++g) {
        u32x2 p; p.x = pk2(o[dt][qt][4 * g] * inv, o[dt][qt][4 * g + 1] * inv); p.y = pk2(o[dt][qt][4 * g + 2] * inv, o[dt][qt][4 * g + 3] * inv);
        *(u32x2*)(orow + dt * 32 + 8 * g + 4 * h) = p;
      }
    if (BAND) { if (h == 0) lse[(size_t)qi * lse_rs] = m[qt] * LN2 + __logf(lt); }
  }
}

template <int DQK>
DI void attn_dense(const bf16_t* __restrict__ Q, const bf16_t* __restrict__ Kp, const bf16_t* __restrict__ Vt, int ldv,
                   int nkeys, float scale_log2, bf16_t* __restrict__ out, size_t out_rs, char* lds) {
  constexpr int KROW = DQK * 2 + 16;
  constexpr int KST = 64 * KROW, VST = 64 * LROW;
  constexpr int NKS = DQK / 16;
  constexpr int KV4 = DQK / 8;
  constexpr int NKL = (64 * KV4) / 256;
  const int tid = tid_(), lane = tid & 63, w = tid >> 6, h = lane >> 5, ql = lane & 31;
  char* const kbase = lds;
  char* const vbase = lds + 2 * KST;
  bf16x8 qf[NKS];
#pragma unroll
  for (int ks = 0; ks < NKS; ++ks) qf[ks] = *(const bf16x8*)(Q + (size_t)(w * 32 + ql) * DQK + ks * 16 + h * 8);
  f32x16 o[2];
#pragma unroll
  for (int a = 0; a < 2; ++a)
#pragma unroll
    for (int r = 0; r < 16; ++r) o[a][r] = 0.f;
  float m = -1e30f, l = 0.f;
  u32x4 rk[NKL], rv[2];
  const int vrow0 = tid >> 3, vch = tid & 7;
#define GLK_(kt) { const int kt_ = (kt); _Pragma("unroll") for (int i_ = 0; i_ < NKL; ++i_) { const int idx = tid + i_ * 256, kr = idx / KV4, kc = idx - kr * KV4; rk[i_] = *(const u32x4*)(Kp + (size_t)(kt_ + kr) * DQK + kc * 8); } }
#define GLV_(kt) { const int kt_ = (kt); _Pragma("unroll") for (int i_ = 0; i_ < 2; ++i_) rv[i_] = *(const u32x4*)(Vt + (size_t)(vrow0 + 32 * i_) * ldv + kt_ + vch * 8); }
#define LSK_(st) { char* st_ = (st); _Pragma("unroll") for (int i_ = 0; i_ < NKL; ++i_) { const int idx = tid + i_ * 256, kr = idx / KV4, kc = idx - kr * KV4; *(u32x4*)(st_ + kr * KROW + kc * 16) = rk[i_]; } }
#define LSV_(st) { char* st_ = (st); _Pragma("unroll") for (int i_ = 0; i_ < 2; ++i_) *(u32x4*)(st_ + (vrow0 + 32 * i_) * LROW + vch * 16) = rv[i_]; }
  const int pr = (ql & ~12) | ((ql & 4) << 1) | ((ql & 8) >> 1);
  const int k_rd = pr * KROW + h * 16;
  const int v_rd = ql * LROW + h * 16;
  GLK_(0); LSK_(kbase);
  GLK_(64); GLV_(0); LSK_(kbase + KST); LSV_(vbase);
  __syncthreads();
  f32x16 sc[2];
#pragma unroll
  for (int a = 0; a < 2; ++a)
#pragma unroll
    for (int r = 0; r < 16; ++r) sc[a][r] = 0.f;
#pragma unroll
  for (int ks = 0; ks < NKS; ++ks) {
    const bf16x8 k0 = *(const bf16x8*)(kbase + k_rd + ks * 32);
    const bf16x8 k1 = *(const bf16x8*)(kbase + k_rd + 32 * KROW + ks * 32);
    sc[0] = MFMA(k0, qf[ks], sc[0]);
    sc[1] = MFMA(k1, qf[ks], sc[1]);
  }
  __syncthreads();
  const int nt = nkeys >> 6;
  const float cc = scale_log2, th = 8.0f / scale_log2;
  for (int i = 0; i < nt; ++i) {
    const bool more1 = (i + 1 < nt), more2 = (i + 2 < nt);
    if (more2) GLK_((i + 2) * 64);
    if (more1) GLV_((i + 1) * 64);
    float mx = sc[0][0];
#pragma unroll
    for (int r = 1; r < 16; ++r) mx = fmaxf(mx, sc[0][r]);
#pragma unroll
    for (int r = 0; r < 16; ++r) mx = fmaxf(mx, sc[1][r]);
    mx = fmaxf(mx, __shfl_xor(mx, 32));
    if (__builtin_amdgcn_ballot_w64(mx > m + th) != 0) {
      const float mn = fmaxf(m, mx);
      const float alpha = __builtin_amdgcn_exp2f((m - mn) * cc);
      m = mn; l *= alpha;
#pragma unroll
      for (int r = 0; r < 16; ++r) { o[0][r] *= alpha; o[1][r] *= alpha; }
    }
    const char* kn = kbase + ((i + 1) & 1) * KST;
    f32x16 sn[2];
#pragma unroll
    for (int a = 0; a < 2; ++a)
#pragma unroll
      for (int r = 0; r < 16; ++r) sn[a][r] = 0.f;
#pragma unroll
    for (int ks = 0; ks < NKS; ++ks) {
      const bf16x8 k0 = *(const bf16x8*)(kn + k_rd + ks * 32);
      const bf16x8 k1 = *(const bf16x8*)(kn + k_rd + 32 * KROW + ks * 32);
      sn[0] = MFMA(k0, qf[ks], sn[0]);
      sn[1] = MFMA(k1, qf[ks], sn[1]);
    }
    const float mc = -m * cc;
    float ls = 0.f;
    bf16x8 pf[4];
#pragma unroll
    for (int a = 0; a < 2; ++a) {
#pragma unroll
      for (int r = 0; r < 16; ++r) { const float pv = __builtin_amdgcn_exp2f(fmaf(sc[a][r], cc, mc)); sc[a][r] = pv; ls += pv; }
#pragma unroll
      for (int s2 = 0; s2 < 2; ++s2) {
        u32x4 pk;
        pk.x = pk2(sc[a][8 * s2 + 0], sc[a][8 * s2 + 1]);
        pk.y = pk2(sc[a][8 * s2 + 2], sc[a][8 * s2 + 3]);
        pk.z = pk2(sc[a][8 * s2 + 4], sc[a][8 * s2 + 5]);
        pk.w = pk2(sc[a][8 * s2 + 6], sc[a][8 * s2 + 7]);
        pf[a * 2 + s2] = __builtin_bit_cast(bf16x8, pk);
      }
    }
    l += ls;
    const char* vs = vbase + (i & 1) * VST;
#pragma unroll
    for (int ks = 0; ks < 4; ++ks) {
      const bf16x8 v0 = *(const bf16x8*)(vs + v_rd + ks * 32);
      const bf16x8 v1 = *(const bf16x8*)(vs + v_rd + 32 * LROW + ks * 32);
      o[0] = MFMA(v0, pf[ks], o[0]);
      o[1] = MFMA(v1, pf[ks], o[1]);
    }
    if (more2) LSK_(kbase + (i & 1) * KST);
    if (more1) LSV_(vbase + ((i + 1) & 1) * VST);
    __syncthreads();
    sc[0] = sn[0]; sc[1] = sn[1];
  }
#undef GLK_
#undef GLV_
#undef LSK_
#undef LSV_
  const float lt = l + __shfl_xor(l, 32);
  const float inv = 1.0f / lt;
  bf16_t* orow = out + (size_t)(w * 32 + ql) * out_rs;
#pragma unroll
  for (int dt = 0; dt < 2; ++dt)
#pragma unroll
    for (int g = 0; g < 4; ++g) {
      u32x2 p; p.x = pk2(o[dt][4 * g] * inv, o[dt][4 * g + 1] * inv); p.y = pk2(o[dt][4 * g + 2] * inv, o[dt][4 * g + 3] * inv);
      *(u32x2*)(orow + dt * 32 + 8 * g + 4 * h) = p;
    }
}

constexpr bool ATT_PIPE = false;
constexpr int AQT = 1;
constexpr int QBLK = 128 * AQT;
DI void phase_attn(const Ctx& c) {
  const int S = c.S, nseq = TC / S, nqb = S / QBLK;
  const int n_mla = nseq * 8 * nqb, n_gqa = n_mla, n_dil = nseq * 12 * nqb;
  const float* bias = (const float*)(c.ws + OFF_BIAS);
  for (int item = blockIdx.x; item < n_mla + n_gqa + n_dil; item += gridDim.x) {
    if (item < n_mla) {
      const int hh = item & 7, rest = item >> 3, seq = rest / nqb, qb = rest - seq * nqb;
      const size_t hs = (size_t)(seq * 8 + hh) * S;
      if (ATT_PIPE) attn_dense<96>(wsb(c, OFF_QA) + (hs + qb * QBLK) * 96, wsb(c, OFF_KA) + hs * 96, wsb(c, OFF_VTA) + (size_t)(seq * 8 + hh) * 64 * (S + 64), S + 64,
                     S, 0.10206207261596577f * LOG2E, wsb(c, OFF_OA) + ((size_t)seq * S + qb * QBLK) * LDO + hh * 64, LDO, c.lds);
      else attn_item<96, false, AQT>(wsb(c, OFF_QA) + (hs + qb * QBLK) * 96, wsb(c, OFF_KA) + hs * 96, wsb(c, OFF_VTA) + (size_t)(seq * 8 + hh) * 64 * (S + 64), S + 64,
                     0, S, 0, nullptr, 0.10206207261596577f * LOG2E, wsb(c, OFF_OA) + ((size_t)seq * S + qb * QBLK) * LDO + hh * 64, LDO, nullptr, 0, c.lds);
    } else if (item < n_mla + n_gqa) {
      const int i2 = item - n_mla;
      const int hq = i2 & 7, rest = i2 >> 3, seq = rest / nqb, qb = rest - seq * nqb;
      const size_t hs = (size_t)(seq * 8 + hq) * S, ks = (size_t)(seq * 2 + (hq >> 2)) * S;
      if (ATT_PIPE) attn_dense<64>(wsb(c, OFF_QC) + (hs + qb * QBLK) * 64, wsb(c, OFF_KC) + ks * 64, wsb(c, OFF_VTC) + (size_t)(seq * 2 + (hq >> 2)) * 64 * (S + 64), S + 64,
                     S, 0.125f * LOG2E, wsb(c, OFF_OC) + ((size_t)seq * S + qb * QBLK) * LDO + hq * 64, LDO, c.lds);
      else attn_item<64, false, AQT>(wsb(c, OFF_QC) + (hs + qb * QBLK) * 64, wsb(c, OFF_KC) + ks * 64, wsb(c, OFF_VTC) + (size_t)(seq * 2 + (hq >> 2)) * 64 * (S + 64), S + 64,
                     0, S, 0, nullptr, 0.125f * LOG2E, wsb(c, OFF_OC) + ((size_t)seq * S + qb * QBLK) * LDO + hq * 64, LDO, nullptr, 0, c.lds);
    } else {
      const int i2 = item - n_mla - n_gqa;
      const int hb = i2 % 12, rest = i2 / 12, seq = rest / nqb, blk = rest - seq * nqb;
      const int dsh = 2 * (hb >> 2), L = S >> dsh, dil = 1 << dsh;
      const int srow0 = blk * QBLK, rr = srow0 / L, l0 = srow0 - rr * L;
      const size_t hs = (size_t)(seq * 12 + hb) * S;
      int kb = l0 - 64; if (kb < 0) kb = 0;
      int ke = l0 + QBLK + 64; if (ke > L) ke = L;
      const size_t tok0 = (size_t)seq * S + (size_t)l0 * dil + rr;
      attn_item<64, true, AQT>(wsb(c, OFF_QB) + (hs + srow0) * 64, wsb(c, OFF_KB) + (hs + (size_t)rr * L) * 64, wsb(c, OFF_VTB) + (size_t)(seq * 12 + hb) * 64 * (S + 64) + (size_t)rr * L, S + 64,
                          kb, ke, l0, bias + hb * 132, 0.125f * LOG2E,
                          wsb(c, OFF_OBG) + tok0 * 768 + hb * 64, (size_t)dil * 768, (float*)(c.ws + OFF_LSE) + tok0 * 12 + hb, dil * 12, c.lds);
    }
    __syncthreads();
  }
}

DI void phase_combine(const Ctx& c) {
  const bf16_t* obg = wsb(c, OFF_OBG);
  const float* lse = (const float*)(c.ws + OFF_LSE);
  bf16_t* ob = wsb(c, OFF_OB);
  const int total = TC * 4 * 8;
  for (int idx = blockIdx.x * NTHREADS + tid_(); idx < total; idx += gridDim.x * NTHREADS) {
    const int d8 = idx & 7, j = (idx >> 3) & 3, tl = idx >> 5;
    const float l0 = lse[tl * 12 + j], l1 = lse[tl * 12 + 4 + j], l2 = lse[tl * 12 + 8 + j];
    const float mx = fmaxf(l0, fmaxf(l1, l2));
    float w0 = __expf(l0 - mx), w1 = __expf(l1 - mx), w2 = __expf(l2 - mx);
    const float inv = 1.0f / (w0 + w1 + w2);
    w0 *= inv; w1 *= inv; w2 *= inv;
    const u32x4 a = *(const u32x4*)(obg + (size_t)tl * 768 + j * 64 + d8 * 8);
    const u32x4 b = *(const u32x4*)(obg + (size_t)tl * 768 + (4 + j) * 64 + d8 * 8);
    const u32x4 d = *(const u32x4*)(obg + (size_t)tl * 768 + (8 + j) * 64 + d8 * 8);
    u32x4 r;
#pragma unroll
    for (int e = 0; e < 4; ++e) {
      const float lo = w0 * __uint_as_float(a[e] << 16) + w1 * __uint_as_float(b[e] << 16) + w2 * __uint_as_float(d[e] << 16);
      const float hi = w0 * __uint_as_float(a[e] & 0xffff0000u) + w1 * __uint_as_float(b[e] & 0xffff0000u) + w2 * __uint_as_float(d[e] & 0xffff0000u);
      r[e] = pk2(lo, hi);
    }
    *(u32x4*)(ob + (size_t)tl * LDOB + j * 64 + d8 * 8) = r;
  }
}

DI void phase_merge(const Ctx& c) {
  const bf16_t* xb = wsb(c, OFF_XB);
  const float* ss = ss_site(c, c.layer, 1);
  const float* bgate = inl(c, 21, 3072);
  bf16_t* mrg = wsb(c, OFF_MRG);
  float* cl = (float*)c.lds; float* rr = (float*)(c.lds + OFF_RR);
  const int tid = tid_(), lane = tid & 63, w = tid >> 6, wm = w >> 1, wn = w & 1, h = lane >> 5, cc = lane & 31;
  const int xcd_ = blockIdx.x & 7, slot_ = blockIdx.x >> 3, nslot_ = gridDim.x >> 3;
  for (int j_ = slot_; j_ < 16 * 16; j_ += nslot_) {
    const int mt = xcd_ * 16 + (j_ & 15), nt = j_ >> 4;
    __syncthreads();
    if (tid < 128) rr[tid] = rsqrtf(ss[mt * 128 + tid] * (1.0f / DM) + EPS);
    f32x16 macc[2][1]; zero_acc<1>(macc);
#pragma unroll 1
    for (int k = 0; k < 3; ++k) {
      f32x16 gacc[2][1]; zero_acc<1>(gacc);
      gemm_mainloop<1>(xb + (size_t)mt * 128 * LDX, LDX, wgt(c, W_GATE) + (size_t)(k * 1024 + nt * 64) * LDX, LDX, DM, gacc, c.lds);
      const float bv = bgate[k * 1024 + nt * 64 + wn * 32 + cc];
#pragma unroll
      for (int i = 0; i < 2; ++i)
#pragma unroll
        for (int r = 0; r < 16; ++r) {
          const float rv = rr[wm * 64 + i * 32 + (r & 3) + 8 * (r >> 2) + 4 * h];
          gacc[i][0][r] = sigmoidf_(gacc[i][0][r] * rv + bv);
        }
      f32x16 acc[2][1]; zero_acc<1>(acc);
      const int Kk = (k == 1) ? 256 : 512;
      const bf16_t* Ao = wsb(c, k == 0 ? OFF_OA : (k == 1 ? OFF_OB : OFF_OC));
      const bf16_t* Wo = wgt(c, k == 0 ? W_OA : (k == 1 ? W_OB : W_OC));
      gemm_mainloop<1>(Ao + (size_t)mt * 128 * (Kk + PADK), Kk + PADK, Wo + (size_t)nt * 64 * (Kk + PADK), Kk + PADK, Kk, acc, c.lds);
#pragma unroll
      for (int i = 0; i < 2; ++i)
#pragma unroll
        for (int r = 0; r < 16; ++r) macc[i][0][r] += gacc[i][0][r] * acc[i][0][r];
    }
    acc_to_lds<1>(macc, cl);
    __syncthreads();
    const int c4 = (tid & 15) * 4, r0 = tid >> 4;
#pragma unroll 4
    for (int it = 0; it < 8; ++it) {
      const int row = r0 + 16 * it;
      const f32x4 v = *(const f32x4*)(cl + row * CLD + c4);
      u32x2 p; p.x = pk2(v[0], v[1]); p.y = pk2(v[2], v[3]);
      *(u32x2*)(mrg + (size_t)(mt * 128 + row) * LDX + nt * 64 + c4) = p;
    }
    __syncthreads();
  }
}

DI void phase_ple(const Ctx& c) {
  const bf16_t* xb = wsb(c, OFF_XB);
  const float* ss = ss_site(c, c.layer, 3);
  float* ssn = ss_site(c, c.layer + 1, 0);
  const bf16_t* peb = wsb(c, OFF_PEB) + (size_t)c.layer * TC * LDPE;
  float* cl = (float*)c.lds; float* rr = (float*)(c.lds + OFF_RR);
  const int tid = tid_(), lane = tid & 63, w = tid >> 6, wm = w >> 1, h = lane >> 5;
  const int xcd_ = blockIdx.x & 7, slot_ = blockIdx.x >> 3, nslot_ = gridDim.x >> 3;
  for (int j_ = slot_; j_ < 16 * 16; j_ += nslot_) {
    const int mt = xcd_ * 16 + (j_ & 15), nt = j_ >> 4;
    if (tid < 128) rr[tid] = rsqrtf(ss[mt * 128 + tid] * (1.0f / DM) + EPS);
    f32x16 g[2][1]; zero_acc<1>(g);
    gemm_mainloop<1>(xb + (size_t)mt * 128 * LDX, LDX, wgt(c, W_PG) + (size_t)nt * 64 * LDX, LDX, DM, g, c.lds);
#pragma unroll
    for (int i = 0; i < 2; ++i)
#pragma unroll
      for (int r = 0; r < 16; ++r) {
        const float rv = rr[wm * 64 + i * 32 + (r & 3) + 8 * (r >> 2) + 4 * h];
        g[i][0][r] = sigmoidf_(g[i][0][r] * rv);
      }
    f32x16 acc[2][1]; zero_acc<1>(acc);
    gemm_mainloop<1>(peb + (size_t)mt * 128 * LDPE, LDPE, wgt(c, W_PLE) + (size_t)nt * 64 * LDPE, LDPE, 256, acc, c.lds);
#pragma unroll
    for (int i = 0; i < 2; ++i)
#pragma unroll
      for (int r = 0; r < 16; ++r) acc[i][0][r] *= g[i][0][r];
    acc_to_lds<1>(acc, cl);
    __syncthreads();
    resid_epilogue<1>(c.x, wsb(c, OFF_XB2), ssn, mt, nt, cl, 1.0f);
    __syncthreads();
  }
}

DI void phase_prologue(const Params& p, char* lds) {
  float* tl = (float*)lds;
  bf16_t* W = (bf16_t*)(p.ws + OFF_W);
  int rot = 0;
  for (int L = 0; L < 2; ++L) {
    bf16_t* wl = W + (size_t)L * W_LAYER;
    transpose_mat(p.in[5] + (size_t)L * 1024 * 5632, 5632, wl + W_FFN1_IN, 5632, 1024, p.in[4] + L * 1024, 1, tl, rot); rot += 88 * 16;
    transpose_mat(p.in[6] + (size_t)L * 2816 * 1024, 1024, wl + W_FFN1_OUT, 1024, 2816, nullptr, 0, tl, rot); rot += 16 * 44;
    transpose_mat(p.in[8] + (size_t)L * 1024 * 3488, 3488, wl + W_IN, 3584, 1024, p.in[7] + L * 1024, 2, tl, rot); rot += 56 * 16;
    transpose_mat(p.in[20] + (size_t)L * 1024 * 3072, 3072, wl + W_GATE, 3072, 1024, p.in[7] + L * 1024, 0, tl, rot); rot += 48 * 16;
    transpose_mat(p.in[11] + (size_t)L * 256 * 768, 768, wl + W_UQ, 768, 256, p.in[9] + L * 256, 3, tl, rot); rot += 12 * 4;
    transpose_mat(p.in[12] + (size_t)L * 128 * 1024, 1024, wl + W_UKV, 1024, 128, p.in[10] + L * 128, 4, tl, rot); rot += 16 * 2;
    transpose_mat(p.in[22] + (size_t)L * 512 * 1024, 1024, wl + W_OA, 1024, 512, nullptr, 0, tl, rot); rot += 16 * 8;
    transpose_mat(p.in[23] + (size_t)L * 256 * 1024, 1024, wl + W_OB, 1024, 256, nullptr, 0, tl, rot); rot += 16 * 4;
    transpose_mat(p.in[24] + (size_t)L * 512 * 1024, 1024, wl + W_OC, 1024, 512, nullptr, 0, tl, rot); rot += 16 * 8;
    transpose_mat(p.in[25] + (size_t)L * 1024 * 1024, 1024, wl + W_OUT, 1024, 1024, nullptr, 0, tl, rot); rot += 16 * 16;
    transpose_mat(p.in[27] + (size_t)L * 1024 * 5632, 5632, wl + W_FFN2_IN, 5632, 1024, p.in[26] + L * 1024, 1, tl, rot); rot += 88 * 16;
    transpose_mat(p.in[28] + (size_t)L * 2816 * 1024, 1024, wl + W_FFN2_OUT, 1024, 2816, nullptr, 0, tl, rot); rot += 16 * 44;
    transpose_mat(p.in[30] + (size_t)L * 1024 * 1024, 1024, wl + W_PG, 1024, 1024, p.in[29] + L * 1024, 0, tl, rot); rot += 16 * 16;
    transpose_mat(p.in[31] + (size_t)L * 256 * 1024, 1024, wl + W_PLE, 1024, 256, nullptr, 0, tl, rot); rot += 16 * 4;
  }
  const int gtid = blockIdx.x * NTHREADS + tid_(), gn = gridDim.x * NTHREADS;
  f32x2* rope = (f32x2*)(p.ws + OFF_ROPE);
  for (int idx = gtid; idx < 16384 * 16; idx += gn) {
    const int pos = idx >> 4, i = idx & 15;
    const float freq = (float)pow(10000.0, -(double)i / 16.0);
    const float ang = (float)pos * freq;
    f32x2 cs; cs.x = (float)cos((double)ang); cs.y = (float)sin((double)ang);
    rope[idx] = cs;
  }
  float* bias = (float*)(p.ws + OFF_BIAS);
  for (int idx = gtid; idx < 12 * 129; idx += gn) {
    const int hb = idx / 129, jj = idx - hb * 129;
    const int dil = 1 << (2 * (hb >> 2));
    const int rel = (jj - 64) * dil;
    const int n = rel < 0 ? -rel : rel;
    int b;
    if (n < 8) b = n;
    else { int lg = 8 + (int)(log((double)n / 8.0) / log(128.0) * 8.0); if (lg > 15) lg = 15; b = lg; }
    if (rel > 0) b += 16;
    bias[hb * 132 + jj] = p.in[17][b * 12 + hb] * LOG2E;
  }
}

DI void phase_init(const Ctx& c) {
  const int tid = tid_(), lane = tid & 63;
  const int gw = blockIdx.x * 4 + (tid >> 6), nw = gridDim.x * 4;
  bf16_t* xb = wsb(c, OFF_XB);
  float* ss0 = ss_site(c, 0, 0);
  for (int row = gw; row < TC; row += nw) {
    float s = 0.f;
#pragma unroll
    for (int i = 0; i < 4; ++i) {
      const size_t gi = (size_t)row * DM + i * 256 + lane * 4;
      const f32x4 v = *(const f32x4*)(c.xin + gi);
      *(f32x4*)(c.x + gi) = v;
      u32x2 p; p.x = pk2(v[0], v[1]); p.y = pk2(v[2], v[3]);
      *(u32x2*)(xb + (size_t)row * LDX + i * 256 + lane * 4) = p;
      s += v[0] * v[0] + v[1] * v[1] + v[2] * v[2] + v[3] * v[3];
    }
#pragma unroll
    for (int o = 32; o >= 1; o >>= 1) s += __shfl_xor(s, o);
    if (lane == 0) ss0[row] = s;
  }
  const int gtid = blockIdx.x * NTHREADS + tid, gn = gridDim.x * NTHREADS;
  float* ssall = (float*)(c.ws + OFF_SS);
  for (int idx = gtid + TC; idx < 3 * 6 * TC; idx += gn) ssall[idx] = 0.f;
  bf16_t* peb = wsb(c, OFF_PEB);
  for (int idx = gtid; idx < 2 * TC * 64; idx += gn) {
    const int L = idx / (TC * 64), r = idx - L * (TC * 64);
    const f32x4 v = *(const f32x4*)(c.pe0 + (size_t)L * c.pe_ls + (size_t)r * 4);
    u32x2 p; p.x = pk2(v[0], v[1]); p.y = pk2(v[2], v[3]);
    *(u32x2*)(peb + ((size_t)L * TC + (r >> 6)) * LDPE + (r & 63) * 4) = p;
  }
}

#ifndef ONLY
#define ONLY -1
#endif
#define PH(n) (ONLY < 0 || ONLY == (n))
#if DUP == 200
#define GSYNC() do { xcd_barrier(xb); xcd_barrier(xb); } while (0)
#else
#define GSYNC() xcd_barrier(xb)
#endif
#define REP(n) for (int rep_ = 0; rep_ < ((DUP == (n) || (DUP == 100 && ((n) == 2 || (n) == 10))) ? 2 : 1); ++rep_)
__global__ void __launch_bounds__(NTHREADS, 2) mega_kernel(Params p) {
  extern __shared__ __attribute__((aligned(16))) char lds[];
  cg::grid_group grid = cg::this_grid();
  volatile LAS unsigned* xst = (volatile LAS unsigned*)(lds + OFF_RR + 512);
  if (threadIdx.x == 0) { xst[0] = 0u; xst[1] = 0u; }
  __syncthreads();
  const XcdBarrier xb = xcd_barrier_post((unsigned*)(p.ws + OFF_BAR), xst);
  REP(0) { if (PH(0)) phase_prologue(p, lds); grid.sync(); }
  for (int chunk = 0; chunk < 3; ++chunk) {
    Ctx c;
    c.p = &p; c.chunk = chunk; c.layer = 0; c.ws = p.ws; c.lds = lds;
    c.S = chunk == 0 ? 4096 : 16384; c.sshift = chunk == 0 ? 12 : 14;
    c.x = p.out + (size_t)chunk * TC * DM;
    c.xin = chunk == 0 ? p.in[0] : p.in[1] + (size_t)(chunk - 1) * TC * DM;
    c.pe0 = chunk == 0 ? p.in[2] : p.in[3] + (size_t)(chunk - 1) * TC * 256;
    c.pe_ls = chunk == 0 ? (size_t)TC * 256 : (size_t)2 * TC * 256;
    REP(1) { if (PH(1)) phase_init(c); GSYNC(); }
#pragma unroll 1
    for (int layer = 0; layer < 2; ++layer) {
      c.layer = layer;
      REP(2) { if (PH(2)) phase_ffn_in(c, wsb(c, layer == 0 ? OFF_XB : OFF_XB2), W_FFN1_IN, 0); GSYNC(); }
#if DUP == 300
      { phase_ffn_probe(c, wsb(c, layer == 0 ? OFF_XB : OFF_XB2), W_FFN1_IN, 0); GSYNC(); }
#endif
      REP(3) { if (PH(3)) phase_resid_gemm(c, wsb(c, OFF_ACT), DFF, W_FFN1_OUT, 0.5f, ss_site(c, layer, 1)); GSYNC(); }
      REP(4) { if (PH(4)) phase_proj(c); GSYNC(); }
      REP(5) { if (PH(5)) phase_mlaup(c); GSYNC(); }
      REP(6) { if (PH(6)) phase_attn(c); GSYNC(); }
      REP(7) { if (PH(7)) phase_combine(c); GSYNC(); }
      REP(8) { if (PH(8)) phase_merge(c); GSYNC(); }
      REP(9) { if (PH(9)) phase_resid_gemm(c, wsb(c, OFF_MRG), DM, W_OUT, 1.0f, ss_site(c, layer, 2)); GSYNC(); }
      REP(10) { if (PH(10)) phase_ffn_in(c, wsb(c, OFF_XB), W_FFN2_IN, 2); GSYNC(); }
      REP(11) { if (PH(11)) phase_resid_gemm(c, wsb(c, OFF_ACT), DFF, W_FFN2_OUT, 0.5f, ss_site(c, layer, 3)); GSYNC(); }
      REP(12) { if (PH(12)) phase_ple(c); GSYNC(); }
    }
  }
}

extern "C" void kernel_launch(void* const* d_in, const int* in_sizes, int n_in, void* d_out, int out_size, void* d_ws, size_t ws_size, hipStream_t stream) {
  static int grid_blocks = 0;
  if (!grid_blocks) {
    int dev = 0, cus = 0, per_cu = 0;
    hipGetDevice(&dev);
    hipDeviceGetAttribute(&cus, hipDeviceAttributeMultiprocessorCount, dev);
    hipFuncSetAttribute((const void*)mega_kernel, hipFuncAttributeMaxDynamicSharedMemorySize, LDS_BYTES);
    hipOccupancyMaxActiveBlocksPerMultiprocessor(&per_cu, mega_kernel, NTHREADS, LDS_BYTES);
    if (per_cu > 2) per_cu = 2;
    if (per_cu < 1) per_cu = 1;
    grid_blocks = cus * per_cu;
  }
  Params p{};
  for (int i = 0; i < 32; ++i) p.in[i] = (const float*)d_in[i];
  p.out = (float*)d_out;
  p.ws = (char*)d_ws;
  hipMemsetAsync((char*)d_ws + OFF_BAR, 0, 16384, stream);
  void* args[] = {&p};
  hipError_t e = hipLaunchCooperativeKernel((const void*)mega_kernel, dim3(grid_blocks), dim3(NTHREADS), args, LDS_BYTES, stream);
  if (e != hipSuccess) fprintf(stderr, "cooperative launch failed: %s (grid %d)\n", hipGetErrorString(e), grid_blocks);
}
```

```cpp
#ifndef DUP
#define DUP -1
#endif
#include <hip/hip_runtime.h>
#include <hip/hip_cooperative_groups.h>
#include <stdint.h>
#include <cstdio>
namespace cg = cooperative_groups;

typedef unsigned short bf16_t;
typedef short bf16x8 __attribute__((ext_vector_type(8)));
typedef float f32x16 __attribute__((ext_vector_type(16)));
typedef float f32x4 __attribute__((ext_vector_type(4)));
typedef float f32x2 __attribute__((ext_vector_type(2)));
typedef unsigned u32x4 __attribute__((ext_vector_type(4)));
typedef unsigned u32x2 __attribute__((ext_vector_type(2)));
typedef __bf16 bf16x2_t __attribute__((ext_vector_type(2)));
#define DI __device__ __forceinline__
#define MFMA(a, b, c) __builtin_amdgcn_mfma_f32_32x32x16_bf16((a), (b), (c), 0, 0, 0)

constexpr int TC = 16384;
constexpr int DM = 1024;
constexpr int DFF = 2816;
constexpr float EPS = 1e-6f;
constexpr float LOG2E = 1.4426950408889634f;
constexpr float LN2 = 0.6931471805599453f;
constexpr int NTHREADS = 256;
constexpr int PADK = 64;
constexpr int LDX = DM + PADK;
constexpr int LDACT = DFF + PADK;
constexpr int LDCQ = 256 + PADK, LDCKV = 128 + PADK, LDO = 512 + PADK, LDOB = 256 + PADK, LDPE = 256 + PADK;

constexpr size_t W_FFN1_IN = 0;
constexpr size_t W_FFN1_OUT = W_FFN1_IN + (size_t)5632 * LDX;
constexpr size_t W_IN = W_FFN1_OUT + (size_t)1024 * LDACT;
constexpr size_t W_GATE = W_IN + (size_t)3584 * LDX;
constexpr size_t W_UQ = W_GATE + (size_t)3072 * LDX;
constexpr size_t W_UKV = W_UQ + (size_t)768 * LDCQ;
constexpr size_t W_OA = W_UKV + (size_t)1024 * LDCKV;
constexpr size_t W_OB = W_OA + (size_t)1024 * LDO;
constexpr size_t W_OC = W_OB + (size_t)1024 * LDOB;
constexpr size_t W_OUT = W_OC + (size_t)1024 * LDO;
constexpr size_t W_FFN2_IN = W_OUT + (size_t)1024 * LDX;
constexpr size_t W_FFN2_OUT = W_FFN2_IN + (size_t)5632 * LDX;
constexpr size_t W_PG = W_FFN2_OUT + (size_t)1024 * LDACT;
constexpr size_t W_PLE = W_PG + (size_t)1024 * LDX;
constexpr size_t W_LAYER = W_PLE + (size_t)1024 * LDPE;

constexpr size_t AL(size_t x) { return (x + 255) & ~(size_t)255; }
constexpr size_t OFF_W = 0;
constexpr size_t OFF_BAR = AL(OFF_W + 2 * W_LAYER * 2);
constexpr size_t OFF_ROPE = AL(OFF_BAR + 16384);
constexpr size_t OFF_BIAS = AL(OFF_ROPE + (size_t)16384 * 16 * 8);
constexpr size_t OFF_SS = AL(OFF_BIAS + 12 * 132 * 4);
constexpr size_t OFF_XB = AL(OFF_SS + (size_t)3 * 6 * TC * 4);
constexpr size_t OFF_XB2 = AL(OFF_XB + (size_t)TC * LDX * 2);
constexpr size_t OFF_PEB = AL(OFF_XB2 + (size_t)TC * LDX * 2);
constexpr size_t OFF_BIG = AL(OFF_PEB + (size_t)2 * TC * LDPE * 2);
constexpr size_t OFF_ACT = OFF_BIG;
constexpr size_t OFF_CQ = OFF_BIG;
constexpr size_t OFF_CKV = AL(OFF_CQ + (size_t)TC * LDCQ * 2);
constexpr size_t OFF_QA = AL(OFF_CKV + (size_t)TC * LDCKV * 2);
constexpr size_t OFF_KA = AL(OFF_QA + (size_t)TC * 768 * 2);
constexpr size_t OFF_VTA = AL(OFF_KA + (size_t)TC * 768 * 2);
constexpr size_t OFF_QB = AL(OFF_VTA + (size_t)(TC + 256) * 512 * 2);
constexpr size_t OFF_KB = AL(OFF_QB + (size_t)TC * 768 * 2);
constexpr size_t OFF_VTB = AL(OFF_KB + (size_t)TC * 768 * 2);
constexpr size_t OFF_QC = AL(OFF_VTB + (size_t)(TC + 256) * 768 * 2);
constexpr size_t OFF_KC = AL(OFF_QC + (size_t)TC * 512 * 2);
constexpr size_t OFF_VTC = AL(OFF_KC + (size_t)TC * 128 * 2);
constexpr size_t OFF_OA = AL(OFF_VTC + (size_t)(TC + 256) * 128 * 2);
constexpr size_t OFF_OBG = AL(OFF_OA + (size_t)TC * LDO * 2);
constexpr size_t OFF_LSE = AL(OFF_OBG + (size_t)TC * 768 * 2);
constexpr size_t OFF_OB = AL(OFF_LSE + (size_t)TC * 12 * 4);
constexpr size_t OFF_OC = AL(OFF_OB + (size_t)TC * LDOB * 2);
constexpr size_t OFF_MRG = AL(OFF_OC + (size_t)TC * LDO * 2);
constexpr size_t OFF_END = AL(OFF_MRG + (size_t)TC * LDX * 2);
static_assert(OFF_END < (size_t)508 * 1024 * 1024, "workspace too large");
static_assert(OFF_ACT + (size_t)TC * LDACT * 2 <= OFF_END, "act fits");

struct Params {
  const float* in[32];
  float* out;
  char* ws;
};

constexpr int LROW = 144;
constexpr int STAGE_OP = 128 * LROW;
constexpr int STAGE = 2 * STAGE_OP;
constexpr int CLD = 132;
constexpr int OFF_RR = 2 * STAGE;
constexpr int LDS_BYTES = 2 * STAGE + 1024;
static_assert(128 * CLD * 4 <= OFF_RR, "lds");

DI int tid_() { int t = threadIdx.x; asm volatile("" : "+v"(t)); return t; }
DI unsigned pk2(float a, float b) { f32x2 v = {a, b}; bf16x2_t r = __builtin_convertvector(v, bf16x2_t); return __builtin_bit_cast(unsigned, r); }
DI bf16_t f2bf(float a) { return (bf16_t)(pk2(a, 0.f) & 0xffffu); }
DI float bf2f(bf16_t v) { return __uint_as_float(((unsigned)v) << 16); }
DI float sigmoidf_(float x) { return 1.0f / (1.0f + __expf(-x)); }

DI int map_col(int map, int n) {
  switch (map) {
    case 0: return n;
    case 1: { int t = n >> 7, w = n & 127; return w < 64 ? t * 64 + w : DFF + t * 64 + (w - 64); }
    case 2: { int slot = n >> 6, d = n & 63; if (slot < 6) return n; if (slot == 6) return d < 32 ? 384 + d : -1; if (slot < 55) return 416 + (n - 448); return -1; }
    case 3: { if (n < 512) return (n >> 6) * 96 + (n & 63); int i = n - 512; return (i >> 5) * 96 + 64 + (i & 31); }
    default: { if (n < 512) return (n >> 6) * 128 + (n & 63); int i = n - 512; return (i >> 6) * 128 + 64 + (i & 63); }
  }
}

DI void transpose_mat(const float* __restrict__ src, int ld_src, bf16_t* __restrict__ dst, int N, int K, const float* __restrict__ gain, int map, float* lds, int rot) {
  const int ntk = K >> 6, ntn = N >> 6, nt = ntk * ntn;
  const int tid = tid_(), c = tid & 63, rq = tid >> 6;
  int b0 = (int)blockIdx.x - (rot % (int)gridDim.x); if (b0 < 0) b0 += gridDim.x;
  for (int t = b0; t < nt; t += gridDim.x) {
    const int tn = t / ntk, tk = t - tn * ntk;
    const int n0 = tn << 6, k0 = tk << 6;
    const int sc = map_col(map, n0 + c);
#pragma unroll 4
    for (int r = 0; r < 16; ++r) {
      const int kk = r * 4 + rq;
      float v = 0.f;
      if (sc >= 0) { v = src[(size_t)(k0 + kk) * ld_src + sc]; if (gain) v *= gain[k0 + kk]; }
      lds[c * 65 + kk] = v;
    }
    __syncthreads();
#pragma unroll 4
    for (int r = 0; r < 16; ++r) {
      const int nn = r * 4 + rq;
      dst[(size_t)(n0 + nn) * (K + PADK) + k0 + c] = f2bf(lds[nn * 65 + c]);
    }
    __syncthreads();
  }
}

template <int NJ> DI void zero_acc(f32x16 (&acc)[2][NJ]) {
#pragma unroll
  for (int i = 0; i < 2; ++i)
#pragma unroll
    for (int j = 0; j < NJ; ++j)
#pragma unroll
      for (int r = 0; r < 16; ++r) acc[i][j][r] = 0.f;
}

template <int NJ> DI void gemm_mainloop(const bf16_t* __restrict__ A, int lda, const bf16_t* __restrict__ Bt, int ldb, int K, f32x16 (&acc)[2][NJ], char* lds) {
  const int tid = tid_(), lane = tid & 63, w = tid >> 6, wm = w >> 1, wn = w & 1;
  const int lr = tid >> 3, lc = tid & 7;
  const char* ap = (const char*)A;
  const char* bp = (const char*)Bt;
  const unsigned aoff = (unsigned)(lr * lda + lc * 8) * 2u, boff = (unsigned)(lr * ldb + lc * 8) * 2u;
  const unsigned astep = (unsigned)(32 * lda) * 2u, bstep = (unsigned)(32 * ldb) * 2u;
  constexpr int NB = 2 * NJ;
  u32x4 ra0[4], rb0[NB], ra1[4], rb1[NB];
  const int wofs = lr * LROW + lc * 16;
  const int a_rd = (wm * 64 + (lane & 31)) * LROW + (lane >> 5) * 16;
  const int b_rd = STAGE_OP + (wn * 32 * NJ + (lane & 31)) * LROW + (lane >> 5) * 16;
#define GL1_(RA, RB, i) { RA[i] = *(const u32x4*)(ap + (aoff + (i) * astep)); if ((i) < NB) RB[(i) < NB ? (i) : 0] = *(const u32x4*)(bp + (boff + (i) * bstep)); }
#define LS1_(RA, RB, ST, i) { char* sn_ = lds + (ST) * STAGE; *(u32x4*)(sn_ + wofs + (i) * 32 * LROW) = RA[i]; \
                              if ((i) < NB) *(u32x4*)(sn_ + STAGE_OP + wofs + (i) * 32 * LROW) = RB[(i) < NB ? (i) : 0]; }
#define RF_(ks) { fa0 = *(const bf16x8*)(st_ + a_rd + (ks) * 32); fa1 = *(const bf16x8*)(st_ + a_rd + 32 * LROW + (ks) * 32); \
      _Pragma("unroll") for (int j = 0; j < NJ; ++j) fb[j] = *(const bf16x8*)(st_ + b_rd + j * 32 * LROW + (ks) * 32); }
#define STEP_(ST, DOL, RAL, RBL, DOS, RAS, RBS) { const char* st_ = lds + (ST) * STAGE; \
    bf16x8 fa0, fa1, fb[NJ]; RF_(0); \
    _Pragma("unroll") for (int ks = 0; ks < 4; ++ks) { \
      if (DOL) GL1_(RAL, RBL, ks); \
      const bf16x8 ca0 = fa0, ca1 = fa1; bf16x8 cb[NJ]; \
      _Pragma("unroll") for (int j = 0; j < NJ; ++j) cb[j] = fb[j]; \
      if (ks < 3) RF_(ks + 1); \
      _Pragma("unroll") for (int j = 0; j < NJ; ++j) { acc[0][j] = MFMA(ca0, cb[j], acc[0][j]); acc[1][j] = MFMA(ca1, cb[j], acc[1][j]); } \
      if (DOS) LS1_(RAS, RBS, 1 - (ST), ks); \
      __builtin_amdgcn_sched_barrier(0); } \
    if (DOL) { ap += 128; bp += 128; } }
#pragma unroll
  for (int i = 0; i < 4; ++i) GL1_(ra0, rb0, i);
  ap += 128; bp += 128;
#pragma unroll
  for (int i = 0; i < 4; ++i) GL1_(ra1, rb1, i);
  ap += 128; bp += 128;
#pragma unroll
  for (int i = 0; i < 4; ++i) LS1_(ra0, rb0, 0, i);
  __syncthreads();
  const int nk = K >> 6;
  for (int kt = 0; kt < nk; kt += 2) {
    const bool l0 = (kt + 2 < nk), l1 = (kt + 3 < nk);
    STEP_(0, l0, ra0, rb0, true, ra1, rb1);
    __syncthreads();
    STEP_(1, l1, ra1, rb1, l0, ra0, rb0);
    __syncthreads();
  }
#undef GL1_
#undef LS1_
#undef STEP_
#undef RF_
}

template <int NJ> DI void acc_to_lds(const f32x16 (&acc)[2][NJ], float* cl) {
  const int tid = tid_(), lane = tid & 63, w = tid >> 6, wm = w >> 1, wn = w & 1, h = lane >> 5, c = lane & 31;
#pragma unroll
  for (int i = 0; i < 2; ++i)
#pragma unroll
    for (int j = 0; j < NJ; ++j)
#pragma unroll
      for (int r = 0; r < 16; ++r) {
        const int row = wm * 64 + i * 32 + (r & 3) + 8 * (r >> 2) + 4 * h;
        cl[row * CLD + wn * 32 * NJ + j * 32 + c] = acc[i][j][r];
      }
}

template <int NJ> DI void resid_epilogue(float* __restrict__ x, bf16_t* __restrict__ xb, float* __restrict__ ssn, int mt, int nt, const float* cl, float scale) {
  constexpr int LPR = 16 * NJ, RPP = 256 / LPR, NP = 128 / RPP;
  const int tid = tid_(), c4 = (tid & (LPR - 1)) * 4, r0 = tid / LPR;
#pragma unroll 4
  for (int it = 0; it < NP; ++it) {
    const int row = r0 + RPP * it;
    const f32x4 c = *(const f32x4*)(cl + row * CLD + c4);
    const size_t gi = (size_t)(mt * 128 + row) * DM + nt * (64 * NJ) + c4;
    f32x4 xv = *(const f32x4*)(x + gi);
    xv = xv + scale * c;
    *(f32x4*)(x + gi) = xv;
    u32x2 p; p.x = pk2(xv[0], xv[1]); p.y = pk2(xv[2], xv[3]);
    *(u32x2*)(xb + (size_t)(mt * 128 + row) * LDX + nt * (64 * NJ) + c4) = p;
    float s_ = xv[0] * xv[0] + xv[1] * xv[1] + xv[2] * xv[2] + xv[3] * xv[3];
    if (NJ == 2) s_ += __shfl_xor(s_, 16);
    s_ += __shfl_xor(s_, 8); s_ += __shfl_xor(s_, 4); s_ += __shfl_xor(s_, 2); s_ += __shfl_xor(s_, 1);
    if ((tid & (LPR - 1)) == 0) atomicAdd(ssn + mt * 128 + row, s_);
  }
}

#define XB_TMO      128
#define XB_XCNT(j)  (256  + 64 * (j))
#define XB_XSUB(j)  (1280 + 64 * (j))
#define XB_XGEN(j)  (2304 + 64 * (j))
#define XB_TOP      3328
#define XB_TOPGEN   3392
#define XCD_BAR_WORDS 3456
#define XB_SPIN_CAP (1u << 22)
#define LAS __attribute__((address_space(3)))
DI unsigned xb_ld(unsigned* p)              { return __hip_atomic_load(p, __ATOMIC_RELAXED, __HIP_MEMORY_SCOPE_AGENT); }
DI unsigned xb_add(unsigned* p, unsigned v) { return __hip_atomic_fetch_add(p, v, __ATOMIC_RELAXED, __HIP_MEMORY_SCOPE_AGENT); }
DI unsigned xb_xcc_id() { return (unsigned)__builtin_amdgcn_s_getreg((3 << 11) | 20) & 0xFu; }
#define XB_SPIN(cond, bar) do { unsigned _sp = 0; while (cond) { __builtin_amdgcn_s_sleep(1); \
    if ((++_sp & 255u) == 0u) { if (xb_ld(&(bar)[XB_TMO])) break; if (_sp > XB_SPIN_CAP) { atomicAdd(&(bar)[XB_TMO], 1u); break; } } } } while (0)
struct XcdBarrier { unsigned* bar; unsigned x; volatile LAS unsigned* st; };
DI XcdBarrier xcd_barrier_post(unsigned* bar, volatile LAS unsigned* st) {
  XcdBarrier b; b.bar = bar; b.x = xb_xcc_id(); b.st = st;
  if (threadIdx.x == 0) (void)xb_add(&bar[XB_XCNT(b.x)], 1u);
  return b;
}
DI void xcd_barrier_complete(unsigned* bar, unsigned x, unsigned& nloc, unsigned& nx) {
  const unsigned G = gridDim.x * gridDim.y * gridDim.z;
  unsigned sum, cnt, mine, sp = 0u;
  for (;;) {
    sum = 0u; cnt = 0u; mine = 0u;
#pragma unroll
    for (unsigned j = 0; j < 16; ++j) { const unsigned c = xb_ld(&bar[XB_XCNT(j)]); sum += c; cnt += (c > 0u) ? 1u : 0u; mine = (j == x) ? c : mine; }
    if (sum == G) break;
    __builtin_amdgcn_s_sleep(1);
    if ((++sp & 255u) == 0u) { if (xb_ld(&bar[XB_TMO])) break; if (sp > XB_SPIN_CAP) { atomicAdd(&bar[XB_TMO], 1u); break; } }
  }
  nloc = mine > 0u ? mine : 1u; nx = cnt > 0u ? cnt : 1u;
}
DI void xcd_barrier(const XcdBarrier& b) {
  asm volatile("s_waitcnt vmcnt(0)" ::: "memory");
  __syncthreads();
  if (threadIdx.x == 0) {
    unsigned* bar = b.bar;
    __builtin_amdgcn_s_waitcnt(0);
    unsigned nloc = b.st[0], nx = b.st[1];
    if (nloc == 0u) { xcd_barrier_complete(bar, b.x, nloc, nx); b.st[0] = nloc; b.st[1] = nx; }
    const unsigned old = xb_add(&bar[XB_XSUB(b.x)], 1u);
    const unsigned gen = old / nloc;
    if (old + 1u == (gen + 1u) * nloc) {
      __builtin_amdgcn_fence(__ATOMIC_RELEASE, "agent");
      asm volatile("s_waitcnt vmcnt(0)" ::: "memory");
      const unsigned og = xb_add(&bar[XB_TOP], 1u);
      const unsigned tg = og / nx;
      if (og + 1u == (tg + 1u) * nx) xb_add(&bar[XB_TOPGEN], 1u);
      else XB_SPIN(xb_ld(&bar[XB_TOPGEN]) == tg, bar);
      __builtin_amdgcn_fence(__ATOMIC_ACQUIRE, "agent");
      xb_add(&bar[XB_XGEN(b.x)], 1u);
      asm volatile("s_waitcnt vmcnt(0)" ::: "memory");
    } else {
      XB_SPIN(xb_ld(&bar[XB_XGEN(b.x)]) == gen, bar);
      __builtin_amdgcn_fence(__ATOMIC_ACQUIRE, "agent");
      asm volatile("s_waitcnt vmcnt(0)" ::: "memory");
    }
  }
  __syncthreads();
}

struct Ctx {
  const Params* p;
  int chunk, layer;
  int S, sshift;
  float* x;
  const float* xin;
  const float* pe0; size_t pe_ls;
  char* ws;
  char* lds;
};
DI bf16_t* wsb(const Ctx& c, size_t off) { return (bf16_t*)(c.ws + off); }
DI float* ss_site(const Ctx& c, int layer, int site) { return (float*)(c.ws + OFF_SS) + ((size_t)layer * 6 + site) * TC; }
DI const bf16_t* wgt(const Ctx& c, size_t off) { return (const bf16_t*)(c.ws + OFF_W) + (size_t)c.layer * W_LAYER + off; }
DI const float* inl(const Ctx& c, int idx, size_t per_layer) { return c.p->in[idx] + (size_t)c.layer * per_layer; }

DI void phase_ffn_in(const Ctx& c, const bf16_t* A, size_t woff, int site) {
  const bf16_t* Bt = wgt(c, woff);
  bf16_t* act = wsb(c, OFF_ACT);
  const float* ss = ss_site(c, c.layer, site);
  float* cl = (float*)c.lds; float* rr = (float*)(c.lds + OFF_RR);
  const int tid = tid_();
  const int xcd_ = blockIdx.x & 7, slot_ = blockIdx.x >> 3, nslot_ = gridDim.x >> 3;
  for (int j_ = slot_; j_ < 16 * 44; j_ += nslot_) {
    const int mt = xcd_ * 16 + (j_ & 15), nt = j_ >> 4;
    f32x16 acc[2][2]; zero_acc<2>(acc);
    gemm_mainloop<2>(A + (size_t)mt * 128 * LDX, LDX, Bt + (size_t)nt * 128 * LDX, LDX, DM, acc, c.lds);
    acc_to_lds<2>(acc, cl);
    if (tid < 128) rr[tid] = rsqrtf(ss[mt * 128 + tid] * (1.0f / DM) + EPS);
    __syncthreads();
    const int c4 = (tid & 15) * 4, r0 = tid >> 4;
#pragma unroll 2
    for (int it = 0; it < 8; ++it) {
      const int row = r0 + 16 * it;
      const float r = rr[row];
      const f32x4 a = *(const f32x4*)(cl + row * CLD + c4);
      const f32x4 b = *(const f32x4*)(cl + row * CLD + 64 + c4);
      float o[4];
#pragma unroll
      for (int e = 0; e < 4; ++e) { const float av = a[e] * r, bv = b[e] * r; o[e] = av * sigmoidf_(av) * bv; }
      u32x2 pq; pq.x = pk2(o[0], o[1]); pq.y = pk2(o[2], o[3]);
      *(u32x2*)(act + (size_t)(mt * 128 + row) * LDACT + nt * 64 + c4) = pq;
    }
    __syncthreads();
  }
}

#if DUP == 300
DI void phase_ffn_probe(const Ctx& c, const bf16_t* A, size_t woff, int site) {
  const bf16_t* Bt = wgt(c, woff);
  bf16_t* act = (bf16_t*)(c.ws + OFF_ACT + (size_t)110 * 1024 * 1024);
  const float* ss = ss_site(c, c.layer, site);
  float* cl = (float*)c.lds; float* rr = (float*)(c.lds + OFF_RR);
  const int tid = tid_();
  const int xcd_ = blockIdx.x & 7, slot_ = blockIdx.x >> 3, nslot_ = gridDim.x >> 3;
  for (int j_ = slot_; j_ < 16 * 44; j_ += nslot_) {
    const int mt = xcd_ * 16 + (j_ & 15), nt = j_ >> 4;
    f32x16 acc[2][2]; zero_acc<2>(acc);
    gemm_mainloop<2>(A + (size_t)(mt & 1) * 128 * LDX, LDX, Bt + (size_t)(nt & 1) * 128 * LDX, LDX, DM, acc, c.lds);
    acc_to_lds<2>(acc, cl);
    if (tid < 128) rr[tid] = rsqrtf(ss[mt * 128 + tid] * (1.0f / DM) + EPS);
    __syncthreads();
    const int c4 = (tid & 15) * 4, r0 = tid >> 4;
#pragma unroll 2
    for (int it = 0; it < 8; ++it) {
      const int row = r0 + 16 * it;
      const float r = rr[row];
      const f32x4 a = *(const f32x4*)(cl + row * CLD + c4);
      const f32x4 b = *(const f32x4*)(cl + row * CLD + 64 + c4);
      float o[4];
#pragma unroll
      for (int e = 0; e < 4; ++e) { const float av = a[e] * r, bv = b[e] * r; o[e] = av * sigmoidf_(av) * bv; }
      u32x2 pq; pq.x = pk2(o[0], o[1]); pq.y = pk2(o[2], o[3]);
      *(u32x2*)(act + (size_t)(mt * 128 + row) * LDACT + nt * 64 + c4) = pq;
    }
    __syncthreads();
  }
}
#endif

DI void phase_resid_gemm(const Ctx& c, const bf16_t* A, int K, size_t woff, float scale, float* ssn) {
  const bf16_t* Bt = wgt(c, woff);
  bf16_t* xb = wsb(c, OFF_XB);
  float* cl = (float*)c.lds;
  const int xcd_ = blockIdx.x & 7, slot_ = blockIdx.x >> 3, nslot_ = gridDim.x >> 3;
  for (int j_ = slot_; j_ < 16 * 8; j_ += nslot_) {
    const int mt = xcd_ * 16 + (j_ & 15), nt = j_ >> 4;
    f32x16 acc[2][2]; zero_acc<2>(acc);
    gemm_mainloop<2>(A + (size_t)mt * 128 * (K + PADK), K + PADK, Bt + (size_t)nt * 128 * (K + PADK), K + PADK, K, acc, c.lds);
    acc_to_lds<2>(acc, cl);
    __syncthreads();
    resid_epilogue<2>(c.x, xb, ssn, mt, nt, cl, scale);
    __syncthreads();
  }
}

DI void load_slot(const float* cl, int row, int col0, float (&v)[64]) {
#pragma unroll
  for (int q = 0; q < 16; ++q) { const f32x4 t = *(const f32x4*)(cl + row * CLD + col0 + q * 4); v[4 * q] = t[0]; v[4 * q + 1] = t[1]; v[4 * q + 2] = t[2]; v[4 * q + 3] = t[3]; }
}
template <int N> DI void store_bf16(bf16_t* dst, const float* v) {
#pragma unroll
  for (int q = 0; q < N / 8; ++q) { u32x4 p; p.x = pk2(v[8 * q], v[8 * q + 1]); p.y = pk2(v[8 * q + 2], v[8 * q + 3]); p.z = pk2(v[8 * q + 4], v[8 * q + 5]); p.w = pk2(v[8 * q + 6], v[8 * q + 7]); *(u32x4*)(dst + 8 * q) = p; }
}
template <int N> DI void rmsnorm_inplace(float* v, const float* __restrict__ g) {
  float s = 0.f;
#pragma unroll
  for (int i = 0; i < N; ++i) s += v[i] * v[i];
  const float r = rsqrtf(s * (1.0f / N) + EPS);
#pragma unroll
  for (int i = 0; i < N; ++i) v[i] = v[i] * r * g[i];
}
DI void rope32(float* v, const f32x2* __restrict__ tab  ) {
#pragma unroll
  for (int i = 0; i < 16; ++i) { const f32x2 cs = tab[i]; const float x1 = v[i], x2 = v[i + 16]; v[i] = x1 * cs.x - x2 * cs.y; v[i + 16] = x1 * cs.y + x2 * cs.x; }
}
DI void vt_write(const float* cl, const float* rr, int col0, int u, bf16_t* dst_row  , int dsh, int L, int pos0) {
  const int d = u & 63, th = u >> 6;
  float v[64];
#pragma unroll
  for (int i = 0; i < 64; ++i) v[i] = cl[(th * 64 + i) * CLD + col0 + d] * rr[th * 64 + i];
  const int p0 = pos0 + th * 64;
  if (dsh == 0) {
    store_bf16<64>(dst_row + p0, v);
  } else if (dsh == 2) {
#pragma unroll
    for (int rr_ = 0; rr_ < 4; ++rr_) {
      float t[16];
#pragma unroll
      for (int a = 0; a < 16; ++a) t[a] = v[4 * a + rr_];
      store_bf16<16>(dst_row + rr_ * L + (p0 >> 2), t);
    }
  } else {
#pragma unroll
    for (int rr_ = 0; rr_ < 16; ++rr_) {
      u32x2 p; p.x = pk2(v[rr_], v[16 + rr_]); p.y = pk2(v[32 + rr_], v[48 + rr_]);
      *(u32x2*)(dst_row + rr_ * L + (p0 >> 4)) = p;
    }
  }
}

DI void phase_proj(const Ctx& c) {
  const bf16_t* A = wsb(c, OFF_XB);
  const bf16_t* Bt = wgt(c, W_IN);
  const float* ss = ss_site(c, c.layer, 1);
  float* ss_cq = ss_site(c, c.layer, 4);
  float* ss_ckv = ss_site(c, c.layer, 5);
  float* cl = (float*)c.lds; float* rr = (float*)(c.lds + OFF_RR);
  const f32x2* rope = (const f32x2*)(c.ws + OFF_ROPE);
  const int tid0 = tid_();
  const int S = c.S, sshift = c.sshift;
  const int xcd_ = blockIdx.x & 7, slot_ = blockIdx.x >> 3, nslot_ = gridDim.x >> 3;
  for (int j_ = slot_; j_ < 16 * 28; j_ += nslot_) {
    const int mt = xcd_ * 16 + (j_ & 15), nt = j_ >> 4;
    f32x16 acc[2][2]; zero_acc<2>(acc);
    gemm_mainloop<2>(A + (size_t)mt * 128 * LDX, LDX, Bt + (size_t)nt * 128 * LDX, LDX, DM, acc, c.lds);
    acc_to_lds<2>(acc, cl);
    const int tid = tid_(), half = __builtin_amdgcn_readfirstlane(tid >> 7), u = tid & 127;
    if (tid < 128) rr[tid] = rsqrtf(ss[mt * 128 + tid] * (1.0f / DM) + EPS);
    __syncthreads();
    const int slot = nt * 2 + half, col0 = half * 64;
    const int tl0 = mt * 128, seq = tl0 >> sshift, pos0 = tl0 & (S - 1);
    const bool is_vb = (slot >= 31 && slot < 43), is_vc = (slot == 53 || slot == 54);
    if (is_vb) {
      const int hb = slot - 31, dsh = 2 * (hb >> 2);
      bf16_t* dst = wsb(c, OFF_VTB) + ((size_t)(seq * 12 + hb) * 64 + (u & 63)) * (S + 64);
      vt_write(cl, rr, col0, u, dst, dsh, S >> dsh, pos0);
    } else if (is_vc) {
      const int hv = slot - 53;
      bf16_t* dst = wsb(c, OFF_VTC) + ((size_t)(seq * 2 + hv) * 64 + (u & 63)) * (S + 64);
      vt_write(cl, rr, col0, u, dst, 0, S, pos0);
    } else if (slot < 55) {
      const int row = u, tl = tl0 + row, pos = pos0 + row;
      const float r = rr[row];
      float v[64];
      load_slot(cl, row, col0, v);
#pragma unroll
      for (int i = 0; i < 64; ++i) v[i] *= r;
      if (slot < 6) {
        float s = 0.f;
#pragma unroll
        for (int i = 0; i < 64; ++i) s += v[i] * v[i];
        if (slot < 4) { store_bf16<64>(wsb(c, OFF_CQ) + (size_t)tl * LDCQ + slot * 64, v); atomicAdd(ss_cq + tl, s); }
        else { store_bf16<64>(wsb(c, OFF_CKV) + (size_t)tl * LDCKV + (slot - 4) * 64, v); atomicAdd(ss_ckv + tl, s); }
      } else if (slot == 6) {
        rmsnorm_inplace<32>(v, inl(c, 14, 96) + 64);
        rope32(v, rope + (size_t)pos * 16);
        bf16_t* dst = wsb(c, OFF_KA) + ((size_t)(seq * 8) * S + pos) * 96 + 64;
#pragma unroll
        for (int hh = 0; hh < 8; ++hh) store_bf16<32>(dst + (size_t)hh * S * 96, v);
      } else if (slot < 31) {
        const bool isq = slot < 19;
        const int hb = isq ? slot - 7 : slot - 19, dsh = 2 * (hb >> 2), L = S >> dsh;
        rmsnorm_inplace<64>(v, inl(c, isq ? 15 : 16, 64));
        const int srow = (pos & ((1 << dsh) - 1)) * L + (pos >> dsh);
        bf16_t* dst = wsb(c, isq ? OFF_QB : OFF_KB) + ((size_t)(seq * 12 + hb) * S + srow) * 64;
        store_bf16<64>(dst, v);
      } else {
        const bool isq = slot < 51;
        rmsnorm_inplace<64>(v, inl(c, isq ? 18 : 19, 64));
        bf16_t* dst = isq ? wsb(c, OFF_QC) + ((size_t)(seq * 8 + (slot - 43)) * S + pos) * 64
                          : wsb(c, OFF_KC) + ((size_t)(seq * 2 + (slot - 51)) * S + pos) * 64;
        asm volatile("" ::: "memory");
        rope32(v, rope + (size_t)(pos >> 6) * 16);
        store_bf16<32>(dst, v);
        asm volatile("" ::: "memory");
        rope32(v + 32, rope + (size_t)(pos & 63) * 16);
        store_bf16<32>(dst + 32, v + 32);
      }
    }
    __syncthreads();
  }
}

DI void phase_mlaup(const Ctx& c) {
  const float* ss_cq = ss_site(c, c.layer, 4);
  const float* ss_ckv = ss_site(c, c.layer, 5);
  float* cl = (float*)c.lds; float* rr = (float*)(c.lds + OFF_RR);
  const f32x2* rope = (const f32x2*)(c.ws + OFF_ROPE);
  const int tid0 = tid_();
  const int S = c.S, sshift = c.sshift;
  const int xcd_ = blockIdx.x & 7, slot_ = blockIdx.x >> 3, nslot_ = gridDim.x >> 3;
  for (int j_ = slot_; j_ < 16 * 14; j_ += nslot_) {
    const int mt = xcd_ * 16 + (j_ & 15), nt = j_ >> 4;
    const bool isq = nt < 6;
    f32x16 acc[2][2]; zero_acc<2>(acc);
    if (isq) gemm_mainloop<2>(wsb(c, OFF_CQ) + (size_t)mt * 128 * LDCQ, LDCQ, wgt(c, W_UQ) + (size_t)nt * 128 * LDCQ, LDCQ, 256, acc, c.lds);
    else gemm_mainloop<2>(wsb(c, OFF_CKV) + (size_t)mt * 128 * LDCKV, LDCKV, wgt(c, W_UKV) + (size_t)(nt - 6) * 128 * LDCKV, LDCKV, 128, acc, c.lds);
    acc_to_lds<2>(acc, cl);
    const int tid = tid_(), half = __builtin_amdgcn_readfirstlane(tid >> 7), u = tid & 127;
    if (tid < 128) rr[tid] = isq ? rsqrtf(ss_cq[mt * 128 + tid] * (1.0f / 256) + EPS) : rsqrtf(ss_ckv[mt * 128 + tid] * (1.0f / 128) + EPS);
    __syncthreads();
    const int col0 = half * 64;
    const int tl0 = mt * 128, seq = tl0 >> sshift, pos0 = tl0 & (S - 1);
    if (!isq && nt >= 10) {
      const int hv = (nt - 10) * 2 + half;
      bf16_t* dst = wsb(c, OFF_VTA) + ((size_t)(seq * 8 + hv) * 64 + (u & 63)) * (S + 64);
      vt_write(cl, rr, col0, u, dst, 0, S, pos0);
    } else {
      const int row = u, pos = pos0 + row;
      const float r = rr[row];
      float v[64];
      load_slot(cl, row, col0, v);
#pragma unroll
      for (int i = 0; i < 64; ++i) v[i] *= r;
      if (isq && nt < 4) {
        const int hh = nt * 2 + half;
        rmsnorm_inplace<64>(v, inl(c, 13, 96));
        store_bf16<64>(wsb(c, OFF_QA) + ((size_t)(seq * 8 + hh) * S + pos) * 96, v);
      } else if (isq) {
        const int h0 = ((nt - 4) * 2 + half) * 2;
        rmsnorm_inplace<32>(v, inl(c, 13, 96) + 64);
        rmsnorm_inplace<32>(v + 32, inl(c, 13, 96) + 64);
        rope32(v, rope + (size_t)pos * 16);
        rope32(v + 32, rope + (size_t)pos * 16);
        store_bf16<32>(wsb(c, OFF_QA) + ((size_t)(seq * 8 + h0) * S + pos) * 96 + 64, v);
        store_bf16<32>(wsb(c, OFF_QA) + ((size_t)(seq * 8 + h0 + 1) * S + pos) * 96 + 64, v + 32);
      } else {
        const int hh = (nt - 6) * 2 + half;
        rmsnorm_inplace<64>(v, inl(c, 14, 96));
        store_bf16<64>(wsb(c, OFF_KA) + ((size_t)(seq * 8 + hh) * S + pos) * 96, v);
      }
    }
    __syncthreads();
  }
}

template <int DQK, bool BAND, int QT>
DI void attn_item(const bf16_t* __restrict__ Q, const bf16_t* __restrict__ Kp, const bf16_t* __restrict__ Vt, int ldv,
                  int kbeg, int kend, int q0, const float* bias_g, float scale_log2,
                  bf16_t* __restrict__ out, size_t out_rs, float* __restrict__ lse, int lse_rs, char* lds) {
  constexpr int KROW = DQK * 2 + 16;
  constexpr int KST = 64 * KROW, VST = 64 * LROW, ST = KST + VST;
  constexpr int NKS = DQK / 16;
  constexpr int KV4 = DQK / 8;
  constexpr int NKL = (64 * KV4) / 256;
  constexpr int WQ = 32 * QT;
  const int tid = tid_(), lane = tid & 63, w = tid >> 6, h = lane >> 5, ql = lane & 31;
  float* bias_l = (float*)(lds + 2 * ST);
  if (BAND) { if (tid < 129) bias_l[tid] = bias_g[tid]; }
  bf16x8 qf[QT][NKS];
#pragma unroll
  for (int qt = 0; qt < QT; ++qt)
#pragma unroll
    for (int ks = 0; ks < NKS; ++ks) qf[qt][ks] = *(const bf16x8*)(Q + (size_t)(w * WQ + qt * 32 + ql) * DQK + ks * 16 + h * 8);
  f32x16 o[2][QT];
#pragma unroll
  for (int a = 0; a < 2; ++a)
#pragma unroll
    for (int b = 0; b < QT; ++b)
#pragma unroll
      for (int r = 0; r < 16; ++r) o[a][b][r] = 0.f;
  float m[QT], l[QT];
#pragma unroll
  for (int qt = 0; qt < QT; ++qt) { m[qt] = -1e30f; l[qt] = 0.f; }
  u32x4 rk[NKL], rv[2];
  const int vrow0 = tid >> 3, vch = tid & 7;
  unsigned klds[NKL];
#pragma unroll
  for (int i = 0; i < NKL; ++i) { const int idx = tid + i * 256, kr = idx / KV4, kc = idx - kr * KV4; klds[i] = kr * KROW + kc * 16; }
  const unsigned koff0 = (unsigned)tid * 16u;
  const unsigned voff0 = (unsigned)(vrow0 * ldv + vch * 8) * 2u, vstep = (unsigned)(32 * ldv) * 2u;
  const unsigned vlds0 = KST + vrow0 * LROW + vch * 16;
  auto gload = [&](int kt) {
    const char* kb = (const char*)Kp + (size_t)kt * (DQK * 2);
    const char* vb = (const char*)Vt + (size_t)kt * 2;
#pragma unroll
    for (int i = 0; i < NKL; ++i) rk[i] = *(const u32x4*)(kb + (koff0 + i * 4096u));
#pragma unroll
    for (int i = 0; i < 2; ++i) rv[i] = *(const u32x4*)(vb + (voff0 + i * vstep));
  };
  auto lstore = [&](char* st) {
#pragma unroll
    for (int i = 0; i < NKL; ++i) *(u32x4*)(st + klds[i]) = rk[i];
#pragma unroll
    for (int i = 0; i < 2; ++i) *(u32x4*)(st + vlds0 + i * 32 * LROW) = rv[i];
  };
  gload(kbeg);
  lstore(lds);
  __syncthreads();
  const int pr = (ql & ~12) | ((ql & 4) << 1) | ((ql & 8) >> 1);
  const int k_rd = pr * KROW + h * 16;
  const int v_rd = KST + ql * LROW + h * 16;
  const int qw0 = q0 + w * WQ;
  int it = 0;
  for (int kt = kbeg; kt < kend; kt += 64, ++it) {
    const char* st = lds + (it & 1) * ST;
    const bool more = (kt + 64 < kend);
    if (more) gload(kt + 64);
    bool need = true;
    if (BAND) need = (kt + 63 >= qw0 - 64) && (kt <= qw0 + WQ - 1 + 64);
    if (need) {
      f32x16 s[2][QT];
#pragma unroll
      for (int a = 0; a < 2; ++a)
#pragma unroll
        for (int b = 0; b < QT; ++b)
#pragma unroll
          for (int r = 0; r < 16; ++r) s[a][b][r] = 0.f;
#pragma unroll
      for (int ks = 0; ks < NKS; ++ks) {
        const bf16x8 k0 = *(const bf16x8*)(st + k_rd + ks * 32);
        const bf16x8 k1 = *(const bf16x8*)(st + k_rd + 32 * KROW + ks * 32);
#pragma unroll
        for (int qt = 0; qt < QT; ++qt) {
          s[0][qt] = MFMA(k0, qf[qt][ks], s[0][qt]);
          s[1][qt] = MFMA(k1, qf[qt][ks], s[1][qt]);
        }
      }
      bf16x8 pf[QT][4];
      const float cc = BAND ? 1.0f : scale_log2;
      const float th = BAND ? 8.0f : 8.0f / scale_log2;
#pragma unroll
      for (int qt = 0; qt < QT; ++qt) {
        if (BAND) {
#pragma unroll
          for (int a = 0; a < 2; ++a)
#pragma unroll
            for (int r = 0; r < 16; ++r) {
              const int kidx = kt + 32 * a + (r & 7) + 8 * h + 16 * (r >> 3);
              const int rel = kidx - (qw0 + qt * 32 + ql);
              const bool ok = (rel >= -64) && (rel <= 64);
              const int bi = ok ? rel + 64 : 0;
              s[a][qt][r] = ok ? fmaf(s[a][qt][r], scale_log2, bias_l[bi]) : -1e30f;
            }
        }
        float mx = s[0][qt][0];
#pragma unroll
        for (int r = 1; r < 16; ++r) mx = fmaxf(mx, s[0][qt][r]);
#pragma unroll
        for (int r = 0; r < 16; ++r) mx = fmaxf(mx, s[1][qt][r]);
        mx = fmaxf(mx, __shfl_xor(mx, 32));
        if (__builtin_amdgcn_ballot_w64(mx > m[qt] + th) != 0) {
          const float mn = fmaxf(m[qt], mx);
          const float alpha = __builtin_amdgcn_exp2f((m[qt] - mn) * cc);
          m[qt] = mn;
          l[qt] *= alpha;
#pragma unroll
          for (int r = 0; r < 16; ++r) { o[0][qt][r] *= alpha; o[1][qt][r] *= alpha; }
        }
        const float mc = -m[qt] * cc;
        float ls = 0.f;
#pragma unroll
        for (int a = 0; a < 2; ++a) {
#pragma unroll
          for (int r = 0; r < 16; ++r) { const float pv = __builtin_amdgcn_exp2f(fmaf(s[a][qt][r], cc, mc)); s[a][qt][r] = pv; ls += pv; }
#pragma unroll
          for (int s2 = 0; s2 < 2; ++s2) {
            u32x4 pk;
            pk.x = pk2(s[a][qt][8 * s2 + 0], s[a][qt][8 * s2 + 1]);
            pk.y = pk2(s[a][qt][8 * s2 + 2], s[a][qt][8 * s2 + 3]);
            pk.z = pk2(s[a][qt][8 * s2 + 4], s[a][qt][8 * s2 + 5]);
            pk.w = pk2(s[a][qt][8 * s2 + 6], s[a][qt][8 * s2 + 7]);
            pf[qt][a * 2 + s2] = __builtin_bit_cast(bf16x8, pk);
          }
        }
        l[qt] += ls;
      }
      if (more) lstore(lds + ((it + 1) & 1) * ST);
#pragma unroll
      for (int ks = 0; ks < 4; ++ks) {
        const bf16x8 v0 = *(const bf16x8*)(st + v_rd + ks * 32);
        const bf16x8 v1 = *(const bf16x8*)(st + v_rd + 32 * LROW + ks * 32);
#pragma unroll
        for (int qt = 0; qt < QT; ++qt) {
          o[0][qt] = MFMA(v0, pf[qt][ks], o[0][qt]);
          o[1][qt] = MFMA(v1, pf[qt][ks], o[1][qt]);
        }
      }
    } else {
      if (more) lstore(lds + ((it + 1) & 1) * ST);
    }
    __syncthreads();
  }
#pragma unroll
  for (int qt = 0; qt < QT; ++qt) {
    const float lt = l[qt] + __shfl_xor(l[qt], 32);
    const float inv = 1.0f / lt;
    const int qi = w * WQ + qt * 32 + ql;
    bf16_t* orow = out + (size_t)qi * out_rs;
#pragma unroll
    for (int dt = 0; dt < 2; ++dt)
#pragma unroll
      for (int g = 0; g < 4; ++g) {
        u32x2 p; p.x = pk2(o[dt][qt][4 * g] * inv, o[dt][qt][4 * g + 1] * inv); p.y = pk2(o[dt][qt][4 * g + 2] * inv, o[dt][qt][4 * g + 3] * inv);
        *(u32x2*)(orow + dt * 32 + 8 * g + 4 * h) = p;
      }
    if (BAND) { if (h == 0) lse[(size_t)qi * lse_rs] = m[qt] * LN2 + __logf(lt); }
  }
}

template <int DQK>
DI void attn_dense(const bf16_t* __restrict__ Q, const bf16_t* __restrict__ Kp, const bf16_t* __restrict__ Vt, int ldv,
                   int nkeys, float scale_log2, bf16_t* __restrict__ out, size_t out_rs, char* lds) {
  constexpr int KROW = DQK * 2 + 16;
  constexpr int KST = 64 * KROW, VST = 64 * LROW;
  constexpr int NKS = DQK / 16;
  constexpr int KV4 = DQK / 8;
  constexpr int NKL = (64 * KV4) / 256;
  const int tid = tid_(), lane = tid & 63, w = tid >> 6, h = lane >> 5, ql = lane & 31;
  char* const kbase = lds;
  char* const vbase = lds + 2 * KST;
  bf16x8 qf[NKS];
#pragma unroll
  for (int ks = 0; ks < NKS; ++ks) qf[ks] = *(const bf16x8*)(Q + (size_t)(w * 32 + ql) * DQK + ks * 16 + h * 8);
  f32x16 o[2];
#pragma unroll
  for (int a = 0; a < 2; ++a)
#pragma unroll
    for (int r = 0; r < 16; ++r) o[a][r] = 0.f;
  float m = -1e30f, l = 0.f;
  u32x4 rk[NKL], rv[2];
  const int vrow0 = tid >> 3, vch = tid & 7;
#define GLK_(kt) { const int kt_ = (kt); _Pragma("unroll") for (int i_ = 0; i_ < NKL; ++i_) { const int idx = tid + i_ * 256, kr = idx / KV4, kc = idx - kr * KV4; rk[i_] = *(const u32x4*)(Kp + (size_t)(kt_ + kr) * DQK + kc * 8); } }
#define GLV_(kt) { const int kt_ = (kt); _Pragma("unroll") for (int i_ = 0; i_ < 2; ++i_) rv[i_] = *(const u32x4*)(Vt + (size_t)(vrow0 + 32 * i_) * ldv + kt_ + vch * 8); }
#define LSK_(st) { char* st_ = (st); _Pragma("unroll") for (int i_ = 0; i_ < NKL; ++i_) { const int idx = tid + i_ * 256, kr = idx / KV4, kc = idx - kr * KV4; *(u32x4*)(st_ + kr * KROW + kc * 16) = rk[i_]; } }
#define LSV_(st) { char* st_ = (st); _Pragma("unroll") for (int i_ = 0; i_ < 2; ++i_) *(u32x4*)(st_ + (vrow0 + 32 * i_) * LROW + vch * 16) = rv[i_]; }
  const int pr = (ql & ~12) | ((ql & 4) << 1) | ((ql & 8) >> 1);
  const int k_rd = pr * KROW + h * 16;
  const int v_rd = ql * LROW + h * 16;
  GLK_(0); LSK_(kbase);
  GLK_(64); GLV_(0); LSK_(kbase + KST); LSV_(vbase);
  __syncthreads();
  f32x16 sc[2];
#pragma unroll
  for (int a = 0; a < 2; ++a)
#pragma unroll
    for (int r = 0; r < 16; ++r) sc[a][r] = 0.f;
#pragma unroll
  for (int ks = 0; ks < NKS; ++ks) {
    const bf16x8 k0 = *(const bf16x8*)(kbase + k_rd + ks * 32);
    const bf16x8 k1 = *(const bf16x8*)(kbase + k_rd + 32 * KROW + ks * 32);
    sc[0] = MFMA(k0, qf[ks], sc[0]);
    sc[1] = MFMA(k1, qf[ks], sc[1]);
  }
  __syncthreads();
  const int nt = nkeys >> 6;
  const float cc = scale_log2, th = 8.0f / scale_log2;
  for (int i = 0; i < nt; ++i) {
    const bool more1 = (i + 1 < nt), more2 = (i + 2 < nt);
    if (more2) GLK_((i + 2) * 64);
    if (more1) GLV_((i + 1) * 64);
    float mx = sc[0][0];
#pragma unroll
    for (int r = 1; r < 16; ++r) mx = fmaxf(mx, sc[0][r]);
#pragma unroll
    for (int r = 0; r < 16; ++r) mx = fmaxf(mx, sc[1][r]);
    mx = fmaxf(mx, __shfl_xor(mx, 32));
    if (__builtin_amdgcn_ballot_w64(mx > m + th) != 0) {
      const float mn = fmaxf(m, mx);
      const float alpha = __builtin_amdgcn_exp2f((m - mn) * cc);
      m = mn; l *= alpha;
#pragma unroll
      for (int r = 0; r < 16; ++r) { o[0][r] *= alpha; o[1][r] *= alpha; }
    }
    const char* kn = kbase + ((i + 1) & 1) * KST;
    f32x16 sn[2];
#pragma unroll
    for (int a = 0; a < 2; ++a)
#pragma unroll
      for (int r = 0; r < 16; ++r) sn[a][r] = 0.f;
#pragma unroll
    for (int ks = 0; ks < NKS; ++ks) {
      const bf16x8 k0 = *(const bf16x8*)(kn + k_rd + ks * 32);
      const bf16x8 k1 = *(const bf16x8*)(kn + k_rd + 32 * KROW + ks * 32);
      sn[0] = MFMA(k0, qf[ks], sn[0]);
      sn[1] = MFMA(k1, qf[ks], sn[1]);
    }
    const float mc = -m * cc;
    float ls = 0.f;
    bf16x8 pf[4];
#pragma unroll
    for (int a = 0; a < 2; ++a) {
#pragma unroll
      for (int r = 0; r < 16; ++r) { const float pv = __builtin_amdgcn_exp2f(fmaf(sc[a][r], cc, mc)); sc[a][r] = pv; ls += pv; }
#pragma unroll
      for (int s2 = 0; s2 < 2; ++s2) {
        u32x4 pk;
        pk.x = pk2(sc[a][8 * s2 + 0], sc[a][8 * s2 + 1]);
        pk.y = pk2(sc[a][8 * s2 + 2], sc[a][8 * s2 + 3]);
        pk.z = pk2(sc[a][8 * s2 + 4], sc[a][8 * s2 + 5]);
        pk.w = pk2(sc[a][8 * s2 + 6], sc[a][8 * s2 + 7]);
        pf[a * 2 + s2] = __builtin_bit_cast(bf16x8, pk);
      }
    }
    l += ls;
    const char* vs = vbase + (i & 1) * VST;
#pragma unroll
    for (int ks = 0; ks < 4; ++ks) {
      const bf16x8 v0 = *(const bf16x8*)(vs + v_rd + ks * 32);
      const bf16x8 v1 = *(const bf16x8*)(vs + v_rd + 32 * LROW + ks * 32);
      o[0] = MFMA(v0, pf[ks], o[0]);
      o[1] = MFMA(v1, pf[ks], o[1]);
    }
    if (more2) LSK_(kbase + (i & 1) * KST);
    if (more1) LSV_(vbase + ((i + 1) & 1) * VST);
    __syncthreads();
    sc[0] = sn[0]; sc[1] = sn[1];
  }
#undef GLK_
#undef GLV_
#undef LSK_
#undef LSV_
  const float lt = l + __shfl_xor(l, 32);
  const float inv = 1.0f / lt;
  bf16_t* orow = out + (size_t)(w * 32 + ql) * out_rs;
#pragma unroll
  for (int dt = 0; dt < 2; ++dt)
#pragma unroll
    for (int g = 0; g < 4; ++g) {
      u32x2 p; p.x = pk2(o[dt][4 * g] * inv, o[dt][4 * g + 1] * inv); p.y = pk2(o[dt][4 * g + 2] * inv, o[dt][4 * g + 3] * inv);
      *(u32x2*)(orow + dt * 32 + 8 * g + 4 * h) = p;
    }
}

constexpr bool ATT_PIPE = false;
constexpr int AQT = 2;
constexpr int QBLK = 128 * AQT;
DI void phase_attn(const Ctx& c) {
  const int S = c.S, nseq = TC / S, nqb = S / QBLK;
  const int n_mla = nseq * 8 * nqb, n_gqa = n_mla, n_dil = nseq * 12 * nqb;
  const float* bias = (const float*)(c.ws + OFF_BIAS);
  for (int item = blockIdx.x; item < n_mla + n_gqa + n_dil; item += gridDim.x) {
    if (item < n_mla) {
      const int hh = item & 7, rest = item >> 3, seq = rest / nqb, qb = rest - seq * nqb;
      const size_t hs = (size_t)(seq * 8 + hh) * S;
      if (ATT_PIPE) attn_dense<96>(wsb(c, OFF_QA) + (hs + qb * QBLK) * 96, wsb(c, OFF_KA) + hs * 96, wsb(c, OFF_VTA) + (size_t)(seq * 8 + hh) * 64 * (S + 64), S + 64,
                     S, 0.10206207261596577f * LOG2E, wsb(c, OFF_OA) + ((size_t)seq * S + qb * QBLK) * LDO + hh * 64, LDO, c.lds);
      else attn_item<96, false, AQT>(wsb(c, OFF_QA) + (hs + qb * QBLK) * 96, wsb(c, OFF_KA) + hs * 96, wsb(c, OFF_VTA) + (size_t)(seq * 8 + hh) * 64 * (S + 64), S + 64,
                     0, S, 0, nullptr, 0.10206207261596577f * LOG2E, wsb(c, OFF_OA) + ((size_t)seq * S + qb * QBLK) * LDO + hh * 64, LDO, nullptr, 0, c.lds);
    } else if (item < n_mla + n_gqa) {
      const int i2 = item - n_mla;
      const int hq = i2 & 7, rest = i2 >> 3, seq = rest / nqb, qb = rest - seq * nqb;
      const size_t hs = (size_t)(seq * 8 + hq) * S, ks = (size_t)(seq * 2 + (hq >> 2)) * S;
      if (ATT_PIPE) attn_dense<64>(wsb(c, OFF_QC) + (hs + qb * QBLK) * 64, wsb(c, OFF_KC) + ks * 64, wsb(c, OFF_VTC) + (size_t)(seq * 2 + (hq >> 2)) * 64 * (S + 64), S + 64,
                     S, 0.125f * LOG2E, wsb(c, OFF_OC) + ((size_t)seq * S + qb * QBLK) * LDO + hq * 64, LDO, c.lds);
      else attn_item<64, false, AQT>(wsb(c, OFF_QC) + (hs + qb * QBLK) * 64, wsb(c, OFF_KC) + ks * 64, wsb(c, OFF_VTC) + (size_t)(seq * 2 + (hq >> 2)) * 64 * (S + 64), S + 64,
                     0, S, 0, nullptr, 0.125f * LOG2E, wsb(c, OFF_OC) + ((size_t)seq * S + qb * QBLK) * LDO + hq * 64, LDO, nullptr, 0, c.lds);
    } else {
      const int i2 = item - n_mla - n_gqa;
      const int hb = i2 % 12, rest = i2 / 12, seq = rest / nqb, blk = rest - seq * nqb;
      const int dsh = 2 * (hb >> 2), L = S >> dsh, dil = 1 << dsh;
      const int srow0 = blk * QBLK, rr = srow0 / L, l0 = srow0 - rr * L;
      const size_t hs = (size_t)(seq * 12 + hb) * S;
      int kb = l0 - 64; if (kb < 0) kb = 0;
      int ke = l0 + QBLK + 64; if (ke > L) ke = L;
      const size_t tok0 = (size_t)seq * S + (size_t)l0 * dil + rr;
      attn_item<64, true, AQT>(wsb(c, OFF_QB) + (hs + srow0) * 64, wsb(c, OFF_KB) + (hs + (size_t)rr * L) * 64, wsb(c, OFF_VTB) + (size_t)(seq * 12 + hb) * 64 * (S + 64) + (size_t)rr * L, S + 64,
                          kb, ke, l0, bias + hb * 132, 0.125f * LOG2E,
                          wsb(c, OFF_OBG) + tok0 * 768 + hb * 64, (size_t)dil * 768, (float*)(c.ws + OFF_LSE) + tok0 * 12 + hb, dil * 12, c.lds);
    }
    __syncthreads();
  }
}

DI void phase_combine(const Ctx& c) {
  const bf16_t* obg = wsb(c, OFF_OBG);
  const float* lse = (const float*)(c.ws + OFF_LSE);
  bf16_t* ob = wsb(c, OFF_OB);
  const int total = TC * 4 * 8;
  for (int idx = blockIdx.x * NTHREADS + tid_(); idx < total; idx += gridDim.x * NTHREADS) {
    const int d8 = idx & 7, j = (idx >> 3) & 3, tl = idx >> 5;
    const float l0 = lse[tl * 12 + j], l1 = lse[tl * 12 + 4 + j], l2 = lse[tl * 12 + 8 + j];
    const float mx = fmaxf(l0, fmaxf(l1, l2));
    float w0 = __expf(l0 - mx), w1 = __expf(l1 - mx), w2 = __expf(l2 - mx);
    const float inv = 1.0f / (w0 + w1 + w2);
    w0 *= inv; w1 *= inv; w2 *= inv;
    const u32x4 a = *(const u32x4*)(obg + (size_t)tl * 768 + j * 64 + d8 * 8);
    const u32x4 b = *(const u32x4*)(obg + (size_t)tl * 768 + (4 + j) * 64 + d8 * 8);
    const u32x4 d = *(const u32x4*)(obg + (size_t)tl * 768 + (8 + j) * 64 + d8 * 8);
    u32x4 r;
#pragma unroll
    for (int e = 0; e < 4; ++e) {
      const float lo = w0 * __uint_as_float(a[e] << 16) + w1 * __uint_as_float(b[e] << 16) + w2 * __uint_as_float(d[e] << 16);
      const float hi = w0 * __uint_as_float(a[e] & 0xffff0000u) + w1 * __uint_as_float(b[e] & 0xffff0000u) + w2 * __uint_as_float(d[e] & 0xffff0000u);
      r[e] = pk2(lo, hi);
    }
    *(u32x4*)(ob + (size_t)tl * LDOB + j * 64 + d8 * 8) = r;
  }
}

DI void phase_merge(const Ctx& c) {
  const bf16_t* xb = wsb(c, OFF_XB);
  const float* ss = ss_site(c, c.layer, 1);
  const float* bgate = inl(c, 21, 3072);
  bf16_t* mrg = wsb(c, OFF_MRG);
  float* cl = (float*)c.lds; float* rr = (float*)(c.lds + OFF_RR);
  const int tid = tid_(), lane = tid & 63, w = tid >> 6, wm = w >> 1, wn = w & 1, h = lane >> 5, cc = lane & 31;
  const int xcd_ = blockIdx.x & 7, slot_ = blockIdx.x >> 3, nslot_ = gridDim.x >> 3;
  for (int j_ = slot_; j_ < 16 * 16; j_ += nslot_) {
    const int mt = xcd_ * 16 + (j_ & 15), nt = j_ >> 4;
    __syncthreads();
    if (tid < 128) rr[tid] = rsqrtf(ss[mt * 128 + tid] * (1.0f / DM) + EPS);
    f32x16 macc[2][1]; zero_acc<1>(macc);
#pragma unroll 1
    for (int k = 0; k < 3; ++k) {
      f32x16 gacc[2][1]; zero_acc<1>(gacc);
      gemm_mainloop<1>(xb + (size_t)mt * 128 * LDX, LDX, wgt(c, W_GATE) + (size_t)(k * 1024 + nt * 64) * LDX, LDX, DM, gacc, c.lds);
      const float bv = bgate[k * 1024 + nt * 64 + wn * 32 + cc];
#pragma unroll
      for (int i = 0; i < 2; ++i)
#pragma unroll
        for (int r = 0; r < 16; ++r) {
          const float rv = rr[wm * 64 + i * 32 + (r & 3) + 8 * (r >> 2) + 4 * h];
          gacc[i][0][r] = sigmoidf_(gacc[i][0][r] * rv + bv);
        }
      f32x16 acc[2][1]; zero_acc<1>(acc);
      const int Kk = (k == 1) ? 256 : 512;
      const bf16_t* Ao = wsb(c, k == 0 ? OFF_OA : (k == 1 ? OFF_OB : OFF_OC));
      const bf16_t* Wo = wgt(c, k == 0 ? W_OA : (k == 1 ? W_OB : W_OC));
      gemm_mainloop<1>(Ao + (size_t)mt * 128 * (Kk + PADK), Kk + PADK, Wo + (size_t)nt * 64 * (Kk + PADK), Kk + PADK, Kk, acc, c.lds);
#pragma unroll
      for (int i = 0; i < 2; ++i)
#pragma unroll
        for (int r = 0; r < 16; ++r) macc[i][0][r] += gacc[i][0][r] * acc[i][0][r];
    }
    acc_to_lds<1>(macc, cl);
    __syncthreads();
    const int c4 = (tid & 15) * 4, r0 = tid >> 4;
#pragma unroll 4
    for (int it = 0; it < 8; ++it) {
      const int row = r0 + 16 * it;
      const f32x4 v = *(const f32x4*)(cl + row * CLD + c4);
      u32x2 p; p.x = pk2(v[0], v[1]); p.y = pk2(v[2], v[3]);
      *(u32x2*)(mrg + (size_t)(mt * 128 + row) * LDX + nt * 64 + c4) = p;
    }
    __syncthreads();
  }
}

DI void phase_ple(const Ctx& c) {
  const bf16_t* xb = wsb(c, OFF_XB);
  const float* ss = ss_site(c, c.layer, 3);
  float* ssn = ss_site(c, c.layer + 1, 0);
  const bf16_t* peb = wsb(c, OFF_PEB) + (size_t)c.layer * TC * LDPE;
  float* cl = (float*)c.lds; float* rr = (float*)(c.lds + OFF_RR);
  const int tid = tid_(), lane = tid & 63, w = tid >> 6, wm = w >> 1, h = lane >> 5;
  const int xcd_ = blockIdx.x & 7, slot_ = blockIdx.x >> 3, nslot_ = gridDim.x >> 3;
  for (int j_ = slot_; j_ < 16 * 16; j_ += nslot_) {
    const int mt = xcd_ * 16 + (j_ & 15), nt = j_ >> 4;
    if (tid < 128) rr[tid] = rsqrtf(ss[mt * 128 + tid] * (1.0f / DM) + EPS);
    f32x16 g[2][1]; zero_acc<1>(g);
    gemm_mainloop<1>(xb + (size_t)mt * 128 * LDX, LDX, wgt(c, W_PG) + (size_t)nt * 64 * LDX, LDX, DM, g, c.lds);
#pragma unroll
    for (int i = 0; i < 2; ++i)
#pragma unroll
      for (int r = 0; r < 16; ++r) {
        const float rv = rr[wm * 64 + i * 32 + (r & 3) + 8 * (r >> 2) + 4 * h];
        g[i][0][r] = sigmoidf_(g[i][0][r] * rv);
      }
    f32x16 acc[2][1]; zero_acc<1>(acc);
    gemm_mainloop<1>(peb + (size_t)mt * 128 * LDPE, LDPE, wgt(c, W_PLE) + (size_t)nt * 64 * LDPE, LDPE, 256, acc, c.lds);
#pragma unroll
    for (int i = 0; i < 2; ++i)
#pragma unroll
      for (int r = 0; r < 16; ++r) acc[i][0][r] *= g[i][0][r];
    acc_to_lds<1>(acc, cl);
    __syncthreads();
    resid_epilogue<1>(c.x, wsb(c, OFF_XB2), ssn, mt, nt, cl, 1.0f);
    __syncthreads();
  }
}

DI void phase_prologue(const Params& p, char* lds) {
  float* tl = (float*)lds;
  bf16_t* W = (bf16_t*)(p.ws + OFF_W);
  int rot = 0;
  for (int L = 0; L < 2; ++L) {
    bf16_t* wl = W + (size_t)L * W_LAYER;
    transpose_mat(p.in[5] + (size_t)L * 1024 * 5632, 5632, wl + W_FFN1_IN, 5632, 1024, p.in[4] + L * 1024, 1, tl, rot); rot += 88 * 16;
    transpose_mat(p.in[6] + (size_t)L * 2816 * 1024, 1024, wl + W_FFN1_OUT, 1024, 2816, nullptr, 0, tl, rot); rot += 16 * 44;
    transpose_mat(p.in[8] + (size_t)L * 1024 * 3488, 3488, wl + W_IN, 3584, 1024, p.in[7] + L * 1024, 2, tl, rot); rot += 56 * 16;
    transpose_mat(p.in[20] + (size_t)L * 1024 * 3072, 3072, wl + W_GATE, 3072, 1024, p.in[7] + L * 1024, 0, tl, rot); rot += 48 * 16;
    transpose_mat(p.in[11] + (size_t)L * 256 * 768, 768, wl + W_UQ, 768, 256, p.in[9] + L * 256, 3, tl, rot); rot += 12 * 4;
    transpose_mat(p.in[12] + (size_t)L * 128 * 1024, 1024, wl + W_UKV, 1024, 128, p.in[10] + L * 128, 4, tl, rot); rot += 16 * 2;
    transpose_mat(p.in[22] + (size_t)L * 512 * 1024, 1024, wl + W_OA, 1024, 512, nullptr, 0, tl, rot); rot += 16 * 8;
    transpose_mat(p.in[23] + (size_t)L * 256 * 1024, 1024, wl + W_OB, 1024, 256, nullptr, 0, tl, rot); rot += 16 * 4;
    transpose_mat(p.in[24] + (size_t)L * 512 * 1024, 1024, wl + W_OC, 1024, 512, nullptr, 0, tl, rot); rot += 16 * 8;
    transpose_mat(p.in[25] + (size_t)L * 1024 * 1024, 1024, wl + W_OUT, 1024, 1024, nullptr, 0, tl, rot); rot += 16 * 16;
    transpose_mat(p.in[27] + (size_t)L * 1024 * 5632, 5632, wl + W_FFN2_IN, 5632, 1024, p.in[26] + L * 1024, 1, tl, rot); rot += 88 * 16;
    transpose_mat(p.in[28] + (size_t)L * 2816 * 1024, 1024, wl + W_FFN2_OUT, 1024, 2816, nullptr, 0, tl, rot); rot += 16 * 44;
    transpose_mat(p.in[30] + (size_t)L * 1024 * 1024, 1024, wl + W_PG, 1024, 1024, p.in[29] + L * 1024, 0, tl, rot); rot += 16 * 16;
    transpose_mat(p.in[31] + (size_t)L * 256 * 1024, 1024, wl + W_PLE, 1024, 256, nullptr, 0, tl, rot); rot += 16 * 4;
  }
  const int gtid = blockIdx.x * NTHREADS + tid_(), gn = gridDim.x * NTHREADS;
  f32x2* rope = (f32x2*)(p.ws + OFF_ROPE);
  for (int idx = gtid; idx < 16384 * 16; idx += gn) {
    const int pos = idx >> 4, i = idx & 15;
    const float freq = (float)pow(10000.0, -(double)i / 16.0);
    const float ang = (float)pos * freq;
    f32x2 cs; cs.x = (float)cos((double)ang); cs.y = (float)sin((double)ang);
    rope[idx] = cs;
  }
  float* bias = (float*)(p.ws + OFF_BIAS);
  for (int idx = gtid; idx < 12 * 129; idx += gn) {
    const int hb = idx / 129, jj = idx - hb * 129;
    const int dil = 1 << (2 * (hb >> 2));
    const int rel = (jj - 64) * dil;
    const int n = rel < 0 ? -rel : rel;
    int b;
    if (n < 8) b = n;
    else { int lg = 8 + (int)(log((double)n / 8.0) / log(128.0) * 8.0); if (lg > 15) lg = 15; b = lg; }
    if (rel > 0) b += 16;
    bias[hb * 132 + jj] = p.in[17][b * 12 + hb] * LOG2E;
  }
}

DI void phase_init(const Ctx& c) {
  const int tid = tid_(), lane = tid & 63;
  const int gw = blockIdx.x * 4 + (tid >> 6), nw = gridDim.x * 4;
  bf16_t* xb = wsb(c, OFF_XB);
  float* ss0 = ss_site(c, 0, 0);
  for (int row = gw; row < TC; row += nw) {
    float s = 0.f;
#pragma unroll
    for (int i = 0; i < 4; ++i) {
      const size_t gi = (size_t)row * DM + i * 256 + lane * 4;
      const f32x4 v = *(const f32x4*)(c.xin + gi);
      *(f32x4*)(c.x + gi) = v;
      u32x2 p; p.x = pk2(v[0], v[1]); p.y = pk2(v[2], v[3]);
      *(u32x2*)(xb + (size_t)row * LDX + i * 256 + lane * 4) = p;
      s += v[0] * v[0] + v[1] * v[1] + v[2] * v[2] + v[3] * v[3];
    }
#pragma unroll
    for (int o = 32; o >= 1; o >>= 1) s += __shfl_xor(s, o);
    if (lane == 0) ss0[row] = s;
  }
  const int gtid = blockIdx.x * NTHREADS + tid, gn = gridDim.x * NTHREADS;
  float* ssall = (float*)(c.ws + OFF_SS);
  for (int idx = gtid + TC; idx < 3 * 6 * TC; idx += gn) ssall[idx] = 0.f;
  bf16_t* peb = wsb(c, OFF_PEB);
  for (int idx = gtid; idx < 2 * TC * 64; idx += gn) {
    const int L = idx / (TC * 64), r = idx - L * (TC * 64);
    const f32x4 v = *(const f32x4*)(c.pe0 + (size_t)L * c.pe_ls + (size_t)r * 4);
    u32x2 p; p.x = pk2(v[0], v[1]); p.y = pk2(v[2], v[3]);
    *(u32x2*)(peb + ((size_t)L * TC + (r >> 6)) * LDPE + (r & 63) * 4) = p;
  }
}

#ifndef ONLY
#define ONLY -1
#endif
#define PH(n) (ONLY < 0 || ONLY == (n))
#if DUP == 200
#define GSYNC() do { xcd_barrier(xb); xcd_barrier(xb); } while (0)
#else
#define GSYNC() xcd_barrier(xb)
#endif
#define REP(n) for (int rep_ = 0; rep_ < ((DUP == (n) || (DUP == 100 && ((n) == 2 || (n) == 10))) ? 2 : 1); ++rep_)
__global__ void __launch_bounds__(NTHREADS, 2) mega_kernel(Params p) {
  extern __shared__ __attribute__((aligned(16))) char lds[];
  cg::grid_group grid = cg::this_grid();
  volatile LAS unsigned* xst = (volatile LAS unsigned*)(lds + OFF_RR + 512);
  if (threadIdx.x == 0) { xst[0] = 0u; xst[1] = 0u; }
  __syncthreads();
  const XcdBarrier xb = xcd_barrier_post((unsigned*)(p.ws + OFF_BAR), xst);
  REP(0) { if (PH(0)) phase_prologue(p, lds); grid.sync(); }
  for (int chunk = 0; chunk < 3; ++chunk) {
    Ctx c;
    c.p = &p; c.chunk = chunk; c.layer = 0; c.ws = p.ws; c.lds = lds;
    c.S = chunk == 0 ? 4096 : 16384; c.sshift = chunk == 0 ? 12 : 14;
    c.x = p.out + (size_t)chunk * TC * DM;
    c.xin = chunk == 0 ? p.in[0] : p.in[1] + (size_t)(chunk - 1) * TC * DM;
    c.pe0 = chunk == 0 ? p.in[2] : p.in[3] + (size_t)(chunk - 1) * TC * 256;
    c.pe_ls = chunk == 0 ? (size_t)TC * 256 : (size_t)2 * TC * 256;
    REP(1) { if (PH(1)) phase_init(c); GSYNC(); }
#pragma unroll 1
    for (int layer = 0; layer < 2; ++layer) {
      c.layer = layer;
      REP(2) { if (PH(2)) phase_ffn_in(c, wsb(c, layer == 0 ? OFF_XB : OFF_XB2), W_FFN1_IN, 0); GSYNC(); }
#if DUP == 300
      { phase_ffn_probe(c, wsb(c, layer == 0 ? OFF_XB : OFF_XB2), W_FFN1_IN, 0); GSYNC(); }
#endif
      REP(3) { if (PH(3)) phase_resid_gemm(c, wsb(c, OFF_ACT), DFF, W_FFN1_OUT, 0.5f, ss_site(c, layer, 1)); GSYNC(); }
      REP(4) { if (PH(4)) phase_proj(c); GSYNC(); }
      REP(5) { if (PH(5)) phase_mlaup(c); GSYNC(); }
      REP(6) { if (PH(6)) phase_attn(c); GSYNC(); }
      REP(7) { if (PH(7)) phase_combine(c); GSYNC(); }
      REP(8) { if (PH(8)) phase_merge(c); GSYNC(); }
      REP(9) { if (PH(9)) phase_resid_gemm(c, wsb(c, OFF_MRG), DM, W_OUT, 1.0f, ss_site(c, layer, 2)); GSYNC(); }
      REP(10) { if (PH(10)) phase_ffn_in(c, wsb(c, OFF_XB), W_FFN2_IN, 2); GSYNC(); }
      REP(11) { if (PH(11)) phase_resid_gemm(c, wsb(c, OFF_ACT), DFF, W_FFN2_OUT, 0.5f, ss_site(c, layer, 3)); GSYNC(); }
      REP(12) { if (PH(12)) phase_ple(c); GSYNC(); }
    }
  }
}

extern "C" void kernel_launch(void* const* d_in, const int* in_sizes, int n_in, void* d_out, int out_size, void* d_ws, size_t ws_size, hipStream_t stream) {
  static int grid_blocks = 0;
  if (!grid_blocks) {
    int dev = 0, cus = 0, per_cu = 0;
    hipGetDevice(&dev);
    hipDeviceGetAttribute(&cus, hipDeviceAttributeMultiprocessorCount, dev);
    hipFuncSetAttribute((const void*)mega_kernel, hipFuncAttributeMaxDynamicSharedMemorySize, LDS_BYTES);
    hipOccupancyMaxActiveBlocksPerMultiprocessor(&per_cu, mega_kernel, NTHREADS, LDS_BYTES);
    if (per_cu > 2) per_cu = 2;
    if (per_cu < 1) per_cu = 1;
    grid_blocks = cus * per_cu;
  }
  Params p{};
  for (int i = 0; i < 32; ++i) p.in[i] = (const float*)d_in[i];
  p.out = (float*)d_out;
  p.ws = (char*)d_ws;
  hipMemsetAsync((char*)d_ws + OFF_BAR, 0, 16384, stream);
  void* args[] = {&p};
  hipError_t e = hipLaunchCooperativeKernel((const void*)mega_kernel, dim3(grid_blocks), dim3(NTHREADS), args, LDS_BYTES, stream);
  if (e != hipSuccess) fprintf(stderr, "cooperative launch failed: %s (grid %d)\n", hipGetErrorString(e), grid_blocks);
}
```

```cpp
#ifndef DUP
#define DUP -1
#endif
#include <hip/hip_runtime.h>
#include <hip/hip_cooperative_groups.h>
#include <stdint.h>
#include <cstdio>
namespace cg = cooperative_groups;

typedef unsigned short bf16_t;
typedef short bf16x8 __attribute__((ext_vector_type(8)));
typedef float f32x16 __attribute__((ext_vector_type(16)));
typedef float f32x4 __attribute__((ext_vector_type(4)));
typedef float f32x2 __attribute__((ext_vector_type(2)));
typedef unsigned u32x4 __attribute__((ext_vector_type(4)));
typedef unsigned u32x2 __attribute__((ext_vector_type(2)));
typedef __bf16 bf16x2_t __attribute__((ext_vector_type(2)));
#define DI __device__ __forceinline__
#define MFMA(a, b, c) __builtin_amdgcn_mfma_f32_32x32x16_bf16((a), (b), (c), 0, 0, 0)

constexpr int TC = 16384;
constexpr int DM = 1024;
constexpr int DFF = 2816;
constexpr float EPS = 1e-6f;
constexpr float LOG2E = 1.4426950408889634f;
constexpr float LN2 = 0.6931471805599453f;
constexpr int NTHREADS = 256;
constexpr int PADK = 64;
constexpr int LDX = DM + PADK;
constexpr int LDACT = DFF + PADK;
constexpr int LDCQ = 256 + PADK, LDCKV = 128 + PADK, LDO = 512 + PADK, LDOB = 256 + PADK, LDPE = 256 + PADK;

constexpr size_t W_FFN1_IN = 0;
constexpr size_t W_FFN1_OUT = W_FFN1_IN + (size_t)5632 * LDX;
constexpr size_t W_IN = W_FFN1_OUT + (size_t)1024 * LDACT;
constexpr size_t W_GATE = W_IN + (size_t)3584 * LDX;
constexpr size_t W_UQ = W_GATE + (size_t)3072 * LDX;
constexpr size_t W_UKV = W_UQ + (size_t)768 * LDCQ;
constexpr size_t W_OA = W_UKV + (size_t)1024 * LDCKV;
constexpr size_t W_OB = W_OA + (size_t)1024 * LDO;
constexpr size_t W_OC = W_OB + (size_t)1024 * LDOB;
constexpr size_t W_OUT = W_OC + (size_t)1024 * LDO;
constexpr size_t W_FFN2_IN = W_OUT + (size_t)1024 * LDX;
constexpr size_t W_FFN2_OUT = W_FFN2_IN + (size_t)5632 * LDX;
constexpr size_t W_PG = W_FFN2_OUT + (size_t)1024 * LDACT;
constexpr size_t W_PLE = W_PG + (size_t)1024 * LDX;
constexpr size_t W_LAYER = W_PLE + (size_t)1024 * LDPE;

constexpr size_t AL(size_t x) { return (x + 255) & ~(size_t)255; }
constexpr size_t OFF_W = 0;
constexpr size_t OFF_BAR = AL(OFF_W + 2 * W_LAYER * 2);
constexpr size_t OFF_ROPE = AL(OFF_BAR + 16384);
constexpr size_t OFF_BIAS = AL(OFF_ROPE + (size_t)16384 * 16 * 8);
constexpr size_t OFF_SS = AL(OFF_BIAS + 12 * 132 * 4);
constexpr size_t OFF_XB = AL(OFF_SS + (size_t)3 * 6 * TC * 4);
constexpr size_t OFF_XB2 = AL(OFF_XB + (size_t)TC * LDX * 2);
constexpr size_t OFF_PEB = AL(OFF_XB2 + (size_t)TC * LDX * 2);
constexpr size_t OFF_BIG = AL(OFF_PEB + (size_t)2 * TC * LDPE * 2);
constexpr size_t OFF_ACT = OFF_BIG;
constexpr size_t OFF_CQ = OFF_BIG;
constexpr size_t OFF_CKV = AL(OFF_CQ + (size_t)TC * LDCQ * 2);
constexpr size_t OFF_QA = AL(OFF_CKV + (size_t)TC * LDCKV * 2);
constexpr size_t OFF_KA = AL(OFF_QA + (size_t)TC * 768 * 2);
constexpr size_t OFF_VTA = AL(OFF_KA + (size_t)TC * 768 * 2);
constexpr size_t OFF_QB = AL(OFF_VTA + (size_t)(TC + 256) * 512 * 2);
constexpr size_t OFF_KB = AL(OFF_QB + (size_t)TC * 768 * 2);
constexpr size_t OFF_VTB = AL(OFF_KB + (size_t)TC * 768 * 2);
constexpr size_t OFF_QC = AL(OFF_VTB + (size_t)(TC + 256) * 768 * 2);
constexpr size_t OFF_KC = AL(OFF_QC + (size_t)TC * 512 * 2);
constexpr size_t OFF_VTC = AL(OFF_KC + (size_t)TC * 128 * 2);
constexpr size_t OFF_OA = AL(OFF_VTC + (size_t)(TC + 256) * 128 * 2);
constexpr size_t OFF_OBG = AL(OFF_OA + (size_t)TC * LDO * 2);
constexpr size_t OFF_LSE = AL(OFF_OBG + (size_t)TC * 768 * 2);
constexpr size_t OFF_OB = AL(OFF_LSE + (size_t)TC * 12 * 4);
constexpr size_t OFF_OC = AL(OFF_OB + (size_t)TC * LDOB * 2);
constexpr size_t OFF_MRG = AL(OFF_OC + (size_t)TC * LDO * 2);
constexpr size_t OFF_END = AL(OFF_MRG + (size_t)TC * LDX * 2);
static_assert(OFF_END < (size_t)508 * 1024 * 1024, "workspace too large");
static_assert(OFF_ACT + (size_t)TC * LDACT * 2 <= OFF_END, "act fits");

struct Params {
  const float* in[32];
  float* out;
  char* ws;
};

constexpr int LROW = 144;
constexpr int STAGE_OP = 128 * LROW;
constexpr int STAGE = 2 * STAGE_OP;
constexpr int CLD = 132;
constexpr int OFF_RR = 2 * STAGE;
constexpr int LDS_BYTES = 2 * STAGE + 1024;
static_assert(128 * CLD * 4 <= OFF_RR, "lds");

DI int tid_() { int t = threadIdx.x; asm volatile("" : "+v"(t)); return t; }
DI unsigned pk2(float a, float b) { f32x2 v = {a, b}; bf16x2_t r = __builtin_convertvector(v, bf16x2_t); return __builtin_bit_cast(unsigned, r); }
DI bf16_t f2bf(float a) { return (bf16_t)(pk2(a, 0.f) & 0xffffu); }
DI float bf2f(bf16_t v) { return __uint_as_float(((unsigned)v) << 16); }
DI float sigmoidf_(float x) { return 1.0f / (1.0f + __expf(-x)); }

DI int map_col(int map, int n) {
  switch (map) {
    case 0: return n;
    case 1: { int t = n >> 7, w = n & 127; return w < 64 ? t * 64 + w : DFF + t * 64 + (w - 64); }
    case 2: { int slot = n >> 6, d = n & 63; if (slot < 6) return n; if (slot == 6) return d < 32 ? 384 + d : -1; if (slot < 55) return 416 + (n - 448); return -1; }
    case 3: { if (n < 512) return (n >> 6) * 96 + (n & 63); int i = n - 512; return (i >> 5) * 96 + 64 + (i & 31); }
    default: { if (n < 512) return (n >> 6) * 128 + (n & 63); int i = n - 512; return (i >> 6) * 128 + 64 + (i & 63); }
  }
}

DI void transpose_mat(const float* __restrict__ src, int ld_src, bf16_t* __restrict__ dst, int N, int K, const float* __restrict__ gain, int map, float* lds, int rot) {
  const int ntk = K >> 6, ntn = N >> 6, nt = ntk * ntn;
  const int tid = tid_(), c = tid & 63, rq = tid >> 6;
  int b0 = (int)blockIdx.x - (rot % (int)gridDim.x); if (b0 < 0) b0 += gridDim.x;
  for (int t = b0; t < nt; t += gridDim.x) {
    const int tn = t / ntk, tk = t - tn * ntk;
    const int n0 = tn << 6, k0 = tk << 6;
    const int sc = map_col(map, n0 + c);
#pragma unroll 4
    for (int r = 0; r < 16; ++r) {
      const int kk = r * 4 + rq;
      float v = 0.f;
      if (sc >= 0) { v = src[(size_t)(k0 + kk) * ld_src + sc]; if (gain) v *= gain[k0 + kk]; }
      lds[c * 65 + kk] = v;
    }
    __syncthreads();
#pragma unroll 4
    for (int r = 0; r < 16; ++r) {
      const int nn = r * 4 + rq;
      dst[(size_t)(n0 + nn) * (K + PADK) + k0 + c] = f2bf(lds[nn * 65 + c]);
    }
    __syncthreads();
  }
}

template <int NJ> DI void zero_acc(f32x16 (&acc)[2][NJ]) {
#pragma unroll
  for (int i = 0; i < 2; ++i)
#pragma unroll
    for (int j = 0; j < NJ; ++j)
#pragma unroll
      for (int r = 0; r < 16; ++r) acc[i][j][r] = 0.f;
}

constexpr int GSTG_B = 128 * 128;
constexpr int GSTG = 2 * GSTG_B;
template <int NJ> DI void gemm_mainloop_glds(const bf16_t* __restrict__ A, int lda, const bf16_t* __restrict__ Bt, int ldb, int K, f32x16 (&acc)[2][NJ], char* lds) {
  const int tid = tid_(), lane = tid & 63, w = __builtin_amdgcn_readfirstlane(tid >> 6), wm = w >> 1, wn = w & 1;
  const int ql = lane & 31, h = lane >> 5;
  const int sw_s = (4 * (w & 1) + (lane >> 4)) & 7;
  const int csrc = (lane & 7) ^ sw_s;
  const char* ap = (const char*)A;
  const char* bp = (const char*)Bt;
  const unsigned aoff = (unsigned)((8 * w + (lane >> 3)) * lda + csrc * 8) * 2u, boff = (unsigned)((8 * w + (lane >> 3)) * ldb + csrc * 8) * 2u;
  const unsigned astep = (unsigned)(32 * lda) * 2u, bstep = (unsigned)(32 * ldb) * 2u;
  constexpr int NB = 2 * NJ;
  const int sw_r = (ql >> 1) & 7;
  int a_rd[4], b_rd[4];
#pragma unroll
  for (int ks = 0; ks < 4; ++ks) { const int pos = ((2 * ks + h) ^ sw_r) * 16; a_rd[ks] = (wm * 64 + ql) * 128 + pos; b_rd[ks] = GSTG_B + (wn * 32 * NJ + ql) * 128 + pos; }
#define GSTAGE_(ST) { char* sb_ = lds + (ST) * GSTG + w * 1024; \
    _Pragma("unroll") for (int i_ = 0; i_ < 4; ++i_) __builtin_amdgcn_global_load_lds((const unsigned*)(ap + (aoff + i_ * astep)), (unsigned*)(sb_ + i_ * 4096), 16, 0, 0); \
    _Pragma("unroll") for (int i_ = 0; i_ < NB; ++i_) __builtin_amdgcn_global_load_lds((const unsigned*)(bp + (boff + i_ * bstep)), (unsigned*)(sb_ + GSTG_B + i_ * 4096), 16, 0, 0); \
    ap += 128; bp += 128; }
  GSTAGE_(0);
  asm volatile("s_waitcnt vmcnt(0)" ::: "memory");
  __syncthreads();
  const int nk = K >> 6;
  for (int kt = 0; kt < nk; ++kt) {
    const int cur = kt & 1;
    if (kt + 1 < nk) GSTAGE_(cur ^ 1);
    const char* st_ = lds + cur * GSTG;
#pragma unroll
    for (int ks = 0; ks < 4; ++ks) {
      const bf16x8 a0 = *(const bf16x8*)(st_ + a_rd[ks]);
      const bf16x8 a1 = *(const bf16x8*)(st_ + a_rd[ks] + 4096);
#pragma unroll
      for (int j = 0; j < NJ; ++j) {
        const bf16x8 b = *(const bf16x8*)(st_ + b_rd[ks] + j * 4096);
        acc[0][j] = MFMA(a0, b, acc[0][j]); acc[1][j] = MFMA(a1, b, acc[1][j]);
      }
    }
    asm volatile("s_waitcnt vmcnt(0)" ::: "memory");
    __syncthreads();
  }
#undef GSTAGE_
}

template <int NJ> DI void gemm_mainloop_reg(const bf16_t* __restrict__ A, int lda, const bf16_t* __restrict__ Bt, int ldb, int K, f32x16 (&acc)[2][NJ], char* lds) {
  const int tid = tid_(), lane = tid & 63, w = tid >> 6, wm = w >> 1, wn = w & 1;
  const int lr = tid >> 3, lc = tid & 7;
  const char* ap = (const char*)A;
  const char* bp = (const char*)Bt;
  const unsigned aoff = (unsigned)(lr * lda + lc * 8) * 2u, boff = (unsigned)(lr * ldb + lc * 8) * 2u;
  const unsigned astep = (unsigned)(32 * lda) * 2u, bstep = (unsigned)(32 * ldb) * 2u;
  constexpr int NB = 2 * NJ;
  u32x4 ra0[4], rb0[NB], ra1[4], rb1[NB];
  const int wofs = lr * LROW + lc * 16;
  const int a_rd = (wm * 64 + (lane & 31)) * LROW + (lane >> 5) * 16;
  const int b_rd = STAGE_OP + (wn * 32 * NJ + (lane & 31)) * LROW + (lane >> 5) * 16;
#define GL1_(RA, RB, i) { RA[i] = *(const u32x4*)(ap + (aoff + (i) * astep)); if ((i) < NB) RB[(i) < NB ? (i) : 0] = *(const u32x4*)(bp + (boff + (i) * bstep)); }
#define LS1_(RA, RB, ST, i) { char* sn_ = lds + (ST) * STAGE; *(u32x4*)(sn_ + wofs + (i) * 32 * LROW) = RA[i]; \
                              if ((i) < NB) *(u32x4*)(sn_ + STAGE_OP + wofs + (i) * 32 * LROW) = RB[(i) < NB ? (i) : 0]; }
#define RF_(ks) { fa0 = *(const bf16x8*)(st_ + a_rd + (ks) * 32); fa1 = *(const bf16x8*)(st_ + a_rd + 32 * LROW + (ks) * 32); \
      _Pragma("unroll") for (int j = 0; j < NJ; ++j) fb[j] = *(const bf16x8*)(st_ + b_rd + j * 32 * LROW + (ks) * 32); }
#define STEP_(ST, DOL, RAL, RBL, DOS, RAS, RBS) { const char* st_ = lds + (ST) * STAGE; \
    bf16x8 fa0, fa1, fb[NJ]; RF_(0); \
    _Pragma("unroll") for (int ks = 0; ks < 4; ++ks) { \
      if (DOL) GL1_(RAL, RBL, ks); \
      const bf16x8 ca0 = fa0, ca1 = fa1; bf16x8 cb[NJ]; \
      _Pragma("unroll") for (int j = 0; j < NJ; ++j) cb[j] = fb[j]; \
      if (ks < 3) RF_(ks + 1); \
      _Pragma("unroll") for (int j = 0; j < NJ; ++j) { acc[0][j] = MFMA(ca0, cb[j], acc[0][j]); acc[1][j] = MFMA(ca1, cb[j], acc[1][j]); } \
      if (DOS) LS1_(RAS, RBS, 1 - (ST), ks); \
      __builtin_amdgcn_sched_barrier(0); } \
    if (DOL) { ap += 128; bp += 128; } }
#pragma unroll
  for (int i = 0; i < 4; ++i) GL1_(ra0, rb0, i);
  ap += 128; bp += 128;
#pragma unroll
  for (int i = 0; i < 4; ++i) GL1_(ra1, rb1, i);
  ap += 128; bp += 128;
#pragma unroll
  for (int i = 0; i < 4; ++i) LS1_(ra0, rb0, 0, i);
  __syncthreads();
  const int nk = K >> 6;
  for (int kt = 0; kt < nk; kt += 2) {
    const bool l0 = (kt + 2 < nk), l1 = (kt + 3 < nk);
    STEP_(0, l0, ra0, rb0, true, ra1, rb1);
    __syncthreads();
    STEP_(1, l1, ra1, rb1, l0, ra0, rb0);
    __syncthreads();
  }
#undef GL1_
#undef LS1_
#undef STEP_
#undef RF_
}

template <int NJ> DI void acc_to_lds(const f32x16 (&acc)[2][NJ], float* cl) {
  const int tid = tid_(), lane = tid & 63, w = tid >> 6, wm = w >> 1, wn = w & 1, h = lane >> 5, c = lane & 31;
#pragma unroll
  for (int i = 0; i < 2; ++i)
#pragma unroll
    for (int j = 0; j < NJ; ++j)
#pragma unroll
      for (int r = 0; r < 16; ++r) {
        const int row = wm * 64 + i * 32 + (r & 3) + 8 * (r >> 2) + 4 * h;
        cl[row * CLD + wn * 32 * NJ + j * 32 + c] = acc[i][j][r];
      }
}

template <int NJ> DI void resid_epilogue(float* __restrict__ x, bf16_t* __restrict__ xb, float* __restrict__ ssn, int mt, int nt, const float* cl, float scale) {
  constexpr int LPR = 16 * NJ, RPP = 256 / LPR, NP = 128 / RPP;
  const int tid = tid_(), c4 = (tid & (LPR - 1)) * 4, r0 = tid / LPR;
#pragma unroll 4
  for (int it = 0; it < NP; ++it) {
    const int row = r0 + RPP * it;
    const f32x4 c = *(const f32x4*)(cl + row * CLD + c4);
    const size_t gi = (size_t)(mt * 128 + row) * DM + nt * (64 * NJ) + c4;
    f32x4 xv = *(const f32x4*)(x + gi);
    xv = xv + scale * c;
    *(f32x4*)(x + gi) = xv;
    u32x2 p; p.x = pk2(xv[0], xv[1]); p.y = pk2(xv[2], xv[3]);
    *(u32x2*)(xb + (size_t)(mt * 128 + row) * LDX + nt * (64 * NJ) + c4) = p;
    float s_ = xv[0] * xv[0] + xv[1] * xv[1] + xv[2] * xv[2] + xv[3] * xv[3];
    if (NJ == 2) s_ += __shfl_xor(s_, 16);
    s_ += __shfl_xor(s_, 8); s_ += __shfl_xor(s_, 4); s_ += __shfl_xor(s_, 2); s_ += __shfl_xor(s_, 1);
    if ((tid & (LPR - 1)) == 0) atomicAdd(ssn + mt * 128 + row, s_);
  }
}

#define XB_TMO      128
#define XB_XCNT(j)  (256  + 64 * (j))
#define XB_XSUB(j)  (1280 + 64 * (j))
#define XB_XGEN(j)  (2304 + 64 * (j))
#define XB_TOP      3328
#define XB_TOPGEN   3392
#define XCD_BAR_WORDS 3456
#define XB_SPIN_CAP (1u << 22)
#define LAS __attribute__((address_space(3)))
DI unsigned xb_ld(unsigned* p)              { return __hip_atomic_load(p, __ATOMIC_RELAXED, __HIP_MEMORY_SCOPE_AGENT); }
DI unsigned xb_add(unsigned* p, unsigned v) { return __hip_atomic_fetch_add(p, v, __ATOMIC_RELAXED, __HIP_MEMORY_SCOPE_AGENT); }
DI unsigned xb_xcc_id() { return (unsigned)__builtin_amdgcn_s_getreg((3 << 11) | 20) & 0xFu; }
#define XB_SPIN(cond, bar) do { unsigned _sp = 0; while (cond) { __builtin_amdgcn_s_sleep(1); \
    if ((++_sp & 255u) == 0u) { if (xb_ld(&(bar)[XB_TMO])) break; if (_sp > XB_SPIN_CAP) { atomicAdd(&(bar)[XB_TMO], 1u); break; } } } } while (0)
struct XcdBarrier { unsigned* bar; unsigned x; volatile LAS unsigned* st; };
DI XcdBarrier xcd_barrier_post(unsigned* bar, volatile LAS unsigned* st) {
  XcdBarrier b; b.bar = bar; b.x = xb_xcc_id(); b.st = st;
  if (threadIdx.x == 0) (void)xb_add(&bar[XB_XCNT(b.x)], 1u);
  return b;
}
DI void xcd_barrier_complete(unsigned* bar, unsigned x, unsigned& nloc, unsigned& nx) {
  const unsigned G = gridDim.x * gridDim.y * gridDim.z;
  unsigned sum, cnt, mine, sp = 0u;
  for (;;) {
    sum = 0u; cnt = 0u; mine = 0u;
#pragma unroll
    for (unsigned j = 0; j < 16; ++j) { const unsigned c = xb_ld(&bar[XB_XCNT(j)]); sum += c; cnt += (c > 0u) ? 1u : 0u; mine = (j == x) ? c : mine; }
    if (sum == G) break;
    __builtin_amdgcn_s_sleep(1);
    if ((++sp & 255u) == 0u) { if (xb_ld(&bar[XB_TMO])) break; if (sp > XB_SPIN_CAP) { atomicAdd(&bar[XB_TMO], 1u); break; } }
  }
  nloc = mine > 0u ? mine : 1u; nx = cnt > 0u ? cnt : 1u;
}
DI void xcd_barrier(const XcdBarrier& b) {
  asm volatile("s_waitcnt vmcnt(0)" ::: "memory");
  __syncthreads();
  if (threadIdx.x == 0) {
    unsigned* bar = b.bar;
    __builtin_amdgcn_s_waitcnt(0);
    unsigned nloc = b.st[0], nx = b.st[1];
    if (nloc == 0u) { xcd_barrier_complete(bar, b.x, nloc, nx); b.st[0] = nloc; b.st[1] = nx; }
    const unsigned old = xb_add(&bar[XB_XSUB(b.x)], 1u);
    const unsigned gen = old / nloc;
    if (old + 1u == (gen + 1u) * nloc) {
      __builtin_amdgcn_fence(__ATOMIC_RELEASE, "agent");
      asm volatile("s_waitcnt vmcnt(0)" ::: "memory");
      const unsigned og = xb_add(&bar[XB_TOP], 1u);
      const unsigned tg = og / nx;
      if (og + 1u == (tg + 1u) * nx) xb_add(&bar[XB_TOPGEN], 1u);
      else XB_SPIN(xb_ld(&bar[XB_TOPGEN]) == tg, bar);
      __builtin_amdgcn_fence(__ATOMIC_ACQUIRE, "agent");
      xb_add(&bar[XB_XGEN(b.x)], 1u);
      asm volatile("s_waitcnt vmcnt(0)" ::: "memory");
    } else {
      XB_SPIN(xb_ld(&bar[XB_XGEN(b.x)]) == gen, bar);
      __builtin_amdgcn_fence(__ATOMIC_ACQUIRE, "agent");
      asm volatile("s_waitcnt vmcnt(0)" ::: "memory");
    }
  }
  __syncthreads();
}

struct Ctx {
  const Params* p;
  int chunk, layer;
  int S, sshift;
  float* x;
  const float* xin;
  const float* pe0; size_t pe_ls;
  char* ws;
  char* lds;
};
DI bf16_t* wsb(const Ctx& c, size_t off) { return (bf16_t*)(c.ws + off); }
DI float* ss_site(const Ctx& c, int layer, int site) { return (float*)(c.ws + OFF_SS) + ((size_t)layer * 6 + site) * TC; }
DI const bf16_t* wgt(const Ctx& c, size_t off) { return (const bf16_t*)(c.ws + OFF_W) + (size_t)c.layer * W_LAYER + off; }
DI const float* inl(const Ctx& c, int idx, size_t per_layer) { return c.p->in[idx] + (size_t)c.layer * per_layer; }

DI void phase_ffn_in(const Ctx& c, const bf16_t* A, size_t woff, int site) {
  const bf16_t* Bt = wgt(c, woff);
  bf16_t* act = wsb(c, OFF_ACT);
  const float* ss = ss_site(c, c.layer, site);
  float* cl = (float*)c.lds; float* rr = (float*)(c.lds + OFF_RR);
  const int tid = tid_();
  const int xcd_ = blockIdx.x & 7, slot_ = blockIdx.x >> 3, nslot_ = gridDim.x >> 3;
  for (int j_ = slot_; j_ < 16 * 44; j_ += nslot_) {
    const int mt = xcd_ * 16 + (j_ & 15), nt = j_ >> 4;
    f32x16 acc[2][2]; zero_acc<2>(acc);
    gemm_mainloop_reg<2>(A + (size_t)mt * 128 * LDX, LDX, Bt + (size_t)nt * 128 * LDX, LDX, DM, acc, c.lds);
    acc_to_lds<2>(acc, cl);
    if (tid < 128) rr[tid] = rsqrtf(ss[mt * 128 + tid] * (1.0f / DM) + EPS);
    __syncthreads();
    const int c4 = (tid & 15) * 4, r0 = tid >> 4;
#pragma unroll 2
    for (int it = 0; it < 8; ++it) {
      const int row = r0 + 16 * it;
      const float r = rr[row];
      const f32x4 a = *(const f32x4*)(cl + row * CLD + c4);
      const f32x4 b = *(const f32x4*)(cl + row * CLD + 64 + c4);
      float o[4];
#pragma unroll
      for (int e = 0; e < 4; ++e) { const float av = a[e] * r, bv = b[e] * r; o[e] = av * sigmoidf_(av) * bv; }
      u32x2 pq; pq.x = pk2(o[0], o[1]); pq.y = pk2(o[2], o[3]);
      *(u32x2*)(act + (size_t)(mt * 128 + row) * LDACT + nt * 64 + c4) = pq;
    }
    __syncthreads();
  }
}

#if DUP == 300
DI void phase_ffn_probe(const Ctx& c, const bf16_t* A, size_t woff, int site) {
  const bf16_t* Bt = wgt(c, woff);
  bf16_t* act = (bf16_t*)(c.ws + OFF_ACT + (size_t)110 * 1024 * 1024);
  const float* ss = ss_site(c, c.layer, site);
  float* cl = (float*)c.lds; float* rr = (float*)(c.lds + OFF_RR);
  const int tid = tid_();
  const int xcd_ = blockIdx.x & 7, slot_ = blockIdx.x >> 3, nslot_ = gridDim.x >> 3;
  for (int j_ = slot_; j_ < 16 * 44; j_ += nslot_) {
    const int mt = xcd_ * 16 + (j_ & 15), nt = j_ >> 4;
    f32x16 acc[2][2]; zero_acc<2>(acc);
    gemm_mainloop_reg<2>(A + (size_t)(mt & 1) * 128 * LDX, LDX, Bt + (size_t)(nt & 1) * 128 * LDX, LDX, DM, acc, c.lds);
    acc_to_lds<2>(acc, cl);
    if (tid < 128) rr[tid] = rsqrtf(ss[mt * 128 + tid] * (1.0f / DM) + EPS);
    __syncthreads();
    const int c4 = (tid & 15) * 4, r0 = tid >> 4;
#pragma unroll 2
    for (int it = 0; it < 8; ++it) {
      const int row = r0 + 16 * it;
      const float r = rr[row];
      const f32x4 a = *(const f32x4*)(cl + row * CLD + c4);
      const f32x4 b = *(const f32x4*)(cl + row * CLD + 64 + c4);
      float o[4];
#pragma unroll
      for (int e = 0; e < 4; ++e) { const float av = a[e] * r, bv = b[e] * r; o[e] = av * sigmoidf_(av) * bv; }
      u32x2 pq; pq.x = pk2(o[0], o[1]); pq.y = pk2(o[2], o[3]);
      *(u32x2*)(act + (size_t)(mt * 128 + row) * LDACT + nt * 64 + c4) = pq;
    }
    __syncthreads();
  }
}
#endif

DI void phase_resid_gemm(const Ctx& c, const bf16_t* A, int K, size_t woff, float scale, float* ssn) {
  const bf16_t* Bt = wgt(c, woff);
  bf16_t* xb = wsb(c, OFF_XB);
  float* cl = (float*)c.lds;
  const int xcd_ = blockIdx.x & 7, slot_ = blockIdx.x >> 3, nslot_ = gridDim.x >> 3;
  for (int j_ = slot_; j_ < 16 * 8; j_ += nslot_) {
    const int mt = xcd_ * 16 + (j_ & 15), nt = j_ >> 4;
    f32x16 acc[2][2]; zero_acc<2>(acc);
    gemm_mainloop_reg<2>(A + (size_t)mt * 128 * (K + PADK), K + PADK, Bt + (size_t)nt * 128 * (K + PADK), K + PADK, K, acc, c.lds);
    acc_to_lds<2>(acc, cl);
    __syncthreads();
    resid_epilogue<2>(c.x, xb, ssn, mt, nt, cl, scale);
    __syncthreads();
  }
}

DI void load_slot(const float* cl, int row, int col0, float (&v)[64]) {
#pragma unroll
  for (int q = 0; q < 16; ++q) { const f32x4 t = *(const f32x4*)(cl + row * CLD + col0 + q * 4); v[4 * q] = t[0]; v[4 * q + 1] = t[1]; v[4 * q + 2] = t[2]; v[4 * q + 3] = t[3]; }
}
template <int N> DI void store_bf16(bf16_t* dst, const float* v) {
#pragma unroll
  for (int q = 0; q < N / 8; ++q) { u32x4 p; p.x = pk2(v[8 * q], v[8 * q + 1]); p.y = pk2(v[8 * q + 2], v[8 * q + 3]); p.z = pk2(v[8 * q + 4], v[8 * q + 5]); p.w = pk2(v[8 * q + 6], v[8 * q + 7]); *(u32x4*)(dst + 8 * q) = p; }
}
template <int N> DI void rmsnorm_inplace(float* v, const float* __restrict__ g) {
  float s = 0.f;
#pragma unroll
  for (int i = 0; i < N; ++i) s += v[i] * v[i];
  const float r = rsqrtf(s * (1.0f / N) + EPS);
#pragma unroll
  for (int i = 0; i < N; ++i) v[i] = v[i] * r * g[i];
}
DI void rope32(float* v, const f32x2* __restrict__ tab  ) {
#pragma unroll
  for (int i = 0; i < 16; ++i) { const f32x2 cs = tab[i]; const float x1 = v[i], x2 = v[i + 16]; v[i] = x1 * cs.x - x2 * cs.y; v[i + 16] = x1 * cs.y + x2 * cs.x; }
}
DI void vt_write(const float* cl, const float* rr, int col0, int u, bf16_t* dst_row  , int dsh, int L, int pos0) {
  const int d = u & 63, th = u >> 6;
  float v[64];
#pragma unroll
  for (int i = 0; i < 64; ++i) v[i] = cl[(th * 64 + i) * CLD + col0 + d] * rr[th * 64 + i];
  const int p0 = pos0 + th * 64;
  if (dsh == 0) {
    store_bf16<64>(dst_row + p0, v);
  } else if (dsh == 2) {
#pragma unroll
    for (int rr_ = 0; rr_ < 4; ++rr_) {
      float t[16];
#pragma unroll
      for (int a = 0; a < 16; ++a) t[a] = v[4 * a + rr_];
      store_bf16<16>(dst_row + rr_ * L + (p0 >> 2), t);
    }
  } else {
#pragma unroll
    for (int rr_ = 0; rr_ < 16; ++rr_) {
      u32x2 p; p.x = pk2(v[rr_], v[16 + rr_]); p.y = pk2(v[32 + rr_], v[48 + rr_]);
      *(u32x2*)(dst_row + rr_ * L + (p0 >> 4)) = p;
    }
  }
}

DI void phase_proj(const Ctx& c) {
  const bf16_t* A = wsb(c, OFF_XB);
  const bf16_t* Bt = wgt(c, W_IN);
  const float* ss = ss_site(c, c.layer, 1);
  float* ss_cq = ss_site(c, c.layer, 4);
  float* ss_ckv = ss_site(c, c.layer, 5);
  float* cl = (float*)c.lds; float* rr = (float*)(c.lds + OFF_RR);
  const f32x2* rope = (const f32x2*)(c.ws + OFF_ROPE);
  const int tid0 = tid_();
  const int S = c.S, sshift = c.sshift;
  const int xcd_ = blockIdx.x & 7, slot_ = blockIdx.x >> 3, nslot_ = gridDim.x >> 3;
  for (int j_ = slot_; j_ < 16 * 28; j_ += nslot_) {
    const int mt = xcd_ * 16 + (j_ & 15), nt = j_ >> 4;
    f32x16 acc[2][2]; zero_acc<2>(acc);
    gemm_mainloop_reg<2>(A + (size_t)mt * 128 * LDX, LDX, Bt + (size_t)nt * 128 * LDX, LDX, DM, acc, c.lds);
    acc_to_lds<2>(acc, cl);
    const int tid = tid_(), half = __builtin_amdgcn_readfirstlane(tid >> 7), u = tid & 127;
    if (tid < 128) rr[tid] = rsqrtf(ss[mt * 128 + tid] * (1.0f / DM) + EPS);
    __syncthreads();
    const int slot = nt * 2 + half, col0 = half * 64;
    const int tl0 = mt * 128, seq = tl0 >> sshift, pos0 = tl0 & (S - 1);
    const bool is_vb = (slot >= 31 && slot < 43), is_vc = (slot == 53 || slot == 54);
    if (is_vb) {
      const int hb = slot - 31, dsh = 2 * (hb >> 2);
      bf16_t* dst = wsb(c, OFF_VTB) + ((size_t)(seq * 12 + hb) * 64 + (u & 63)) * (S + 64);
      vt_write(cl, rr, col0, u, dst, dsh, S >> dsh, pos0);
    } else if (is_vc) {
      const int hv = slot - 53;
      bf16_t* dst = wsb(c, OFF_VTC) + ((size_t)(seq * 2 + hv) * 64 + (u & 63)) * (S + 64);
      vt_write(cl, rr, col0, u, dst, 0, S, pos0);
    } else if (slot < 55) {
      const int row = u, tl = tl0 + row, pos = pos0 + row;
      const float r = rr[row];
      float v[64];
      load_slot(cl, row, col0, v);
#pragma unroll
      for (int i = 0; i < 64; ++i) v[i] *= r;
      if (slot < 6) {
        float s = 0.f;
#pragma unroll
        for (int i = 0; i < 64; ++i) s += v[i] * v[i];
        if (slot < 4) { store_bf16<64>(wsb(c, OFF_CQ) + (size_t)tl * LDCQ + slot * 64, v); atomicAdd(ss_cq + tl, s); }
        else { store_bf16<64>(wsb(c, OFF_CKV) + (size_t)tl * LDCKV + (slot - 4) * 64, v); atomicAdd(ss_ckv + tl, s); }
      } else if (slot == 6) {
        rmsnorm_inplace<32>(v, inl(c, 14, 96) + 64);
        rope32(v, rope + (size_t)pos * 16);
        bf16_t* dst = wsb(c, OFF_KA) + ((size_t)(seq * 8) * S + pos) * 96 + 64;
#pragma unroll
        for (int hh = 0; hh < 8; ++hh) store_bf16<32>(dst + (size_t)hh * S * 96, v);
      } else if (slot < 31) {
        const bool isq = slot < 19;
        const int hb = isq ? slot - 7 : slot - 19, dsh = 2 * (hb >> 2), L = S >> dsh;
        rmsnorm_inplace<64>(v, inl(c, isq ? 15 : 16, 64));
        const int srow = (pos & ((1 << dsh) - 1)) * L + (pos >> dsh);
        bf16_t* dst = wsb(c, isq ? OFF_QB : OFF_KB) + ((size_t)(seq * 12 + hb) * S + srow) * 64;
        store_bf16<64>(dst, v);
      } else {
        const bool isq = slot < 51;
        rmsnorm_inplace<64>(v, inl(c, isq ? 18 : 19, 64));
        bf16_t* dst = isq ? wsb(c, OFF_QC) + ((size_t)(seq * 8 + (slot - 43)) * S + pos) * 64
                          : wsb(c, OFF_KC) + ((size_t)(seq * 2 + (slot - 51)) * S + pos) * 64;
        asm volatile("" ::: "memory");
        rope32(v, rope + (size_t)(pos >> 6) * 16);
        store_bf16<32>(dst, v);
        asm volatile("" ::: "memory");
        rope32(v + 32, rope + (size_t)(pos & 63) * 16);
        store_bf16<32>(dst + 32, v + 32);
      }
    }
    __syncthreads();
  }
}

DI void phase_mlaup(const Ctx& c) {
  const float* ss_cq = ss_site(c, c.layer, 4);
  const float* ss_ckv = ss_site(c, c.layer, 5);
  float* cl = (float*)c.lds; float* rr = (float*)(c.lds + OFF_RR);
  const f32x2* rope = (const f32x2*)(c.ws + OFF_ROPE);
  const int tid0 = tid_();
  const int S = c.S, sshift = c.sshift;
  const int xcd_ = blockIdx.x & 7, slot_ = blockIdx.x >> 3, nslot_ = gridDim.x >> 3;
  for (int j_ = slot_; j_ < 16 * 14; j_ += nslot_) {
    const int mt = xcd_ * 16 + (j_ & 15), nt = j_ >> 4;
    const bool isq = nt < 6;
    f32x16 acc[2][2]; zero_acc<2>(acc);
    if (isq) gemm_mainloop_reg<2>(wsb(c, OFF_CQ) + (size_t)mt * 128 * LDCQ, LDCQ, wgt(c, W_UQ) + (size_t)nt * 128 * LDCQ, LDCQ, 256, acc, c.lds);
    else gemm_mainloop_reg<2>(wsb(c, OFF_CKV) + (size_t)mt * 128 * LDCKV, LDCKV, wgt(c, W_UKV) + (size_t)(nt - 6) * 128 * LDCKV, LDCKV, 128, acc, c.lds);
    acc_to_lds<2>(acc, cl);
    const int tid = tid_(), half = __builtin_amdgcn_readfirstlane(tid >> 7), u = tid & 127;
    if (tid < 128) rr[tid] = isq ? rsqrtf(ss_cq[mt * 128 + tid] * (1.0f / 256) + EPS) : rsqrtf(ss_ckv[mt * 128 + tid] * (1.0f / 128) + EPS);
    __syncthreads();
    const int col0 = half * 64;
    const int tl0 = mt * 128, seq = tl0 >> sshift, pos0 = tl0 & (S - 1);
    if (!isq && nt >= 10) {
      const int hv = (nt - 10) * 2 + half;
      bf16_t* dst = wsb(c, OFF_VTA) + ((size_t)(seq * 8 + hv) * 64 + (u & 63)) * (S + 64);
      vt_write(cl, rr, col0, u, dst, 0, S, pos0);
    } else {
      const int row = u, pos = pos0 + row;
      const float r = rr[row];
      float v[64];
      load_slot(cl, row, col0, v);
#pragma unroll
      for (int i = 0; i < 64; ++i) v[i] *= r;
      if (isq && nt < 4) {
        const int hh = nt * 2 + half;
        rmsnorm_inplace<64>(v, inl(c, 13, 96));
        store_bf16<64>(wsb(c, OFF_QA) + ((size_t)(seq * 8 + hh) * S + pos) * 96, v);
      } else if (isq) {
        const int h0 = ((nt - 4) * 2 + half) * 2;
        rmsnorm_inplace<32>(v, inl(c, 13, 96) + 64);
        rmsnorm_inplace<32>(v + 32, inl(c, 13, 96) + 64);
        rope32(v, rope + (size_t)pos * 16);
        rope32(v + 32, rope + (size_t)pos * 16);
        store_bf16<32>(wsb(c, OFF_QA) + ((size_t)(seq * 8 + h0) * S + pos) * 96 + 64, v);
        store_bf16<32>(wsb(c, OFF_QA) + ((size_t)(seq * 8 + h0 + 1) * S + pos) * 96 + 64, v + 32);
      } else {
        const int hh = (nt - 6) * 2 + half;
        rmsnorm_inplace<64>(v, inl(c, 14, 96));
        store_bf16<64>(wsb(c, OFF_KA) + ((size_t)(seq * 8 + hh) * S + pos) * 96, v);
      }
    }
    __syncthreads();
  }
}

template <int DQK, bool BAND, int QT>
DI void attn_item(const bf16_t* __restrict__ Q, const bf16_t* __restrict__ Kp, const bf16_t* __restrict__ Vt, int ldv,
                  int kbeg, int kend, int q0, const float* bias_g, float scale_log2,
                  bf16_t* __restrict__ out, size_t out_rs, float* __restrict__ lse, int lse_rs, char* lds) {
  constexpr int KROW = DQK * 2 + 16;
  constexpr int KST = 64 * KROW, VST = 64 * LROW, ST = KST + VST;
  constexpr int NKS = DQK / 16;
  constexpr int KV4 = DQK / 8;
  constexpr int NKL = (64 * KV4) / 256;
  constexpr int WQ = 32 * QT;
  const int tid = tid_(), lane = tid & 63, w = tid >> 6, h = lane >> 5, ql = lane & 31;
  float* bias_l = (float*)(lds + 2 * ST);
  if (BAND) { if (tid < 129) bias_l[tid] = bias_g[tid]; }
  bf16x8 qf[QT][NKS];
#pragma unroll
  for (int qt = 0; qt < QT; ++qt)
#pragma unroll
    for (int ks = 0; ks < NKS; ++ks) qf[qt][ks] = *(const bf16x8*)(Q + (size_t)(w * WQ + qt * 32 + ql) * DQK + ks * 16 + h * 8);
  f32x16 o[2][QT];
#pragma unroll
  for (int a = 0; a < 2; ++a)
#pragma unroll
    for (int b = 0; b < QT; ++b)
#pragma unroll
      for (int r = 0; r < 16; ++r) o[a][b][r] = 0.f;
  float m[QT], l[QT];
#pragma unroll
  for (int qt = 0; qt < QT; ++qt) { m[qt] = -1e30f; l[qt] = 0.f; }
  u32x4 rk[NKL], rv[2];
  const int vrow0 = tid >> 3, vch = tid & 7;
  unsigned klds[NKL];
#pragma unroll
  for (int i = 0; i < NKL; ++i) { const int idx = tid + i * 256, kr = idx / KV4, kc = idx - kr * KV4; klds[i] = kr * KROW + kc * 16; }
  const unsigned koff0 = (unsigned)tid * 16u;
  const unsigned voff0 = (unsigned)(vrow0 * ldv + vch * 8) * 2u, vstep = (unsigned)(32 * ldv) * 2u;
  const unsigned vlds0 = KST + vrow0 * LROW + vch * 16;
  auto gload = [&](int kt) {
    const char* kb = (const char*)Kp + (size_t)kt * (DQK * 2);
    const char* vb = (const char*)Vt + (size_t)kt * 2;
#pragma unroll
    for (int i = 0; i < NKL; ++i) rk[i] = *(const u32x4*)(kb + (koff0 + i * 4096u));
#pragma unroll
    for (int i = 0; i < 2; ++i) rv[i] = *(const u32x4*)(vb + (voff0 + i * vstep));
  };
  auto lstore = [&](char* st) {
#pragma unroll
    for (int i = 0; i < NKL; ++i) *(u32x4*)(st + klds[i]) = rk[i];
#pragma unroll
    for (int i = 0; i < 2; ++i) *(u32x4*)(st + vlds0 + i * 32 * LROW) = rv[i];
  };
  gload(kbeg);
  lstore(lds);
  __syncthreads();
  const int pr = (ql & ~12) | ((ql & 4) << 1) | ((ql & 8) >> 1);
  const int k_rd = pr * KROW + h * 16;
  const int v_rd = KST + ql * LROW + h * 16;
  const int qw0 = q0 + w * WQ;
  int it = 0;
  for (int kt = kbeg; kt < kend; kt += 64, ++it) {
    const char* st = lds + (it & 1) * ST;
    const bool more = (kt + 64 < kend);
    if (more) gload(kt + 64);
    bool need = true;
    if (BAND) need = (kt + 63 >= qw0 - 64) && (kt <= qw0 + WQ - 1 + 64);
    if (need) {
      f32x16 s[2][QT];
#pragma unroll
      for (int a = 0; a < 2; ++a)
#pragma unroll
        for (int b = 0; b < QT; ++b)
#pragma unroll
          for (int r = 0; r < 16; ++r) s[a][b][r] = 0.f;
#pragma unroll
      for (int ks = 0; ks < NKS; ++ks) {
        const bf16x8 k0 = *(const bf16x8*)(st + k_rd + ks * 32);
        const bf16x8 k1 = *(const bf16x8*)(st + k_rd + 32 * KROW + ks * 32);
#pragma unroll
        for (int qt = 0; qt < QT; ++qt) {
          s[0][qt] = MFMA(k0, qf[qt][ks], s[0][qt]);
          s[1][qt] = MFMA(k1, qf[qt][ks], s[1][qt]);
        }
      }
      bf16x8 pf[QT][4];
      const float cc = BAND ? 1.0f : scale_log2;
      const float th = BAND ? 8.0f : 8.0f / scale_log2;
#pragma unroll
      for (int qt = 0; qt < QT; ++qt) {
        if (BAND) {
#pragma unroll
          for (int a = 0; a < 2; ++a)
#pragma unroll
            for (int r = 0; r < 16; ++r) {
              const int kidx = kt + 32 * a + (r & 7) + 8 * h + 16 * (r >> 3);
              const int rel = kidx - (qw0 + qt * 32 + ql);
              const bool ok = (rel >= -64) && (rel <= 64);
              const int bi = ok ? rel + 64 : 0;
              s[a][qt][r] = ok ? fmaf(s[a][qt][r], scale_log2, bias_l[bi]) : -1e30f;
            }
        }
        float mx = s[0][qt][0];
#pragma unroll
        for (int r = 1; r < 16; ++r) mx = fmaxf(mx, s[0][qt][r]);
#pragma unroll
        for (int r = 0; r < 16; ++r) mx = fmaxf(mx, s[1][qt][r]);
        mx = fmaxf(mx, __shfl_xor(mx, 32));
        if (__builtin_amdgcn_ballot_w64(mx > m[qt] + th) != 0) {
          const float mn = fmaxf(m[qt], mx);
          const float alpha = __builtin_amdgcn_exp2f((m[qt] - mn) * cc);
          m[qt] = mn;
          l[qt] *= alpha;
#pragma unroll
          for (int r = 0; r < 16; ++r) { o[0][qt][r] *= alpha; o[1][qt][r] *= alpha; }
        }
        const float mc = -m[qt] * cc;
        float ls = 0.f;
#pragma unroll
        for (int a = 0; a < 2; ++a) {
#pragma unroll
          for (int r = 0; r < 16; ++r) { const float pv = __builtin_amdgcn_exp2f(fmaf(s[a][qt][r], cc, mc)); s[a][qt][r] = pv; ls += pv; }
#pragma unroll
          for (int s2 = 0; s2 < 2; ++s2) {
            u32x4 pk;
            pk.x = pk2(s[a][qt][8 * s2 + 0], s[a][qt][8 * s2 + 1]);
            pk.y = pk2(s[a][qt][8 * s2 + 2], s[a][qt][8 * s2 + 3]);
            pk.z = pk2(s[a][qt][8 * s2 + 4], s[a][qt][8 * s2 + 5]);
            pk.w = pk2(s[a][qt][8 * s2 + 6], s[a][qt][8 * s2 + 7]);
            pf[qt][a * 2 + s2] = __builtin_bit_cast(bf16x8, pk);
          }
        }
        l[qt] += ls;
      }
      if (more) lstore(lds + ((it + 1) & 1) * ST);
#pragma unroll
      for (int ks = 0; ks < 4; ++ks) {
        const bf16x8 v0 = *(const bf16x8*)(st + v_rd + ks * 32);
        const bf16x8 v1 = *(const bf16x8*)(st + v_rd + 32 * LROW + ks * 32);
#pragma unroll
        for (int qt = 0; qt < QT; ++qt) {
          o[0][qt] = MFMA(v0, pf[qt][ks], o[0][qt]);
          o[1][qt] = MFMA(v1, pf[qt][ks], o[1][qt]);
        }
      }
    } else {
      if (more) lstore(lds + ((it + 1) & 1) * ST);
    }
    __syncthreads();
  }
#pragma unroll
  for (int qt = 0; qt < QT; ++qt) {
    const float lt = l[qt] + __shfl_xor(l[qt], 32);
    const float inv = 1.0f / lt;
    const int qi = w * WQ + qt * 32 + ql;
    bf16_t* orow = out + (size_t)qi * out_rs;
#pragma unroll
    for (int dt = 0; dt < 2; ++dt)
#pragma unroll
      for (int g = 0; g < 4; ++g) {
        u32x2 p; p.x = pk2(o[dt][qt][4 * g] * inv, o[dt][qt][4 * g + 1] * inv); p.y = pk2(o[dt][qt][4 * g + 2] * inv, o[dt][qt][4 * g + 3] * inv);
        *(u32x2*)(orow + dt * 32 + 8 * g + 4 * h) = p;
      }
    if (BAND) { if (h == 0) lse[(size_t)qi * lse_rs] = m[qt] * LN2 + __logf(lt); }
  }
}

template <int DQK>
DI void attn_dense(const bf16_t* __restrict__ Q, const bf16_t* __restrict__ Kp, const bf16_t* __restrict__ Vt, int ldv,
                   int nkeys, float scale_log2, bf16_t* __restrict__ out, size_t out_rs, char* lds) {
  constexpr int KROW = DQK * 2 + 16;
  constexpr int KST = 64 * KROW, VST = 64 * LROW;
  constexpr int NKS = DQK / 16;
  constexpr int KV4 = DQK / 8;
  constexpr int NKL = (64 * KV4) / 256;
  const int tid = tid_(), lane = tid & 63, w = tid >> 6, h = lane >> 5, ql = lane & 31;
  char* const kbase = lds;
  char* const vbase = lds + 2 * KST;
  bf16x8 qf[NKS];
#pragma unroll
  for (int ks = 0; ks < NKS; ++ks) qf[ks] = *(const bf16x8*)(Q + (size_t)(w * 32 + ql) * DQK + ks * 16 + h * 8);
  f32x16 o[2];
#pragma unroll
  for (int a = 0; a < 2; ++a)
#pragma unroll
    for (int r = 0; r < 16; ++r) o[a][r] = 0.f;
  float m = -1e30f, l = 0.f;
  u32x4 rk[NKL], rv[2];
  const int vrow0 = tid >> 3, vch = tid & 7;
#define GLK_(kt) { const int kt_ = (kt); _Pragma("unroll") for (int i_ = 0; i_ < NKL; ++i_) { const int idx = tid + i_ * 256, kr = idx / KV4, kc = idx - kr * KV4; rk[i_] = *(const u32x4*)(Kp + (size_t)(kt_ + kr) * DQK + kc * 8); } }
#define GLV_(kt) { const int kt_ = (kt); _Pragma("unroll") for (int i_ = 0; i_ < 2; ++i_) rv[i_] = *(const u32x4*)(Vt + (size_t)(vrow0 + 32 * i_) * ldv + kt_ + vch * 8); }
#define LSK_(st) { char* st_ = (st); _Pragma("unroll") for (int i_ = 0; i_ < NKL; ++i_) { const int idx = tid + i_ * 256, kr = idx / KV4, kc = idx - kr * KV4; *(u32x4*)(st_ + kr * KROW + kc * 16) = rk[i_]; } }
#define LSV_(st) { char* st_ = (st); _Pragma("unroll") for (int i_ = 0; i_ < 2; ++i_) *(u32x4*)(st_ + (vrow0 + 32 * i_) * LROW + vch * 16) = rv[i_]; }
  const int pr = (ql & ~12) | ((ql & 4) << 1) | ((ql & 8) >> 1);
  const int k_rd = pr * KROW + h * 16;
  const int v_rd = ql * LROW + h * 16;
  GLK_(0); LSK_(kbase);
  GLK_(64); GLV_(0); LSK_(kbase + KST); LSV_(vbase);
  __syncthreads();
  f32x16 sc[2];
#pragma unroll
  for (int a = 0; a < 2; ++a)
#pragma unroll
    for (int r = 0; r < 16; ++r) sc[a][r] = 0.f;
#pragma unroll
  for (int ks = 0; ks < NKS; ++ks) {
    const bf16x8 k0 = *(const bf16x8*)(kbase + k_rd + ks * 32);
    const bf16x8 k1 = *(const bf16x8*)(kbase + k_rd + 32 * KROW + ks * 32);
    sc[0] = MFMA(k0, qf[ks], sc[0]);
    sc[1] = MFMA(k1, qf[ks], sc[1]);
  }
  __syncthreads();
  const int nt = nkeys >> 6;
  const float cc = scale_log2, th = 8.0f / scale_log2;
  for (int i = 0; i < nt; ++i) {
    const bool more1 = (i + 1 < nt), more2 = (i + 2 < nt);
    if (more2) GLK_((i + 2) * 64);
    if (more1) GLV_((i + 1) * 64);
    float mx = sc[0][0];
#pragma unroll
    for (int r = 1; r < 16; ++r) mx = fmaxf(mx, sc[0][r]);
#pragma unroll
    for (int r = 0; r < 16; ++r) mx = fmaxf(mx, sc[1][r]);
    mx = fmaxf(mx, __shfl_xor(mx, 32));
    if (__builtin_amdgcn_ballot_w64(mx > m + th) != 0) {
      const float mn = fmaxf(m, mx);
      const float alpha = __builtin_amdgcn_exp2f((m - mn) * cc);
      m = mn; l *= alpha;
#pragma unroll
      for (int r = 0; r < 16; ++r) { o[0][r] *= alpha; o[1][r] *= alpha; }
    }
    const char* kn = kbase + ((i + 1) & 1) * KST;
    f32x16 sn[2];
#pragma unroll
    for (int a = 0; a < 2; ++a)
#pragma unroll
      for (int r = 0; r < 16; ++r) sn[a][r] = 0.f;
#pragma unroll
    for (int ks = 0; ks < NKS; ++ks) {
      const bf16x8 k0 = *(const bf16x8*)(kn + k_rd + ks * 32);
      const bf16x8 k1 = *(const bf16x8*)(kn + k_rd + 32 * KROW + ks * 32);
      sn[0] = MFMA(k0, qf[ks], sn[0]);
      sn[1] = MFMA(k1, qf[ks], sn[1]);
    }
    const float mc = -m * cc;
    float ls = 0.f;
    bf16x8 pf[4];
#pragma unroll
    for (int a = 0; a < 2; ++a) {
#pragma unroll
      for (int r = 0; r < 16; ++r) { const float pv = __builtin_amdgcn_exp2f(fmaf(sc[a][r], cc, mc)); sc[a][r] = pv; ls += pv; }
#pragma unroll
      for (int s2 = 0; s2 < 2; ++s2) {
        u32x4 pk;
        pk.x = pk2(sc[a][8 * s2 + 0], sc[a][8 * s2 + 1]);
        pk.y = pk2(sc[a][8 * s2 + 2], sc[a][8 * s2 + 3]);
        pk.z = pk2(sc[a][8 * s2 + 4], sc[a][8 * s2 + 5]);
        pk.w = pk2(sc[a][8 * s2 + 6], sc[a][8 * s2 + 7]);
        pf[a * 2 + s2] = __builtin_bit_cast(bf16x8, pk);
      }
    }
    l += ls;
    const char* vs = vbase + (i & 1) * VST;
#pragma unroll
    for (int ks = 0; ks < 4; ++ks) {
      const bf16x8 v0 = *(const bf16x8*)(vs + v_rd + ks * 32);
      const bf16x8 v1 = *(const bf16x8*)(vs + v_rd + 32 * LROW + ks * 32);
      o[0] = MFMA(v0, pf[ks], o[0]);
      o[1] = MFMA(v1, pf[ks], o[1]);
    }
    if (more2) LSK_(kbase + (i & 1) * KST);
    if (more1) LSV_(vbase + ((i + 1) & 1) * VST);
    __syncthreads();
    sc[0] = sn[0]; sc[1] = sn[1];
  }
#undef GLK_
#undef GLV_
#undef LSK_
#undef LSV_
  const float lt = l + __shfl_xor(l, 32);
  const float inv = 1.0f / lt;
  bf16_t* orow = out + (size_t)(w * 32 + ql) * out_rs;
#pragma unroll
  for (int dt = 0; dt < 2; ++dt)
#pragma unroll
    for (int g = 0; g < 4; ++g) {
      u32x2 p; p.x = pk2(o[dt][4 * g] * inv, o[dt][4 * g + 1] * inv); p.y = pk2(o[dt][4 * g + 2] * inv, o[dt][4 * g + 3] * inv);
      *(u32x2*)(orow + dt * 32 + 8 * g + 4 * h) = p;
    }
}

constexpr bool ATT_PIPE = false;
constexpr int AQT = 2;
constexpr int QBLK = 128 * AQT;
DI void phase_attn(const Ctx& c) {
  const int S = c.S, nseq = TC / S, nqb = S / QBLK;
  const int n_mla = nseq * 8 * nqb, n_gqa = n_mla, n_dil = nseq * 12 * nqb;
  const float* bias = (const float*)(c.ws + OFF_BIAS);
  for (int item = blockIdx.x; item < n_mla + n_gqa + n_dil; item += gridDim.x) {
    if (item < n_mla) {
      const int hh = item & 7, rest = item >> 3, seq = rest / nqb, qb = rest - seq * nqb;
      const size_t hs = (size_t)(seq * 8 + hh) * S;
      if (ATT_PIPE) attn_dense<96>(wsb(c, OFF_QA) + (hs + qb * QBLK) * 96, wsb(c, OFF_KA) + hs * 96, wsb(c, OFF_VTA) + (size_t)(seq * 8 + hh) * 64 * (S + 64), S + 64,
                     S, 0.10206207261596577f * LOG2E, wsb(c, OFF_OA) + ((size_t)seq * S + qb * QBLK) * LDO + hh * 64, LDO, c.lds);
      else attn_item<96, false, AQT>(wsb(c, OFF_QA) + (hs + qb * QBLK) * 96, wsb(c, OFF_KA) + hs * 96, wsb(c, OFF_VTA) + (size_t)(seq * 8 + hh) * 64 * (S + 64), S + 64,
                     0, S, 0, nullptr, 0.10206207261596577f * LOG2E, wsb(c, OFF_OA) + ((size_t)seq * S + qb * QBLK) * LDO + hh * 64, LDO, nullptr, 0, c.lds);
    } else if (item < n_mla + n_gqa) {
      const int i2 = item - n_mla;
      const int hq = i2 & 7, rest = i2 >> 3, seq = rest / nqb, qb = rest - seq * nqb;
      const size_t hs = (size_t)(seq * 8 + hq) * S, ks = (size_t)(seq * 2 + (hq >> 2)) * S;
      if (ATT_PIPE) attn_dense<64>(wsb(c, OFF_QC) + (hs + qb * QBLK) * 64, wsb(c, OFF_KC) + ks * 64, wsb(c, OFF_VTC) + (size_t)(seq * 2 + (hq >> 2)) * 64 * (S + 64), S + 64,
                     S, 0.125f * LOG2E, wsb(c, OFF_OC) + ((size_t)seq * S + qb * QBLK) * LDO + hq * 64, LDO, c.lds);
      else attn_item<64, false, AQT>(wsb(c, OFF_QC) + (hs + qb * QBLK) * 64, wsb(c, OFF_KC) + ks * 64, wsb(c, OFF_VTC) + (size_t)(seq * 2 + (hq >> 2)) * 64 * (S + 64), S + 64,
                     0, S, 0, nullptr, 0.125f * LOG2E, wsb(c, OFF_OC) + ((size_t)seq * S + qb * QBLK) * LDO + hq * 64, LDO, nullptr, 0, c.lds);
    } else {
      const int i2 = item - n_mla - n_gqa;
      const int hb = i2 % 12, rest = i2 / 12, seq = rest / nqb, blk = rest - seq * nqb;
      const int dsh = 2 * (hb >> 2), L = S >> dsh, dil = 1 << dsh;
      const int srow0 = blk * QBLK, rr = srow0 / L, l0 = srow0 - rr * L;
      const size_t hs = (size_t)(seq * 12 + hb) * S;
      int kb = l0 - 64; if (kb < 0) kb = 0;
      int ke = l0 + QBLK + 64; if (ke > L) ke = L;
      const size_t tok0 = (size_t)seq * S + (size_t)l0 * dil + rr;
      attn_item<64, true, AQT>(wsb(c, OFF_QB) + (hs + srow0) * 64, wsb(c, OFF_KB) + (hs + (size_t)rr * L) * 64, wsb(c, OFF_VTB) + (size_t)(seq * 12 + hb) * 64 * (S + 64) + (size_t)rr * L, S + 64,
                          kb, ke, l0, bias + hb * 132, 0.125f * LOG2E,
                          wsb(c, OFF_OBG) + tok0 * 768 + hb * 64, (size_t)dil * 768, (float*)(c.ws + OFF_LSE) + tok0 * 12 + hb, dil * 12, c.lds);
    }
    __syncthreads();
  }
}

DI void phase_combine(const Ctx& c) {
  const bf16_t* obg = wsb(c, OFF_OBG);
  const float* lse = (const float*)(c.ws + OFF_LSE);
  bf16_t* ob = wsb(c, OFF_OB);
  const int total = TC * 4 * 8;
  for (int idx = blockIdx.x * NTHREADS + tid_(); idx < total; idx += gridDim.x * NTHREADS) {
    const int d8 = idx & 7, j = (idx >> 3) & 3, tl = idx >> 5;
    const float l0 = lse[tl * 12 + j], l1 = lse[tl * 12 + 4 + j], l2 = lse[tl * 12 + 8 + j];
    const float mx = fmaxf(l0, fmaxf(l1, l2));
    float w0 = __expf(l0 - mx), w1 = __expf(l1 - mx), w2 = __expf(l2 - mx);
    const float inv = 1.0f / (w0 + w1 + w2);
    w0 *= inv; w1 *= inv; w2 *= inv;
    const u32x4 a = *(const u32x4*)(obg + (size_t)tl * 768 + j * 64 + d8 * 8);
    const u32x4 b = *(const u32x4*)(obg + (size_t)tl * 768 + (4 + j) * 64 + d8 * 8);
    const u32x4 d = *(const u32x4*)(obg + (size_t)tl * 768 + (8 + j) * 64 + d8 * 8);
    u32x4 r;
#pragma unroll
    for (int e = 0; e < 4; ++e) {
      const float lo = w0 * __uint_as_float(a[e] << 16) + w1 * __uint_as_float(b[e] << 16) + w2 * __uint_as_float(d[e] << 16);
      const float hi = w0 * __uint_as_float(a[e] & 0xffff0000u) + w1 * __uint_as_float(b[e] & 0xffff0000u) + w2 * __uint_as_float(d[e] & 0xffff0000u);
      r[e] = pk2(lo, hi);
    }
    *(u32x4*)(ob + (size_t)tl * LDOB + j * 64 + d8 * 8) = r;
  }
}

DI void phase_merge(const Ctx& c) {
  const bf16_t* xb = wsb(c, OFF_XB);
  const float* ss = ss_site(c, c.layer, 1);
  const float* bgate = inl(c, 21, 3072);
  bf16_t* mrg = wsb(c, OFF_MRG);
  float* cl = (float*)c.lds; float* rr = (float*)(c.lds + OFF_RR);
  const int xcd_ = blockIdx.x & 7, slot_ = blockIdx.x >> 3, nslot_ = gridDim.x >> 3;
  for (int j_ = slot_; j_ < 16 * 8; j_ += nslot_) {
    const int mt = xcd_ * 16 + (j_ & 15), nt = j_ >> 4;
    __syncthreads();
    { const int t0 = tid_(); if (t0 < 128) rr[t0] = rsqrtf(ss[mt * 128 + t0] * (1.0f / DM) + EPS); }
    f32x16 macc[2][2]; zero_acc<2>(macc);
#pragma unroll 1
    for (int k = 0; k < 3; ++k) {
      unsigned gp[2][2][8];
      {
        f32x16 gacc[2][2]; zero_acc<2>(gacc);
        gemm_mainloop_glds<2>(xb + (size_t)mt * 128 * LDX, LDX, wgt(c, W_GATE) + (size_t)(k * 1024 + nt * 128) * LDX, LDX, DM, gacc, c.lds);
        const int tid = tid_(), lane = tid & 63, w = tid >> 6, wm = w >> 1, wn = w & 1, h = lane >> 5, cc = lane & 31;
#pragma unroll
        for (int j = 0; j < 2; ++j) {
          const float bv = bgate[k * 1024 + nt * 128 + wn * 64 + j * 32 + cc];
#pragma unroll
          for (int i = 0; i < 2; ++i)
#pragma unroll
            for (int r2 = 0; r2 < 8; ++r2) {
              const int ra = 2 * r2, rb = 2 * r2 + 1;
              const float r_a = rr[wm * 64 + i * 32 + (ra & 3) + 8 * (ra >> 2) + 4 * h];
              const float r_b = rr[wm * 64 + i * 32 + (rb & 3) + 8 * (rb >> 2) + 4 * h];
              gp[i][j][r2] = pk2(sigmoidf_(gacc[i][j][ra] * r_a + bv), sigmoidf_(gacc[i][j][rb] * r_b + bv));
            }
        }
      }
      {
        f32x16 acc[2][2]; zero_acc<2>(acc);
        const int Kk = (k == 1) ? 256 : 512;
        const bf16_t* Ao = wsb(c, k == 0 ? OFF_OA : (k == 1 ? OFF_OB : OFF_OC));
        const bf16_t* Wo = wgt(c, k == 0 ? W_OA : (k == 1 ? W_OB : W_OC));
        gemm_mainloop_glds<2>(Ao + (size_t)mt * 128 * (Kk + PADK), Kk + PADK, Wo + (size_t)nt * 128 * (Kk + PADK), Kk + PADK, Kk, acc, c.lds);
#pragma unroll
        for (int i = 0; i < 2; ++i)
#pragma unroll
          for (int j = 0; j < 2; ++j)
#pragma unroll
            for (int r2 = 0; r2 < 8; ++r2) {
              const unsigned g2 = gp[i][j][r2];
              macc[i][j][2 * r2] += __uint_as_float(g2 << 16) * acc[i][j][2 * r2];
              macc[i][j][2 * r2 + 1] += __uint_as_float(g2 & 0xffff0000u) * acc[i][j][2 * r2 + 1];
            }
      }
    }
    acc_to_lds<2>(macc, cl);
    __syncthreads();
    const int tid = tid_();
    const int c4 = (tid & 31) * 4, r0 = tid >> 5;
#pragma unroll 4
    for (int it = 0; it < 16; ++it) {
      const int row = r0 + 8 * it;
      const f32x4 v = *(const f32x4*)(cl + row * CLD + c4);
      u32x2 p; p.x = pk2(v[0], v[1]); p.y = pk2(v[2], v[3]);
      *(u32x2*)(mrg + (size_t)(mt * 128 + row) * LDX + nt * 128 + c4) = p;
    }
    __syncthreads();
  }
}

DI void phase_ple(const Ctx& c) {
  const bf16_t* xb = wsb(c, OFF_XB);
  const float* ss = ss_site(c, c.layer, 3);
  float* ssn = ss_site(c, c.layer + 1, 0);
  const bf16_t* peb = wsb(c, OFF_PEB) + (size_t)c.layer * TC * LDPE;
  float* cl = (float*)c.lds; float* rr = (float*)(c.lds + OFF_RR);
  const int tid = tid_(), lane = tid & 63, w = tid >> 6, wm = w >> 1, h = lane >> 5;
  const int xcd_ = blockIdx.x & 7, slot_ = blockIdx.x >> 3, nslot_ = gridDim.x >> 3;
  for (int j_ = slot_; j_ < 16 * 8; j_ += nslot_) {
    const int mt = xcd_ * 16 + (j_ & 15), nt = j_ >> 4;
    if (tid < 128) rr[tid] = rsqrtf(ss[mt * 128 + tid] * (1.0f / DM) + EPS);
    unsigned gp[2][2][8];
    {
      f32x16 g[2][2]; zero_acc<2>(g);
      gemm_mainloop_glds<2>(xb + (size_t)mt * 128 * LDX, LDX, wgt(c, W_PG) + (size_t)nt * 128 * LDX, LDX, DM, g, c.lds);
#pragma unroll
      for (int i = 0; i < 2; ++i)
#pragma unroll
        for (int j = 0; j < 2; ++j)
#pragma unroll
          for (int r2 = 0; r2 < 8; ++r2) {
            const int ra = 2 * r2, rb = 2 * r2 + 1;
            const float r_a = rr[wm * 64 + i * 32 + (ra & 3) + 8 * (ra >> 2) + 4 * h];
            const float r_b = rr[wm * 64 + i * 32 + (rb & 3) + 8 * (rb >> 2) + 4 * h];
            gp[i][j][r2] = pk2(sigmoidf_(g[i][j][ra] * r_a), sigmoidf_(g[i][j][rb] * r_b));
          }
    }
    f32x16 acc[2][2]; zero_acc<2>(acc);
    gemm_mainloop_glds<2>(peb + (size_t)mt * 128 * LDPE, LDPE, wgt(c, W_PLE) + (size_t)nt * 128 * LDPE, LDPE, 256, acc, c.lds);
#pragma unroll
    for (int i = 0; i < 2; ++i)
#pragma unroll
      for (int j = 0; j < 2; ++j)
#pragma unroll
        for (int r2 = 0; r2 < 8; ++r2) {
          const unsigned g2 = gp[i][j][r2];
          acc[i][j][2 * r2] *= __uint_as_float(g2 << 16);
          acc[i][j][2 * r2 + 1] *= __uint_as_float(g2 & 0xffff0000u);
        }
    acc_to_lds<2>(acc, cl);
    __syncthreads();
    resid_epilogue<2>(c.x, wsb(c, OFF_XB2), ssn, mt, nt, cl, 1.0f);
    __syncthreads();
  }
}

DI void phase_prologue(const Params& p, char* lds) {
  float* tl = (float*)lds;
  bf16_t* W = (bf16_t*)(p.ws + OFF_W);
  int rot = 0;
  for (int L = 0; L < 2; ++L) {
    bf16_t* wl = W + (size_t)L * W_LAYER;
    transpose_mat(p.in[5] + (size_t)L * 1024 * 5632, 5632, wl + W_FFN1_IN, 5632, 1024, p.in[4] + L * 1024, 1, tl, rot); rot += 88 * 16;
    transpose_mat(p.in[6] + (size_t)L * 2816 * 1024, 1024, wl + W_FFN1_OUT, 1024, 2816, nullptr, 0, tl, rot); rot += 16 * 44;
    transpose_mat(p.in[8] + (size_t)L * 1024 * 3488, 3488, wl + W_IN, 3584, 1024, p.in[7] + L * 1024, 2, tl, rot); rot += 56 * 16;
    transpose_mat(p.in[20] + (size_t)L * 1024 * 3072, 3072, wl + W_GATE, 3072, 1024, p.in[7] + L * 1024, 0, tl, rot); rot += 48 * 16;
    transpose_mat(p.in[11] + (size_t)L * 256 * 768, 768, wl + W_UQ, 768, 256, p.in[9] + L * 256, 3, tl, rot); rot += 12 * 4;
    transpose_mat(p.in[12] + (size_t)L * 128 * 1024, 1024, wl + W_UKV, 1024, 128, p.in[10] + L * 128, 4, tl, rot); rot += 16 * 2;
    transpose_mat(p.in[22] + (size_t)L * 512 * 1024, 1024, wl + W_OA, 1024, 512, nullptr, 0, tl, rot); rot += 16 * 8;
    transpose_mat(p.in[23] + (size_t)L * 256 * 1024, 1024, wl + W_OB, 1024, 256, nullptr, 0, tl, rot); rot += 16 * 4;
    transpose_mat(p.in[24] + (size_t)L * 512 * 1024, 1024, wl + W_OC, 1024, 512, nullptr, 0, tl, rot); rot += 16 * 8;
    transpose_mat(p.in[25] + (size_t)L * 1024 * 1024, 1024, wl + W_OUT, 1024, 1024, nullptr, 0, tl, rot); rot += 16 * 16;
    transpose_mat(p.in[27] + (size_t)L * 1024 * 5632, 5632, wl + W_FFN2_IN, 5632, 1024, p.in[26] + L * 1024, 1, tl, rot); rot += 88 * 16;
    transpose_mat(p.in[28] + (size_t)L * 2816 * 1024, 1024, wl + W_FFN2_OUT, 1024, 2816, nullptr, 0, tl, rot); rot += 16 * 44;
    transpose_mat(p.in[30] + (size_t)L * 1024 * 1024, 1024, wl + W_PG, 1024, 1024, p.in[29] + L * 1024, 0, tl, rot); rot += 16 * 16;
    transpose_mat(p.in[31] + (size_t)L * 256 * 1024, 1024, wl + W_PLE, 1024, 256, nullptr, 0, tl, rot); rot += 16 * 4;
  }
  const int gtid = blockIdx.x * NTHREADS + tid_(), gn = gridDim.x * NTHREADS;
  f32x2* rope = (f32x2*)(p.ws + OFF_ROPE);
  for (int idx = gtid; idx < 16384 * 16; idx += gn) {
    const int pos = idx >> 4, i = idx & 15;
    const float freq = (float)pow(10000.0, -(double)i / 16.0);
    const float ang = (float)pos * freq;
    f32x2 cs; cs.x = (float)cos((double)ang); cs.y = (float)sin((double)ang);
    rope[idx] = cs;
  }
  float* bias = (float*)(p.ws + OFF_BIAS);
  for (int idx = gtid; idx < 12 * 129; idx += gn) {
    const int hb = idx / 129, jj = idx - hb * 129;
    const int dil = 1 << (2 * (hb >> 2));
    const int rel = (jj - 64) * dil;
    const int n = rel < 0 ? -rel : rel;
    int b;
    if (n < 8) b = n;
    else { int lg = 8 + (int)(log((double)n / 8.0) / log(128.0) * 8.0); if (lg > 15) lg = 15; b = lg; }
    if (rel > 0) b += 16;
    bias[hb * 132 + jj] = p.in[17][b * 12 + hb] * LOG2E;
  }
}

DI void phase_init(const Ctx& c) {
  const int tid = tid_(), lane = tid & 63;
  const int gw = blockIdx.x * 4 + (tid >> 6), nw = gridDim.x * 4;
  bf16_t* xb = wsb(c, OFF_XB);
  float* ss0 = ss_site(c, 0, 0);
  for (int row = gw; row < TC; row += nw) {
    float s = 0.f;
#pragma unroll
    for (int i = 0; i < 4; ++i) {
      const size_t gi = (size_t)row * DM + i * 256 + lane * 4;
      const f32x4 v = *(const f32x4*)(c.xin + gi);
      *(f32x4*)(c.x + gi) = v;
      u32x2 p; p.x = pk2(v[0], v[1]); p.y = pk2(v[2], v[3]);
      *(u32x2*)(xb + (size_t)row * LDX + i * 256 + lane * 4) = p;
      s += v[0] * v[0] + v[1] * v[1] + v[2] * v[2] + v[3] * v[3];
    }
#pragma unroll
    for (int o = 32; o >= 1; o >>= 1) s += __shfl_xor(s, o);
    if (lane == 0) ss0[row] = s;
  }
  const int gtid = blockIdx.x * NTHREADS + tid, gn = gridDim.x * NTHREADS;
  float* ssall = (float*)(c.ws + OFF_SS);
  for (int idx = gtid + TC; idx < 3 * 6 * TC; idx += gn) ssall[idx] = 0.f;
  bf16_t* peb = wsb(c, OFF_PEB);
  for (int idx = gtid; idx < 2 * TC * 64; idx += gn) {
    const int L = idx / (TC * 64), r = idx - L * (TC * 64);
    const f32x4 v = *(const f32x4*)(c.pe0 + (size_t)L * c.pe_ls + (size_t)r * 4);
    u32x2 p; p.x = pk2(v[0], v[1]); p.y = pk2(v[2], v[3]);
    *(u32x2*)(peb + ((size_t)L * TC + (r >> 6)) * LDPE + (r & 63) * 4) = p;
  }
}

#ifndef ONLY
#define ONLY -1
#endif
#define PH(n) (ONLY < 0 || ONLY == (n))
#if DUP == 200
#define GSYNC() do { xcd_barrier(xb); xcd_barrier(xb); } while (0)
#else
#define GSYNC() xcd_barrier(xb)
#endif
#define REP(n) for (int rep_ = 0; rep_ < ((DUP == (n) || (DUP == 100 && ((n) == 2 || (n) == 10))) ? 2 : 1); ++rep_)
__global__ void __launch_bounds__(NTHREADS, 2) mega_kernel(Params p) {
  extern __shared__ __attribute__((aligned(16))) char lds[];
  cg::grid_group grid = cg::this_grid();
  volatile LAS unsigned* xst = (volatile LAS unsigned*)(lds + OFF_RR + 512);
  if (threadIdx.x == 0) { xst[0] = 0u; xst[1] = 0u; }
  __syncthreads();
  const XcdBarrier xb = xcd_barrier_post((unsigned*)(p.ws + OFF_BAR), xst);
  REP(0) { if (PH(0)) phase_prologue(p, lds); grid.sync(); }
  for (int chunk = 0; chunk < 3; ++chunk) {
    Ctx c;
    c.p = &p; c.chunk = chunk; c.layer = 0; c.ws = p.ws; c.lds = lds;
    c.S = chunk == 0 ? 4096 : 16384; c.sshift = chunk == 0 ? 12 : 14;
    c.x = p.out + (size_t)chunk * TC * DM;
    c.xin = chunk == 0 ? p.in[0] : p.in[1] + (size_t)(chunk - 1) * TC * DM;
    c.pe0 = chunk == 0 ? p.in[2] : p.in[3] + (size_t)(chunk - 1) * TC * 256;
    c.pe_ls = chunk == 0 ? (size_t)TC * 256 : (size_t)2 * TC * 256;
    REP(1) { if (PH(1)) phase_init(c); GSYNC(); }
#pragma unroll 1
    for (int layer = 0; layer < 2; ++layer) {
      c.layer = layer;
      REP(2) { if (PH(2)) phase_ffn_in(c, wsb(c, layer == 0 ? OFF_XB : OFF_XB2), W_FFN1_IN, 0); GSYNC(); }
#if DUP == 300
      { phase_ffn_probe(c, wsb(c, layer == 0 ? OFF_XB : OFF_XB2), W_FFN1_IN, 0); GSYNC(); }
#endif
      REP(3) { if (PH(3)) phase_resid_gemm(c, wsb(c, OFF_ACT), DFF, W_FFN1_OUT, 0.5f, ss_site(c, layer, 1)); GSYNC(); }
      REP(4) { if (PH(4)) phase_proj(c); GSYNC(); }
      REP(5) { if (PH(5)) phase_mlaup(c); GSYNC(); }
      REP(6) { if (PH(6)) phase_attn(c); GSYNC(); }
      REP(7) { if (PH(7)) phase_combine(c); GSYNC(); }
      REP(8) { if (PH(8)) phase_merge(c); GSYNC(); }
      REP(9) { if (PH(9)) phase_resid_gemm(c, wsb(c, OFF_MRG), DM, W_OUT, 1.0f, ss_site(c, layer, 2)); GSYNC(); }
      REP(10) { if (PH(10)) phase_ffn_in(c, wsb(c, OFF_XB), W_FFN2_IN, 2); GSYNC(); }
      REP(11) { if (PH(11)) phase_resid_gemm(c, wsb(c, OFF_ACT), DFF, W_FFN2_OUT, 0.5f, ss_site(c, layer, 3)); GSYNC(); }
      REP(12) { if (PH(12)) phase_ple(c); GSYNC(); }
    }
  }
}

extern "C" void kernel_launch(void* const* d_in, const int* in_sizes, int n_in, void* d_out, int out_size, void* d_ws, size_t ws_size, hipStream_t stream) {
  static int grid_blocks = 0;
  if (!grid_blocks) {
    int dev = 0, cus = 0, per_cu = 0;
    hipGetDevice(&dev);
    hipDeviceGetAttribute(&cus, hipDeviceAttributeMultiprocessorCount, dev);
    hipFuncSetAttribute((const void*)mega_kernel, hipFuncAttributeMaxDynamicSharedMemorySize, LDS_BYTES);
    hipOccupancyMaxActiveBlocksPerMultiprocessor(&per_cu, mega_kernel, NTHREADS, LDS_BYTES);
    if (per_cu > 2) per_cu = 2;
    if (per_cu < 1) per_cu = 1;
    grid_blocks = cus * per_cu;
  }
  Params p{};
  for (int i = 0; i < 32; ++i) p.in[i] = (const float*)d_in[i];
  p.out = (float*)d_out;
  p.ws = (char*)d_ws;
  hipMemsetAsync((char*)d_ws + OFF_BAR, 0, 16384, stream);
  void* args[] = {&p};
  hipError_t e = hipLaunchCooperativeKernel((const void*)mega_kernel, dim3(grid_blocks), dim3(NTHREADS), args, LDS_BYTES, stream);
  if (e != hipSuccess) fprintf(stderr, "cooperative launch failed: %s (grid %d)\n", hipGetErrorString(e), grid_blocks);
}
```

```cpp
#ifndef DUP
#define DUP -1
#endif
#include <hip/hip_runtime.h>
#include <hip/hip_cooperative_groups.h>
#include <stdint.h>
#include <cstdio>
namespace cg = cooperative_groups;

typedef unsigned short bf16_t;
typedef short bf16x8 __attribute__((ext_vector_type(8)));
typedef float f32x16 __attribute__((ext_vector_type(16)));
typedef float f32x4 __attribute__((ext_vector_type(4)));
typedef float f32x2 __attribute__((ext_vector_type(2)));
typedef unsigned u32x4 __attribute__((ext_vector_type(4)));
typedef unsigned u32x2 __attribute__((ext_vector_type(2)));
typedef __bf16 bf16x2_t __attribute__((ext_vector_type(2)));
#define DI __device__ __forceinline__
#define MFMA(a, b, c) __builtin_amdgcn_mfma_f32_32x32x16_bf16((a), (b), (c), 0, 0, 0)

constexpr int TC = 16384;
constexpr int DM = 1024;
constexpr int DFF = 2816;
constexpr float EPS = 1e-6f;
constexpr float LOG2E = 1.4426950408889634f;
constexpr float LN2 = 0.6931471805599453f;
constexpr int NTHREADS = 256;
constexpr int PADK = 64;
constexpr int LDX = DM + PADK;
constexpr int LDACT = DFF + PADK;
constexpr int LDCQ = 256 + PADK, LDCKV = 128 + PADK, LDO = 512 + PADK, LDOB = 256 + PADK, LDPE = 256 + PADK;

constexpr size_t W_FFN1_IN = 0;
constexpr size_t W_FFN1_OUT = W_FFN1_IN + (size_t)5632 * LDX;
constexpr size_t W_IN = W_FFN1_OUT + (size_t)1024 * LDACT;
constexpr size_t W_GATE = W_IN + (size_t)3584 * LDX;
constexpr size_t W_UQ = W_GATE + (size_t)3072 * LDX;
constexpr size_t W_UKV = W_UQ + (size_t)768 * LDCQ;
constexpr size_t W_OA = W_UKV + (size_t)1024 * LDCKV;
constexpr size_t W_OB = W_OA + (size_t)1024 * LDO;
constexpr size_t W_OC = W_OB + (size_t)1024 * LDOB;
constexpr size_t W_OUT = W_OC + (size_t)1024 * LDO;
constexpr size_t W_FFN2_IN = W_OUT + (size_t)1024 * LDX;
constexpr size_t W_FFN2_OUT = W_FFN2_IN + (size_t)5632 * LDX;
constexpr size_t W_PG = W_FFN2_OUT + (size_t)1024 * LDACT;
constexpr size_t W_PLE = W_PG + (size_t)1024 * LDX;
constexpr size_t W_LAYER = W_PLE + (size_t)1024 * LDPE;

constexpr size_t AL(size_t x) { return (x + 255) & ~(size_t)255; }
constexpr size_t OFF_W = 0;
constexpr size_t OFF_BAR = AL(OFF_W + 2 * W_LAYER * 2);
constexpr size_t OFF_ROPE = AL(OFF_BAR + 16384);
constexpr size_t OFF_BIAS = AL(OFF_ROPE + (size_t)16384 * 16 * 8);
constexpr size_t OFF_SS = AL(OFF_BIAS + 12 * 132 * 4);
constexpr size_t OFF_XB = AL(OFF_SS + (size_t)3 * 6 * TC * 4);
constexpr size_t OFF_XB2 = AL(OFF_XB + (size_t)TC * LDX * 2);
constexpr size_t OFF_PEB = AL(OFF_XB2 + (size_t)TC * LDX * 2);
constexpr size_t OFF_BIG = AL(OFF_PEB + (size_t)2 * TC * LDPE * 2);
constexpr size_t OFF_ACT = OFF_BIG;
constexpr size_t OFF_CQ = OFF_BIG;
constexpr size_t OFF_CKV = AL(OFF_CQ + (size_t)TC * LDCQ * 2);
constexpr size_t OFF_QA = AL(OFF_CKV + (size_t)TC * LDCKV * 2);
constexpr size_t OFF_KA = AL(OFF_QA + (size_t)TC * 768 * 2);
constexpr size_t OFF_VTA = AL(OFF_KA + (size_t)TC * 768 * 2);
constexpr size_t OFF_QB = AL(OFF_VTA + (size_t)(TC + 256) * 512 * 2);
constexpr size_t OFF_KB = AL(OFF_QB + (size_t)TC * 768 * 2);
constexpr size_t OFF_VTB = AL(OFF_KB + (size_t)TC * 768 * 2);
constexpr size_t OFF_QC = AL(OFF_VTB + (size_t)(TC + 256) * 768 * 2);
constexpr size_t OFF_KC = AL(OFF_QC + (size_t)TC * 512 * 2);
constexpr size_t OFF_VTC = AL(OFF_KC + (size_t)TC * 128 * 2);
constexpr size_t OFF_OA = AL(OFF_VTC + (size_t)(TC + 256) * 128 * 2);
constexpr size_t OFF_OBG = AL(OFF_OA + (size_t)TC * LDO * 2);
constexpr size_t OFF_LSE = AL(OFF_OBG + (size_t)TC * 768 * 2);
constexpr size_t OFF_OB = AL(OFF_LSE + (size_t)TC * 12 * 4);
constexpr size_t OFF_OC = AL(OFF_OB + (size_t)TC * LDOB * 2);
constexpr size_t OFF_MRG = AL(OFF_OC + (size_t)TC * LDO * 2);
constexpr size_t OFF_END = AL(OFF_MRG + (size_t)TC * LDX * 2);
static_assert(OFF_END < (size_t)508 * 1024 * 1024, "workspace too large");
static_assert(OFF_ACT + (size_t)TC * LDACT * 2 <= OFF_END, "act fits");

struct Params {
  const float* in[32];
  float* out;
  char* ws;
};

constexpr int LROW = 144;
constexpr int STAGE_OP = 128 * LROW;
constexpr int STAGE = 2 * STAGE_OP;
constexpr int CLD = 132;
constexpr int OFF_RR = 2 * STAGE;
constexpr int LDS_BYTES = 2 * STAGE + 1024;
static_assert(128 * CLD * 4 <= OFF_RR, "lds");

DI int tid_() { int t = threadIdx.x; asm volatile("" : "+v"(t)); return t; }
DI unsigned pk2(float a, float b) { f32x2 v = {a, b}; bf16x2_t r = __builtin_convertvector(v, bf16x2_t); return __builtin_bit_cast(unsigned, r); }
DI bf16_t f2bf(float a) { return (bf16_t)(pk2(a, 0.f) & 0xffffu); }
DI float bf2f(bf16_t v) { return __uint_as_float(((unsigned)v) << 16); }
DI float sigmoidf_(float x) { return 1.0f / (1.0f + __expf(-x)); }

DI int map_col(int map, int n) {
  switch (map) {
    case 0: return n;
    case 1: { int t = n >> 7, w = n & 127; return w < 64 ? t * 64 + w : DFF + t * 64 + (w - 64); }
    case 2: { int slot = n >> 6, d = n & 63; if (slot < 6) return n; if (slot == 6) return d < 32 ? 384 + d : -1; if (slot < 55) return 416 + (n - 448); return -1; }
    case 3: { if (n < 512) return (n >> 6) * 96 + (n & 63); int i = n - 512; return (i >> 5) * 96 + 64 + (i & 31); }
    default: { if (n < 512) return (n >> 6) * 128 + (n & 63); int i = n - 512; return (i >> 6) * 128 + 64 + (i & 63); }
  }
}

DI void transpose_mat(const float* __restrict__ src, int ld_src, bf16_t* __restrict__ dst, int N, int K, const float* __restrict__ gain, int map, float* lds, int rot) {
  const int ntk = K >> 6, ntn = N >> 6, nt = ntk * ntn;
  const int tid = tid_(), c = tid & 63, rq = tid >> 6;
  int b0 = (int)blockIdx.x - (rot % (int)gridDim.x); if (b0 < 0) b0 += gridDim.x;
  for (int t = b0; t < nt; t += gridDim.x) {
    const int tn = t / ntk, tk = t - tn * ntk;
    const int n0 = tn << 6, k0 = tk << 6;
    const int sc = map_col(map, n0 + c);
#pragma unroll 4
    for (int r = 0; r < 16; ++r) {
      const int kk = r * 4 + rq;
      float v = 0.f;
      if (sc >= 0) { v = src[(size_t)(k0 + kk) * ld_src + sc]; if (gain) v *= gain[k0 + kk]; }
      lds[c * 65 + kk] = v;
    }
    __syncthreads();
#pragma unroll 4
    for (int r = 0; r < 16; ++r) {
      const int nn = r * 4 + rq;
      dst[(size_t)(n0 + nn) * (K + PADK) + k0 + c] = f2bf(lds[nn * 65 + c]);
    }
    __syncthreads();
  }
}

template <int NJ> DI void zero_acc(f32x16 (&acc)[2][NJ]) {
#pragma unroll
  for (int i = 0; i < 2; ++i)
#pragma unroll
    for (int j = 0; j < NJ; ++j)
#pragma unroll
      for (int r = 0; r < 16; ++r) acc[i][j][r] = 0.f;
}

constexpr int GSTG_B = 128 * 128;
constexpr int GSTG = 2 * GSTG_B;
template <int NJ> DI void gemm_mainloop_glds(const bf16_t* __restrict__ A, int lda, const bf16_t* __restrict__ Bt, int ldb, int K, f32x16 (&acc)[2][NJ], char* lds) {
  const int tid = tid_(), lane = tid & 63, w = __builtin_amdgcn_readfirstlane(tid >> 6), wm = w >> 1, wn = w & 1;
  const int ql = lane & 31, h = lane >> 5;
  const int sw_s = (4 * (w & 1) + (lane >> 4)) & 7;
  const int csrc = (lane & 7) ^ sw_s;
  const char* ap = (const char*)A;
  const char* bp = (const char*)Bt;
  const unsigned aoff = (unsigned)((8 * w + (lane >> 3)) * lda + csrc * 8) * 2u, boff = (unsigned)((8 * w + (lane >> 3)) * ldb + csrc * 8) * 2u;
  const unsigned astep = (unsigned)(32 * lda) * 2u, bstep = (unsigned)(32 * ldb) * 2u;
  constexpr int NB = 2 * NJ;
  const int sw_r = (ql >> 1) & 7;
  int a_rd[4], b_rd[4];
#pragma unroll
  for (int ks = 0; ks < 4; ++ks) { const int pos = ((2 * ks + h) ^ sw_r) * 16; a_rd[ks] = (wm * 64 + ql) * 128 + pos; b_rd[ks] = GSTG_B + (wn * 32 * NJ + ql) * 128 + pos; }
#define GSTAGE_(ST) { char* sb_ = lds + (ST) * GSTG + w * 1024; \
    _Pragma("unroll") for (int i_ = 0; i_ < 4; ++i_) __builtin_amdgcn_global_load_lds((const unsigned*)(ap + (aoff + i_ * astep)), (unsigned*)(sb_ + i_ * 4096), 16, 0, 0); \
    _Pragma("unroll") for (int i_ = 0; i_ < NB; ++i_) __builtin_amdgcn_global_load_lds((const unsigned*)(bp + (boff + i_ * bstep)), (unsigned*)(sb_ + GSTG_B + i_ * 4096), 16, 0, 0); \
    ap += 128; bp += 128; }
  GSTAGE_(0);
  asm volatile("s_waitcnt vmcnt(0)" ::: "memory");
  __syncthreads();
  const int nk = K >> 6;
  for (int kt = 0; kt < nk; ++kt) {
    const int cur = kt & 1;
    if (kt + 1 < nk) GSTAGE_(cur ^ 1);
    const char* st_ = lds + cur * GSTG;
#pragma unroll
    for (int ks = 0; ks < 4; ++ks) {
      const bf16x8 a0 = *(const bf16x8*)(st_ + a_rd[ks]);
      const bf16x8 a1 = *(const bf16x8*)(st_ + a_rd[ks] + 4096);
#pragma unroll
      for (int j = 0; j < NJ; ++j) {
        const bf16x8 b = *(const bf16x8*)(st_ + b_rd[ks] + j * 4096);
        acc[0][j] = MFMA(a0, b, acc[0][j]); acc[1][j] = MFMA(a1, b, acc[1][j]);
      }
    }
    asm volatile("s_waitcnt vmcnt(0)" ::: "memory");
    __syncthreads();
  }
#undef GSTAGE_
}

template <int NJ> DI void gemm_mainloop_reg(const bf16_t* __restrict__ A, int lda, const bf16_t* __restrict__ Bt, int ldb, int K, f32x16 (&acc)[2][NJ], char* lds) {
  const int tid = tid_(), lane = tid & 63, w = tid >> 6, wm = w >> 1, wn = w & 1;
  const int lr = tid >> 3, lc = tid & 7;
  const char* ap = (const char*)A;
  const char* bp = (const char*)Bt;
  const unsigned aoff = (unsigned)(lr * lda + lc * 8) * 2u, boff = (unsigned)(lr * ldb + lc * 8) * 2u;
  const unsigned astep = (unsigned)(32 * lda) * 2u, bstep = (unsigned)(32 * ldb) * 2u;
  constexpr int NB = 2 * NJ;
  u32x4 ra0[4], rb0[NB], ra1[4], rb1[NB];
  const int wofs = lr * LROW + lc * 16;
  const int a_rd = (wm * 64 + (lane & 31)) * LROW + (lane >> 5) * 16;
  const int b_rd = STAGE_OP + (wn * 32 * NJ + (lane & 31)) * LROW + (lane >> 5) * 16;
#define GL1_(RA, RB, i) { RA[i] = *(const u32x4*)(ap + (aoff + (i) * astep)); if ((i) < NB) RB[(i) < NB ? (i) : 0] = *(const u32x4*)(bp + (boff + (i) * bstep)); }
#define LS1_(RA, RB, ST, i) { char* sn_ = lds + (ST) * STAGE; *(u32x4*)(sn_ + wofs + (i) * 32 * LROW) = RA[i]; \
                              if ((i) < NB) *(u32x4*)(sn_ + STAGE_OP + wofs + (i) * 32 * LROW) = RB[(i) < NB ? (i) : 0]; }
#define RF_(ks) { fa0 = *(const bf16x8*)(st_ + a_rd + (ks) * 32); fa1 = *(const bf16x8*)(st_ + a_rd + 32 * LROW + (ks) * 32); \
      _Pragma("unroll") for (int j = 0; j < NJ; ++j) fb[j] = *(const bf16x8*)(st_ + b_rd + j * 32 * LROW + (ks) * 32); }
#define STEP_(ST, DOL, RAL, RBL, DOS, RAS, RBS) { const char* st_ = lds + (ST) * STAGE; \
    bf16x8 fa0, fa1, fb[NJ]; RF_(0); \
    _Pragma("unroll") for (int ks = 0; ks < 4; ++ks) { \
      if (DOL) GL1_(RAL, RBL, ks); \
      const bf16x8 ca0 = fa0, ca1 = fa1; bf16x8 cb[NJ]; \
      _Pragma("unroll") for (int j = 0; j < NJ; ++j) cb[j] = fb[j]; \
      if (ks < 3) RF_(ks + 1); \
      _Pragma("unroll") for (int j = 0; j < NJ; ++j) { acc[0][j] = MFMA(ca0, cb[j], acc[0][j]); acc[1][j] = MFMA(ca1, cb[j], acc[1][j]); } \
      if (DOS) LS1_(RAS, RBS, 1 - (ST), ks); \
      __builtin_amdgcn_sched_barrier(0); } \
    if (DOL) { ap += 128; bp += 128; } }
#pragma unroll
  for (int i = 0; i < 4; ++i) GL1_(ra0, rb0, i);
  ap += 128; bp += 128;
#pragma unroll
  for (int i = 0; i < 4; ++i) GL1_(ra1, rb1, i);
  ap += 128; bp += 128;
#pragma unroll
  for (int i = 0; i < 4; ++i) LS1_(ra0, rb0, 0, i);
  __syncthreads();
  const int nk = K >> 6;
  for (int kt = 0; kt < nk; kt += 2) {
    const bool l0 = (kt + 2 < nk), l1 = (kt + 3 < nk);
    STEP_(0, l0, ra0, rb0, true, ra1, rb1);
    __syncthreads();
    STEP_(1, l1, ra1, rb1, l0, ra0, rb0);
    __syncthreads();
  }
#undef GL1_
#undef LS1_
#undef STEP_
#undef RF_
}

template <int NJ> DI void acc_to_lds(const f32x16 (&acc)[2][NJ], float* cl) {
  const int tid = tid_(), lane = tid & 63, w = tid >> 6, wm = w >> 1, wn = w & 1, h = lane >> 5, c = lane & 31;
#pragma unroll
  for (int i = 0; i < 2; ++i)
#pragma unroll
    for (int j = 0; j < NJ; ++j)
#pragma unroll
      for (int r = 0; r < 16; ++r) {
        const int row = wm * 64 + i * 32 + (r & 3) + 8 * (r >> 2) + 4 * h;
        cl[row * CLD + wn * 32 * NJ + j * 32 + c] = acc[i][j][r];
      }
}

template <int NJ> DI void resid_epilogue(float* __restrict__ x, bf16_t* __restrict__ xb, float* __restrict__ ssn, int mt, int nt, const float* cl, float scale) {
  constexpr int LPR = 16 * NJ, RPP = 256 / LPR, NP = 128 / RPP;
  const int tid = tid_(), c4 = (tid & (LPR - 1)) * 4, r0 = tid / LPR;
#pragma unroll 4
  for (int it = 0; it < NP; ++it) {
    const int row = r0 + RPP * it;
    const f32x4 c = *(const f32x4*)(cl + row * CLD + c4);
    const size_t gi = (size_t)(mt * 128 + row) * DM + nt * (64 * NJ) + c4;
    f32x4 xv = *(const f32x4*)(x + gi);
    xv = xv + scale * c;
    *(f32x4*)(x + gi) = xv;
    u32x2 p; p.x = pk2(xv[0], xv[1]); p.y = pk2(xv[2], xv[3]);
    *(u32x2*)(xb + (size_t)(mt * 128 + row) * LDX + nt * (64 * NJ) + c4) = p;
    float s_ = xv[0] * xv[0] + xv[1] * xv[1] + xv[2] * xv[2] + xv[3] * xv[3];
    if (NJ == 2) s_ += __shfl_xor(s_, 16);
    s_ += __shfl_xor(s_, 8); s_ += __shfl_xor(s_, 4); s_ += __shfl_xor(s_, 2); s_ += __shfl_xor(s_, 1);
    if ((tid & (LPR - 1)) == 0) atomicAdd(ssn + mt * 128 + row, s_);
  }
}

#define XB_TMO      128
#define XB_XCNT(j)  (256  + 64 * (j))
#define XB_XSUB(j)  (1280 + 64 * (j))
#define XB_XGEN(j)  (2304 + 64 * (j))
#define XB_TOP      3328
#define XB_TOPGEN   3392
#define XCD_BAR_WORDS 3456
#define XB_SPIN_CAP (1u << 22)
#define LAS __attribute__((address_space(3)))
DI unsigned xb_ld(unsigned* p)              { return __hip_atomic_load(p, __ATOMIC_RELAXED, __HIP_MEMORY_SCOPE_AGENT); }
DI unsigned xb_add(unsigned* p, unsigned v) { return __hip_atomic_fetch_add(p, v, __ATOMIC_RELAXED, __HIP_MEMORY_SCOPE_AGENT); }
DI unsigned xb_xcc_id() { return (unsigned)__builtin_amdgcn_s_getreg((3 << 11) | 20) & 0xFu; }
#define XB_SPIN(cond, bar) do { unsigned _sp = 0; while (cond) { __builtin_amdgcn_s_sleep(1); \
    if ((++_sp & 255u) == 0u) { if (xb_ld(&(bar)[XB_TMO])) break; if (_sp > XB_SPIN_CAP) { atomicAdd(&(bar)[XB_TMO], 1u); break; } } } } while (0)
struct XcdBarrier { unsigned* bar; unsigned x; volatile LAS unsigned* st; };
DI XcdBarrier xcd_barrier_post(unsigned* bar, volatile LAS unsigned* st) {
  XcdBarrier b; b.bar = bar; b.x = xb_xcc_id(); b.st = st;
  if (threadIdx.x == 0) (void)xb_add(&bar[XB_XCNT(b.x)], 1u);
  return b;
}
DI void xcd_barrier_complete(unsigned* bar, unsigned x, unsigned& nloc, unsigned& nx) {
  const unsigned G = gridDim.x * gridDim.y * gridDim.z;
  unsigned sum, cnt, mine, sp = 0u;
  for (;;) {
    sum = 0u; cnt = 0u; mine = 0u;
#pragma unroll
    for (unsigned j = 0; j < 16; ++j) { const unsigned c = xb_ld(&bar[XB_XCNT(j)]); sum += c; cnt += (c > 0u) ? 1u : 0u; mine = (j == x) ? c : mine; }
    if (sum == G) break;
    __builtin_amdgcn_s_sleep(1);
    if ((++sp & 255u) == 0u) { if (xb_ld(&bar[XB_TMO])) break; if (sp > XB_SPIN_CAP) { atomicAdd(&bar[XB_TMO], 1u); break; } }
  }
  nloc = mine > 0u ? mine : 1u; nx = cnt > 0u ? cnt : 1u;
}
DI void xcd_barrier(const XcdBarrier& b) {
  asm volatile("s_waitcnt vmcnt(0)" ::: "memory");
  __syncthreads();
  if (threadIdx.x == 0) {
    unsigned* bar = b.bar;
    __builtin_amdgcn_s_waitcnt(0);
    unsigned nloc = b.st[0], nx = b.st[1];
    if (nloc == 0u) { xcd_barrier_complete(bar, b.x, nloc, nx); b.st[0] = nloc; b.st[1] = nx; }
    const unsigned old = xb_add(&bar[XB_XSUB(b.x)], 1u);
    const unsigned gen = old / nloc;
    if (old + 1u == (gen + 1u) * nloc) {
      __builtin_amdgcn_fence(__ATOMIC_RELEASE, "agent");
      asm volatile("s_waitcnt vmcnt(0)" ::: "memory");
      const unsigned og = xb_add(&bar[XB_TOP], 1u);
      const unsigned tg = og / nx;
      if (og + 1u == (tg + 1u) * nx) xb_add(&bar[XB_TOPGEN], 1u);
      else XB_SPIN(xb_ld(&bar[XB_TOPGEN]) == tg, bar);
      __builtin_amdgcn_fence(__ATOMIC_ACQUIRE, "agent");
      xb_add(&bar[XB_XGEN(b.x)], 1u);
      asm volatile("s_waitcnt vmcnt(0)" ::: "memory");
    } else {
      XB_SPIN(xb_ld(&bar[XB_XGEN(b.x)]) == gen, bar);
      __builtin_amdgcn_fence(__ATOMIC_ACQUIRE, "agent");
      asm volatile("s_waitcnt vmcnt(0)" ::: "memory");
    }
  }
  __syncthreads();
}

constexpr int CTR_ATTN = 3520, CTR_FFN = 3584, CTR_PROJ = 3840;
DI int grab_next(unsigned* ctr, char* lds) {
  volatile int* nx = (volatile int*)(lds + OFF_RR + 528);
  if (tid_() == 0) *nx = (int)__hip_atomic_fetch_add(ctr, 1u, __ATOMIC_RELAXED, __HIP_MEMORY_SCOPE_AGENT);
  __syncthreads();
  const int v = __builtin_amdgcn_readfirstlane(*nx);
  __syncthreads();
  return v;
}

struct Ctx {
  const Params* p;
  int chunk, layer;
  int S, sshift;
  float* x;
  const float* xin;
  const float* pe0; size_t pe_ls;
  char* ws;
  char* lds;
};
DI bf16_t* wsb(const Ctx& c, size_t off) { return (bf16_t*)(c.ws + off); }
DI float* ss_site(const Ctx& c, int layer, int site) { return (float*)(c.ws + OFF_SS) + ((size_t)layer * 6 + site) * TC; }
DI const bf16_t* wgt(const Ctx& c, size_t off) { return (const bf16_t*)(c.ws + OFF_W) + (size_t)c.layer * W_LAYER + off; }
DI const float* inl(const Ctx& c, int idx, size_t per_layer) { return c.p->in[idx] + (size_t)c.layer * per_layer; }

DI void phase_ffn_in(const Ctx& c, const bf16_t* A, size_t woff, int site) {
  const bf16_t* Bt = wgt(c, woff);
  bf16_t* act = wsb(c, OFF_ACT);
  const float* ss = ss_site(c, c.layer, site);
  float* cl = (float*)c.lds; float* rr = (float*)(c.lds + OFF_RR);
  const int tid = tid_();
  const int xcd_ = blockIdx.x & 7;
  unsigned* ctr = (unsigned*)(c.ws + OFF_BAR) + CTR_FFN + ((c.chunk * 2 + c.layer) * 2 + (site == 2 ? 1 : 0)) * 8 + xcd_;
  for (;;) {
    const int j_ = grab_next(ctr, c.lds);
    if (j_ >= 16 * 44) break;
    const int mt = xcd_ * 16 + (j_ & 15), nt = j_ >> 4;
    f32x16 acc[2][2]; zero_acc<2>(acc);
    gemm_mainloop_reg<2>(A + (size_t)mt * 128 * LDX, LDX, Bt + (size_t)nt * 128 * LDX, LDX, DM, acc, c.lds);
    acc_to_lds<2>(acc, cl);
    if (tid < 128) rr[tid] = rsqrtf(ss[mt * 128 + tid] * (1.0f / DM) + EPS);
    __syncthreads();
    const int c4 = (tid & 15) * 4, r0 = tid >> 4;
#pragma unroll 2
    for (int it = 0; it < 8; ++it) {
      const int row = r0 + 16 * it;
      const float r = rr[row];
      const f32x4 a = *(const f32x4*)(cl + row * CLD + c4);
      const f32x4 b = *(const f32x4*)(cl + row * CLD + 64 + c4);
      float o[4];
#pragma unroll
      for (int e = 0; e < 4; ++e) { const float av = a[e] * r, bv = b[e] * r; o[e] = av * sigmoidf_(av) * bv; }
      u32x2 pq; pq.x = pk2(o[0], o[1]); pq.y = pk2(o[2], o[3]);
      *(u32x2*)(act + (size_t)(mt * 128 + row) * LDACT + nt * 64 + c4) = pq;
    }
    __syncthreads();
  }
}

#if DUP == 300
DI void phase_ffn_probe(const Ctx& c, const bf16_t* A, size_t woff, int site) {
  const bf16_t* Bt = wgt(c, woff);
  bf16_t* act = (bf16_t*)(c.ws + OFF_ACT + (size_t)110 * 1024 * 1024);
  const float* ss = ss_site(c, c.layer, site);
  float* cl = (float*)c.lds; float* rr = (float*)(c.lds + OFF_RR);
  const int tid = tid_();
  const int xcd_ = blockIdx.x & 7, slot_ = blockIdx.x >> 3, nslot_ = gridDim.x >> 3;
  for (int j_ = slot_; j_ < 16 * 44; j_ += nslot_) {
    const int mt = xcd_ * 16 + (j_ & 15), nt = j_ >> 4;
    f32x16 acc[2][2]; zero_acc<2>(acc);
    gemm_mainloop_reg<2>(A + (size_t)(mt & 1) * 128 * LDX, LDX, Bt + (size_t)(nt & 1) * 128 * LDX, LDX, DM, acc, c.lds);
    acc_to_lds<2>(acc, cl);
    if (tid < 128) rr[tid] = rsqrtf(ss[mt * 128 + tid] * (1.0f / DM) + EPS);
    __syncthreads();
    const int c4 = (tid & 15) * 4, r0 = tid >> 4;
#pragma unroll 2
    for (int it = 0; it < 8; ++it) {
      const int row = r0 + 16 * it;
      const float r = rr[row];
      const f32x4 a = *(const f32x4*)(cl + row * CLD + c4);
      const f32x4 b = *(const f32x4*)(cl + row * CLD + 64 + c4);
      float o[4];
#pragma unroll
      for (int e = 0; e < 4; ++e) { const float av = a[e] * r, bv = b[e] * r; o[e] = av * sigmoidf_(av) * bv; }
      u32x2 pq; pq.x = pk2(o[0], o[1]); pq.y = pk2(o[2], o[3]);
      *(u32x2*)(act + (size_t)(mt * 128 + row) * LDACT + nt * 64 + c4) = pq;
    }
    __syncthreads();
  }
}
#endif

DI void phase_resid_gemm(const Ctx& c, const bf16_t* A, int K, size_t woff, float scale, float* ssn) {
  const bf16_t* Bt = wgt(c, woff);
  bf16_t* xb = wsb(c, OFF_XB);
  float* cl = (float*)c.lds;
  const int xcd_ = blockIdx.x & 7, slot_ = blockIdx.x >> 3, nslot_ = gridDim.x >> 3;
  for (int j_ = slot_; j_ < 16 * 8; j_ += nslot_) {
    const int mt = xcd_ * 16 + (j_ & 15), nt = j_ >> 4;
    f32x16 acc[2][2]; zero_acc<2>(acc);
    gemm_mainloop_reg<2>(A + (size_t)mt * 128 * (K + PADK), K + PADK, Bt + (size_t)nt * 128 * (K + PADK), K + PADK, K, acc, c.lds);
    acc_to_lds<2>(acc, cl);
    __syncthreads();
    resid_epilogue<2>(c.x, xb, ssn, mt, nt, cl, scale);
    __syncthreads();
  }
}

DI void load_slot(const float* cl, int row, int col0, float (&v)[64]) {
#pragma unroll
  for (int q = 0; q < 16; ++q) { const f32x4 t = *(const f32x4*)(cl + row * CLD + col0 + q * 4); v[4 * q] = t[0]; v[4 * q + 1] = t[1]; v[4 * q + 2] = t[2]; v[4 * q + 3] = t[3]; }
}
template <int N> DI void store_bf16(bf16_t* dst, const float* v) {
#pragma unroll
  for (int q = 0; q < N / 8; ++q) { u32x4 p; p.x = pk2(v[8 * q], v[8 * q + 1]); p.y = pk2(v[8 * q + 2], v[8 * q + 3]); p.z = pk2(v[8 * q + 4], v[8 * q + 5]); p.w = pk2(v[8 * q + 6], v[8 * q + 7]); *(u32x4*)(dst + 8 * q) = p; }
}
template <int N> DI void rmsnorm_inplace(float* v, const float* __restrict__ g) {
  float s = 0.f;
#pragma unroll
  for (int i = 0; i < N; ++i) s += v[i] * v[i];
  const float r = rsqrtf(s * (1.0f / N) + EPS);
#pragma unroll
  for (int i = 0; i < N; ++i) v[i] = v[i] * r * g[i];
}
DI void rope32(float* v, const f32x2* __restrict__ tab  ) {
#pragma unroll
  for (int i = 0; i < 16; ++i) { const f32x2 cs = tab[i]; const float x1 = v[i], x2 = v[i + 16]; v[i] = x1 * cs.x - x2 * cs.y; v[i + 16] = x1 * cs.y + x2 * cs.x; }
}
DI void vt_write(const float* cl, const float* rr, int col0, int u, bf16_t* dst_row  , int dsh, int L, int pos0) {
  const int d = u & 63, th = u >> 6;
  float v[64];
#pragma unroll
  for (int i = 0; i < 64; ++i) v[i] = cl[(th * 64 + i) * CLD + col0 + d] * rr[th * 64 + i];
  const int p0 = pos0 + th * 64;
  if (dsh == 0) {
    store_bf16<64>(dst_row + p0, v);
  } else if (dsh == 2) {
#pragma unroll
    for (int rr_ = 0; rr_ < 4; ++rr_) {
      float t[16];
#pragma unroll
      for (int a = 0; a < 16; ++a) t[a] = v[4 * a + rr_];
      store_bf16<16>(dst_row + rr_ * L + (p0 >> 2), t);
    }
  } else {
#pragma unroll
    for (int rr_ = 0; rr_ < 16; ++rr_) {
      u32x2 p; p.x = pk2(v[rr_], v[16 + rr_]); p.y = pk2(v[32 + rr_], v[48 + rr_]);
      *(u32x2*)(dst_row + rr_ * L + (p0 >> 4)) = p;
    }
  }
}

DI void phase_proj(const Ctx& c, bool dummy_ss = false) {
  const bf16_t* A = wsb(c, OFF_XB);
  const bf16_t* Bt = wgt(c, W_IN);
  const float* ss = ss_site(c, c.layer, 1);
  float* ss_cq = ss_site(c, dummy_ss ? 2 : c.layer, 4);
  float* ss_ckv = ss_site(c, dummy_ss ? 2 : c.layer, 5);
  float* cl = (float*)c.lds; float* rr = (float*)(c.lds + OFF_RR);
  const f32x2* rope = (const f32x2*)(c.ws + OFF_ROPE);
  const int tid0 = tid_();
  const int S = c.S, sshift = c.sshift;
  const int xcd_ = blockIdx.x & 7;
  unsigned* ctr = (unsigned*)(c.ws + OFF_BAR) + CTR_PROJ + (c.chunk * 2 + c.layer + (dummy_ss ? 6 : 0)) * 8 + xcd_;
  for (;;) {
    const int j_ = grab_next(ctr, c.lds);
    if (j_ >= 16 * 28) break;
    const int mt = xcd_ * 16 + (j_ & 15), nt = j_ >> 4;
    f32x16 acc[2][2]; zero_acc<2>(acc);
    gemm_mainloop_reg<2>(A + (size_t)mt * 128 * LDX, LDX, Bt + (size_t)nt * 128 * LDX, LDX, DM, acc, c.lds);
    acc_to_lds<2>(acc, cl);
    const int tid = tid_(), half = __builtin_amdgcn_readfirstlane(tid >> 7), u = tid & 127;
    if (tid < 128) rr[tid] = rsqrtf(ss[mt * 128 + tid] * (1.0f / DM) + EPS);
    __syncthreads();
    const int slot = nt * 2 + half, col0 = half * 64;
    const int tl0 = mt * 128, seq = tl0 >> sshift, pos0 = tl0 & (S - 1);
    const bool is_vb = (slot >= 31 && slot < 43), is_vc = (slot == 53 || slot == 54);
    if (is_vb) {
      const int hb = slot - 31, dsh = 2 * (hb >> 2);
      bf16_t* dst = wsb(c, OFF_VTB) + ((size_t)(seq * 12 + hb) * 64 + (u & 63)) * (S + 64);
      vt_write(cl, rr, col0, u, dst, dsh, S >> dsh, pos0);
    } else if (is_vc) {
      const int hv = slot - 53;
      bf16_t* dst = wsb(c, OFF_VTC) + ((size_t)(seq * 2 + hv) * 64 + (u & 63)) * (S + 64);
      vt_write(cl, rr, col0, u, dst, 0, S, pos0);
    } else if (slot < 55) {
      const int row = u, tl = tl0 + row, pos = pos0 + row;
      const float r = rr[row];
      float v[64];
      load_slot(cl, row, col0, v);
#pragma unroll
      for (int i = 0; i < 64; ++i) v[i] *= r;
      if (slot < 6) {
        float s = 0.f;
#pragma unroll
        for (int i = 0; i < 64; ++i) s += v[i] * v[i];
        if (slot < 4) { store_bf16<64>(wsb(c, OFF_CQ) + (size_t)tl * LDCQ + slot * 64, v); atomicAdd(ss_cq + tl, s); }
        else { store_bf16<64>(wsb(c, OFF_CKV) + (size_t)tl * LDCKV + (slot - 4) * 64, v); atomicAdd(ss_ckv + tl, s); }
      } else if (slot == 6) {
        rmsnorm_inplace<32>(v, inl(c, 14, 96) + 64);
        rope32(v, rope + (size_t)pos * 16);
        bf16_t* dst = wsb(c, OFF_KA) + ((size_t)(seq * 8) * S + pos) * 96 + 64;
#pragma unroll
        for (int hh = 0; hh < 8; ++hh) store_bf16<32>(dst + (size_t)hh * S * 96, v);
      } else if (slot < 31) {
        const bool isq = slot < 19;
        const int hb = isq ? slot - 7 : slot - 19, dsh = 2 * (hb >> 2), L = S >> dsh;
        rmsnorm_inplace<64>(v, inl(c, isq ? 15 : 16, 64));
        const int srow = (pos & ((1 << dsh) - 1)) * L + (pos >> dsh);
        bf16_t* dst = wsb(c, isq ? OFF_QB : OFF_KB) + ((size_t)(seq * 12 + hb) * S + srow) * 64;
        store_bf16<64>(dst, v);
      } else {
        const bool isq = slot < 51;
        rmsnorm_inplace<64>(v, inl(c, isq ? 18 : 19, 64));
        bf16_t* dst = isq ? wsb(c, OFF_QC) + ((size_t)(seq * 8 + (slot - 43)) * S + pos) * 64
                          : wsb(c, OFF_KC) + ((size_t)(seq * 2 + (slot - 51)) * S + pos) * 64;
        asm volatile("" ::: "memory");
        rope32(v, rope + (size_t)(pos >> 6) * 16);
        store_bf16<32>(dst, v);
        asm volatile("" ::: "memory");
        rope32(v + 32, rope + (size_t)(pos & 63) * 16);
        store_bf16<32>(dst + 32, v + 32);
      }
    }
    __syncthreads();
  }
}

DI void phase_mlaup(const Ctx& c) {
  const float* ss_cq = ss_site(c, c.layer, 4);
  const float* ss_ckv = ss_site(c, c.layer, 5);
  float* cl = (float*)c.lds; float* rr = (float*)(c.lds + OFF_RR);
  const f32x2* rope = (const f32x2*)(c.ws + OFF_ROPE);
  const int tid0 = tid_();
  const int S = c.S, sshift = c.sshift;
  const int xcd_ = blockIdx.x & 7, slot_ = blockIdx.x >> 3, nslot_ = gridDim.x >> 3;
  for (int j_ = slot_; j_ < 16 * 14; j_ += nslot_) {
    const int mt = xcd_ * 16 + (j_ & 15), nt = j_ >> 4;
    const bool isq = nt < 6;
    f32x16 acc[2][2]; zero_acc<2>(acc);
    if (isq) gemm_mainloop_reg<2>(wsb(c, OFF_CQ) + (size_t)mt * 128 * LDCQ, LDCQ, wgt(c, W_UQ) + (size_t)nt * 128 * LDCQ, LDCQ, 256, acc, c.lds);
    else gemm_mainloop_reg<2>(wsb(c, OFF_CKV) + (size_t)mt * 128 * LDCKV, LDCKV, wgt(c, W_UKV) + (size_t)(nt - 6) * 128 * LDCKV, LDCKV, 128, acc, c.lds);
    acc_to_lds<2>(acc, cl);
    const int tid = tid_(), half = __builtin_amdgcn_readfirstlane(tid >> 7), u = tid & 127;
    if (tid < 128) rr[tid] = isq ? rsqrtf(ss_cq[mt * 128 + tid] * (1.0f / 256) + EPS) : rsqrtf(ss_ckv[mt * 128 + tid] * (1.0f / 128) + EPS);
    __syncthreads();
    const int col0 = half * 64;
    const int tl0 = mt * 128, seq = tl0 >> sshift, pos0 = tl0 & (S - 1);
    if (!isq && nt >= 10) {
      const int hv = (nt - 10) * 2 + half;
      bf16_t* dst = wsb(c, OFF_VTA) + ((size_t)(seq * 8 + hv) * 64 + (u & 63)) * (S + 64);
      vt_write(cl, rr, col0, u, dst, 0, S, pos0);
    } else {
      const int row = u, pos = pos0 + row;
      const float r = rr[row];
      float v[64];
      load_slot(cl, row, col0, v);
#pragma unroll
      for (int i = 0; i < 64; ++i) v[i] *= r;
      if (isq && nt < 4) {
        const int hh = nt * 2 + half;
        rmsnorm_inplace<64>(v, inl(c, 13, 96));
        store_bf16<64>(wsb(c, OFF_QA) + ((size_t)(seq * 8 + hh) * S + pos) * 96, v);
      } else if (isq) {
        const int h0 = ((nt - 4) * 2 + half) * 2;
        rmsnorm_inplace<32>(v, inl(c, 13, 96) + 64);
        rmsnorm_inplace<32>(v + 32, inl(c, 13, 96) + 64);
        rope32(v, rope + (size_t)pos * 16);
        rope32(v + 32, rope + (size_t)pos * 16);
        store_bf16<32>(wsb(c, OFF_QA) + ((size_t)(seq * 8 + h0) * S + pos) * 96 + 64, v);
        store_bf16<32>(wsb(c, OFF_QA) + ((size_t)(seq * 8 + h0 + 1) * S + pos) * 96 + 64, v + 32);
      } else {
        const int hh = (nt - 6) * 2 + half;
        rmsnorm_inplace<64>(v, inl(c, 14, 96));
        store_bf16<64>(wsb(c, OFF_KA) + ((size_t)(seq * 8 + hh) * S + pos) * 96, v);
      }
    }
    __syncthreads();
  }
}

template <int DQK, bool BAND, int QT>
DI void attn_item(const bf16_t* __restrict__ Q, const bf16_t* __restrict__ Kp, const bf16_t* __restrict__ Vt, int ldv,
                  int kbeg, int kend, int q0, const float* bias_g, float scale_log2,
                  bf16_t* __restrict__ out, size_t out_rs, float* __restrict__ lse, int lse_rs, char* lds) {
  constexpr int KROW = DQK * 2 + 16;
  constexpr int KST = 64 * KROW, VST = 64 * LROW, ST = KST + VST;
  constexpr int NKS = DQK / 16;
  constexpr int KV4 = DQK / 8;
  constexpr int NKL = (64 * KV4) / 256;
  constexpr int WQ = 32 * QT;
  const int tid = tid_(), lane = tid & 63, w = tid >> 6, h = lane >> 5, ql = lane & 31;
  float* bias_l = (float*)(lds + 2 * ST);
  if (BAND) { if (tid < 129) bias_l[tid] = bias_g[tid]; }
  bf16x8 qf[QT][NKS];
#pragma unroll
  for (int qt = 0; qt < QT; ++qt)
#pragma unroll
    for (int ks = 0; ks < NKS; ++ks) qf[qt][ks] = *(const bf16x8*)(Q + (size_t)(w * WQ + qt * 32 + ql) * DQK + ks * 16 + h * 8);
  f32x16 o[2][QT];
#pragma unroll
  for (int a = 0; a < 2; ++a)
#pragma unroll
    for (int b = 0; b < QT; ++b)
#pragma unroll
      for (int r = 0; r < 16; ++r) o[a][b][r] = 0.f;
  float m[QT], l[QT];
#pragma unroll
  for (int qt = 0; qt < QT; ++qt) { m[qt] = -1e30f; l[qt] = 0.f; }
  u32x4 rk[NKL], rv[2];
  const int vrow0 = tid >> 3, vch = tid & 7;
  unsigned klds[NKL];
#pragma unroll
  for (int i = 0; i < NKL; ++i) { const int idx = tid + i * 256, kr = idx / KV4, kc = idx - kr * KV4; klds[i] = kr * KROW + kc * 16; }
  const unsigned koff0 = (unsigned)tid * 16u;
  const unsigned voff0 = (unsigned)(vrow0 * ldv + vch * 8) * 2u, vstep = (unsigned)(32 * ldv) * 2u;
  const unsigned vlds0 = KST + vrow0 * LROW + vch * 16;
  auto gload = [&](int kt) {
    const char* kb = (const char*)Kp + (size_t)kt * (DQK * 2);
    const char* vb = (const char*)Vt + (size_t)kt * 2;
#pragma unroll
    for (int i = 0; i < NKL; ++i) rk[i] = *(const u32x4*)(kb + (koff0 + i * 4096u));
#pragma unroll
    for (int i = 0; i < 2; ++i) rv[i] = *(const u32x4*)(vb + (voff0 + i * vstep));
  };
  auto lstore = [&](char* st) {
#pragma unroll
    for (int i = 0; i < NKL; ++i) *(u32x4*)(st + klds[i]) = rk[i];
#pragma unroll
    for (int i = 0; i < 2; ++i) *(u32x4*)(st + vlds0 + i * 32 * LROW) = rv[i];
  };
  gload(kbeg);
  lstore(lds);
  __syncthreads();
  const int pr = (ql & ~12) | ((ql & 4) << 1) | ((ql & 8) >> 1);
  const int k_rd = pr * KROW + h * 16;
  const int v_rd = KST + ql * LROW + h * 16;
  const int qw0 = q0 + w * WQ;
  int it = 0;
  for (int kt = kbeg; kt < kend; kt += 64, ++it) {
    const char* st = lds + (it & 1) * ST;
    const bool more = (kt + 64 < kend);
    if (more) gload(kt + 64);
    bool need = true;
    if (BAND) need = (kt + 63 >= qw0 - 64) && (kt <= qw0 + WQ - 1 + 64);
    if (need) {
      f32x16 s[2][QT];
#pragma unroll
      for (int a = 0; a < 2; ++a)
#pragma unroll
        for (int b = 0; b < QT; ++b)
#pragma unroll
          for (int r = 0; r < 16; ++r) s[a][b][r] = 0.f;
#pragma unroll
      for (int ks = 0; ks < NKS; ++ks) {
        const bf16x8 k0 = *(const bf16x8*)(st + k_rd + ks * 32);
        const bf16x8 k1 = *(const bf16x8*)(st + k_rd + 32 * KROW + ks * 32);
#pragma unroll
        for (int qt = 0; qt < QT; ++qt) {
          s[0][qt] = MFMA(k0, qf[qt][ks], s[0][qt]);
          s[1][qt] = MFMA(k1, qf[qt][ks], s[1][qt]);
        }
      }
      bf16x8 pf[QT][4];
      const float cc = BAND ? 1.0f : scale_log2;
      const float th = BAND ? 8.0f : 8.0f / scale_log2;
#pragma unroll
      for (int qt = 0; qt < QT; ++qt) {
        if (BAND) {
#pragma unroll
          for (int a = 0; a < 2; ++a)
#pragma unroll
            for (int r = 0; r < 16; ++r) {
              const int kidx = kt + 32 * a + (r & 7) + 8 * h + 16 * (r >> 3);
              const int rel = kidx - (qw0 + qt * 32 + ql);
              const bool ok = (rel >= -64) && (rel <= 64);
              const int bi = ok ? rel + 64 : 0;
              s[a][qt][r] = ok ? fmaf(s[a][qt][r], scale_log2, bias_l[bi]) : -1e30f;
            }
        }
        float mx = s[0][qt][0];
#pragma unroll
        for (int r = 1; r < 16; ++r) mx = fmaxf(mx, s[0][qt][r]);
#pragma unroll
        for (int r = 0; r < 16; ++r) mx = fmaxf(mx, s[1][qt][r]);
        mx = fmaxf(mx, __shfl_xor(mx, 32));
        if (__builtin_amdgcn_ballot_w64(mx > m[qt] + th) != 0) {
          const float mn = fmaxf(m[qt], mx);
          const float alpha = __builtin_amdgcn_exp2f((m[qt] - mn) * cc);
          m[qt] = mn;
          l[qt] *= alpha;
#pragma unroll
          for (int r = 0; r < 16; ++r) { o[0][qt][r] *= alpha; o[1][qt][r] *= alpha; }
        }
        const float mc = -m[qt] * cc;
        float ls = 0.f;
#pragma unroll
        for (int a = 0; a < 2; ++a) {
#pragma unroll
          for (int r = 0; r < 16; ++r) { const float pv = __builtin_amdgcn_exp2f(fmaf(s[a][qt][r], cc, mc)); s[a][qt][r] = pv; ls += pv; }
#pragma unroll
          for (int s2 = 0; s2 < 2; ++s2) {
            u32x4 pk;
            pk.x = pk2(s[a][qt][8 * s2 + 0], s[a][qt][8 * s2 + 1]);
            pk.y = pk2(s[a][qt][8 * s2 + 2], s[a][qt][8 * s2 + 3]);
            pk.z = pk2(s[a][qt][8 * s2 + 4], s[a][qt][8 * s2 + 5]);
            pk.w = pk2(s[a][qt][8 * s2 + 6], s[a][qt][8 * s2 + 7]);
            pf[qt][a * 2 + s2] = __builtin_bit_cast(bf16x8, pk);
          }
        }
        l[qt] += ls;
      }
      if (more) lstore(lds + ((it + 1) & 1) * ST);
#pragma unroll
      for (int ks = 0; ks < 4; ++ks) {
        const bf16x8 v0 = *(const bf16x8*)(st + v_rd + ks * 32);
        const bf16x8 v1 = *(const bf16x8*)(st + v_rd + 32 * LROW + ks * 32);
#pragma unroll
        for (int qt = 0; qt < QT; ++qt) {
          o[0][qt] = MFMA(v0, pf[qt][ks], o[0][qt]);
          o[1][qt] = MFMA(v1, pf[qt][ks], o[1][qt]);
        }
      }
    } else {
      if (more) lstore(lds + ((it + 1) & 1) * ST);
    }
    __syncthreads();
  }
#pragma unroll
  for (int qt = 0; qt < QT; ++qt) {
    const float lt = l[qt] + __shfl_xor(l[qt], 32);
    const float inv = 1.0f / lt;
    const int qi = w * WQ + qt * 32 + ql;
    bf16_t* orow = out + (size_t)qi * out_rs;
#pragma unroll
    for (int dt = 0; dt < 2; ++dt)
#pragma unroll
      for (int g = 0; g < 4; ++g) {
        u32x2 p; p.x = pk2(o[dt][qt][4 * g] * inv, o[dt][qt][4 * g + 1] * inv); p.y = pk2(o[dt][qt][4 * g + 2] * inv, o[dt][qt][4 * g + 3] * inv);
        *(u32x2*)(orow + dt * 32 + 8 * g + 4 * h) = p;
      }
    if (BAND) { if (h == 0) lse[(size_t)qi * lse_rs] = m[qt] * LN2 + __logf(lt); }
  }
}

template <int DQK>
DI void attn_dense(const bf16_t* __restrict__ Q, const bf16_t* __restrict__ Kp, const bf16_t* __restrict__ Vt, int ldv,
                   int nkeys, float scale_log2, bf16_t* __restrict__ out, size_t out_rs, char* lds) {
  constexpr int KROW = DQK * 2 + 16;
  constexpr int KST = 64 * KROW, VST = 64 * LROW;
  constexpr int NKS = DQK / 16;
  constexpr int KV4 = DQK / 8;
  constexpr int NKL = (64 * KV4) / 256;
  const int tid = tid_(), lane = tid & 63, w = tid >> 6, h = lane >> 5, ql = lane & 31;
  char* const kbase = lds;
  char* const vbase = lds + 2 * KST;
  bf16x8 qf[NKS];
#pragma unroll
  for (int ks = 0; ks < NKS; ++ks) qf[ks] = *(const bf16x8*)(Q + (size_t)(w * 32 + ql) * DQK + ks * 16 + h * 8);
  f32x16 o[2];
#pragma unroll
  for (int a = 0; a < 2; ++a)
#pragma unroll
    for (int r = 0; r < 16; ++r) o[a][r] = 0.f;
  float m = -1e30f, l = 0.f;
  u32x4 rk[NKL], rv[2];
  const int vrow0 = tid >> 3, vch = tid & 7;
#define GLK_(kt) { const int kt_ = (kt); _Pragma("unroll") for (int i_ = 0; i_ < NKL; ++i_) { const int idx = tid + i_ * 256, kr = idx / KV4, kc = idx - kr * KV4; rk[i_] = *(const u32x4*)(Kp + (size_t)(kt_ + kr) * DQK + kc * 8); } }
#define GLV_(kt) { const int kt_ = (kt); _Pragma("unroll") for (int i_ = 0; i_ < 2; ++i_) rv[i_] = *(const u32x4*)(Vt + (size_t)(vrow0 + 32 * i_) * ldv + kt_ + vch * 8); }
#define LSK_(st) { char* st_ = (st); _Pragma("unroll") for (int i_ = 0; i_ < NKL; ++i_) { const int idx = tid + i_ * 256, kr = idx / KV4, kc = idx - kr * KV4; *(u32x4*)(st_ + kr * KROW + kc * 16) = rk[i_]; } }
#define LSV_(st) { char* st_ = (st); _Pragma("unroll") for (int i_ = 0; i_ < 2; ++i_) *(u32x4*)(st_ + (vrow0 + 32 * i_) * LROW + vch * 16) = rv[i_]; }
  const int pr = (ql & ~12) | ((ql & 4) << 1) | ((ql & 8) >> 1);
  const int k_rd = pr * KROW + h * 16;
  const int v_rd = ql * LROW + h * 16;
  GLK_(0); LSK_(kbase);
  GLK_(64); GLV_(0); LSK_(kbase + KST); LSV_(vbase);
  __syncthreads();
  f32x16 sc[2];
#pragma unroll
  for (int a = 0; a < 2; ++a)
#pragma unroll
    for (int r = 0; r < 16; ++r) sc[a][r] = 0.f;
#pragma unroll
  for (int ks = 0; ks < NKS; ++ks) {
    const bf16x8 k0 = *(const bf16x8*)(kbase + k_rd + ks * 32);
    const bf16x8 k1 = *(const bf16x8*)(kbase + k_rd + 32 * KROW + ks * 32);
    sc[0] = MFMA(k0, qf[ks], sc[0]);
    sc[1] = MFMA(k1, qf[ks], sc[1]);
  }
  __syncthreads();
  const int nt = nkeys >> 6;
  const float cc = scale_log2, th = 8.0f / scale_log2;
  for (int i = 0; i < nt; ++i) {
    const bool more1 = (i + 1 < nt), more2 = (i + 2 < nt);
    if (more2) GLK_((i + 2) * 64);
    if (more1) GLV_((i + 1) * 64);
    float mx = sc[0][0];
#pragma unroll
    for (int r = 1; r < 16; ++r) mx = fmaxf(mx, sc[0][r]);
#pragma unroll
    for (int r = 0; r < 16; ++r) mx = fmaxf(mx, sc[1][r]);
    mx = fmaxf(mx, __shfl_xor(mx, 32));
    if (__builtin_amdgcn_ballot_w64(mx > m + th) != 0) {
      const float mn = fmaxf(m, mx);
      const float alpha = __builtin_amdgcn_exp2f((m - mn) * cc);
      m = mn; l *= alpha;
#pragma unroll
      for (int r = 0; r < 16; ++r) { o[0][r] *= alpha; o[1][r] *= alpha; }
    }
    const char* kn = kbase + ((i + 1) & 1) * KST;
    f32x16 sn[2];
#pragma unroll
    for (int a = 0; a < 2; ++a)
#pragma unroll
      for (int r = 0; r < 16; ++r) sn[a][r] = 0.f;
#pragma unroll
    for (int ks = 0; ks < NKS; ++ks) {
      const bf16x8 k0 = *(const bf16x8*)(kn + k_rd + ks * 32);
      const bf16x8 k1 = *(const bf16x8*)(kn + k_rd + 32 * KROW + ks * 32);
      sn[0] = MFMA(k0, qf[ks], sn[0]);
      sn[1] = MFMA(k1, qf[ks], sn[1]);
    }
    const float mc = -m * cc;
    float ls = 0.f;
    bf16x8 pf[4];
#pragma unroll
    for (int a = 0; a < 2; ++a) {
#pragma unroll
      for (int r = 0; r < 16; ++r) { const float pv = __builtin_amdgcn_exp2f(fmaf(sc[a][r], cc, mc)); sc[a][r] = pv; ls += pv; }
#pragma unroll
      for (int s2 = 0; s2 < 2; ++s2) {
        u32x4 pk;
        pk.x = pk2(sc[a][8 * s2 + 0], sc[a][8 * s2 + 1]);
        pk.y = pk2(sc[a][8 * s2 + 2], sc[a][8 * s2 + 3]);
        pk.z = pk2(sc[a][8 * s2 + 4], sc[a][8 * s2 + 5]);
        pk.w = pk2(sc[a][8 * s2 + 6], sc[a][8 * s2 + 7]);
        pf[a * 2 + s2] = __builtin_bit_cast(bf16x8, pk);
      }
    }
    l += ls;
    const char* vs = vbase + (i & 1) * VST;
#pragma unroll
    for (int ks = 0; ks < 4; ++ks) {
      const bf16x8 v0 = *(const bf16x8*)(vs + v_rd + ks * 32);
      const bf16x8 v1 = *(const bf16x8*)(vs + v_rd + 32 * LROW + ks * 32);
      o[0] = MFMA(v0, pf[ks], o[0]);
      o[1] = MFMA(v1, pf[ks], o[1]);
    }
    if (more2) LSK_(kbase + (i & 1) * KST);
    if (more1) LSV_(vbase + ((i + 1) & 1) * VST);
    __syncthreads();
    sc[0] = sn[0]; sc[1] = sn[1];
  }
#undef GLK_
#undef GLV_
#undef LSK_
#undef LSV_
  const float lt = l + __shfl_xor(l, 32);
  const float inv = 1.0f / lt;
  bf16_t* orow = out + (size_t)(w * 32 + ql) * out_rs;
#pragma unroll
  for (int dt = 0; dt < 2; ++dt)
#pragma unroll
    for (int g = 0; g < 4; ++g) {
      u32x2 p; p.x = pk2(o[dt][4 * g] * inv, o[dt][4 * g + 1] * inv); p.y = pk2(o[dt][4 * g + 2] * inv, o[dt][4 * g + 3] * inv);
      *(u32x2*)(orow + dt * 32 + 8 * g + 4 * h) = p;
    }
}

constexpr bool ATT_PIPE = false;
constexpr int AQT = 2;
constexpr int QBLK = 128 * AQT;
DI void phase_attn(const Ctx& c) {
  const int S = c.S, nseq = TC / S, nqb = S / QBLK;
  const int n_mla = nseq * 8 * nqb, n_gqa = n_mla, n_dil = nseq * 12 * nqb;
  const float* bias = (const float*)(c.ws + OFF_BIAS);
  const int xcd_ = blockIdx.x & 7;
  unsigned* ctr = (unsigned*)(c.ws + OFF_BAR) + CTR_ATTN + (c.chunk * 2 + c.layer) * 8 + xcd_;
  const int n_per_xcd = (n_mla + n_gqa + n_dil) >> 3;
  for (;;) {
    const int jg = grab_next(ctr, c.lds);
    if (jg >= n_per_xcd) break;
    const int item = jg * 8 + xcd_;
    if (item < n_mla) {
      const int hh = item & 7, rest = item >> 3, seq = rest / nqb, qb = rest - seq * nqb;
      const size_t hs = (size_t)(seq * 8 + hh) * S;
      if (ATT_PIPE) attn_dense<96>(wsb(c, OFF_QA) + (hs + qb * QBLK) * 96, wsb(c, OFF_KA) + hs * 96, wsb(c, OFF_VTA) + (size_t)(seq * 8 + hh) * 64 * (S + 64), S + 64,
                     S, 0.10206207261596577f * LOG2E, wsb(c, OFF_OA) + ((size_t)seq * S + qb * QBLK) * LDO + hh * 64, LDO, c.lds);
      else attn_item<96, false, AQT>(wsb(c, OFF_QA) + (hs + qb * QBLK) * 96, wsb(c, OFF_KA) + hs * 96, wsb(c, OFF_VTA) + (size_t)(seq * 8 + hh) * 64 * (S + 64), S + 64,
                     0, S, 0, nullptr, 0.10206207261596577f * LOG2E, wsb(c, OFF_OA) + ((size_t)seq * S + qb * QBLK) * LDO + hh * 64, LDO, nullptr, 0, c.lds);
    } else if (item < n_mla + n_gqa) {
      const int i2 = item - n_mla;
      const int hq = i2 & 7, rest = i2 >> 3, seq = rest / nqb, qb = rest - seq * nqb;
      const size_t hs = (size_t)(seq * 8 + hq) * S, ks = (size_t)(seq * 2 + (hq >> 2)) * S;
      if (ATT_PIPE) attn_dense<64>(wsb(c, OFF_QC) + (hs + qb * QBLK) * 64, wsb(c, OFF_KC) + ks * 64, wsb(c, OFF_VTC) + (size_t)(seq * 2 + (hq >> 2)) * 64 * (S + 64), S + 64,
                     S, 0.125f * LOG2E, wsb(c, OFF_OC) + ((size_t)seq * S + qb * QBLK) * LDO + hq * 64, LDO, c.lds);
      else attn_item<64, false, AQT>(wsb(c, OFF_QC) + (hs + qb * QBLK) * 64, wsb(c, OFF_KC) + ks * 64, wsb(c, OFF_VTC) + (size_t)(seq * 2 + (hq >> 2)) * 64 * (S + 64), S + 64,
                     0, S, 0, nullptr, 0.125f * LOG2E, wsb(c, OFF_OC) + ((size_t)seq * S + qb * QBLK) * LDO + hq * 64, LDO, nullptr, 0, c.lds);
    } else {
      const int i2 = item - n_mla - n_gqa;
      const int hb = i2 % 12, rest = i2 / 12, seq = rest / nqb, blk = rest - seq * nqb;
      const int dsh = 2 * (hb >> 2), L = S >> dsh, dil = 1 << dsh;
      const int srow0 = blk * QBLK, rr = srow0 / L, l0 = srow0 - rr * L;
      const size_t hs = (size_t)(seq * 12 + hb) * S;
      int kb = l0 - 64; if (kb < 0) kb = 0;
      int ke = l0 + QBLK + 64; if (ke > L) ke = L;
      const size_t tok0 = (size_t)seq * S + (size_t)l0 * dil + rr;
      attn_item<64, true, AQT>(wsb(c, OFF_QB) + (hs + srow0) * 64, wsb(c, OFF_KB) + (hs + (size_t)rr * L) * 64, wsb(c, OFF_VTB) + (size_t)(seq * 12 + hb) * 64 * (S + 64) + (size_t)rr * L, S + 64,
                          kb, ke, l0, bias + hb * 132, 0.125f * LOG2E,
                          wsb(c, OFF_OBG) + tok0 * 768 + hb * 64, (size_t)dil * 768, (float*)(c.ws + OFF_LSE) + tok0 * 12 + hb, dil * 12, c.lds);
    }
    __syncthreads();
  }
}

DI void phase_combine(const Ctx& c) {
  const bf16_t* obg = wsb(c, OFF_OBG);
  const float* lse = (const float*)(c.ws + OFF_LSE);
  bf16_t* ob = wsb(c, OFF_OB);
  const int total = TC * 4 * 8;
  for (int idx = blockIdx.x * NTHREADS + tid_(); idx < total; idx += gridDim.x * NTHREADS) {
    const int d8 = idx & 7, j = (idx >> 3) & 3, tl = idx >> 5;
    const float l0 = lse[tl * 12 + j], l1 = lse[tl * 12 + 4 + j], l2 = lse[tl * 12 + 8 + j];
    const float mx = fmaxf(l0, fmaxf(l1, l2));
    float w0 = __expf(l0 - mx), w1 = __expf(l1 - mx), w2 = __expf(l2 - mx);
    const float inv = 1.0f / (w0 + w1 + w2);
    w0 *= inv; w1 *= inv; w2 *= inv;
    const u32x4 a = *(const u32x4*)(obg + (size_t)tl * 768 + j * 64 + d8 * 8);
    const u32x4 b = *(const u32x4*)(obg + (size_t)tl * 768 + (4 + j) * 64 + d8 * 8);
    const u32x4 d = *(const u32x4*)(obg + (size_t)tl * 768 + (8 + j) * 64 + d8 * 8);
    u32x4 r;
#pragma unroll
    for (int e = 0; e < 4; ++e) {
      const float lo = w0 * __uint_as_float(a[e] << 16) + w1 * __uint_as_float(b[e] << 16) + w2 * __uint_as_float(d[e] << 16);
      const float hi = w0 * __uint_as_float(a[e] & 0xffff0000u) + w1 * __uint_as_float(b[e] & 0xffff0000u) + w2 * __uint_as_float(d[e] & 0xffff0000u);
      r[e] = pk2(lo, hi);
    }
    *(u32x4*)(ob + (size_t)tl * LDOB + j * 64 + d8 * 8) = r;
  }
}

DI void phase_merge(const Ctx& c) {
  const bf16_t* xb = wsb(c, OFF_XB);
  const float* ss = ss_site(c, c.layer, 1);
  const float* bgate = inl(c, 21, 3072);
  bf16_t* mrg = wsb(c, OFF_MRG);
  float* cl = (float*)c.lds; float* rr = (float*)(c.lds + OFF_RR);
  const int xcd_ = blockIdx.x & 7, slot_ = blockIdx.x >> 3, nslot_ = gridDim.x >> 3;
  for (int j_ = slot_; j_ < 16 * 8; j_ += nslot_) {
    const int mt = xcd_ * 16 + (j_ & 15), nt = j_ >> 4;
    __syncthreads();
    { const int t0 = tid_(); if (t0 < 128) rr[t0] = rsqrtf(ss[mt * 128 + t0] * (1.0f / DM) + EPS); }
    f32x16 macc[2][2]; zero_acc<2>(macc);
#pragma unroll 1
    for (int k = 0; k < 3; ++k) {
      unsigned gp[2][2][8];
      {
        f32x16 gacc[2][2]; zero_acc<2>(gacc);
        gemm_mainloop_glds<2>(xb + (size_t)mt * 128 * LDX, LDX, wgt(c, W_GATE) + (size_t)(k * 1024 + nt * 128) * LDX, LDX, DM, gacc, c.lds);
        const int tid = tid_(), lane = tid & 63, w = tid >> 6, wm = w >> 1, wn = w & 1, h = lane >> 5, cc = lane & 31;
#pragma unroll
        for (int j = 0; j < 2; ++j) {
          const float bv = bgate[k * 1024 + nt * 128 + wn * 64 + j * 32 + cc];
#pragma unroll
          for (int i = 0; i < 2; ++i)
#pragma unroll
            for (int r2 = 0; r2 < 8; ++r2) {
              const int ra = 2 * r2, rb = 2 * r2 + 1;
              const float r_a = rr[wm * 64 + i * 32 + (ra & 3) + 8 * (ra >> 2) + 4 * h];
              const float r_b = rr[wm * 64 + i * 32 + (rb & 3) + 8 * (rb >> 2) + 4 * h];
              gp[i][j][r2] = pk2(sigmoidf_(gacc[i][j][ra] * r_a + bv), sigmoidf_(gacc[i][j][rb] * r_b + bv));
            }
        }
      }
      {
        f32x16 acc[2][2]; zero_acc<2>(acc);
        const int Kk = (k == 1) ? 256 : 512;
        const bf16_t* Ao = wsb(c, k == 0 ? OFF_OA : (k == 1 ? OFF_OB : OFF_OC));
        const bf16_t* Wo = wgt(c, k == 0 ? W_OA : (k == 1 ? W_OB : W_OC));
        gemm_mainloop_glds<2>(Ao + (size_t)mt * 128 * (Kk + PADK), Kk + PADK, Wo + (size_t)nt * 128 * (Kk + PADK), Kk + PADK, Kk, acc, c.lds);
#pragma unroll
        for (int i = 0; i < 2; ++i)
#pragma unroll
          for (int j = 0; j < 2; ++j)
#pragma unroll
            for (int r2 = 0; r2 < 8; ++r2) {
              const unsigned g2 = gp[i][j][r2];
              macc[i][j][2 * r2] += __uint_as_float(g2 << 16) * acc[i][j][2 * r2];
              macc[i][j][2 * r2 + 1] += __uint_as_float(g2 & 0xffff0000u) * acc[i][j][2 * r2 + 1];
            }
      }
    }
    acc_to_lds<2>(macc, cl);
    __syncthreads();
    const int tid = tid_();
    const int c4 = (tid & 31) * 4, r0 = tid >> 5;
#pragma unroll 4
    for (int it = 0; it < 16; ++it) {
      const int row = r0 + 8 * it;
      const f32x4 v = *(const f32x4*)(cl + row * CLD + c4);
      u32x2 p; p.x = pk2(v[0], v[1]); p.y = pk2(v[2], v[3]);
      *(u32x2*)(mrg + (size_t)(mt * 128 + row) * LDX + nt * 128 + c4) = p;
    }
    __syncthreads();
  }
}

DI void phase_ple(const Ctx& c, bool probe = false) {
  const bf16_t* xb = wsb(c, OFF_XB);
  const float* ss = ss_site(c, c.layer, 3);
  float* ssn = probe ? ss_site(c, 2, 5) : ss_site(c, c.layer + 1, 0);
  const bf16_t* peb = wsb(c, OFF_PEB) + (size_t)c.layer * TC * LDPE;
  float* cl = (float*)c.lds; float* rr = (float*)(c.lds + OFF_RR);
  const int tid = tid_(), lane = tid & 63, w = tid >> 6, wm = w >> 1, h = lane >> 5;
  const int xcd_ = blockIdx.x & 7, slot_ = blockIdx.x >> 3, nslot_ = gridDim.x >> 3;
  for (int j_ = slot_; j_ < 16 * 8; j_ += nslot_) {
    const int mt = xcd_ * 16 + (j_ & 15), nt = j_ >> 4;
    if (tid < 128) rr[tid] = rsqrtf(ss[mt * 128 + tid] * (1.0f / DM) + EPS);
    unsigned gp[2][2][8];
    {
      f32x16 g[2][2]; zero_acc<2>(g);
      gemm_mainloop_glds<2>(xb + (size_t)mt * 128 * LDX, LDX, wgt(c, W_PG) + (size_t)nt * 128 * LDX, LDX, DM, g, c.lds);
#pragma unroll
      for (int i = 0; i < 2; ++i)
#pragma unroll
        for (int j = 0; j < 2; ++j)
#pragma unroll
          for (int r2 = 0; r2 < 8; ++r2) {
            const int ra = 2 * r2, rb = 2 * r2 + 1;
            const float r_a = rr[wm * 64 + i * 32 + (ra & 3) + 8 * (ra >> 2) + 4 * h];
            const float r_b = rr[wm * 64 + i * 32 + (rb & 3) + 8 * (rb >> 2) + 4 * h];
            gp[i][j][r2] = pk2(sigmoidf_(g[i][j][ra] * r_a), sigmoidf_(g[i][j][rb] * r_b));
          }
    }
    f32x16 acc[2][2]; zero_acc<2>(acc);
    gemm_mainloop_glds<2>(peb + (size_t)mt * 128 * LDPE, LDPE, wgt(c, W_PLE) + (size_t)nt * 128 * LDPE, LDPE, 256, acc, c.lds);
#pragma unroll
    for (int i = 0; i < 2; ++i)
#pragma unroll
      for (int j = 0; j < 2; ++j)
#pragma unroll
        for (int r2 = 0; r2 < 8; ++r2) {
          const unsigned g2 = gp[i][j][r2];
          acc[i][j][2 * r2] *= __uint_as_float(g2 << 16);
          acc[i][j][2 * r2 + 1] *= __uint_as_float(g2 & 0xffff0000u);
        }
    acc_to_lds<2>(acc, cl);
    __syncthreads();
    resid_epilogue<2>(c.x, wsb(c, OFF_XB2), ssn, mt, nt, cl, probe ? 0.0f : 1.0f);
    __syncthreads();
  }
}

DI void phase_prologue(const Params& p, char* lds) {
  float* tl = (float*)lds;
  bf16_t* W = (bf16_t*)(p.ws + OFF_W);
  int rot = 0;
  for (int L = 0; L < 2; ++L) {
    bf16_t* wl = W + (size_t)L * W_LAYER;
    transpose_mat(p.in[5] + (size_t)L * 1024 * 5632, 5632, wl + W_FFN1_IN, 5632, 1024, p.in[4] + L * 1024, 1, tl, rot); rot += 88 * 16;
    transpose_mat(p.in[6] + (size_t)L * 2816 * 1024, 1024, wl + W_FFN1_OUT, 1024, 2816, nullptr, 0, tl, rot); rot += 16 * 44;
    transpose_mat(p.in[8] + (size_t)L * 1024 * 3488, 3488, wl + W_IN, 3584, 1024, p.in[7] + L * 1024, 2, tl, rot); rot += 56 * 16;
    transpose_mat(p.in[20] + (size_t)L * 1024 * 3072, 3072, wl + W_GATE, 3072, 1024, p.in[7] + L * 1024, 0, tl, rot); rot += 48 * 16;
    transpose_mat(p.in[11] + (size_t)L * 256 * 768, 768, wl + W_UQ, 768, 256, p.in[9] + L * 256, 3, tl, rot); rot += 12 * 4;
    transpose_mat(p.in[12] + (size_t)L * 128 * 1024, 1024, wl + W_UKV, 1024, 128, p.in[10] + L * 128, 4, tl, rot); rot += 16 * 2;
    transpose_mat(p.in[22] + (size_t)L * 512 * 1024, 1024, wl + W_OA, 1024, 512, nullptr, 0, tl, rot); rot += 16 * 8;
    transpose_mat(p.in[23] + (size_t)L * 256 * 1024, 1024, wl + W_OB, 1024, 256, nullptr, 0, tl, rot); rot += 16 * 4;
    transpose_mat(p.in[24] + (size_t)L * 512 * 1024, 1024, wl + W_OC, 1024, 512, nullptr, 0, tl, rot); rot += 16 * 8;
    transpose_mat(p.in[25] + (size_t)L * 1024 * 1024, 1024, wl + W_OUT, 1024, 1024, nullptr, 0, tl, rot); rot += 16 * 16;
    transpose_mat(p.in[27] + (size_t)L * 1024 * 5632, 5632, wl + W_FFN2_IN, 5632, 1024, p.in[26] + L * 1024, 1, tl, rot); rot += 88 * 16;
    transpose_mat(p.in[28] + (size_t)L * 2816 * 1024, 1024, wl + W_FFN2_OUT, 1024, 2816, nullptr, 0, tl, rot); rot += 16 * 44;
    transpose_mat(p.in[30] + (size_t)L * 1024 * 1024, 1024, wl + W_PG, 1024, 1024, p.in[29] + L * 1024, 0, tl, rot); rot += 16 * 16;
    transpose_mat(p.in[31] + (size_t)L * 256 * 1024, 1024, wl + W_PLE, 1024, 256, nullptr, 0, tl, rot); rot += 16 * 4;
  }
  const int gtid = blockIdx.x * NTHREADS + tid_(), gn = gridDim.x * NTHREADS;
  f32x2* rope = (f32x2*)(p.ws + OFF_ROPE);
  for (int idx = gtid; idx < 16384 * 16; idx += gn) {
    const int pos = idx >> 4, i = idx & 15;
    const float freq = (float)pow(10000.0, -(double)i / 16.0);
    const float ang = (float)pos * freq;
    f32x2 cs; cs.x = (float)cos((double)ang); cs.y = (float)sin((double)ang);
    rope[idx] = cs;
  }
  float* bias = (float*)(p.ws + OFF_BIAS);
  for (int idx = gtid; idx < 12 * 129; idx += gn) {
    const int hb = idx / 129, jj = idx - hb * 129;
    const int dil = 1 << (2 * (hb >> 2));
    const int rel = (jj - 64) * dil;
    const int n = rel < 0 ? -rel : rel;
    int b;
    if (n < 8) b = n;
    else { int lg = 8 + (int)(log((double)n / 8.0) / log(128.0) * 8.0); if (lg > 15) lg = 15; b = lg; }
    if (rel > 0) b += 16;
    bias[hb * 132 + jj] = p.in[17][b * 12 + hb] * LOG2E;
  }
}

DI void phase_init(const Ctx& c) {
  const int tid = tid_(), lane = tid & 63;
  const int gw = blockIdx.x * 4 + (tid >> 6), nw = gridDim.x * 4;
  bf16_t* xb = wsb(c, OFF_XB);
  float* ss0 = ss_site(c, 0, 0);
  for (int row = gw; row < TC; row += nw) {
    float s = 0.f;
#pragma unroll
    for (int i = 0; i < 4; ++i) {
      const size_t gi = (size_t)row * DM + i * 256 + lane * 4;
      const f32x4 v = *(const f32x4*)(c.xin + gi);
      *(f32x4*)(c.x + gi) = v;
      u32x2 p; p.x = pk2(v[0], v[1]); p.y = pk2(v[2], v[3]);
      *(u32x2*)(xb + (size_t)row * LDX + i * 256 + lane * 4) = p;
      s += v[0] * v[0] + v[1] * v[1] + v[2] * v[2] + v[3] * v[3];
    }
#pragma unroll
    for (int o = 32; o >= 1; o >>= 1) s += __shfl_xor(s, o);
    if (lane == 0) ss0[row] = s;
  }
  const int gtid = blockIdx.x * NTHREADS + tid, gn = gridDim.x * NTHREADS;
  float* ssall = (float*)(c.ws + OFF_SS);
  for (int idx = gtid + TC; idx < 3 * 6 * TC; idx += gn) ssall[idx] = 0.f;
  bf16_t* peb = wsb(c, OFF_PEB);
  for (int idx = gtid; idx < 2 * TC * 64; idx += gn) {
    const int L = idx / (TC * 64), r = idx - L * (TC * 64);
    const f32x4 v = *(const f32x4*)(c.pe0 + (size_t)L * c.pe_ls + (size_t)r * 4);
    u32x2 p; p.x = pk2(v[0], v[1]); p.y = pk2(v[2], v[3]);
    *(u32x2*)(peb + ((size_t)L * TC + (r >> 6)) * LDPE + (r & 63) * 4) = p;
  }
}

#ifndef ONLY
#define ONLY -1
#endif
#define PH(n) (ONLY < 0 || ONLY == (n))
#if DUP == 200
#define GSYNC() do { xcd_barrier(xb); xcd_barrier(xb); } while (0)
#else
#define GSYNC() xcd_barrier(xb)
#endif
#define REP(n) for (int rep_ = 0; rep_ < ((DUP == (n) || (DUP == 100 && ((n) == 2 || (n) == 10))) ? 2 : 1); ++rep_)
__global__ void __launch_bounds__(NTHREADS, 2) mega_kernel(Params p) {
  extern __shared__ __attribute__((aligned(16))) char lds[];
  cg::grid_group grid = cg::this_grid();
  volatile LAS unsigned* xst = (volatile LAS unsigned*)(lds + OFF_RR + 512);
  if (threadIdx.x == 0) { xst[0] = 0u; xst[1] = 0u; }
  __syncthreads();
  const XcdBarrier xb = xcd_barrier_post((unsigned*)(p.ws + OFF_BAR), xst);
  REP(0) { if (PH(0)) phase_prologue(p, lds); grid.sync(); }
  for (int chunk = 0; chunk < 3; ++chunk) {
    Ctx c;
    c.p = &p; c.chunk = chunk; c.layer = 0; c.ws = p.ws; c.lds = lds;
    c.S = chunk == 0 ? 4096 : 16384; c.sshift = chunk == 0 ? 12 : 14;
    c.x = p.out + (size_t)chunk * TC * DM;
    c.xin = chunk == 0 ? p.in[0] : p.in[1] + (size_t)(chunk - 1) * TC * DM;
    c.pe0 = chunk == 0 ? p.in[2] : p.in[3] + (size_t)(chunk - 1) * TC * 256;
    c.pe_ls = chunk == 0 ? (size_t)TC * 256 : (size_t)2 * TC * 256;
    REP(1) { if (PH(1)) phase_init(c); GSYNC(); }
#pragma unroll 1
    for (int layer = 0; layer < 2; ++layer) {
      c.layer = layer;
      REP(2) { if (PH(2)) phase_ffn_in(c, wsb(c, layer == 0 ? OFF_XB : OFF_XB2), W_FFN1_IN, 0); GSYNC(); }
#if DUP == 300
      { phase_ffn_probe(c, wsb(c, layer == 0 ? OFF_XB : OFF_XB2), W_FFN1_IN, 0); GSYNC(); }
#endif
      REP(3) { if (PH(3)) phase_resid_gemm(c, wsb(c, OFF_ACT), DFF, W_FFN1_OUT, 0.5f, ss_site(c, layer, 1)); GSYNC(); }
#if DUP == 303
      { phase_resid_gemm(c, wsb(c, OFF_ACT), DFF, W_FFN1_OUT, 0.0f, ss_site(c, 2, 5)); GSYNC(); }
#endif
      REP(4) { if (PH(4)) phase_proj(c); GSYNC(); }
#if DUP == 304
      { phase_proj(c, true); GSYNC(); }
#endif
      REP(5) { if (PH(5)) phase_mlaup(c); GSYNC(); }
      REP(6) { if (PH(6)) phase_attn(c); GSYNC(); }
      REP(7) { if (PH(7)) phase_combine(c); GSYNC(); }
      REP(8) { if (PH(8)) phase_merge(c); GSYNC(); }
      REP(9) { if (PH(9)) phase_resid_gemm(c, wsb(c, OFF_MRG), DM, W_OUT, 1.0f, ss_site(c, layer, 2)); GSYNC(); }
#if DUP == 305
      { phase_resid_gemm(c, wsb(c, OFF_MRG), DM, W_OUT, 0.0f, ss_site(c, 2, 5)); GSYNC(); }
#endif
      REP(10) { if (PH(10)) phase_ffn_in(c, wsb(c, OFF_XB), W_FFN2_IN, 2); GSYNC(); }
      REP(11) { if (PH(11)) phase_resid_gemm(c, wsb(c, OFF_ACT), DFF, W_FFN2_OUT, 0.5f, ss_site(c, layer, 3)); GSYNC(); }
      REP(12) { if (PH(12)) phase_ple(c); GSYNC(); }
#if DUP == 306
      { phase_ple(c, true); GSYNC(); }
#endif
    }
  }
}

extern "C" void kernel_launch(void* const* d_in, const int* in_sizes, int n_in, void* d_out, int out_size, void* d_ws, size_t ws_size, hipStream_t stream) {
  static int grid_blocks = 0;
  if (!grid_blocks) {
    int dev = 0, cus = 0, per_cu = 0;
    hipGetDevice(&dev);
    hipDeviceGetAttribute(&cus, hipDeviceAttributeMultiprocessorCount, dev);
    hipFuncSetAttribute((const void*)mega_kernel, hipFuncAttributeMaxDynamicSharedMemorySize, LDS_BYTES);
    hipOccupancyMaxActiveBlocksPerMultiprocessor(&per_cu, mega_kernel, NTHREADS, LDS_BYTES);
    if (per_cu > 2) per_cu = 2;
    if (per_cu < 1) per_cu = 1;
    grid_blocks = cus * per_cu;
  }
  Params p{};
  for (int i = 0; i < 32; ++i) p.in[i] = (const float*)d_in[i];
  p.out = (float*)d_out;
  p.ws = (char*)d_ws;
  hipMemsetAsync((char*)d_ws + OFF_BAR, 0, 16384, stream);
  void* args[] = {&p};
  hipError_t e = hipLaunchCooperativeKernel((const void*)mega_kernel, dim3(grid_blocks), dim3(NTHREADS), args, LDS_BYTES, stream);
  if (e != hipSuccess) fprintf(stderr, "cooperative launch failed: %s (grid %d)\n", hipGetErrorString(e), grid_blocks);
}
```

```cpp
#ifndef DUP
#define DUP -1
#endif
#include <hip/hip_runtime.h>
#include <hip/hip_cooperative_groups.h>
#include <stdint.h>
#include <cstdio>
namespace cg = cooperative_groups;

typedef unsigned short bf16_t;
typedef short bf16x8 __attribute__((ext_vector_type(8)));
typedef float f32x16 __attribute__((ext_vector_type(16)));
typedef float f32x4 __attribute__((ext_vector_type(4)));
typedef float f32x2 __attribute__((ext_vector_type(2)));
typedef unsigned u32x4 __attribute__((ext_vector_type(4)));
typedef unsigned u32x2 __attribute__((ext_vector_type(2)));
typedef __bf16 bf16x2_t __attribute__((ext_vector_type(2)));
#define DI __device__ __forceinline__
#define MFMA(a, b, c) __builtin_amdgcn_mfma_f32_32x32x16_bf16((a), (b), (c), 0, 0, 0)

constexpr int TC = 16384;
constexpr int DM = 1024;
constexpr int DFF = 2816;
constexpr float EPS = 1e-6f;
constexpr float LOG2E = 1.4426950408889634f;
constexpr float LN2 = 0.6931471805599453f;
constexpr int NTHREADS = 256;
constexpr int PADK = 64;
constexpr int LDX = DM + PADK;
constexpr int LDACT = DFF + PADK;
constexpr int LDCQ = 256 + PADK, LDCKV = 128 + PADK, LDO = 512 + PADK, LDOB = 256 + PADK, LDPE = 256 + PADK;

constexpr size_t W_FFN1_IN = 0;
constexpr size_t W_FFN1_OUT = W_FFN1_IN + (size_t)5632 * LDX;
constexpr size_t W_IN = W_FFN1_OUT + (size_t)1024 * LDACT;
constexpr size_t W_GATE = W_IN + (size_t)3584 * LDX;
constexpr size_t W_UQ = W_GATE + (size_t)3072 * LDX;
constexpr size_t W_UKV = W_UQ + (size_t)768 * LDCQ;
constexpr size_t W_OA = W_UKV + (size_t)1024 * LDCKV;
constexpr size_t W_OB = W_OA + (size_t)1024 * LDO;
constexpr size_t W_OC = W_OB + (size_t)1024 * LDOB;
constexpr size_t W_OUT = W_OC + (size_t)1024 * LDO;
constexpr size_t W_FFN2_IN = W_OUT + (size_t)1024 * LDX;
constexpr size_t W_FFN2_OUT = W_FFN2_IN + (size_t)5632 * LDX;
constexpr size_t W_PG = W_FFN2_OUT + (size_t)1024 * LDACT;
constexpr size_t W_PLE = W_PG + (size_t)1024 * LDX;
constexpr size_t W_LAYER = W_PLE + (size_t)1024 * LDPE;

constexpr size_t AL(size_t x) { return (x + 255) & ~(size_t)255; }
constexpr size_t OFF_W = 0;
constexpr size_t OFF_BAR = AL(OFF_W + 2 * W_LAYER * 2);
constexpr size_t OFF_ROPE = AL(OFF_BAR + 16384);
constexpr size_t OFF_BIAS = AL(OFF_ROPE + (size_t)16384 * 16 * 8);
constexpr size_t OFF_SS = AL(OFF_BIAS + 12 * 132 * 4);
constexpr size_t OFF_XB = AL(OFF_SS + (size_t)3 * 6 * TC * 4);
constexpr size_t OFF_XB2 = AL(OFF_XB + (size_t)TC * LDX * 2);
constexpr size_t OFF_PEB = AL(OFF_XB2 + (size_t)TC * LDX * 2);
constexpr size_t OFF_BIG = AL(OFF_PEB + (size_t)2 * TC * LDPE * 2);
constexpr size_t OFF_ACT = OFF_BIG;
constexpr size_t OFF_CQ = OFF_BIG;
constexpr size_t OFF_CKV = AL(OFF_CQ + (size_t)TC * LDCQ * 2);
constexpr size_t OFF_QA = AL(OFF_CKV + (size_t)TC * LDCKV * 2);
constexpr size_t OFF_KA = AL(OFF_QA + (size_t)TC * 768 * 2);
constexpr size_t OFF_VTA = AL(OFF_KA + (size_t)TC * 768 * 2);
constexpr size_t OFF_QB = AL(OFF_VTA + (size_t)(TC + 256) * 512 * 2);
constexpr size_t OFF_KB = AL(OFF_QB + (size_t)TC * 768 * 2);
constexpr size_t OFF_VTB = AL(OFF_KB + (size_t)TC * 768 * 2);
constexpr size_t OFF_QC = AL(OFF_VTB + (size_t)(TC + 256) * 768 * 2);
constexpr size_t OFF_KC = AL(OFF_QC + (size_t)TC * 512 * 2);
constexpr size_t OFF_VTC = AL(OFF_KC + (size_t)TC * 128 * 2);
constexpr size_t OFF_OA = AL(OFF_VTC + (size_t)(TC + 256) * 128 * 2);
constexpr size_t OFF_OBG = AL(OFF_OA + (size_t)TC * LDO * 2);
constexpr size_t OFF_LSE = AL(OFF_OBG + (size_t)TC * 768 * 2);
constexpr size_t OFF_OB = AL(OFF_LSE + (size_t)TC * 12 * 4);
constexpr size_t OFF_OC = AL(OFF_OB + (size_t)TC * LDOB * 2);
constexpr size_t OFF_MRG = AL(OFF_OC + (size_t)TC * LDO * 2);
constexpr size_t OFF_END = AL(OFF_MRG + (size_t)TC * LDX * 2);
static_assert(OFF_END < (size_t)508 * 1024 * 1024, "workspace too large");
static_assert(OFF_ACT + (size_t)TC * LDACT * 2 <= OFF_END, "act fits");

struct Params {
  const float* in[32];
  float* out;
  char* ws;
};

constexpr int LROW = 144;
constexpr int STAGE_OP = 128 * LROW;
constexpr int STAGE = 2 * STAGE_OP;
constexpr int CLD = 132;
constexpr int OFF_RR = 2 * STAGE;
constexpr int LDS_BYTES = 2 * STAGE + 1024;
static_assert(128 * CLD * 4 <= OFF_RR, "lds");

DI int tid_() { int t = threadIdx.x; asm volatile("" : "+v"(t)); return t; }
DI unsigned pk2(float a, float b) { f32x2 v = {a, b}; bf16x2_t r = __builtin_convertvector(v, bf16x2_t); return __builtin_bit_cast(unsigned, r); }
DI bf16_t f2bf(float a) { return (bf16_t)(pk2(a, 0.f) & 0xffffu); }
DI float bf2f(bf16_t v) { return __uint_as_float(((unsigned)v) << 16); }
DI float sigmoidf_(float x) { return 1.0f / (1.0f + __expf(-x)); }

DI int map_col(int map, int n) {
  switch (map) {
    case 0: return n;
    case 1: { int t = n >> 7, w = n & 127; return w < 64 ? t * 64 + w : DFF + t * 64 + (w - 64); }
    case 2: { int slot = n >> 6, d = n & 63; if (slot < 6) return n; if (slot == 6) return d < 32 ? 384 + d : -1; if (slot < 55) return 416 + (n - 448); return -1; }
    case 3: { if (n < 512) return (n >> 6) * 96 + (n & 63); int i = n - 512; return (i >> 5) * 96 + 64 + (i & 31); }
    default: { if (n < 512) return (n >> 6) * 128 + (n & 63); int i = n - 512; return (i >> 6) * 128 + 64 + (i & 63); }
  }
}

DI void transpose_mat(const float* __restrict__ src, int ld_src, bf16_t* __restrict__ dst, int N, int K, const float* __restrict__ gain, int map, float* lds, int rot) {
  const int ntk = K >> 6, ntn = N >> 6, nt = ntk * ntn;
  const int tid = tid_(), c = tid & 63, rq = tid >> 6;
  int b0 = (int)blockIdx.x - (rot % (int)gridDim.x); if (b0 < 0) b0 += gridDim.x;
  for (int t = b0; t < nt; t += gridDim.x) {
    const int tn = t / ntk, tk = t - tn * ntk;
    const int n0 = tn << 6, k0 = tk << 6;
    const int sc = map_col(map, n0 + c);
#pragma unroll 4
    for (int r = 0; r < 16; ++r) {
      const int kk = r * 4 + rq;
      float v = 0.f;
      if (sc >= 0) { v = src[(size_t)(k0 + kk) * ld_src + sc]; if (gain) v *= gain[k0 + kk]; }
      lds[c * 65 + kk] = v;
    }
    __syncthreads();
#pragma unroll 4
    for (int r = 0; r < 16; ++r) {
      const int nn = r * 4 + rq;
      dst[(size_t)(n0 + nn) * (K + PADK) + k0 + c] = f2bf(lds[nn * 65 + c]);
    }
    __syncthreads();
  }
}

template <int NJ> DI void zero_acc(f32x16 (&acc)[2][NJ]) {
#pragma unroll
  for (int i = 0; i < 2; ++i)
#pragma unroll
    for (int j = 0; j < NJ; ++j)
#pragma unroll
      for (int r = 0; r < 16; ++r) acc[i][j][r] = 0.f;
}

constexpr int GSTG_B = 128 * 128;
constexpr int GSTG = 2 * GSTG_B;
template <int NJ> DI void gemm_mainloop_glds(const bf16_t* __restrict__ A, int lda, const bf16_t* __restrict__ Bt, int ldb, int K, f32x16 (&acc)[2][NJ], char* lds) {
  const int tid = tid_(), lane = tid & 63, w = __builtin_amdgcn_readfirstlane(tid >> 6), wm = w >> 1, wn = w & 1;
  const int ql = lane & 31, h = lane >> 5;
  const int sw_s = (4 * (w & 1) + (lane >> 4)) & 7;
  const int csrc = (lane & 7) ^ sw_s;
  const char* ap = (const char*)A;
  const char* bp = (const char*)Bt;
  const unsigned aoff = (unsigned)((8 * w + (lane >> 3)) * lda + csrc * 8) * 2u, boff = (unsigned)((8 * w + (lane >> 3)) * ldb + csrc * 8) * 2u;
  const unsigned astep = (unsigned)(32 * lda) * 2u, bstep = (unsigned)(32 * ldb) * 2u;
  constexpr int NB = 2 * NJ;
  const int sw_r = (ql >> 1) & 7;
  int a_rd[4], b_rd[4];
#pragma unroll
  for (int ks = 0; ks < 4; ++ks) { const int pos = ((2 * ks + h) ^ sw_r) * 16; a_rd[ks] = (wm * 64 + ql) * 128 + pos; b_rd[ks] = GSTG_B + (wn * 32 * NJ + ql) * 128 + pos; }
#define GSTAGE_(ST) { char* sb_ = lds + (ST) * GSTG + w * 1024; \
    _Pragma("unroll") for (int i_ = 0; i_ < 4; ++i_) __builtin_amdgcn_global_load_lds((const unsigned*)(ap + (aoff + i_ * astep)), (unsigned*)(sb_ + i_ * 4096), 16, 0, 0); \
    _Pragma("unroll") for (int i_ = 0; i_ < NB; ++i_) __builtin_amdgcn_global_load_lds((const unsigned*)(bp + (boff + i_ * bstep)), (unsigned*)(sb_ + GSTG_B + i_ * 4096), 16, 0, 0); \
    ap += 128; bp += 128; }
  GSTAGE_(0);
  asm volatile("s_waitcnt vmcnt(0)" ::: "memory");
  __syncthreads();
  const int nk = K >> 6;
  for (int kt = 0; kt < nk; ++kt) {
    const int cur = kt & 1;
    if (kt + 1 < nk) GSTAGE_(cur ^ 1);
    const char* st_ = lds + cur * GSTG;
#pragma unroll
    for (int ks = 0; ks < 4; ++ks) {
      const bf16x8 a0 = *(const bf16x8*)(st_ + a_rd[ks]);
      const bf16x8 a1 = *(const bf16x8*)(st_ + a_rd[ks] + 4096);
#pragma unroll
      for (int j = 0; j < NJ; ++j) {
        const bf16x8 b = *(const bf16x8*)(st_ + b_rd[ks] + j * 4096);
        acc[0][j] = MFMA(a0, b, acc[0][j]); acc[1][j] = MFMA(a1, b, acc[1][j]);
      }
    }
    asm volatile("s_waitcnt vmcnt(0)" ::: "memory");
    __syncthreads();
  }
#undef GSTAGE_
}

template <int NJ> DI void gemm_mainloop_reg(const bf16_t* __restrict__ A, int lda, const bf16_t* __restrict__ Bt, int ldb, int K, f32x16 (&acc)[2][NJ], char* lds) {
  const int tid = tid_(), lane = tid & 63, w = tid >> 6, wm = w >> 1, wn = w & 1;
  const int lr = tid >> 3, lc = tid & 7;
  const char* ap = (const char*)A;
  const char* bp = (const char*)Bt;
  const unsigned aoff = (unsigned)(lr * lda + lc * 8) * 2u, boff = (unsigned)(lr * ldb + lc * 8) * 2u;
  const unsigned astep = (unsigned)(32 * lda) * 2u, bstep = (unsigned)(32 * ldb) * 2u;
  constexpr int NB = 2 * NJ;
  u32x4 ra0[4], rb0[NB], ra1[4], rb1[NB];
  const int wofs = lr * LROW + lc * 16;
  const int a_rd = (wm * 64 + (lane & 31)) * LROW + (lane >> 5) * 16;
  const int b_rd = STAGE_OP + (wn * 32 * NJ + (lane & 31)) * LROW + (lane >> 5) * 16;
#define GL1_(RA, RB, i) { RA[i] = *(const u32x4*)(ap + (aoff + (i) * astep)); if ((i) < NB) RB[(i) < NB ? (i) : 0] = *(const u32x4*)(bp + (boff + (i) * bstep)); }
#define LS1_(RA, RB, ST, i) { char* sn_ = lds + (ST) * STAGE; *(u32x4*)(sn_ + wofs + (i) * 32 * LROW) = RA[i]; \
                              if ((i) < NB) *(u32x4*)(sn_ + STAGE_OP + wofs + (i) * 32 * LROW) = RB[(i) < NB ? (i) : 0]; }
#define RF_(ks) { fa0 = *(const bf16x8*)(st_ + a_rd + (ks) * 32); fa1 = *(const bf16x8*)(st_ + a_rd + 32 * LROW + (ks) * 32); \
      _Pragma("unroll") for (int j = 0; j < NJ; ++j) fb[j] = *(const bf16x8*)(st_ + b_rd + j * 32 * LROW + (ks) * 32); }
#define STEP_(ST, DOL, RAL, RBL, DOS, RAS, RBS) { const char* st_ = lds + (ST) * STAGE; \
    bf16x8 fa0, fa1, fb[NJ]; RF_(0); \
    _Pragma("unroll") for (int ks = 0; ks < 4; ++ks) { \
      if (DOL) GL1_(RAL, RBL, ks); \
      const bf16x8 ca0 = fa0, ca1 = fa1; bf16x8 cb[NJ]; \
      _Pragma("unroll") for (int j = 0; j < NJ; ++j) cb[j] = fb[j]; \
      if (ks < 3) RF_(ks + 1); \
      _Pragma("unroll") for (int j = 0; j < NJ; ++j) { acc[0][j] = MFMA(ca0, cb[j], acc[0][j]); acc[1][j] = MFMA(ca1, cb[j], acc[1][j]); } \
      if (DOS) LS1_(RAS, RBS, 1 - (ST), ks); \
      __builtin_amdgcn_sched_barrier(0); } \
    if (DOL) { ap += 128; bp += 128; } }
#pragma unroll
  for (int i = 0; i < 4; ++i) GL1_(ra0, rb0, i);
  ap += 128; bp += 128;
#pragma unroll
  for (int i = 0; i < 4; ++i) GL1_(ra1, rb1, i);
  ap += 128; bp += 128;
#pragma unroll
  for (int i = 0; i < 4; ++i) LS1_(ra0, rb0, 0, i);
  __syncthreads();
  const int nk = K >> 6;
  for (int kt = 0; kt < nk; kt += 2) {
    const bool l0 = (kt + 2 < nk), l1 = (kt + 3 < nk);
    STEP_(0, l0, ra0, rb0, true, ra1, rb1);
    __syncthreads();
    STEP_(1, l1, ra1, rb1, l0, ra0, rb0);
    __syncthreads();
  }
#undef GL1_
#undef LS1_
#undef STEP_
#undef RF_
}

template <int NJ> DI void acc_to_lds(const f32x16 (&acc)[2][NJ], float* cl) {
  const int tid = tid_(), lane = tid & 63, w = tid >> 6, wm = w >> 1, wn = w & 1, h = lane >> 5, c = lane & 31;
#pragma unroll
  for (int i = 0; i < 2; ++i)
#pragma unroll
    for (int j = 0; j < NJ; ++j)
#pragma unroll
      for (int r = 0; r < 16; ++r) {
        const int row = wm * 64 + i * 32 + (r & 3) + 8 * (r >> 2) + 4 * h;
        cl[row * CLD + wn * 32 * NJ + j * 32 + c] = acc[i][j][r];
      }
}

template <int NJ> DI void resid_epilogue(float* __restrict__ x, bf16_t* __restrict__ xb, float* __restrict__ ssn, int mt, int nt, const float* cl, float scale) {
  constexpr int LPR = 16 * NJ, RPP = 256 / LPR, NP = 128 / RPP;
  const int tid = tid_(), c4 = (tid & (LPR - 1)) * 4, r0 = tid / LPR;
#pragma unroll 4
  for (int it = 0; it < NP; ++it) {
    const int row = r0 + RPP * it;
    const f32x4 c = *(const f32x4*)(cl + row * CLD + c4);
    const size_t gi = (size_t)(mt * 128 + row) * DM + nt * (64 * NJ) + c4;
    f32x4 xv = *(const f32x4*)(x + gi);
    xv = xv + scale * c;
    *(f32x4*)(x + gi) = xv;
    u32x2 p; p.x = pk2(xv[0], xv[1]); p.y = pk2(xv[2], xv[3]);
    *(u32x2*)(xb + (size_t)(mt * 128 + row) * LDX + nt * (64 * NJ) + c4) = p;
    float s_ = xv[0] * xv[0] + xv[1] * xv[1] + xv[2] * xv[2] + xv[3] * xv[3];
    if (NJ == 2) s_ += __shfl_xor(s_, 16);
    s_ += __shfl_xor(s_, 8); s_ += __shfl_xor(s_, 4); s_ += __shfl_xor(s_, 2); s_ += __shfl_xor(s_, 1);
    if ((tid & (LPR - 1)) == 0) atomicAdd(ssn + mt * 128 + row, s_);
  }
}

#define XB_TMO      128
#define XB_XCNT(j)  (256  + 64 * (j))
#define XB_XSUB(j)  (1280 + 64 * (j))
#define XB_XGEN(j)  (2304 + 64 * (j))
#define XB_TOP      3328
#define XB_TOPGEN   3392
#define XCD_BAR_WORDS 3456
#define XB_SPIN_CAP (1u << 22)
#define LAS __attribute__((address_space(3)))
DI unsigned xb_ld(unsigned* p)              { return __hip_atomic_load(p, __ATOMIC_RELAXED, __HIP_MEMORY_SCOPE_AGENT); }
DI unsigned xb_add(unsigned* p, unsigned v) { return __hip_atomic_fetch_add(p, v, __ATOMIC_RELAXED, __HIP_MEMORY_SCOPE_AGENT); }
DI unsigned xb_xcc_id() { return (unsigned)__builtin_amdgcn_s_getreg((3 << 11) | 20) & 0xFu; }
#define XB_SPIN(cond, bar) do { unsigned _sp = 0; while (cond) { __builtin_amdgcn_s_sleep(1); \
    if ((++_sp & 255u) == 0u) { if (xb_ld(&(bar)[XB_TMO])) break; if (_sp > XB_SPIN_CAP) { atomicAdd(&(bar)[XB_TMO], 1u); break; } } } } while (0)
struct XcdBarrier { unsigned* bar; unsigned x; volatile LAS unsigned* st; };
DI XcdBarrier xcd_barrier_post(unsigned* bar, volatile LAS unsigned* st) {
  XcdBarrier b; b.bar = bar; b.x = xb_xcc_id(); b.st = st;
  if (threadIdx.x == 0) (void)xb_add(&bar[XB_XCNT(b.x)], 1u);
  return b;
}
DI void xcd_barrier_complete(unsigned* bar, unsigned x, unsigned& nloc, unsigned& nx) {
  const unsigned G = gridDim.x * gridDim.y * gridDim.z;
  unsigned sum, cnt, mine, sp = 0u;
  for (;;) {
    sum = 0u; cnt = 0u; mine = 0u;
#pragma unroll
    for (unsigned j = 0; j < 16; ++j) { const unsigned c = xb_ld(&bar[XB_XCNT(j)]); sum += c; cnt += (c > 0u) ? 1u : 0u; mine = (j == x) ? c : mine; }
    if (sum == G) break;
    __builtin_amdgcn_s_sleep(1);
    if ((++sp & 255u) == 0u) { if (xb_ld(&bar[XB_TMO])) break; if (sp > XB_SPIN_CAP) { atomicAdd(&bar[XB_TMO], 1u); break; } }
  }
  nloc = mine > 0u ? mine : 1u; nx = cnt > 0u ? cnt : 1u;
}
DI void xcd_barrier(const XcdBarrier& b) {
  asm volatile("s_waitcnt vmcnt(0)" ::: "memory");
  __syncthreads();
  if (threadIdx.x == 0) {
    unsigned* bar = b.bar;
    __builtin_amdgcn_s_waitcnt(0);
    unsigned nloc = b.st[0], nx = b.st[1];
    if (nloc == 0u) { xcd_barrier_complete(bar, b.x, nloc, nx); b.st[0] = nloc; b.st[1] = nx; }
    const unsigned old = xb_add(&bar[XB_XSUB(b.x)], 1u);
    const unsigned gen = old / nloc;
    if (old + 1u == (gen + 1u) * nloc) {
      __builtin_amdgcn_fence(__ATOMIC_RELEASE, "agent");
      asm volatile("s_waitcnt vmcnt(0)" ::: "memory");
      const unsigned og = xb_add(&bar[XB_TOP], 1u);
      const unsigned tg = og / nx;
      if (og + 1u == (tg + 1u) * nx) xb_add(&bar[XB_TOPGEN], 1u);
      else XB_SPIN(xb_ld(&bar[XB_TOPGEN]) == tg, bar);
      __builtin_amdgcn_fence(__ATOMIC_ACQUIRE, "agent");
      xb_add(&bar[XB_XGEN(b.x)], 1u);
      asm volatile("s_waitcnt vmcnt(0)" ::: "memory");
    } else {
      XB_SPIN(xb_ld(&bar[XB_XGEN(b.x)]) == gen, bar);
      __builtin_amdgcn_fence(__ATOMIC_ACQUIRE, "agent");
      asm volatile("s_waitcnt vmcnt(0)" ::: "memory");
    }
  }
  __syncthreads();
}

constexpr int CTR_ATTN = 3520, CTR_FFN = 3584, CTR_PROJ = 3840;
DI int grab_next(unsigned* ctr, char* lds) {
  volatile int* nx = (volatile int*)(lds + OFF_RR + 528);
  if (tid_() == 0) *nx = (int)__hip_atomic_fetch_add(ctr, 1u, __ATOMIC_RELAXED, __HIP_MEMORY_SCOPE_AGENT);
  __syncthreads();
  const int v = __builtin_amdgcn_readfirstlane(*nx);
  __syncthreads();
  return v;
}

struct Ctx {
  const Params* p;
  int chunk, layer;
  int S, sshift;
  float* x;
  const float* xin;
  const float* pe0; size_t pe_ls;
  char* ws;
  char* lds;
};
DI bf16_t* wsb(const Ctx& c, size_t off) { return (bf16_t*)(c.ws + off); }
DI float* ss_site(const Ctx& c, int layer, int site) { return (float*)(c.ws + OFF_SS) + ((size_t)layer * 6 + site) * TC; }
DI const bf16_t* wgt(const Ctx& c, size_t off) { return (const bf16_t*)(c.ws + OFF_W) + (size_t)c.layer * W_LAYER + off; }
DI const float* inl(const Ctx& c, int idx, size_t per_layer) { return c.p->in[idx] + (size_t)c.layer * per_layer; }

DI void phase_ffn_in(const Ctx& c, const bf16_t* A, size_t woff, int site) {
  const bf16_t* Bt = wgt(c, woff);
  bf16_t* act = wsb(c, OFF_ACT);
  const float* ss = ss_site(c, c.layer, site);
  float* cl = (float*)c.lds; float* rr = (float*)(c.lds + OFF_RR);
  const int tid = tid_();
  const int xcd_ = blockIdx.x & 7;
  unsigned* ctr = (unsigned*)(c.ws + OFF_BAR) + CTR_FFN + ((c.chunk * 2 + c.layer) * 2 + (site == 2 ? 1 : 0)) * 8 + xcd_;
  for (;;) {
    const int j_ = grab_next(ctr, c.lds);
    if (j_ >= 16 * 44) break;
    const int mt = xcd_ * 16 + (j_ & 15), nt = j_ >> 4;
    f32x16 acc[2][2]; zero_acc<2>(acc);
    gemm_mainloop_reg<2>(A + (size_t)mt * 128 * LDX, LDX, Bt + (size_t)nt * 128 * LDX, LDX, DM, acc, c.lds);
    acc_to_lds<2>(acc, cl);
    if (tid < 128) rr[tid] = rsqrtf(ss[mt * 128 + tid] * (1.0f / DM) + EPS);
    __syncthreads();
    const int c4 = (tid & 15) * 4, r0 = tid >> 4;
#pragma unroll 2
    for (int it = 0; it < 8; ++it) {
      const int row = r0 + 16 * it;
      const float r = rr[row];
      const f32x4 a = *(const f32x4*)(cl + row * CLD + c4);
      const f32x4 b = *(const f32x4*)(cl + row * CLD + 64 + c4);
      float o[4];
#pragma unroll
      for (int e = 0; e < 4; ++e) { const float av = a[e] * r, bv = b[e] * r; o[e] = av * sigmoidf_(av) * bv; }
      u32x2 pq; pq.x = pk2(o[0], o[1]); pq.y = pk2(o[2], o[3]);
      *(u32x2*)(act + (size_t)(mt * 128 + row) * LDACT + nt * 64 + c4) = pq;
    }
    __syncthreads();
  }
}

#if DUP == 300
DI void phase_ffn_probe(const Ctx& c, const bf16_t* A, size_t woff, int site) {
  const bf16_t* Bt = wgt(c, woff);
  bf16_t* act = (bf16_t*)(c.ws + OFF_ACT + (size_t)110 * 1024 * 1024);
  const float* ss = ss_site(c, c.layer, site);
  float* cl = (float*)c.lds; float* rr = (float*)(c.lds + OFF_RR);
  const int tid = tid_();
  const int xcd_ = blockIdx.x & 7, slot_ = blockIdx.x >> 3, nslot_ = gridDim.x >> 3;
  for (int j_ = slot_; j_ < 16 * 44; j_ += nslot_) {
    const int mt = xcd_ * 16 + (j_ & 15), nt = j_ >> 4;
    f32x16 acc[2][2]; zero_acc<2>(acc);
    gemm_mainloop_reg<2>(A + (size_t)(mt & 1) * 128 * LDX, LDX, Bt + (size_t)(nt & 1) * 128 * LDX, LDX, DM, acc, c.lds);
    acc_to_lds<2>(acc, cl);
    if (tid < 128) rr[tid] = rsqrtf(ss[mt * 128 + tid] * (1.0f / DM) + EPS);
    __syncthreads();
    const int c4 = (tid & 15) * 4, r0 = tid >> 4;
#pragma unroll 2
    for (int it = 0; it < 8; ++it) {
      const int row = r0 + 16 * it;
      const float r = rr[row];
      const f32x4 a = *(const f32x4*)(cl + row * CLD + c4);
      const f32x4 b = *(const f32x4*)(cl + row * CLD + 64 + c4);
      float o[4];
#pragma unroll
      for (int e = 0; e < 4; ++e) { const float av = a[e] * r, bv = b[e] * r; o[e] = av * sigmoidf_(av) * bv; }
      u32x2 pq; pq.x = pk2(o[0], o[1]); pq.y = pk2(o[2], o[3]);
      *(u32x2*)(act + (size_t)(mt * 128 + row) * LDACT + nt * 64 + c4) = pq;
    }
    __syncthreads();
  }
}
#endif

DI void phase_resid_gemm(const Ctx& c, const bf16_t* A, int K, size_t woff, float scale, float* ssn) {
  const bf16_t* Bt = wgt(c, woff);
  bf16_t* xb = wsb(c, OFF_XB);
  float* cl = (float*)c.lds;
  const int xcd_ = blockIdx.x & 7, slot_ = blockIdx.x >> 3, nslot_ = gridDim.x >> 3;
  for (int j_ = slot_; j_ < 16 * 8; j_ += nslot_) {
    const int mt = xcd_ * 16 + (j_ & 15), nt = j_ >> 4;
    f32x16 acc[2][2]; zero_acc<2>(acc);
    gemm_mainloop_reg<2>(A + (size_t)mt * 128 * (K + PADK), K + PADK, Bt + (size_t)nt * 128 * (K + PADK), K + PADK, K, acc, c.lds);
    acc_to_lds<2>(acc, cl);
    __syncthreads();
    resid_epilogue<2>(c.x, xb, ssn, mt, nt, cl, scale);
    __syncthreads();
  }
}

DI void load_slot(const float* cl, int row, int col0, float (&v)[64]) {
#pragma unroll
  for (int q = 0; q < 16; ++q) { const f32x4 t = *(const f32x4*)(cl + row * CLD + col0 + q * 4); v[4 * q] = t[0]; v[4 * q + 1] = t[1]; v[4 * q + 2] = t[2]; v[4 * q + 3] = t[3]; }
}
template <int N> DI void store_bf16(bf16_t* dst, const float* v) {
#pragma unroll
  for (int q = 0; q < N / 8; ++q) { u32x4 p; p.x = pk2(v[8 * q], v[8 * q + 1]); p.y = pk2(v[8 * q + 2], v[8 * q + 3]); p.z = pk2(v[8 * q + 4], v[8 * q + 5]); p.w = pk2(v[8 * q + 6], v[8 * q + 7]); *(u32x4*)(dst + 8 * q) = p; }
}
template <int N> DI void rmsnorm_inplace(float* v, const float* __restrict__ g) {
  float s = 0.f;
#pragma unroll
  for (int i = 0; i < N; ++i) s += v[i] * v[i];
  const float r = rsqrtf(s * (1.0f / N) + EPS);
#pragma unroll
  for (int i = 0; i < N; ++i) v[i] = v[i] * r * g[i];
}
DI void rope32(float* v, const f32x2* __restrict__ tab  ) {
#pragma unroll
  for (int i = 0; i < 16; ++i) { const f32x2 cs = tab[i]; const float x1 = v[i], x2 = v[i + 16]; v[i] = x1 * cs.x - x2 * cs.y; v[i + 16] = x1 * cs.y + x2 * cs.x; }
}
DI void vt_write(const float* cl, const float* rr, int col0, int u, bf16_t* dst_row  , int dsh, int L, int pos0) {
  const int d = u & 63, th = u >> 6;
  float v[64];
#pragma unroll
  for (int i = 0; i < 64; ++i) v[i] = cl[(th * 64 + i) * CLD + col0 + d] * rr[th * 64 + i];
  const int p0 = pos0 + th * 64;
  if (dsh == 0) {
    store_bf16<64>(dst_row + p0, v);
  } else if (dsh == 2) {
#pragma unroll
    for (int rr_ = 0; rr_ < 4; ++rr_) {
      float t[16];
#pragma unroll
      for (int a = 0; a < 16; ++a) t[a] = v[4 * a + rr_];
      store_bf16<16>(dst_row + rr_ * L + (p0 >> 2), t);
    }
  } else {
#pragma unroll
    for (int rr_ = 0; rr_ < 16; ++rr_) {
      u32x2 p; p.x = pk2(v[rr_], v[16 + rr_]); p.y = pk2(v[32 + rr_], v[48 + rr_]);
      *(u32x2*)(dst_row + rr_ * L + (p0 >> 4)) = p;
    }
  }
}

DI void phase_proj(const Ctx& c, bool dummy_ss = false) {
  const bf16_t* A = wsb(c, OFF_XB);
  const bf16_t* Bt = wgt(c, W_IN);
  const float* ss = ss_site(c, c.layer, 1);
  float* ss_cq = ss_site(c, dummy_ss ? 2 : c.layer, 4);
  float* ss_ckv = ss_site(c, dummy_ss ? 2 : c.layer, 5);
  float* cl = (float*)c.lds; float* rr = (float*)(c.lds + OFF_RR);
  const f32x2* rope = (const f32x2*)(c.ws + OFF_ROPE);
  const int tid0 = tid_();
  const int S = c.S, sshift = c.sshift;
  const int xcd_ = blockIdx.x & 7;
  unsigned* ctr = (unsigned*)(c.ws + OFF_BAR) + CTR_PROJ + (c.chunk * 2 + c.layer + (dummy_ss ? 6 : 0)) * 8 + xcd_;
  for (;;) {
    const int j_ = grab_next(ctr, c.lds);
    if (j_ >= 16 * 28) break;
    const int mt = xcd_ * 16 + (j_ & 15), nt = j_ >> 4;
    f32x16 acc[2][2]; zero_acc<2>(acc);
    gemm_mainloop_reg<2>(A + (size_t)mt * 128 * LDX, LDX, Bt + (size_t)nt * 128 * LDX, LDX, DM, acc, c.lds);
    acc_to_lds<2>(acc, cl);
    const int tid = tid_(), half = __builtin_amdgcn_readfirstlane(tid >> 7), u = tid & 127;
    if (tid < 128) rr[tid] = rsqrtf(ss[mt * 128 + tid] * (1.0f / DM) + EPS);
    __syncthreads();
    const int slot = nt * 2 + half, col0 = half * 64;
    const int tl0 = mt * 128, seq = tl0 >> sshift, pos0 = tl0 & (S - 1);
    const bool is_vb = (slot >= 31 && slot < 43), is_vc = (slot == 53 || slot == 54);
    if (is_vb) {
      const int hb = slot - 31, dsh = 2 * (hb >> 2);
      bf16_t* dst = wsb(c, OFF_VTB) + ((size_t)(seq * 12 + hb) * 64 + (u & 63)) * (S + 64);
      vt_write(cl, rr, col0, u, dst, dsh, S >> dsh, pos0);
    } else if (is_vc) {
      const int hv = slot - 53;
      bf16_t* dst = wsb(c, OFF_VTC) + ((size_t)(seq * 2 + hv) * 64 + (u & 63)) * (S + 64);
      vt_write(cl, rr, col0, u, dst, 0, S, pos0);
    } else if (slot < 55) {
      const int row = u, tl = tl0 + row, pos = pos0 + row;
      const float r = rr[row];
      float v[64];
      load_slot(cl, row, col0, v);
#pragma unroll
      for (int i = 0; i < 64; ++i) v[i] *= r;
      if (slot < 6) {
        float s = 0.f;
#pragma unroll
        for (int i = 0; i < 64; ++i) s += v[i] * v[i];
        if (slot < 4) { store_bf16<64>(wsb(c, OFF_CQ) + (size_t)tl * LDCQ + slot * 64, v); atomicAdd(ss_cq + tl, s); }
        else { store_bf16<64>(wsb(c, OFF_CKV) + (size_t)tl * LDCKV + (slot - 4) * 64, v); atomicAdd(ss_ckv + tl, s); }
      } else if (slot == 6) {
        rmsnorm_inplace<32>(v, inl(c, 14, 96) + 64);
        rope32(v, rope + (size_t)pos * 16);
        bf16_t* dst = wsb(c, OFF_KA) + ((size_t)(seq * 8) * S + pos) * 96 + 64;
#pragma unroll
        for (int hh = 0; hh < 8; ++hh) store_bf16<32>(dst + (size_t)hh * S * 96, v);
      } else if (slot < 31) {
        const bool isq = slot < 19;
        const int hb = isq ? slot - 7 : slot - 19, dsh = 2 * (hb >> 2), L = S >> dsh;
        rmsnorm_inplace<64>(v, inl(c, isq ? 15 : 16, 64));
        const int srow = (pos & ((1 << dsh) - 1)) * L + (pos >> dsh);
        bf16_t* dst = wsb(c, isq ? OFF_QB : OFF_KB) + ((size_t)(seq * 12 + hb) * S + srow) * 64;
        store_bf16<64>(dst, v);
      } else {
        const bool isq = slot < 51;
        rmsnorm_inplace<64>(v, inl(c, isq ? 18 : 19, 64));
        bf16_t* dst = isq ? wsb(c, OFF_QC) + ((size_t)(seq * 8 + (slot - 43)) * S + pos) * 64
                          : wsb(c, OFF_KC) + ((size_t)(seq * 2 + (slot - 51)) * S + pos) * 64;
        asm volatile("" ::: "memory");
        rope32(v, rope + (size_t)(pos >> 6) * 16);
        store_bf16<32>(dst, v);
        asm volatile("" ::: "memory");
        rope32(v + 32, rope + (size_t)(pos & 63) * 16);
        store_bf16<32>(dst + 32, v + 32);
      }
    }
    __syncthreads();
  }
}

DI void phase_mlaup(const Ctx& c) {
  const float* ss_cq = ss_site(c, c.layer, 4);
  const float* ss_ckv = ss_site(c, c.layer, 5);
  float* cl = (float*)c.lds; float* rr = (float*)(c.lds + OFF_RR);
  const f32x2* rope = (const f32x2*)(c.ws + OFF_ROPE);
  const int tid0 = tid_();
  const int S = c.S, sshift = c.sshift;
  const int xcd_ = blockIdx.x & 7, slot_ = blockIdx.x >> 3, nslot_ = gridDim.x >> 3;
  for (int j_ = slot_; j_ < 16 * 14; j_ += nslot_) {
    const int mt = xcd_ * 16 + (j_ & 15), nt = j_ >> 4;
    const bool isq = nt < 6;
    f32x16 acc[2][2]; zero_acc<2>(acc);
    if (isq) gemm_mainloop_reg<2>(wsb(c, OFF_CQ) + (size_t)mt * 128 * LDCQ, LDCQ, wgt(c, W_UQ) + (size_t)nt * 128 * LDCQ, LDCQ, 256, acc, c.lds);
    else gemm_mainloop_reg<2>(wsb(c, OFF_CKV) + (size_t)mt * 128 * LDCKV, LDCKV, wgt(c, W_UKV) + (size_t)(nt - 6) * 128 * LDCKV, LDCKV, 128, acc, c.lds);
    acc_to_lds<2>(acc, cl);
    const int tid = tid_(), half = __builtin_amdgcn_readfirstlane(tid >> 7), u = tid & 127;
    if (tid < 128) rr[tid] = isq ? rsqrtf(ss_cq[mt * 128 + tid] * (1.0f / 256) + EPS) : rsqrtf(ss_ckv[mt * 128 + tid] * (1.0f / 128) + EPS);
    __syncthreads();
    const int col0 = half * 64;
    const int tl0 = mt * 128, seq = tl0 >> sshift, pos0 = tl0 & (S - 1);
    if (!isq && nt >= 10) {
      const int hv = (nt - 10) * 2 + half;
      bf16_t* dst = wsb(c, OFF_VTA) + ((size_t)(seq * 8 + hv) * 64 + (u & 63)) * (S + 64);
      vt_write(cl, rr, col0, u, dst, 0, S, pos0);
    } else {
      const int row = u, pos = pos0 + row;
      const float r = rr[row];
      float v[64];
      load_slot(cl, row, col0, v);
#pragma unroll
      for (int i = 0; i < 64; ++i) v[i] *= r;
      if (isq && nt < 4) {
        const int hh = nt * 2 + half;
        rmsnorm_inplace<64>(v, inl(c, 13, 96));
        store_bf16<64>(wsb(c, OFF_QA) + ((size_t)(seq * 8 + hh) * S + pos) * 96, v);
      } else if (isq) {
        const int h0 = ((nt - 4) * 2 + half) * 2;
        rmsnorm_inplace<32>(v, inl(c, 13, 96) + 64);
        rmsnorm_inplace<32>(v + 32, inl(c, 13, 96) + 64);
        rope32(v, rope + (size_t)pos * 16);
        rope32(v + 32, rope + (size_t)pos * 16);
        store_bf16<32>(wsb(c, OFF_QA) + ((size_t)(seq * 8 + h0) * S + pos) * 96 + 64, v);
        store_bf16<32>(wsb(c, OFF_QA) + ((size_t)(seq * 8 + h0 + 1) * S + pos) * 96 + 64, v + 32);
      } else {
        const int hh = (nt - 6) * 2 + half;
        rmsnorm_inplace<64>(v, inl(c, 14, 96));
        store_bf16<64>(wsb(c, OFF_KA) + ((size_t)(seq * 8 + hh) * S + pos) * 96, v);
      }
    }
    __syncthreads();
  }
}

template <int DQK, bool BAND, int QT>
DI void attn_item(const bf16_t* __restrict__ Q, const bf16_t* __restrict__ Kp, const bf16_t* __restrict__ Vt, int ldv,
                  int kbeg, int kend, int q0, const float* bias_g, float scale_log2,
                  bf16_t* __restrict__ out, size_t out_rs, float* __restrict__ lse, int lse_rs, char* lds) {
  constexpr int KROW = DQK * 2 + 16;
  constexpr int KST = 64 * KROW, VST = 64 * LROW, ST = KST + VST;
  constexpr int NKS = DQK / 16;
  constexpr int KV4 = DQK / 8;
  constexpr int NKL = (64 * KV4) / 256;
  constexpr int WQ = 32 * QT;
  const int tid = tid_(), lane = tid & 63, w = tid >> 6, h = lane >> 5, ql = lane & 31;
  float* bias_l = (float*)(lds + 2 * ST);
  if (BAND) { if (tid < 129) bias_l[tid] = bias_g[tid]; }
  bf16x8 qf[QT][NKS];
#pragma unroll
  for (int qt = 0; qt < QT; ++qt)
#pragma unroll
    for (int ks = 0; ks < NKS; ++ks) qf[qt][ks] = *(const bf16x8*)(Q + (size_t)(w * WQ + qt * 32 + ql) * DQK + ks * 16 + h * 8);
  f32x16 o[2][QT];
#pragma unroll
  for (int a = 0; a < 2; ++a)
#pragma unroll
    for (int b = 0; b < QT; ++b)
#pragma unroll
      for (int r = 0; r < 16; ++r) o[a][b][r] = 0.f;
  float m[QT], l[QT];
#pragma unroll
  for (int qt = 0; qt < QT; ++qt) { m[qt] = -1e30f; l[qt] = 0.f; }
  u32x4 rk[NKL], rv[2];
  const int vrow0 = tid >> 3, vch = tid & 7;
  unsigned klds[NKL];
#pragma unroll
  for (int i = 0; i < NKL; ++i) { const int idx = tid + i * 256, kr = idx / KV4, kc = idx - kr * KV4; klds[i] = kr * KROW + kc * 16; }
  const unsigned koff0 = (unsigned)tid * 16u;
  const unsigned voff0 = (unsigned)(vrow0 * ldv + vch * 8) * 2u, vstep = (unsigned)(32 * ldv) * 2u;
  const unsigned vlds0 = KST + vrow0 * LROW + vch * 16;
  auto gload = [&](int kt) {
    const char* kb = (const char*)Kp + (size_t)kt * (DQK * 2);
    const char* vb = (const char*)Vt + (size_t)kt * 2;
#pragma unroll
    for (int i = 0; i < NKL; ++i) rk[i] = *(const u32x4*)(kb + (koff0 + i * 4096u));
#pragma unroll
    for (int i = 0; i < 2; ++i) rv[i] = *(const u32x4*)(vb + (voff0 + i * vstep));
  };
  auto lstore = [&](char* st) {
#pragma unroll
    for (int i = 0; i < NKL; ++i) *(u32x4*)(st + klds[i]) = rk[i];
#pragma unroll
    for (int i = 0; i < 2; ++i) *(u32x4*)(st + vlds0 + i * 32 * LROW) = rv[i];
  };
  gload(kbeg);
  lstore(lds);
  __syncthreads();
  const int pr = (ql & ~12) | ((ql & 4) << 1) | ((ql & 8) >> 1);
  const int k_rd = pr * KROW + h * 16;
  const int v_rd = KST + ql * LROW + h * 16;
  const int qw0 = q0 + w * WQ;
  int it = 0;
  for (int kt = kbeg; kt < kend; kt += 64, ++it) {
    const char* st = lds + (it & 1) * ST;
    const bool more = (kt + 64 < kend);
    if (more) gload(kt + 64);
    bool need = true;
    if (BAND) need = (kt + 63 >= qw0 - 64) && (kt <= qw0 + WQ - 1 + 64);
    if (need) {
      f32x16 s[2][QT];
#pragma unroll
      for (int a = 0; a < 2; ++a)
#pragma unroll
        for (int b = 0; b < QT; ++b)
#pragma unroll
          for (int r = 0; r < 16; ++r) s[a][b][r] = 0.f;
#pragma unroll
      for (int ks = 0; ks < NKS; ++ks) {
        const bf16x8 k0 = *(const bf16x8*)(st + k_rd + ks * 32);
        const bf16x8 k1 = *(const bf16x8*)(st + k_rd + 32 * KROW + ks * 32);
#pragma unroll
        for (int qt = 0; qt < QT; ++qt) {
          s[0][qt] = MFMA(k0, qf[qt][ks], s[0][qt]);
          s[1][qt] = MFMA(k1, qf[qt][ks], s[1][qt]);
        }
      }
      __builtin_amdgcn_s_setprio(1);
      bf16x8 pf[QT][4];
      const float cc = BAND ? 1.0f : scale_log2;
      const float th = BAND ? 8.0f : 8.0f / scale_log2;
#pragma unroll
      for (int qt = 0; qt < QT; ++qt) {
        if (BAND) {
#pragma unroll
          for (int a = 0; a < 2; ++a)
#pragma unroll
            for (int r = 0; r < 16; ++r) {
              const int kidx = kt + 32 * a + (r & 7) + 8 * h + 16 * (r >> 3);
              const int rel = kidx - (qw0 + qt * 32 + ql);
              const bool ok = (rel >= -64) && (rel <= 64);
              const int bi = ok ? rel + 64 : 0;
              s[a][qt][r] = ok ? fmaf(s[a][qt][r], scale_log2, bias_l[bi]) : -1e30f;
            }
        }
        float mx = s[0][qt][0];
#pragma unroll
        for (int r = 1; r < 16; ++r) mx = fmaxf(mx, s[0][qt][r]);
#pragma unroll
        for (int r = 0; r < 16; ++r) mx = fmaxf(mx, s[1][qt][r]);
        mx = fmaxf(mx, __shfl_xor(mx, 32));
        if (__builtin_amdgcn_ballot_w64(mx > m[qt] + th) != 0) {
          const float mn = fmaxf(m[qt], mx);
          const float alpha = __builtin_amdgcn_exp2f((m[qt] - mn) * cc);
          m[qt] = mn;
          l[qt] *= alpha;
#pragma unroll
          for (int r = 0; r < 16; ++r) { o[0][qt][r] *= alpha; o[1][qt][r] *= alpha; }
        }
        const float mc = -m[qt] * cc;
        float ls = 0.f;
#pragma unroll
        for (int a = 0; a < 2; ++a) {
#pragma unroll
          for (int r = 0; r < 16; ++r) { const float pv = __builtin_amdgcn_exp2f(fmaf(s[a][qt][r], cc, mc)); s[a][qt][r] = pv; ls += pv; }
#pragma unroll
          for (int s2 = 0; s2 < 2; ++s2) {
            u32x4 pk;
            pk.x = pk2(s[a][qt][8 * s2 + 0], s[a][qt][8 * s2 + 1]);
            pk.y = pk2(s[a][qt][8 * s2 + 2], s[a][qt][8 * s2 + 3]);
            pk.z = pk2(s[a][qt][8 * s2 + 4], s[a][qt][8 * s2 + 5]);
            pk.w = pk2(s[a][qt][8 * s2 + 6], s[a][qt][8 * s2 + 7]);
            pf[qt][a * 2 + s2] = __builtin_bit_cast(bf16x8, pk);
          }
        }
        l[qt] += ls;
      }
      __builtin_amdgcn_s_setprio(0);
      if (more) lstore(lds + ((it + 1) & 1) * ST);
#pragma unroll
      for (int ks = 0; ks < 4; ++ks) {
        const bf16x8 v0 = *(const bf16x8*)(st + v_rd + ks * 32);
        const bf16x8 v1 = *(const bf16x8*)(st + v_rd + 32 * LROW + ks * 32);
#pragma unroll
        for (int qt = 0; qt < QT; ++qt) {
          o[0][qt] = MFMA(v0, pf[qt][ks], o[0][qt]);
          o[1][qt] = MFMA(v1, pf[qt][ks], o[1][qt]);
        }
      }
    } else {
      if (more) lstore(lds + ((it + 1) & 1) * ST);
    }
    __syncthreads();
  }
#pragma unroll
  for (int qt = 0; qt < QT; ++qt) {
    const float lt = l[qt] + __shfl_xor(l[qt], 32);
    const float inv = 1.0f / lt;
    const int qi = w * WQ + qt * 32 + ql;
    bf16_t* orow = out + (size_t)qi * out_rs;
#pragma unroll
    for (int dt = 0; dt < 2; ++dt)
#pragma unroll
      for (int g = 0; g < 4; ++g) {
        u32x2 p; p.x = pk2(o[dt][qt][4 * g] * inv, o[dt][qt][4 * g + 1] * inv); p.y = pk2(o[dt][qt][4 * g + 2] * inv, o[dt][qt][4 * g + 3] * inv);
        *(u32x2*)(orow + dt * 32 + 8 * g + 4 * h) = p;
      }
    if (BAND) { if (h == 0) lse[(size_t)qi * lse_rs] = m[qt] * LN2 + __logf(lt); }
  }
}

template <int DQK>
DI void attn_dense(const bf16_t* __restrict__ Q, const bf16_t* __restrict__ Kp, const bf16_t* __restrict__ Vt, int ldv,
                   int nkeys, float scale_log2, bf16_t* __restrict__ out, size_t out_rs, char* lds) {
  constexpr int KROW = DQK * 2 + 16;
  constexpr int KST = 64 * KROW, VST = 64 * LROW;
  constexpr int NKS = DQK / 16;
  constexpr int KV4 = DQK / 8;
  constexpr int NKL = (64 * KV4) / 256;
  const int tid = tid_(), lane = tid & 63, w = tid >> 6, h = lane >> 5, ql = lane & 31;
  char* const kbase = lds;
  char* const vbase = lds + 2 * KST;
  bf16x8 qf[NKS];
#pragma unroll
  for (int ks = 0; ks < NKS; ++ks) qf[ks] = *(const bf16x8*)(Q + (size_t)(w * 32 + ql) * DQK + ks * 16 + h * 8);
  f32x16 o[2];
#pragma unroll
  for (int a = 0; a < 2; ++a)
#pragma unroll
    for (int r = 0; r < 16; ++r) o[a][r] = 0.f;
  float m = -1e30f, l = 0.f;
  u32x4 rk[NKL], rv[2];
  const int vrow0 = tid >> 3, vch = tid & 7;
#define GLK_(kt) { const int kt_ = (kt); _Pragma("unroll") for (int i_ = 0; i_ < NKL; ++i_) { const int idx = tid + i_ * 256, kr = idx / KV4, kc = idx - kr * KV4; rk[i_] = *(const u32x4*)(Kp + (size_t)(kt_ + kr) * DQK + kc * 8); } }
#define GLV_(kt) { const int kt_ = (kt); _Pragma("unroll") for (int i_ = 0; i_ < 2; ++i_) rv[i_] = *(const u32x4*)(Vt + (size_t)(vrow0 + 32 * i_) * ldv + kt_ + vch * 8); }
#define LSK_(st) { char* st_ = (st); _Pragma("unroll") for (int i_ = 0; i_ < NKL; ++i_) { const int idx = tid + i_ * 256, kr = idx / KV4, kc = idx - kr * KV4; *(u32x4*)(st_ + kr * KROW + kc * 16) = rk[i_]; } }
#define LSV_(st) { char* st_ = (st); _Pragma("unroll") for (int i_ = 0; i_ < 2; ++i_) *(u32x4*)(st_ + (vrow0 + 32 * i_) * LROW + vch * 16) = rv[i_]; }
  const int pr = (ql & ~12) | ((ql & 4) << 1) | ((ql & 8) >> 1);
  const int k_rd = pr * KROW + h * 16;
  const int v_rd = ql * LROW + h * 16;
  GLK_(0); LSK_(kbase);
  GLK_(64); GLV_(0); LSK_(kbase + KST); LSV_(vbase);
  __syncthreads();
  f32x16 sc[2];
#pragma unroll
  for (int a = 0; a < 2; ++a)
#pragma unroll
    for (int r = 0; r < 16; ++r) sc[a][r] = 0.f;
#pragma unroll
  for (int ks = 0; ks < NKS; ++ks) {
    const bf16x8 k0 = *(const bf16x8*)(kbase + k_rd + ks * 32);
    const bf16x8 k1 = *(const bf16x8*)(kbase + k_rd + 32 * KROW + ks * 32);
    sc[0] = MFMA(k0, qf[ks], sc[0]);
    sc[1] = MFMA(k1, qf[ks], sc[1]);
  }
  __syncthreads();
  const int nt = nkeys >> 6;
  const float cc = scale_log2, th = 8.0f / scale_log2;
  for (int i = 0; i < nt; ++i) {
    const bool more1 = (i + 1 < nt), more2 = (i + 2 < nt);
    if (more2) GLK_((i + 2) * 64);
    if (more1) GLV_((i + 1) * 64);
    float mx = sc[0][0];
#pragma unroll
    for (int r = 1; r < 16; ++r) mx = fmaxf(mx, sc[0][r]);
#pragma unroll
    for (int r = 0; r < 16; ++r) mx = fmaxf(mx, sc[1][r]);
    mx = fmaxf(mx, __shfl_xor(mx, 32));
    if (__builtin_amdgcn_ballot_w64(mx > m + th) != 0) {
      const float mn = fmaxf(m, mx);
      const float alpha = __builtin_amdgcn_exp2f((m - mn) * cc);
      m = mn; l *= alpha;
#pragma unroll
      for (int r = 0; r < 16; ++r) { o[0][r] *= alpha; o[1][r] *= alpha; }
    }
    const char* kn = kbase + ((i + 1) & 1) * KST;
    f32x16 sn[2];
#pragma unroll
    for (int a = 0; a < 2; ++a)
#pragma unroll
      for (int r = 0; r < 16; ++r) sn[a][r] = 0.f;
#pragma unroll
    for (int ks = 0; ks < NKS; ++ks) {
      const bf16x8 k0 = *(const bf16x8*)(kn + k_rd + ks * 32);
      const bf16x8 k1 = *(const bf16x8*)(kn + k_rd + 32 * KROW + ks * 32);
      sn[0] = MFMA(k0, qf[ks], sn[0]);
      sn[1] = MFMA(k1, qf[ks], sn[1]);
    }
    const float mc = -m * cc;
    float ls = 0.f;
    bf16x8 pf[4];
#pragma unroll
    for (int a = 0; a < 2; ++a) {
#pragma unroll
      for (int r = 0; r < 16; ++r) { const float pv = __builtin_amdgcn_exp2f(fmaf(sc[a][r], cc, mc)); sc[a][r] = pv; ls += pv; }
#pragma unroll
      for (int s2 = 0; s2 < 2; ++s2) {
        u32x4 pk;
        pk.x = pk2(sc[a][8 * s2 + 0], sc[a][8 * s2 + 1]);
        pk.y = pk2(sc[a][8 * s2 + 2], sc[a][8 * s2 + 3]);
        pk.z = pk2(sc[a][8 * s2 + 4], sc[a][8 * s2 + 5]);
        pk.w = pk2(sc[a][8 * s2 + 6], sc[a][8 * s2 + 7]);
        pf[a * 2 + s2] = __builtin_bit_cast(bf16x8, pk);
      }
    }
    l += ls;
    const char* vs = vbase + (i & 1) * VST;
#pragma unroll
    for (int ks = 0; ks < 4; ++ks) {
      const bf16x8 v0 = *(const bf16x8*)(vs + v_rd + ks * 32);
      const bf16x8 v1 = *(const bf16x8*)(vs + v_rd + 32 * LROW + ks * 32);
      o[0] = MFMA(v0, pf[ks], o[0]);
      o[1] = MFMA(v1, pf[ks], o[1]);
    }
    if (more2) LSK_(kbase + (i & 1) * KST);
    if (more1) LSV_(vbase + ((i + 1) & 1) * VST);
    __syncthreads();
    sc[0] = sn[0]; sc[1] = sn[1];
  }
#undef GLK_
#undef GLV_
#undef LSK_
#undef LSV_
  const float lt = l + __shfl_xor(l, 32);
  const float inv = 1.0f / lt;
  bf16_t* orow = out + (size_t)(w * 32 + ql) * out_rs;
#pragma unroll
  for (int dt = 0; dt < 2; ++dt)
#pragma unroll
    for (int g = 0; g < 4; ++g) {
      u32x2 p; p.x = pk2(o[dt][4 * g] * inv, o[dt][4 * g + 1] * inv); p.y = pk2(o[dt][4 * g + 2] * inv, o[dt][4 * g + 3] * inv);
      *(u32x2*)(orow + dt * 32 + 8 * g + 4 * h) = p;
    }
}

constexpr bool ATT_PIPE = false;
constexpr int AQT = 2;
constexpr int QBLK = 128 * AQT;
DI void phase_attn(const Ctx& c) {
  const int S = c.S, nseq = TC / S, nqb = S / QBLK;
  const int n_mla = nseq * 8 * nqb, n_gqa = n_mla, n_dil = nseq * 12 * nqb;
  const float* bias = (const float*)(c.ws + OFF_BIAS);
  const int xcd_ = blockIdx.x & 7;
  unsigned* ctr = (unsigned*)(c.ws + OFF_BAR) + CTR_ATTN + (c.chunk * 2 + c.layer) * 8 + xcd_;
  const int n_per_xcd = (n_mla + n_gqa + n_dil) >> 3;
  for (;;) {
    const int jg = grab_next(ctr, c.lds);
    if (jg >= n_per_xcd) break;
    const int item = jg * 8 + xcd_;
    if (item < n_mla) {
      const int hh = item & 7, rest = item >> 3, seq = rest / nqb, qb = rest - seq * nqb;
      const size_t hs = (size_t)(seq * 8 + hh) * S;
      if (ATT_PIPE) attn_dense<96>(wsb(c, OFF_QA) + (hs + qb * QBLK) * 96, wsb(c, OFF_KA) + hs * 96, wsb(c, OFF_VTA) + (size_t)(seq * 8 + hh) * 64 * (S + 64), S + 64,
                     S, 0.10206207261596577f * LOG2E, wsb(c, OFF_OA) + ((size_t)seq * S + qb * QBLK) * LDO + hh * 64, LDO, c.lds);
      else attn_item<96, false, AQT>(wsb(c, OFF_QA) + (hs + qb * QBLK) * 96, wsb(c, OFF_KA) + hs * 96, wsb(c, OFF_VTA) + (size_t)(seq * 8 + hh) * 64 * (S + 64), S + 64,
                     0, S, 0, nullptr, 0.10206207261596577f * LOG2E, wsb(c, OFF_OA) + ((size_t)seq * S + qb * QBLK) * LDO + hh * 64, LDO, nullptr, 0, c.lds);
    } else if (item < n_mla + n_gqa) {
      const int i2 = item - n_mla;
      const int hq = i2 & 7, rest = i2 >> 3, seq = rest / nqb, qb = rest - seq * nqb;
      const size_t hs = (size_t)(seq * 8 + hq) * S, ks = (size_t)(seq * 2 + (hq >> 2)) * S;
      if (ATT_PIPE) attn_dense<64>(wsb(c, OFF_QC) + (hs + qb * QBLK) * 64, wsb(c, OFF_KC) + ks * 64, wsb(c, OFF_VTC) + (size_t)(seq * 2 + (hq >> 2)) * 64 * (S + 64), S + 64,
                     S, 0.125f * LOG2E, wsb(c, OFF_OC) + ((size_t)seq * S + qb * QBLK) * LDO + hq * 64, LDO, c.lds);
      else attn_item<64, false, AQT>(wsb(c, OFF_QC) + (hs + qb * QBLK) * 64, wsb(c, OFF_KC) + ks * 64, wsb(c, OFF_VTC) + (size_t)(seq * 2 + (hq >> 2)) * 64 * (S + 64), S + 64,
                     0, S, 0, nullptr, 0.125f * LOG2E, wsb(c, OFF_OC) + ((size_t)seq * S + qb * QBLK) * LDO + hq * 64, LDO, nullptr, 0, c.lds);
    } else {
      const int i2 = item - n_mla - n_gqa;
      const int hb = i2 % 12, rest = i2 / 12, seq = rest / nqb, blk = rest - seq * nqb;
      const int dsh = 2 * (hb >> 2), L = S >> dsh, dil = 1 << dsh;
      const int srow0 = blk * QBLK, rr = srow0 / L, l0 = srow0 - rr * L;
      const size_t hs = (size_t)(seq * 12 + hb) * S;
      int kb = l0 - 64; if (kb < 0) kb = 0;
      int ke = l0 + QBLK + 64; if (ke > L) ke = L;
      const size_t tok0 = (size_t)seq * S + (size_t)l0 * dil + rr;
      attn_item<64, true, AQT>(wsb(c, OFF_QB) + (hs + srow0) * 64, wsb(c, OFF_KB) + (hs + (size_t)rr * L) * 64, wsb(c, OFF_VTB) + (size_t)(seq * 12 + hb) * 64 * (S + 64) + (size_t)rr * L, S + 64,
                          kb, ke, l0, bias + hb * 132, 0.125f * LOG2E,
                          wsb(c, OFF_OBG) + tok0 * 768 + hb * 64, (size_t)dil * 768, (float*)(c.ws + OFF_LSE) + tok0 * 12 + hb, dil * 12, c.lds);
    }
    __syncthreads();
  }
}

DI void phase_combine(const Ctx& c) {
  const bf16_t* obg = wsb(c, OFF_OBG);
  const float* lse = (const float*)(c.ws + OFF_LSE);
  bf16_t* ob = wsb(c, OFF_OB);
  const int total = TC * 4 * 8;
  for (int idx = blockIdx.x * NTHREADS + tid_(); idx < total; idx += gridDim.x * NTHREADS) {
    const int d8 = idx & 7, j = (idx >> 3) & 3, tl = idx >> 5;
    const float l0 = lse[tl * 12 + j], l1 = lse[tl * 12 + 4 + j], l2 = lse[tl * 12 + 8 + j];
    const float mx = fmaxf(l0, fmaxf(l1, l2));
    float w0 = __expf(l0 - mx), w1 = __expf(l1 - mx), w2 = __expf(l2 - mx);
    const float inv = 1.0f / (w0 + w1 + w2);
    w0 *= inv; w1 *= inv; w2 *= inv;
    const u32x4 a = *(const u32x4*)(obg + (size_t)tl * 768 + j * 64 + d8 * 8);
    const u32x4 b = *(const u32x4*)(obg + (size_t)tl * 768 + (4 + j) * 64 + d8 * 8);
    const u32x4 d = *(const u32x4*)(obg + (size_t)tl * 768 + (8 + j) * 64 + d8 * 8);
    u32x4 r;
#pragma unroll
    for (int e = 0; e < 4; ++e) {
      const float lo = w0 * __uint_as_float(a[e] << 16) + w1 * __uint_as_float(b[e] << 16) + w2 * __uint_as_float(d[e] << 16);
      const float hi = w0 * __uint_as_float(a[e] & 0xffff0000u) + w1 * __uint_as_float(b[e] & 0xffff0000u) + w2 * __uint_as_float(d[e] & 0xffff0000u);
      r[e] = pk2(lo, hi);
    }
    *(u32x4*)(ob + (size_t)tl * LDOB + j * 64 + d8 * 8) = r;
  }
}

DI void phase_merge(const Ctx& c) {
  const bf16_t* xb = wsb(c, OFF_XB);
  const float* ss = ss_site(c, c.layer, 1);
  const float* bgate = inl(c, 21, 3072);
  bf16_t* mrg = wsb(c, OFF_MRG);
  float* cl = (float*)c.lds; float* rr = (float*)(c.lds + OFF_RR);
  const int xcd_ = blockIdx.x & 7, slot_ = blockIdx.x >> 3, nslot_ = gridDim.x >> 3;
  for (int j_ = slot_; j_ < 16 * 8; j_ += nslot_) {
    const int mt = xcd_ * 16 + (j_ & 15), nt = j_ >> 4;
    __syncthreads();
    { const int t0 = tid_(); if (t0 < 128) rr[t0] = rsqrtf(ss[mt * 128 + t0] * (1.0f / DM) + EPS); }
    f32x16 macc[2][2]; zero_acc<2>(macc);
#pragma unroll 1
    for (int k = 0; k < 3; ++k) {
      unsigned gp[2][2][8];
      {
        f32x16 gacc[2][2]; zero_acc<2>(gacc);
        gemm_mainloop_glds<2>(xb + (size_t)mt * 128 * LDX, LDX, wgt(c, W_GATE) + (size_t)(k * 1024 + nt * 128) * LDX, LDX, DM, gacc, c.lds);
        const int tid = tid_(), lane = tid & 63, w = tid >> 6, wm = w >> 1, wn = w & 1, h = lane >> 5, cc = lane & 31;
#pragma unroll
        for (int j = 0; j < 2; ++j) {
          const float bv = bgate[k * 1024 + nt * 128 + wn * 64 + j * 32 + cc];
#pragma unroll
          for (int i = 0; i < 2; ++i)
#pragma unroll
            for (int r2 = 0; r2 < 8; ++r2) {
              const int ra = 2 * r2, rb = 2 * r2 + 1;
              const float r_a = rr[wm * 64 + i * 32 + (ra & 3) + 8 * (ra >> 2) + 4 * h];
              const float r_b = rr[wm * 64 + i * 32 + (rb & 3) + 8 * (rb >> 2) + 4 * h];
              gp[i][j][r2] = pk2(sigmoidf_(gacc[i][j][ra] * r_a + bv), sigmoidf_(gacc[i][j][rb] * r_b + bv));
            }
        }
      }
      {
        f32x16 acc[2][2]; zero_acc<2>(acc);
        const int Kk = (k == 1) ? 256 : 512;
        const bf16_t* Ao = wsb(c, k == 0 ? OFF_OA : (k == 1 ? OFF_OB : OFF_OC));
        const bf16_t* Wo = wgt(c, k == 0 ? W_OA : (k == 1 ? W_OB : W_OC));
        gemm_mainloop_glds<2>(Ao + (size_t)mt * 128 * (Kk + PADK), Kk + PADK, Wo + (size_t)nt * 128 * (Kk + PADK), Kk + PADK, Kk, acc, c.lds);
#pragma unroll
        for (int i = 0; i < 2; ++i)
#pragma unroll
          for (int j = 0; j < 2; ++j)
#pragma unroll
            for (int r2 = 0; r2 < 8; ++r2) {
              const unsigned g2 = gp[i][j][r2];
              macc[i][j][2 * r2] += __uint_as_float(g2 << 16) * acc[i][j][2 * r2];
              macc[i][j][2 * r2 + 1] += __uint_as_float(g2 & 0xffff0000u) * acc[i][j][2 * r2 + 1];
            }
      }
    }
    acc_to_lds<2>(macc, cl);
    __syncthreads();
    const int tid = tid_();
    const int c4 = (tid & 31) * 4, r0 = tid >> 5;
#pragma unroll 4
    for (int it = 0; it < 16; ++it) {
      const int row = r0 + 8 * it;
      const f32x4 v = *(const f32x4*)(cl + row * CLD + c4);
      u32x2 p; p.x = pk2(v[0], v[1]); p.y = pk2(v[2], v[3]);
      *(u32x2*)(mrg + (size_t)(mt * 128 + row) * LDX + nt * 128 + c4) = p;
    }
    __syncthreads();
  }
}

DI void phase_ple(const Ctx& c, bool probe = false) {
  const bf16_t* xb = wsb(c, OFF_XB);
  const float* ss = ss_site(c, c.layer, 3);
  float* ssn = probe ? ss_site(c, 2, 5) : ss_site(c, c.layer + 1, 0);
  const bf16_t* peb = wsb(c, OFF_PEB) + (size_t)c.layer * TC * LDPE;
  float* cl = (float*)c.lds; float* rr = (float*)(c.lds + OFF_RR);
  const int tid = tid_(), lane = tid & 63, w = tid >> 6, wm = w >> 1, h = lane >> 5;
  const int xcd_ = blockIdx.x & 7, slot_ = blockIdx.x >> 3, nslot_ = gridDim.x >> 3;
  for (int j_ = slot_; j_ < 16 * 8; j_ += nslot_) {
    const int mt = xcd_ * 16 + (j_ & 15), nt = j_ >> 4;
    if (tid < 128) rr[tid] = rsqrtf(ss[mt * 128 + tid] * (1.0f / DM) + EPS);
    unsigned gp[2][2][8];
    {
      f32x16 g[2][2]; zero_acc<2>(g);
      gemm_mainloop_glds<2>(xb + (size_t)mt * 128 * LDX, LDX, wgt(c, W_PG) + (size_t)nt * 128 * LDX, LDX, DM, g, c.lds);
#pragma unroll
      for (int i = 0; i < 2; ++i)
#pragma unroll
        for (int j = 0; j < 2; ++j)
#pragma unroll
          for (int r2 = 0; r2 < 8; ++r2) {
            const int ra = 2 * r2, rb = 2 * r2 + 1;
            const float r_a = rr[wm * 64 + i * 32 + (ra & 3) + 8 * (ra >> 2) + 4 * h];
            const float r_b = rr[wm * 64 + i * 32 + (rb & 3) + 8 * (rb >> 2) + 4 * h];
            gp[i][j][r2] = pk2(sigmoidf_(g[i][j][ra] * r_a), sigmoidf_(g[i][j][rb] * r_b));
          }
    }
    f32x16 acc[2][2]; zero_acc<2>(acc);
    gemm_mainloop_glds<2>(peb + (size_t)mt * 128 * LDPE, LDPE, wgt(c, W_PLE) + (size_t)nt * 128 * LDPE, LDPE, 256, acc, c.lds);
#pragma unroll
    for (int i = 0; i < 2; ++i)
#pragma unroll
      for (int j = 0; j < 2; ++j)
#pragma unroll
        for (int r2 = 0; r2 < 8; ++r2) {
          const unsigned g2 = gp[i][j][r2];
          acc[i][j][2 * r2] *= __uint_as_float(g2 << 16);
          acc[i][j][2 * r2 + 1] *= __uint_as_float(g2 & 0xffff0000u);
        }
    acc_to_lds<2>(acc, cl);
    __syncthreads();
    resid_epilogue<2>(c.x, wsb(c, OFF_XB2), ssn, mt, nt, cl, probe ? 0.0f : 1.0f);
    __syncthreads();
  }
}

DI void phase_prologue(const Params& p, char* lds) {
  float* tl = (float*)lds;
  bf16_t* W = (bf16_t*)(p.ws + OFF_W);
  int rot = 0;
  for (int L = 0; L < 2; ++L) {
    bf16_t* wl = W + (size_t)L * W_LAYER;
    transpose_mat(p.in[5] + (size_t)L * 1024 * 5632, 5632, wl + W_FFN1_IN, 5632, 1024, p.in[4] + L * 1024, 1, tl, rot); rot += 88 * 16;
    transpose_mat(p.in[6] + (size_t)L * 2816 * 1024, 1024, wl + W_FFN1_OUT, 1024, 2816, nullptr, 0, tl, rot); rot += 16 * 44;
    transpose_mat(p.in[8] + (size_t)L * 1024 * 3488, 3488, wl + W_IN, 3584, 1024, p.in[7] + L * 1024, 2, tl, rot); rot += 56 * 16;
    transpose_mat(p.in[20] + (size_t)L * 1024 * 3072, 3072, wl + W_GATE, 3072, 1024, p.in[7] + L * 1024, 0, tl, rot); rot += 48 * 16;
    transpose_mat(p.in[11] + (size_t)L * 256 * 768, 768, wl + W_UQ, 768, 256, p.in[9] + L * 256, 3, tl, rot); rot += 12 * 4;
    transpose_mat(p.in[12] + (size_t)L * 128 * 1024, 1024, wl + W_UKV, 1024, 128, p.in[10] + L * 128, 4, tl, rot); rot += 16 * 2;
    transpose_mat(p.in[22] + (size_t)L * 512 * 1024, 1024, wl + W_OA, 1024, 512, nullptr, 0, tl, rot); rot += 16 * 8;
    transpose_mat(p.in[23] + (size_t)L * 256 * 1024, 1024, wl + W_OB, 1024, 256, nullptr, 0, tl, rot); rot += 16 * 4;
    transpose_mat(p.in[24] + (size_t)L * 512 * 1024, 1024, wl + W_OC, 1024, 512, nullptr, 0, tl, rot); rot += 16 * 8;
    transpose_mat(p.in[25] + (size_t)L * 1024 * 1024, 1024, wl + W_OUT, 1024, 1024, nullptr, 0, tl, rot); rot += 16 * 16;
    transpose_mat(p.in[27] + (size_t)L * 1024 * 5632, 5632, wl + W_FFN2_IN, 5632, 1024, p.in[26] + L * 1024, 1, tl, rot); rot += 88 * 16;
    transpose_mat(p.in[28] + (size_t)L * 2816 * 1024, 1024, wl + W_FFN2_OUT, 1024, 2816, nullptr, 0, tl, rot); rot += 16 * 44;
    transpose_mat(p.in[30] + (size_t)L * 1024 * 1024, 1024, wl + W_PG, 1024, 1024, p.in[29] + L * 1024, 0, tl, rot); rot += 16 * 16;
    transpose_mat(p.in[31] + (size_t)L * 256 * 1024, 1024, wl + W_PLE, 1024, 256, nullptr, 0, tl, rot); rot += 16 * 4;
  }
  const int gtid = blockIdx.x * NTHREADS + tid_(), gn = gridDim.x * NTHREADS;
  f32x2* rope = (f32x2*)(p.ws + OFF_ROPE);
  for (int idx = gtid; idx < 16384 * 16; idx += gn) {
    const int pos = idx >> 4, i = idx & 15;
    const float freq = (float)pow(10000.0, -(double)i / 16.0);
    const float ang = (float)pos * freq;
    f32x2 cs; cs.x = (float)cos((double)ang); cs.y = (float)sin((double)ang);
    rope[idx] = cs;
  }
  float* bias = (float*)(p.ws + OFF_BIAS);
  for (int idx = gtid; idx < 12 * 129; idx += gn) {
    const int hb = idx / 129, jj = idx - hb * 129;
    const int dil = 1 << (2 * (hb >> 2));
    const int rel = (jj - 64) * dil;
    const int n = rel < 0 ? -rel : rel;
    int b;
    if (n < 8) b = n;
    else { int lg = 8 + (int)(log((double)n / 8.0) / log(128.0) * 8.0); if (lg > 15) lg = 15; b = lg; }
    if (rel > 0) b += 16;
    bias[hb * 132 + jj] = p.in[17][b * 12 + hb] * LOG2E;
  }
}

DI void phase_init(const Ctx& c) {
  const int tid = tid_(), lane = tid & 63;
  const int gw = blockIdx.x * 4 + (tid >> 6), nw = gridDim.x * 4;
  bf16_t* xb = wsb(c, OFF_XB);
  float* ss0 = ss_site(c, 0, 0);
  for (int row = gw; row < TC; row += nw) {
    float s = 0.f;
#pragma unroll
    for (int i = 0; i < 4; ++i) {
      const size_t gi = (size_t)row * DM + i * 256 + lane * 4;
      const f32x4 v = *(const f32x4*)(c.xin + gi);
      *(f32x4*)(c.x + gi) = v;
      u32x2 p; p.x = pk2(v[0], v[1]); p.y = pk2(v[2], v[3]);
      *(u32x2*)(xb + (size_t)row * LDX + i * 256 + lane * 4) = p;
      s += v[0] * v[0] + v[1] * v[1] + v[2] * v[2] + v[3] * v[3];
    }
#pragma unroll
    for (int o = 32; o >= 1; o >>= 1) s += __shfl_xor(s, o);
    if (lane == 0) ss0[row] = s;
  }
  const int gtid = blockIdx.x * NTHREADS + tid, gn = gridDim.x * NTHREADS;
  float* ssall = (float*)(c.ws + OFF_SS);
  for (int idx = gtid + TC; idx < 3 * 6 * TC; idx += gn) ssall[idx] = 0.f;
  bf16_t* peb = wsb(c, OFF_PEB);
  for (int idx = gtid; idx < 2 * TC * 64; idx += gn) {
    const int L = idx / (TC * 64), r = idx - L * (TC * 64);
    const f32x4 v = *(const f32x4*)(c.pe0 + (size_t)L * c.pe_ls + (size_t)r * 4);
    u32x2 p; p.x = pk2(v[0], v[1]); p.y = pk2(v[2], v[3]);
    *(u32x2*)(peb + ((size_t)L * TC + (r >> 6)) * LDPE + (r & 63) * 4) = p;
  }
}

#ifndef ONLY
#define ONLY -1
#endif
#define PH(n) (ONLY < 0 || ONLY == (n))
#if DUP == 200
#define GSYNC() do { xcd_barrier(xb); xcd_barrier(xb); } while (0)
#else
#define GSYNC() xcd_barrier(xb)
#endif
#define REP(n) for (int rep_ = 0; rep_ < ((DUP == (n) || (DUP == 100 && ((n) == 2 || (n) == 10))) ? 2 : 1); ++rep_)
__global__ void __launch_bounds__(NTHREADS, 2) mega_kernel(Params p) {
  extern __shared__ __attribute__((aligned(16))) char lds[];
  cg::grid_group grid = cg::this_grid();
  volatile LAS unsigned* xst = (volatile LAS unsigned*)(lds + OFF_RR + 512);
  if (threadIdx.x == 0) { xst[0] = 0u; xst[1] = 0u; }
  __syncthreads();
  const XcdBarrier xb = xcd_barrier_post((unsigned*)(p.ws + OFF_BAR), xst);
  REP(0) { if (PH(0)) phase_prologue(p, lds); grid.sync(); }
  for (int chunk = 0; chunk < 3; ++chunk) {
    Ctx c;
    c.p = &p; c.chunk = chunk; c.layer = 0; c.ws = p.ws; c.lds = lds;
    c.S = chunk == 0 ? 4096 : 16384; c.sshift = chunk == 0 ? 12 : 14;
    c.x = p.out + (size_t)chunk * TC * DM;
    c.xin = chunk == 0 ? p.in[0] : p.in[1] + (size_t)(chunk - 1) * TC * DM;
    c.pe0 = chunk == 0 ? p.in[2] : p.in[3] + (size_t)(chunk - 1) * TC * 256;
    c.pe_ls = chunk == 0 ? (size_t)TC * 256 : (size_t)2 * TC * 256;
    REP(1) { if (PH(1)) phase_init(c); GSYNC(); }
#pragma unroll 1
    for (int layer = 0; layer < 2; ++layer) {
      c.layer = layer;
      REP(2) { if (PH(2)) phase_ffn_in(c, wsb(c, layer == 0 ? OFF_XB : OFF_XB2), W_FFN1_IN, 0); GSYNC(); }
#if DUP == 300
      { phase_ffn_probe(c, wsb(c, layer == 0 ? OFF_XB : OFF_XB2), W_FFN1_IN, 0); GSYNC(); }
#endif
      REP(3) { if (PH(3)) phase_resid_gemm(c, wsb(c, OFF_ACT), DFF, W_FFN1_OUT, 0.5f, ss_site(c, layer, 1)); GSYNC(); }
#if DUP == 303
      { phase_resid_gemm(c, wsb(c, OFF_ACT), DFF, W_FFN1_OUT, 0.0f, ss_site(c, 2, 5)); GSYNC(); }
#endif
      REP(4) { if (PH(4)) phase_proj(c); GSYNC(); }
#if DUP == 304
      { phase_proj(c, true); GSYNC(); }
#endif
      REP(5) { if (PH(5)) phase_mlaup(c); GSYNC(); }
      REP(6) { if (PH(6)) phase_attn(c); GSYNC(); }
      REP(7) { if (PH(7)) phase_combine(c); GSYNC(); }
      REP(8) { if (PH(8)) phase_merge(c); GSYNC(); }
      REP(9) { if (PH(9)) phase_resid_gemm(c, wsb(c, OFF_MRG), DM, W_OUT, 1.0f, ss_site(c, layer, 2)); GSYNC(); }
#if DUP == 305
      { phase_resid_gemm(c, wsb(c, OFF_MRG), DM, W_OUT, 0.0f, ss_site(c, 2, 5)); GSYNC(); }
#endif
      REP(10) { if (PH(10)) phase_ffn_in(c, wsb(c, OFF_XB), W_FFN2_IN, 2); GSYNC(); }
      REP(11) { if (PH(11)) phase_resid_gemm(c, wsb(c, OFF_ACT), DFF, W_FFN2_OUT, 0.5f, ss_site(c, layer, 3)); GSYNC(); }
      REP(12) { if (PH(12)) phase_ple(c); GSYNC(); }
#if DUP == 306
      { phase_ple(c, true); GSYNC(); }
#endif
    }
  }
}

extern "C" void kernel_launch(void* const* d_in, const int* in_sizes, int n_in, void* d_out, int out_size, void* d_ws, size_t ws_size, hipStream_t stream) {
  static int grid_blocks = 0;
  if (!grid_blocks) {
    int dev = 0, cus = 0, per_cu = 0;
    hipGetDevice(&dev);
    hipDeviceGetAttribute(&cus, hipDeviceAttributeMultiprocessorCount, dev);
    hipFuncSetAttribute((const void*)mega_kernel, hipFuncAttributeMaxDynamicSharedMemorySize, LDS_BYTES);
    hipOccupancyMaxActiveBlocksPerMultiprocessor(&per_cu, mega_kernel, NTHREADS, LDS_BYTES);
    if (per_cu > 2) per_cu = 2;
    if (per_cu < 1) per_cu = 1;
    grid_blocks = cus * per_cu;
  }
  Params p{};
  for (int i = 0; i < 32; ++i) p.in[i] = (const float*)d_in[i];
  p.out = (float*)d_out;
  p.ws = (char*)d_ws;
  hipMemsetAsync((char*)d_ws + OFF_BAR, 0, 16384, stream);
  void* args[] = {&p};
  hipError_t e = hipLaunchCooperativeKernel((const void*)mega_kernel, dim3(grid_blocks), dim3(NTHREADS), args, LDS_BYTES, stream);
  if (e != hipSuccess) fprintf(stderr, "cooperative launch failed: %s (grid %d)\n", hipGetErrorString(e), grid_blocks);
}
```

```cpp
#ifndef DUP
#define DUP -1
#endif
#include <hip/hip_runtime.h>
#include <hip/hip_cooperative_groups.h>
#include <stdint.h>
#include <cstdio>
namespace cg = cooperative_groups;

typedef unsigned short bf16_t;
typedef short bf16x8 __attribute__((ext_vector_type(8)));
typedef float f32x16 __attribute__((ext_vector_type(16)));
typedef float f32x4 __attribute__((ext_vector_type(4)));
typedef float f32x2 __attribute__((ext_vector_type(2)));
typedef unsigned u32x4 __attribute__((ext_vector_type(4)));
typedef unsigned u32x2 __attribute__((ext_vector_type(2)));
typedef __bf16 bf16x2_t __attribute__((ext_vector_type(2)));
#define DI __device__ __forceinline__
#define MFMA(a, b, c) __builtin_amdgcn_mfma_f32_32x32x16_bf16((a), (b), (c), 0, 0, 0)

constexpr int TC = 16384;
constexpr int DM = 1024;
constexpr int DFF = 2816;
constexpr float EPS = 1e-6f;
constexpr float LOG2E = 1.4426950408889634f;
constexpr float LN2 = 0.6931471805599453f;
constexpr int NTHREADS = 256;
constexpr int PADK = 64;
constexpr int LDX = DM + PADK;
constexpr int LDACT = DFF + PADK;
constexpr int LDCQ = 256 + PADK, LDCKV = 128 + PADK, LDO = 512 + PADK, LDOB = 256 + PADK, LDPE = 256 + PADK;

constexpr size_t W_FFN1_IN = 0;
constexpr size_t W_FFN1_OUT = W_FFN1_IN + (size_t)5632 * LDX;
constexpr size_t W_IN = W_FFN1_OUT + (size_t)1024 * LDACT;
constexpr size_t W_GATE = W_IN + (size_t)3584 * LDX;
constexpr size_t W_UQ = W_GATE + (size_t)3072 * LDX;
constexpr size_t W_UKV = W_UQ + (size_t)768 * LDCQ;
constexpr size_t W_OA = W_UKV + (size_t)1024 * LDCKV;
constexpr size_t W_OB = W_OA + (size_t)1024 * LDO;
constexpr size_t W_OC = W_OB + (size_t)1024 * LDOB;
constexpr size_t W_OUT = W_OC + (size_t)1024 * LDO;
constexpr size_t W_FFN2_IN = W_OUT + (size_t)1024 * LDX;
constexpr size_t W_FFN2_OUT = W_FFN2_IN + (size_t)5632 * LDX;
constexpr size_t W_PG = W_FFN2_OUT + (size_t)1024 * LDACT;
constexpr size_t W_PLE = W_PG + (size_t)1024 * LDX;
constexpr size_t W_LAYER = W_PLE + (size_t)1024 * LDPE;

constexpr size_t AL(size_t x) { return (x + 255) & ~(size_t)255; }
constexpr size_t OFF_W = 0;
constexpr size_t OFF_BAR = AL(OFF_W + 2 * W_LAYER * 2);
constexpr size_t OFF_ROPE = AL(OFF_BAR + 16384);
constexpr size_t OFF_BIAS = AL(OFF_ROPE + (size_t)16384 * 16 * 8);
constexpr size_t OFF_SS = AL(OFF_BIAS + 12 * 132 * 4);
constexpr size_t OFF_XB = AL(OFF_SS + (size_t)3 * 6 * TC * 4);
constexpr size_t OFF_XB2 = AL(OFF_XB + (size_t)TC * LDX * 2);
constexpr size_t OFF_PEB = AL(OFF_XB2 + (size_t)TC * LDX * 2);
constexpr size_t OFF_BIG = AL(OFF_PEB + (size_t)2 * TC * LDPE * 2);
constexpr size_t OFF_ACT = OFF_BIG;
constexpr size_t OFF_CQ = OFF_BIG;
constexpr size_t OFF_CKV = AL(OFF_CQ + (size_t)TC * LDCQ * 2);
constexpr size_t OFF_QA = AL(OFF_CKV + (size_t)TC * LDCKV * 2);
constexpr size_t OFF_KA = AL(OFF_QA + (size_t)TC * 768 * 2);
constexpr size_t OFF_VTA = AL(OFF_KA + (size_t)TC * 768 * 2);
constexpr size_t OFF_QB = AL(OFF_VTA + (size_t)(TC + 256) * 512 * 2);
constexpr size_t OFF_KB = AL(OFF_QB + (size_t)TC * 768 * 2);
constexpr size_t OFF_VTB = AL(OFF_KB + (size_t)TC * 768 * 2);
constexpr size_t OFF_QC = AL(OFF_VTB + (size_t)(TC + 256) * 768 * 2);
constexpr size_t OFF_KC = AL(OFF_QC + (size_t)TC * 512 * 2);
constexpr size_t OFF_VTC = AL(OFF_KC + (size_t)TC * 128 * 2);
constexpr size_t OFF_OA = AL(OFF_VTC + (size_t)(TC + 256) * 128 * 2);
constexpr size_t OFF_OBG = AL(OFF_OA + (size_t)TC * LDO * 2);
constexpr size_t OFF_LSE = AL(OFF_OBG + (size_t)TC * 768 * 2);
constexpr size_t OFF_OB = AL(OFF_LSE + (size_t)TC * 12 * 4);
constexpr size_t OFF_OC = AL(OFF_OB + (size_t)TC * LDOB * 2);
constexpr size_t OFF_MRG = AL(OFF_OC + (size_t)TC * LDO * 2);
constexpr size_t OFF_END = AL(OFF_MRG + (size_t)TC * LDX * 2);
static_assert(OFF_END < (size_t)508 * 1024 * 1024, "workspace too large");
static_assert(OFF_ACT + (size_t)TC * LDACT * 2 <= OFF_END, "act fits");

struct Params {
  const float* in[32];
  float* out;
  char* ws;
};

constexpr int LROW = 144;
constexpr int STAGE_OP = 128 * LROW;
constexpr int STAGE = 2 * STAGE_OP;
constexpr int CLD = 132;
constexpr int OFF_RR = 2 * STAGE;
constexpr int LDS_BYTES = 2 * STAGE + 1024;
static_assert(128 * CLD * 4 <= OFF_RR, "lds");

DI int tid_() { int t = threadIdx.x; asm volatile("" : "+v"(t)); return t; }
DI unsigned pk2(float a, float b) { f32x2 v = {a, b}; bf16x2_t r = __builtin_convertvector(v, bf16x2_t); return __builtin_bit_cast(unsigned, r); }
DI bf16_t f2bf(float a) { return (bf16_t)(pk2(a, 0.f) & 0xffffu); }
DI float bf2f(bf16_t v) { return __uint_as_float(((unsigned)v) << 16); }
DI float sigmoidf_(float x) { return 1.0f / (1.0f + __expf(-x)); }

DI int map_col(int map, int n) {
  switch (map) {
    case 0: return n;
    case 1: { int t = n >> 7, w = n & 127; return w < 64 ? t * 64 + w : DFF + t * 64 + (w - 64); }
    case 2: { int slot = n >> 6, d = n & 63; if (slot < 6) return n; if (slot == 6) return d < 32 ? 384 + d : -1; if (slot < 55) return 416 + (n - 448); return -1; }
    case 3: { if (n < 512) return (n >> 6) * 96 + (n & 63); int i = n - 512; return (i >> 5) * 96 + 64 + (i & 31); }
    default: { if (n < 512) return (n >> 6) * 128 + (n & 63); int i = n - 512; return (i >> 6) * 128 + 64 + (i & 63); }
  }
}

DI void transpose_mat(const float* __restrict__ src, int ld_src, bf16_t* __restrict__ dst, int N, int K, const float* __restrict__ gain, int map, float* lds, int rot) {
  const int ntk = K >> 6, ntn = N >> 6, nt = ntk * ntn;
  const int tid = tid_(), c = tid & 63, rq = tid >> 6;
  int b0 = (int)blockIdx.x - (rot % (int)gridDim.x); if (b0 < 0) b0 += gridDim.x;
  for (int t = b0; t < nt; t += gridDim.x) {
    const int tn = t / ntk, tk = t - tn * ntk;
    const int n0 = tn << 6, k0 = tk << 6;
    const int sc = map_col(map, n0 + c);
#pragma unroll 4
    for (int r = 0; r < 16; ++r) {
      const int kk = r * 4 + rq;
      float v = 0.f;
      if (sc >= 0) { v = src[(size_t)(k0 + kk) * ld_src + sc]; if (gain) v *= gain[k0 + kk]; }
      lds[c * 65 + kk] = v;
    }
    __syncthreads();
#pragma unroll 4
    for (int r = 0; r < 16; ++r) {
      const int nn = r * 4 + rq;
      dst[(size_t)(n0 + nn) * (K + PADK) + k0 + c] = f2bf(lds[nn * 65 + c]);
    }
    __syncthreads();
  }
}

template <int NJ> DI void zero_acc(f32x16 (&acc)[2][NJ]) {
#pragma unroll
  for (int i = 0; i < 2; ++i)
#pragma unroll
    for (int j = 0; j < NJ; ++j)
#pragma unroll
      for (int r = 0; r < 16; ++r) acc[i][j][r] = 0.f;
}

constexpr int GSTG_B = 128 * 128;
constexpr int GSTG = 2 * GSTG_B;
template <int NJ> DI void gemm_mainloop_glds(const bf16_t* __restrict__ A, int lda, const bf16_t* __restrict__ Bt, int ldb, int K, f32x16 (&acc)[2][NJ], char* lds) {
  const int tid = tid_(), lane = tid & 63, w = __builtin_amdgcn_readfirstlane(tid >> 6), wm = w >> 1, wn = w & 1;
  const int ql = lane & 31, h = lane >> 5;
  const int sw_s = (4 * (w & 1) + (lane >> 4)) & 7;
  const int csrc = (lane & 7) ^ sw_s;
  const char* ap = (const char*)A;
  const char* bp = (const char*)Bt;
  const unsigned aoff = (unsigned)((8 * w + (lane >> 3)) * lda + csrc * 8) * 2u, boff = (unsigned)((8 * w + (lane >> 3)) * ldb + csrc * 8) * 2u;
  const unsigned astep = (unsigned)(32 * lda) * 2u, bstep = (unsigned)(32 * ldb) * 2u;
  constexpr int NB = 2 * NJ;
  const int sw_r = (ql >> 1) & 7;
  int a_rd[4], b_rd[4];
#pragma unroll
  for (int ks = 0; ks < 4; ++ks) { const int pos = ((2 * ks + h) ^ sw_r) * 16; a_rd[ks] = (wm * 64 + ql) * 128 + pos; b_rd[ks] = GSTG_B + (wn * 32 * NJ + ql) * 128 + pos; }
#define GSTAGE_(ST) { char* sb_ = lds + (ST) * GSTG + w * 1024; \
    _Pragma("unroll") for (int i_ = 0; i_ < 4; ++i_) __builtin_amdgcn_global_load_lds((const unsigned*)(ap + (aoff + i_ * astep)), (unsigned*)(sb_ + i_ * 4096), 16, 0, 0); \
    _Pragma("unroll") for (int i_ = 0; i_ < NB; ++i_) __builtin_amdgcn_global_load_lds((const unsigned*)(bp + (boff + i_ * bstep)), (unsigned*)(sb_ + GSTG_B + i_ * 4096), 16, 0, 0); \
    ap += 128; bp += 128; }
  GSTAGE_(0);
  asm volatile("s_waitcnt vmcnt(0)" ::: "memory");
  __syncthreads();
  const int nk = K >> 6;
  for (int kt = 0; kt < nk; ++kt) {
    const int cur = kt & 1;
    if (kt + 1 < nk) GSTAGE_(cur ^ 1);
    const char* st_ = lds + cur * GSTG;
#pragma unroll
    for (int ks = 0; ks < 4; ++ks) {
      const bf16x8 a0 = *(const bf16x8*)(st_ + a_rd[ks]);
      const bf16x8 a1 = *(const bf16x8*)(st_ + a_rd[ks] + 4096);
#pragma unroll
      for (int j = 0; j < NJ; ++j) {
        const bf16x8 b = *(const bf16x8*)(st_ + b_rd[ks] + j * 4096);
        acc[0][j] = MFMA(a0, b, acc[0][j]); acc[1][j] = MFMA(a1, b, acc[1][j]);
      }
    }
    asm volatile("s_waitcnt vmcnt(0)" ::: "memory");
    __syncthreads();
  }
#undef GSTAGE_
}

template <int NJ> DI void gemm_mainloop_reg(const bf16_t* __restrict__ A, int lda, const bf16_t* __restrict__ Bt, int ldb, int K, f32x16 (&acc)[2][NJ], char* lds) {
  const int tid = tid_(), lane = tid & 63, w = tid >> 6, wm = w >> 1, wn = w & 1;
  const int lr = tid >> 3, lc = tid & 7;
  const char* ap = (const char*)A;
  const char* bp = (const char*)Bt;
  const unsigned aoff = (unsigned)(lr * lda + lc * 8) * 2u, boff = (unsigned)(lr * ldb + lc * 8) * 2u;
  const unsigned astep = (unsigned)(32 * lda) * 2u, bstep = (unsigned)(32 * ldb) * 2u;
  constexpr int NB = 2 * NJ;
  u32x4 ra0[4], rb0[NB], ra1[4], rb1[NB];
  const int wofs = lr * LROW + lc * 16;
  const int a_rd = (wm * 64 + (lane & 31)) * LROW + (lane >> 5) * 16;
  const int b_rd = STAGE_OP + (wn * 32 * NJ + (lane & 31)) * LROW + (lane >> 5) * 16;
#define GL1_(RA, RB, i) { RA[i] = *(const u32x4*)(ap + (aoff + (i) * astep)); if ((i) < NB) RB[(i) < NB ? (i) : 0] = *(const u32x4*)(bp + (boff + (i) * bstep)); }
#define LS1_(RA, RB, ST, i) { char* sn_ = lds + (ST) * STAGE; *(u32x4*)(sn_ + wofs + (i) * 32 * LROW) = RA[i]; \
                              if ((i) < NB) *(u32x4*)(sn_ + STAGE_OP + wofs + (i) * 32 * LROW) = RB[(i) < NB ? (i) : 0]; }
#define RF_(ks) { fa0 = *(const bf16x8*)(st_ + a_rd + (ks) * 32); fa1 = *(const bf16x8*)(st_ + a_rd + 32 * LROW + (ks) * 32); \
      _Pragma("unroll") for (int j = 0; j < NJ; ++j) fb[j] = *(const bf16x8*)(st_ + b_rd + j * 32 * LROW + (ks) * 32); }
#define STEP_(ST, DOL, RAL, RBL, DOS, RAS, RBS) { const char* st_ = lds + (ST) * STAGE; \
    bf16x8 fa0, fa1, fb[NJ]; RF_(0); \
    _Pragma("unroll") for (int ks = 0; ks < 4; ++ks) { \
      if (DOL) GL1_(RAL, RBL, ks); \
      const bf16x8 ca0 = fa0, ca1 = fa1; bf16x8 cb[NJ]; \
      _Pragma("unroll") for (int j = 0; j < NJ; ++j) cb[j] = fb[j]; \
      if (ks < 3) RF_(ks + 1); \
      _Pragma("unroll") for (int j = 0; j < NJ; ++j) { acc[0][j] = MFMA(ca0, cb[j], acc[0][j]); acc[1][j] = MFMA(ca1, cb[j], acc[1][j]); } \
      if (DOS) LS1_(RAS, RBS, 1 - (ST), ks); \
      __builtin_amdgcn_sched_barrier(0); } \
    if (DOL) { ap += 128; bp += 128; } }
#pragma unroll
  for (int i = 0; i < 4; ++i) GL1_(ra0, rb0, i);
  ap += 128; bp += 128;
#pragma unroll
  for (int i = 0; i < 4; ++i) GL1_(ra1, rb1, i);
  ap += 128; bp += 128;
#pragma unroll
  for (int i = 0; i < 4; ++i) LS1_(ra0, rb0, 0, i);
  __syncthreads();
  const int nk = K >> 6;
  for (int kt = 0; kt < nk; kt += 2) {
    const bool l0 = (kt + 2 < nk), l1 = (kt + 3 < nk);
    STEP_(0, l0, ra0, rb0, true, ra1, rb1);
    __syncthreads();
    STEP_(1, l1, ra1, rb1, l0, ra0, rb0);
    __syncthreads();
  }
#undef GL1_
#undef LS1_
#undef STEP_
#undef RF_
}

template <int NJ> DI void acc_to_lds(const f32x16 (&acc)[2][NJ], float* cl) {
  const int tid = tid_(), lane = tid & 63, w = tid >> 6, wm = w >> 1, wn = w & 1, h = lane >> 5, c = lane & 31;
#pragma unroll
  for (int i = 0; i < 2; ++i)
#pragma unroll
    for (int j = 0; j < NJ; ++j)
#pragma unroll
      for (int r = 0; r < 16; ++r) {
        const int row = wm * 64 + i * 32 + (r & 3) + 8 * (r >> 2) + 4 * h;
        cl[row * CLD + wn * 32 * NJ + j * 32 + c] = acc[i][j][r];
      }
}

template <int NJ> DI void resid_epilogue(float* __restrict__ x, bf16_t* __restrict__ xb, float* __restrict__ ssn, int mt, int nt, const float* cl, float scale) {
  constexpr int LPR = 16 * NJ, RPP = 256 / LPR, NP = 128 / RPP;
  const int tid = tid_(), c4 = (tid & (LPR - 1)) * 4, r0 = tid / LPR;
#pragma unroll 4
  for (int it = 0; it < NP; ++it) {
    const int row = r0 + RPP * it;
    const f32x4 c = *(const f32x4*)(cl + row * CLD + c4);
    const size_t gi = (size_t)(mt * 128 + row) * DM + nt * (64 * NJ) + c4;
    f32x4 xv = *(const f32x4*)(x + gi);
    xv = xv + scale * c;
    *(f32x4*)(x + gi) = xv;
    u32x2 p; p.x = pk2(xv[0], xv[1]); p.y = pk2(xv[2], xv[3]);
    *(u32x2*)(xb + (size_t)(mt * 128 + row) * LDX + nt * (64 * NJ) + c4) = p;
    float s_ = xv[0] * xv[0] + xv[1] * xv[1] + xv[2] * xv[2] + xv[3] * xv[3];
    if (NJ == 2) s_ += __shfl_xor(s_, 16);
    s_ += __shfl_xor(s_, 8); s_ += __shfl_xor(s_, 4); s_ += __shfl_xor(s_, 2); s_ += __shfl_xor(s_, 1);
    if ((tid & (LPR - 1)) == 0) atomicAdd(ssn + mt * 128 + row, s_);
  }
}

#define XB_TMO      128
#define XB_XCNT(j)  (256  + 64 * (j))
#define XB_XSUB(j)  (1280 + 64 * (j))
#define XB_XGEN(j)  (2304 + 64 * (j))
#define XB_TOP      3328
#define XB_TOPGEN   3392
#define XCD_BAR_WORDS 3456
#define XB_SPIN_CAP (1u << 22)
#define LAS __attribute__((address_space(3)))
DI unsigned xb_ld(unsigned* p)              { return __hip_atomic_load(p, __ATOMIC_RELAXED, __HIP_MEMORY_SCOPE_AGENT); }
DI unsigned xb_add(unsigned* p, unsigned v) { return __hip_atomic_fetch_add(p, v, __ATOMIC_RELAXED, __HIP_MEMORY_SCOPE_AGENT); }
DI unsigned xb_xcc_id() { return (unsigned)__builtin_amdgcn_s_getreg((3 << 11) | 20) & 0xFu; }
#define XB_SPIN(cond, bar) do { unsigned _sp = 0; while (cond) { __builtin_amdgcn_s_sleep(1); \
    if ((++_sp & 255u) == 0u) { if (xb_ld(&(bar)[XB_TMO])) break; if (_sp > XB_SPIN_CAP) { atomicAdd(&(bar)[XB_TMO], 1u); break; } } } } while (0)
struct XcdBarrier { unsigned* bar; unsigned x; volatile LAS unsigned* st; };
DI XcdBarrier xcd_barrier_post(unsigned* bar, volatile LAS unsigned* st) {
  XcdBarrier b; b.bar = bar; b.x = xb_xcc_id(); b.st = st;
  if (threadIdx.x == 0) (void)xb_add(&bar[XB_XCNT(b.x)], 1u);
  return b;
}
DI void xcd_barrier_complete(unsigned* bar, unsigned x, unsigned& nloc, unsigned& nx) {
  const unsigned G = gridDim.x * gridDim.y * gridDim.z;
  unsigned sum, cnt, mine, sp = 0u;
  for (;;) {
    sum = 0u; cnt = 0u; mine = 0u;
#pragma unroll
    for (unsigned j = 0; j < 16; ++j) { const unsigned c = xb_ld(&bar[XB_XCNT(j)]); sum += c; cnt += (c > 0u) ? 1u : 0u; mine = (j == x) ? c : mine; }
    if (sum == G) break;
    __builtin_amdgcn_s_sleep(1);
    if ((++sp & 255u) == 0u) { if (xb_ld(&bar[XB_TMO])) break; if (sp > XB_SPIN_CAP) { atomicAdd(&bar[XB_TMO], 1u); break; } }
  }
  nloc = mine > 0u ? mine : 1u; nx = cnt > 0u ? cnt : 1u;
}
DI void xcd_barrier(const XcdBarrier& b) {
  asm volatile("s_waitcnt vmcnt(0)" ::: "memory");
  __syncthreads();
  if (threadIdx.x == 0) {
    unsigned* bar = b.bar;
    __builtin_amdgcn_s_waitcnt(0);
    unsigned nloc = b.st[0], nx = b.st[1];
    if (nloc == 0u) { xcd_barrier_complete(bar, b.x, nloc, nx); b.st[0] = nloc; b.st[1] = nx; }
    const unsigned old = xb_add(&bar[XB_XSUB(b.x)], 1u);
    const unsigned gen = old / nloc;
    if (old + 1u == (gen + 1u) * nloc) {
      __builtin_amdgcn_fence(__ATOMIC_RELEASE, "agent");
      asm volatile("s_waitcnt vmcnt(0)" ::: "memory");
      const unsigned og = xb_add(&bar[XB_TOP], 1u);
      const unsigned tg = og / nx;
      if (og + 1u == (tg + 1u) * nx) xb_add(&bar[XB_TOPGEN], 1u);
      else XB_SPIN(xb_ld(&bar[XB_TOPGEN]) == tg, bar);
      __builtin_amdgcn_fence(__ATOMIC_ACQUIRE, "agent");
      xb_add(&bar[XB_XGEN(b.x)], 1u);
      asm volatile("s_waitcnt vmcnt(0)" ::: "memory");
    } else {
      XB_SPIN(xb_ld(&bar[XB_XGEN(b.x)]) == gen, bar);
      __builtin_amdgcn_fence(__ATOMIC_ACQUIRE, "agent");
      asm volatile("s_waitcnt vmcnt(0)" ::: "memory");
    }
  }
  __syncthreads();
}

constexpr int CTR_ATTN = 3520, CTR_FFN = 3584, CTR_PROJ = 3840;
DI int grab_next(unsigned* ctr, char* lds) {
  volatile int* nx = (volatile int*)(lds + OFF_RR + 528);
  if (tid_() == 0) *nx = (int)__hip_atomic_fetch_add(ctr, 1u, __ATOMIC_RELAXED, __HIP_MEMORY_SCOPE_AGENT);
  __syncthreads();
  const int v = __builtin_amdgcn_readfirstlane(*nx);
  __syncthreads();
  return v;
}

struct Ctx {
  const Params* p;
  int chunk, layer;
  int S, sshift;
  float* x;
  const float* xin;
  const float* pe0; size_t pe_ls;
  char* ws;
  char* lds;
};
DI bf16_t* wsb(const Ctx& c, size_t off) { return (bf16_t*)(c.ws + off); }
DI float* ss_site(const Ctx& c, int layer, int site) { return (float*)(c.ws + OFF_SS) + ((size_t)layer * 6 + site) * TC; }
DI const bf16_t* wgt(const Ctx& c, size_t off) { return (const bf16_t*)(c.ws + OFF_W) + (size_t)c.layer * W_LAYER + off; }
DI const float* inl(const Ctx& c, int idx, size_t per_layer) { return c.p->in[idx] + (size_t)c.layer * per_layer; }

DI void phase_ffn_in(const Ctx& c, const bf16_t* A, size_t woff, int site) {
  const bf16_t* Bt = wgt(c, woff);
  bf16_t* act = wsb(c, OFF_ACT);
  const float* ss = ss_site(c, c.layer, site);
  float* cl = (float*)c.lds; float* rr = (float*)(c.lds + OFF_RR);
  const int tid = tid_();
  const int xcd_ = blockIdx.x & 7;
  unsigned* ctr = (unsigned*)(c.ws + OFF_BAR) + CTR_FFN + ((c.chunk * 2 + c.layer) * 2 + (site == 2 ? 1 : 0)) * 8 + xcd_;
  for (;;) {
    const int j_ = grab_next(ctr, c.lds);
    if (j_ >= 16 * 44) break;
    const int mt = xcd_ * 16 + (j_ & 15), nt = j_ >> 4;
    f32x16 acc[2][2]; zero_acc<2>(acc);
    gemm_mainloop_reg<2>(A + (size_t)mt * 128 * LDX, LDX, Bt + (size_t)nt * 128 * LDX, LDX, DM, acc, c.lds);
    acc_to_lds<2>(acc, cl);
    if (tid < 128) rr[tid] = rsqrtf(ss[mt * 128 + tid] * (1.0f / DM) + EPS);
    __syncthreads();
    const int c4 = (tid & 15) * 4, r0 = tid >> 4;
#pragma unroll 2
    for (int it = 0; it < 8; ++it) {
      const int row = r0 + 16 * it;
      const float r = rr[row];
      const f32x4 a = *(const f32x4*)(cl + row * CLD + c4);
      const f32x4 b = *(const f32x4*)(cl + row * CLD + 64 + c4);
      float o[4];
#pragma unroll
      for (int e = 0; e < 4; ++e) { const float av = a[e] * r, bv = b[e] * r; o[e] = av * sigmoidf_(av) * bv; }
      u32x2 pq; pq.x = pk2(o[0], o[1]); pq.y = pk2(o[2], o[3]);
      *(u32x2*)(act + (size_t)(mt * 128 + row) * LDACT + nt * 64 + c4) = pq;
    }
    __syncthreads();
  }
}

#if DUP == 300
DI void phase_ffn_probe(const Ctx& c, const bf16_t* A, size_t woff, int site) {
  const bf16_t* Bt = wgt(c, woff);
  bf16_t* act = (bf16_t*)(c.ws + OFF_ACT + (size_t)110 * 1024 * 1024);
  const float* ss = ss_site(c, c.layer, site);
  float* cl = (float*)c.lds; float* rr = (float*)(c.lds + OFF_RR);
  const int tid = tid_();
  const int xcd_ = blockIdx.x & 7, slot_ = blockIdx.x >> 3, nslot_ = gridDim.x >> 3;
  for (int j_ = slot_; j_ < 16 * 44; j_ += nslot_) {
    const int mt = xcd_ * 16 + (j_ & 15), nt = j_ >> 4;
    f32x16 acc[2][2]; zero_acc<2>(acc);
    gemm_mainloop_reg<2>(A + (size_t)(mt & 1) * 128 * LDX, LDX, Bt + (size_t)(nt & 1) * 128 * LDX, LDX, DM, acc, c.lds);
    acc_to_lds<2>(acc, cl);
    if (tid < 128) rr[tid] = rsqrtf(ss[mt * 128 + tid] * (1.0f / DM) + EPS);
    __syncthreads();
    const int c4 = (tid & 15) * 4, r0 = tid >> 4;
#pragma unroll 2
    for (int it = 0; it < 8; ++it) {
      const int row = r0 + 16 * it;
      const float r = rr[row];
      const f32x4 a = *(const f32x4*)(cl + row * CLD + c4);
      const f32x4 b = *(const f32x4*)(cl + row * CLD + 64 + c4);
      float o[4];
#pragma unroll
      for (int e = 0; e < 4; ++e) { const float av = a[e] * r, bv = b[e] * r; o[e] = av * sigmoidf_(av) * bv; }
      u32x2 pq; pq.x = pk2(o[0], o[1]); pq.y = pk2(o[2], o[3]);
      *(u32x2*)(act + (size_t)(mt * 128 + row) * LDACT + nt * 64 + c4) = pq;
    }
    __syncthreads();
  }
}
#endif

DI void phase_resid_gemm(const Ctx& c, const bf16_t* A, int K, size_t woff, float scale, float* ssn) {
  const bf16_t* Bt = wgt(c, woff);
  bf16_t* xb = wsb(c, OFF_XB);
  float* cl = (float*)c.lds;
  const int xcd_ = blockIdx.x & 7, slot_ = blockIdx.x >> 3, nslot_ = gridDim.x >> 3;
  for (int j_ = slot_; j_ < 16 * 8; j_ += nslot_) {
    const int mt = xcd_ * 16 + (j_ & 15), nt = j_ >> 4;
    f32x16 acc[2][2]; zero_acc<2>(acc);
    gemm_mainloop_reg<2>(A + (size_t)mt * 128 * (K + PADK), K + PADK, Bt + (size_t)nt * 128 * (K + PADK), K + PADK, K, acc, c.lds);
    acc_to_lds<2>(acc, cl);
    __syncthreads();
    resid_epilogue<2>(c.x, xb, ssn, mt, nt, cl, scale);
    __syncthreads();
  }
}

DI void load_slot(const float* cl, int row, int col0, float (&v)[64]) {
#pragma unroll
  for (int q = 0; q < 16; ++q) { const f32x4 t = *(const f32x4*)(cl + row * CLD + col0 + q * 4); v[4 * q] = t[0]; v[4 * q + 1] = t[1]; v[4 * q + 2] = t[2]; v[4 * q + 3] = t[3]; }
}
template <int N> DI void store_bf16(bf16_t* dst, const float* v) {
#pragma unroll
  for (int q = 0; q < N / 8; ++q) { u32x4 p; p.x = pk2(v[8 * q], v[8 * q + 1]); p.y = pk2(v[8 * q + 2], v[8 * q + 3]); p.z = pk2(v[8 * q + 4], v[8 * q + 5]); p.w = pk2(v[8 * q + 6], v[8 * q + 7]); *(u32x4*)(dst + 8 * q) = p; }
}
template <int N> DI void rmsnorm_inplace(float* v, const float* __restrict__ g) {
  float s = 0.f;
#pragma unroll
  for (int i = 0; i < N; ++i) s += v[i] * v[i];
  const float r = rsqrtf(s * (1.0f / N) + EPS);
#pragma unroll
  for (int i = 0; i < N; ++i) v[i] = v[i] * r * g[i];
}
DI void rope32(float* v, const f32x2* __restrict__ tab  ) {
#pragma unroll
  for (int i = 0; i < 16; ++i) { const f32x2 cs = tab[i]; const float x1 = v[i], x2 = v[i + 16]; v[i] = x1 * cs.x - x2 * cs.y; v[i + 16] = x1 * cs.y + x2 * cs.x; }
}
DI void vt_write(const float* cl, const float* rr, int col0, int u, bf16_t* dst_row  , int dsh, int L, int pos0) {
  const int d = u & 63, th = u >> 6;
  float v[64];
#pragma unroll
  for (int i = 0; i < 64; ++i) v[i] = cl[(th * 64 + i) * CLD + col0 + d] * rr[th * 64 + i];
  const int p0 = pos0 + th * 64;
  if (dsh == 0) {
    store_bf16<64>(dst_row + p0, v);
  } else if (dsh == 2) {
#pragma unroll
    for (int rr_ = 0; rr_ < 4; ++rr_) {
      float t[16];
#pragma unroll
      for (int a = 0; a < 16; ++a) t[a] = v[4 * a + rr_];
      store_bf16<16>(dst_row + rr_ * L + (p0 >> 2), t);
    }
  } else {
#pragma unroll
    for (int rr_ = 0; rr_ < 16; ++rr_) {
      u32x2 p; p.x = pk2(v[rr_], v[16 + rr_]); p.y = pk2(v[32 + rr_], v[48 + rr_]);
      *(u32x2*)(dst_row + rr_ * L + (p0 >> 4)) = p;
    }
  }
}

DI void phase_proj(const Ctx& c, bool dummy_ss = false) {
  const bf16_t* A = wsb(c, OFF_XB);
  const bf16_t* Bt = wgt(c, W_IN);
  const float* ss = ss_site(c, c.layer, 1);
  float* ss_cq = ss_site(c, dummy_ss ? 2 : c.layer, 4);
  float* ss_ckv = ss_site(c, dummy_ss ? 2 : c.layer, 5);
  float* cl = (float*)c.lds; float* rr = (float*)(c.lds + OFF_RR);
  const f32x2* rope = (const f32x2*)(c.ws + OFF_ROPE);
  const int tid0 = tid_();
  const int S = c.S, sshift = c.sshift;
  const int xcd_ = blockIdx.x & 7;
  unsigned* ctr = (unsigned*)(c.ws + OFF_BAR) + CTR_PROJ + (c.chunk * 2 + c.layer + (dummy_ss ? 6 : 0)) * 8 + xcd_;
  for (;;) {
    const int j_ = grab_next(ctr, c.lds);
    if (j_ >= 16 * 28) break;
    const int mt = xcd_ * 16 + (j_ & 15), nt = j_ >> 4;
    f32x16 acc[2][2]; zero_acc<2>(acc);
    gemm_mainloop_reg<2>(A + (size_t)mt * 128 * LDX, LDX, Bt + (size_t)nt * 128 * LDX, LDX, DM, acc, c.lds);
    acc_to_lds<2>(acc, cl);
    const int tid = tid_(), half = __builtin_amdgcn_readfirstlane(tid >> 7), u = tid & 127;
    if (tid < 128) rr[tid] = rsqrtf(ss[mt * 128 + tid] * (1.0f / DM) + EPS);
    __syncthreads();
    const int slot = nt * 2 + half, col0 = half * 64;
    const int tl0 = mt * 128, seq = tl0 >> sshift, pos0 = tl0 & (S - 1);
    const bool is_vb = (slot >= 31 && slot < 43), is_vc = (slot == 53 || slot == 54);
    if (is_vb) {
      const int hb = slot - 31, dsh = 2 * (hb >> 2);
      bf16_t* dst = wsb(c, OFF_VTB) + ((size_t)(seq * 12 + hb) * 64 + (u & 63)) * (S + 64);
      vt_write(cl, rr, col0, u, dst, dsh, S >> dsh, pos0);
    } else if (is_vc) {
      const int hv = slot - 53;
      bf16_t* dst = wsb(c, OFF_VTC) + ((size_t)(seq * 2 + hv) * 64 + (u & 63)) * (S + 64);
      vt_write(cl, rr, col0, u, dst, 0, S, pos0);
    } else if (slot < 55) {
      const int row = u, tl = tl0 + row, pos = pos0 + row;
      const float r = rr[row];
      float v[64];
      load_slot(cl, row, col0, v);
#pragma unroll
      for (int i = 0; i < 64; ++i) v[i] *= r;
      if (slot < 6) {
        float s = 0.f;
#pragma unroll
        for (int i = 0; i < 64; ++i) s += v[i] * v[i];
        if (slot < 4) { store_bf16<64>(wsb(c, OFF_CQ) + (size_t)tl * LDCQ + slot * 64, v); atomicAdd(ss_cq + tl, s); }
        else { store_bf16<64>(wsb(c, OFF_CKV) + (size_t)tl * LDCKV + (slot - 4) * 64, v); atomicAdd(ss_ckv + tl, s); }
      } else if (slot == 6) {
        rmsnorm_inplace<32>(v, inl(c, 14, 96) + 64);
        rope32(v, rope + (size_t)pos * 16);
        bf16_t* dst = wsb(c, OFF_KA) + ((size_t)(seq * 8) * S + pos) * 96 + 64;
#pragma unroll
        for (int hh = 0; hh < 8; ++hh) store_bf16<32>(dst + (size_t)hh * S * 96, v);
      } else if (slot < 31) {
        const bool isq = slot < 19;
        const int hb = isq ? slot - 7 : slot - 19, dsh = 2 * (hb >> 2), L = S >> dsh;
        rmsnorm_inplace<64>(v, inl(c, isq ? 15 : 16, 64));
        const int srow = (pos & ((1 << dsh) - 1)) * L + (pos >> dsh);
        bf16_t* dst = wsb(c, isq ? OFF_QB : OFF_KB) + ((size_t)(seq * 12 + hb) * S + srow) * 64;
        store_bf16<64>(dst, v);
      } else {
        const bool isq = slot < 51;
        rmsnorm_inplace<64>(v, inl(c, isq ? 18 : 19, 64));
        bf16_t* dst = isq ? wsb(c, OFF_QC) + ((size_t)(seq * 8 + (slot - 43)) * S + pos) * 64
                          : wsb(c, OFF_KC) + ((size_t)(seq * 2 + (slot - 51)) * S + pos) * 64;
        asm volatile("" ::: "memory");
        rope32(v, rope + (size_t)(pos >> 6) * 16);
        store_bf16<32>(dst, v);
        asm volatile("" ::: "memory");
        rope32(v + 32, rope + (size_t)(pos & 63) * 16);
        store_bf16<32>(dst + 32, v + 32);
      }
    }
    __syncthreads();
  }
}

DI void phase_mlaup(const Ctx& c) {
  const float* ss_cq = ss_site(c, c.layer, 4);
  const float* ss_ckv = ss_site(c, c.layer, 5);
  float* cl = (float*)c.lds; float* rr = (float*)(c.lds + OFF_RR);
  const f32x2* rope = (const f32x2*)(c.ws + OFF_ROPE);
  const int tid0 = tid_();
  const int S = c.S, sshift = c.sshift;
  const int xcd_ = blockIdx.x & 7, slot_ = blockIdx.x >> 3, nslot_ = gridDim.x >> 3;
  for (int j_ = slot_; j_ < 16 * 14; j_ += nslot_) {
    const int mt = xcd_ * 16 + (j_ & 15), nt = j_ >> 4;
    const bool isq = nt < 6;
    f32x16 acc[2][2]; zero_acc<2>(acc);
    if (isq) gemm_mainloop_reg<2>(wsb(c, OFF_CQ) + (size_t)mt * 128 * LDCQ, LDCQ, wgt(c, W_UQ) + (size_t)nt * 128 * LDCQ, LDCQ, 256, acc, c.lds);
    else gemm_mainloop_reg<2>(wsb(c, OFF_CKV) + (size_t)mt * 128 * LDCKV, LDCKV, wgt(c, W_UKV) + (size_t)(nt - 6) * 128 * LDCKV, LDCKV, 128, acc, c.lds);
    acc_to_lds<2>(acc, cl);
    const int tid = tid_(), half = __builtin_amdgcn_readfirstlane(tid >> 7), u = tid & 127;
    if (tid < 128) rr[tid] = isq ? rsqrtf(ss_cq[mt * 128 + tid] * (1.0f / 256) + EPS) : rsqrtf(ss_ckv[mt * 128 + tid] * (1.0f / 128) + EPS);
    __syncthreads();
    const int col0 = half * 64;
    const int tl0 = mt * 128, seq = tl0 >> sshift, pos0 = tl0 & (S - 1);
    if (!isq && nt >= 10) {
      const int hv = (nt - 10) * 2 + half;
      bf16_t* dst = wsb(c, OFF_VTA) + ((size_t)(seq * 8 + hv) * 64 + (u & 63)) * (S + 64);
      vt_write(cl, rr, col0, u, dst, 0, S, pos0);
    } else {
      const int row = u, pos = pos0 + row;
      const float r = rr[row];
      float v[64];
      load_slot(cl, row, col0, v);
#pragma unroll
      for (int i = 0; i < 64; ++i) v[i] *= r;
      if (isq && nt < 4) {
        const int hh = nt * 2 + half;
        rmsnorm_inplace<64>(v, inl(c, 13, 96));
        store_bf16<64>(wsb(c, OFF_QA) + ((size_t)(seq * 8 + hh) * S + pos) * 96, v);
      } else if (isq) {
        const int h0 = ((nt - 4) * 2 + half) * 2;
        rmsnorm_inplace<32>(v, inl(c, 13, 96) + 64);
        rmsnorm_inplace<32>(v + 32, inl(c, 13, 96) + 64);
        rope32(v, rope + (size_t)pos * 16);
        rope32(v + 32, rope + (size_t)pos * 16);
        store_bf16<32>(wsb(c, OFF_QA) + ((size_t)(seq * 8 + h0) * S + pos) * 96 + 64, v);
        store_bf16<32>(wsb(c, OFF_QA) + ((size_t)(seq * 8 + h0 + 1) * S + pos) * 96 + 64, v + 32);
      } else {
        const int hh = (nt - 6) * 2 + half;
        rmsnorm_inplace<64>(v, inl(c, 14, 96));
        store_bf16<64>(wsb(c, OFF_KA) + ((size_t)(seq * 8 + hh) * S + pos) * 96, v);
      }
    }
    __syncthreads();
  }
}

template <int DQK, bool BAND, int QT>
DI void attn_item(const bf16_t* __restrict__ Q, const bf16_t* __restrict__ Kp, const bf16_t* __restrict__ Vt, int ldv,
                  int kbeg, int kend, int q0, const float* bias_g, float scale_log2,
                  bf16_t* __restrict__ out, size_t out_rs, float* __restrict__ lse, int lse_rs, char* lds) {
  constexpr int KROW = DQK * 2 + 16;
  constexpr int KST = 64 * KROW, VST = 64 * LROW, ST = KST + VST;
  constexpr int NKS = DQK / 16;
  constexpr int KV4 = DQK / 8;
  constexpr int NKL = (64 * KV4) / 256;
  constexpr int WQ = 32 * QT;
  const int tid = tid_(), lane = tid & 63, w = tid >> 6, h = lane >> 5, ql = lane & 31;
  float* bias_l = (float*)(lds + 2 * ST);
  if (BAND) { if (tid < 129) bias_l[tid] = bias_g[tid]; }
  bf16x8 qf[QT][NKS];
#pragma unroll
  for (int qt = 0; qt < QT; ++qt)
#pragma unroll
    for (int ks = 0; ks < NKS; ++ks) qf[qt][ks] = *(const bf16x8*)(Q + (size_t)(w * WQ + qt * 32 + ql) * DQK + ks * 16 + h * 8);
  f32x16 o[2][QT];
#pragma unroll
  for (int a = 0; a < 2; ++a)
#pragma unroll
    for (int b = 0; b < QT; ++b)
#pragma unroll
      for (int r = 0; r < 16; ++r) o[a][b][r] = 0.f;
  float m[QT], l[QT];
#pragma unroll
  for (int qt = 0; qt < QT; ++qt) { m[qt] = -1e30f; l[qt] = 0.f; }
  u32x4 rk[NKL], rv[2];
  const int vrow0 = tid >> 3, vch = tid & 7;
  unsigned klds[NKL];
#pragma unroll
  for (int i = 0; i < NKL; ++i) { const int idx = tid + i * 256, kr = idx / KV4, kc = idx - kr * KV4; klds[i] = kr * KROW + kc * 16; }
  const unsigned koff0 = (unsigned)tid * 16u;
  const unsigned voff0 = (unsigned)(vrow0 * ldv + vch * 8) * 2u, vstep = (unsigned)(32 * ldv) * 2u;
  const unsigned vlds0 = KST + vrow0 * LROW + vch * 16;
  auto gload = [&](int kt) {
    const char* kb = (const char*)Kp + (size_t)kt * (DQK * 2);
    const char* vb = (const char*)Vt + (size_t)kt * 2;
#pragma unroll
    for (int i = 0; i < NKL; ++i) rk[i] = *(const u32x4*)(kb + (koff0 + i * 4096u));
#pragma unroll
    for (int i = 0; i < 2; ++i) rv[i] = *(const u32x4*)(vb + (voff0 + i * vstep));
  };
  auto lstore = [&](char* st) {
#pragma unroll
    for (int i = 0; i < NKL; ++i) *(u32x4*)(st + klds[i]) = rk[i];
#pragma unroll
    for (int i = 0; i < 2; ++i) *(u32x4*)(st + vlds0 + i * 32 * LROW) = rv[i];
  };
  gload(kbeg);
  lstore(lds);
  __syncthreads();
  const int pr = (ql & ~12) | ((ql & 4) << 1) | ((ql & 8) >> 1);
  const int k_rd = pr * KROW + h * 16;
  const int v_rd = KST + ql * LROW + h * 16;
  const int qw0 = q0 + w * WQ;
  int it = 0;
  for (int kt = kbeg; kt < kend; kt += 64, ++it) {
    const char* st = lds + (it & 1) * ST;
    const bool more = (kt + 64 < kend);
    if (more) gload(kt + 64);
    bool need = true;
    if (BAND) need = (kt + 63 >= qw0 - 64) && (kt <= qw0 + WQ - 1 + 64);
    if (need) {
      f32x16 s[2][QT];
#pragma unroll
      for (int a = 0; a < 2; ++a)
#pragma unroll
        for (int b = 0; b < QT; ++b)
#pragma unroll
          for (int r = 0; r < 16; ++r) s[a][b][r] = 0.f;
#pragma unroll
      for (int ks = 0; ks < NKS; ++ks) {
        const bf16x8 k0 = *(const bf16x8*)(st + k_rd + ks * 32);
        const bf16x8 k1 = *(const bf16x8*)(st + k_rd + 32 * KROW + ks * 32);
#pragma unroll
        for (int qt = 0; qt < QT; ++qt) {
          s[0][qt] = MFMA(k0, qf[qt][ks], s[0][qt]);
          s[1][qt] = MFMA(k1, qf[qt][ks], s[1][qt]);
        }
      }
      __builtin_amdgcn_s_setprio(3);
      bf16x8 pf[QT][4];
      const float cc = BAND ? 1.0f : scale_log2;
      const float th = BAND ? 8.0f : 8.0f / scale_log2;
#pragma unroll
      for (int qt = 0; qt < QT; ++qt) {
        if (BAND) {
#pragma unroll
          for (int a = 0; a < 2; ++a)
#pragma unroll
            for (int r = 0; r < 16; ++r) {
              const int kidx = kt + 32 * a + (r & 7) + 8 * h + 16 * (r >> 3);
              const int rel = kidx - (qw0 + qt * 32 + ql);
              const bool ok = (rel >= -64) && (rel <= 64);
              const int bi = ok ? rel + 64 : 0;
              s[a][qt][r] = ok ? fmaf(s[a][qt][r], scale_log2, bias_l[bi]) : -1e30f;
            }
        }
        float mx = s[0][qt][0];
#pragma unroll
        for (int r = 1; r < 16; ++r) mx = fmaxf(mx, s[0][qt][r]);
#pragma unroll
        for (int r = 0; r < 16; ++r) mx = fmaxf(mx, s[1][qt][r]);
        mx = fmaxf(mx, __shfl_xor(mx, 32));
        if (__builtin_amdgcn_ballot_w64(mx > m[qt] + th) != 0) {
          const float mn = fmaxf(m[qt], mx);
          const float alpha = __builtin_amdgcn_exp2f((m[qt] - mn) * cc);
          m[qt] = mn;
          l[qt] *= alpha;
#pragma unroll
          for (int r = 0; r < 16; ++r) { o[0][qt][r] *= alpha; o[1][qt][r] *= alpha; }
        }
        const float mc = -m[qt] * cc;
        float ls = 0.f;
#pragma unroll
        for (int a = 0; a < 2; ++a) {
#pragma unroll
          for (int r = 0; r < 16; ++r) { const float pv = __builtin_amdgcn_exp2f(fmaf(s[a][qt][r], cc, mc)); s[a][qt][r] = pv; ls += pv; }
#pragma unroll
          for (int s2 = 0; s2 < 2; ++s2) {
            u32x4 pk;
            pk.x = pk2(s[a][qt][8 * s2 + 0], s[a][qt][8 * s2 + 1]);
            pk.y = pk2(s[a][qt][8 * s2 + 2], s[a][qt][8 * s2 + 3]);
            pk.z = pk2(s[a][qt][8 * s2 + 4], s[a][qt][8 * s2 + 5]);
            pk.w = pk2(s[a][qt][8 * s2 + 6], s[a][qt][8 * s2 + 7]);
            pf[qt][a * 2 + s2] = __builtin_bit_cast(bf16x8, pk);
          }
        }
        l[qt] += ls;
      }
      __builtin_amdgcn_s_setprio(0);
      if (more) lstore(lds + ((it + 1) & 1) * ST);
#pragma unroll
      for (int ks = 0; ks < 4; ++ks) {
        const bf16x8 v0 = *(const bf16x8*)(st + v_rd + ks * 32);
        const bf16x8 v1 = *(const bf16x8*)(st + v_rd + 32 * LROW + ks * 32);
#pragma unroll
        for (int qt = 0; qt < QT; ++qt) {
          o[0][qt] = MFMA(v0, pf[qt][ks], o[0][qt]);
          o[1][qt] = MFMA(v1, pf[qt][ks], o[1][qt]);
        }
      }
    } else {
      if (more) lstore(lds + ((it + 1) & 1) * ST);
    }
    __syncthreads();
  }
#pragma unroll
  for (int qt = 0; qt < QT; ++qt) {
    const float lt = l[qt] + __shfl_xor(l[qt], 32);
    const float inv = 1.0f / lt;
    const int qi = w * WQ + qt * 32 + ql;
    bf16_t* orow = out + (size_t)qi * out_rs;
#pragma unroll
    for (int dt = 0; dt < 2; ++dt)
#pragma unroll
      for (int g = 0; g < 4; ++g) {
        u32x2 p; p.x = pk2(o[dt][qt][4 * g] * inv, o[dt][qt][4 * g + 1] * inv); p.y = pk2(o[dt][qt][4 * g + 2] * inv, o[dt][qt][4 * g + 3] * inv);
        *(u32x2*)(orow + dt * 32 + 8 * g + 4 * h) = p;
      }
    if (BAND) { if (h == 0) lse[(size_t)qi * lse_rs] = m[qt] * LN2 + __logf(lt); }
  }
}

template <int DQK>
DI void attn_dense(const bf16_t* __restrict__ Q, const bf16_t* __restrict__ Kp, const bf16_t* __restrict__ Vt, int ldv,
                   int nkeys, float scale_log2, bf16_t* __restrict__ out, size_t out_rs, char* lds) {
  constexpr int KROW = DQK * 2 + 16;
  constexpr int KST = 64 * KROW, VST = 64 * LROW;
  constexpr int NKS = DQK / 16;
  constexpr int KV4 = DQK / 8;
  constexpr int NKL = (64 * KV4) / 256;
  const int tid = tid_(), lane = tid & 63, w = tid >> 6, h = lane >> 5, ql = lane & 31;
  char* const kbase = lds;
  char* const vbase = lds + 2 * KST;
  bf16x8 qf[NKS];
#pragma unroll
  for (int ks = 0; ks < NKS; ++ks) qf[ks] = *(const bf16x8*)(Q + (size_t)(w * 32 + ql) * DQK + ks * 16 + h * 8);
  f32x16 o[2];
#pragma unroll
  for (int a = 0; a < 2; ++a)
#pragma unroll
    for (int r = 0; r < 16; ++r) o[a][r] = 0.f;
  float m = -1e30f, l = 0.f;
  u32x4 rk[NKL], rv[2];
  const int vrow0 = tid >> 3, vch = tid & 7;
#define GLK_(kt) { const int kt_ = (kt); _Pragma("unroll") for (int i_ = 0; i_ < NKL; ++i_) { const int idx = tid + i_ * 256, kr = idx / KV4, kc = idx - kr * KV4; rk[i_] = *(const u32x4*)(Kp + (size_t)(kt_ + kr) * DQK + kc * 8); } }
#define GLV_(kt) { const int kt_ = (kt); _Pragma("unroll") for (int i_ = 0; i_ < 2; ++i_) rv[i_] = *(const u32x4*)(Vt + (size_t)(vrow0 + 32 * i_) * ldv + kt_ + vch * 8); }
#define LSK_(st) { char* st_ = (st); _Pragma("unroll") for (int i_ = 0; i_ < NKL; ++i_) { const int idx = tid + i_ * 256, kr = idx / KV4, kc = idx - kr * KV4; *(u32x4*)(st_ + kr * KROW + kc * 16) = rk[i_]; } }
#define LSV_(st) { char* st_ = (st); _Pragma("unroll") for (int i_ = 0; i_ < 2; ++i_) *(u32x4*)(st_ + (vrow0 + 32 * i_) * LROW + vch * 16) = rv[i_]; }
  const int pr = (ql & ~12) | ((ql & 4) << 1) | ((ql & 8) >> 1);
  const int k_rd = pr * KROW + h * 16;
  const int v_rd = ql * LROW + h * 16;
  GLK_(0); LSK_(kbase);
  GLK_(64); GLV_(0); LSK_(kbase + KST); LSV_(vbase);
  __syncthreads();
  f32x16 sc[2];
#pragma unroll
  for (int a = 0; a < 2; ++a)
#pragma unroll
    for (int r = 0; r < 16; ++r) sc[a][r] = 0.f;
#pragma unroll
  for (int ks = 0; ks < NKS; ++ks) {
    const bf16x8 k0 = *(const bf16x8*)(kbase + k_rd + ks * 32);
    const bf16x8 k1 = *(const bf16x8*)(kbase + k_rd + 32 * KROW + ks * 32);
    sc[0] = MFMA(k0, qf[ks], sc[0]);
    sc[1] = MFMA(k1, qf[ks], sc[1]);
  }
  __syncthreads();
  const int nt = nkeys >> 6;
  const float cc = scale_log2, th = 8.0f / scale_log2;
  for (int i = 0; i < nt; ++i) {
    const bool more1 = (i + 1 < nt), more2 = (i + 2 < nt);
    if (more2) GLK_((i + 2) * 64);
    if (more1) GLV_((i + 1) * 64);
    float mx = sc[0][0];
#pragma unroll
    for (int r = 1; r < 16; ++r) mx = fmaxf(mx, sc[0][r]);
#pragma unroll
    for (int r = 0; r < 16; ++r) mx = fmaxf(mx, sc[1][r]);
    mx = fmaxf(mx, __shfl_xor(mx, 32));
    if (__builtin_amdgcn_ballot_w64(mx > m + th) != 0) {
      const float mn = fmaxf(m, mx);
      const float alpha = __builtin_amdgcn_exp2f((m - mn) * cc);
      m = mn; l *= alpha;
#pragma unroll
      for (int r = 0; r < 16; ++r) { o[0][r] *= alpha; o[1][r] *= alpha; }
    }
    const char* kn = kbase + ((i + 1) & 1) * KST;
    f32x16 sn[2];
#pragma unroll
    for (int a = 0; a < 2; ++a)
#pragma unroll
      for (int r = 0; r < 16; ++r) sn[a][r] = 0.f;
#pragma unroll
    for (int ks = 0; ks < NKS; ++ks) {
      const bf16x8 k0 = *(const bf16x8*)(kn + k_rd + ks * 32);
      const bf16x8 k1 = *(const bf16x8*)(kn + k_rd + 32 * KROW + ks * 32);
      sn[0] = MFMA(k0, qf[ks], sn[0]);
      sn[1] = MFMA(k1, qf[ks], sn[1]);
    }
    const float mc = -m * cc;
    float ls = 0.f;
    bf16x8 pf[4];
#pragma unroll
    for (int a = 0; a < 2; ++a) {
#pragma unroll
      for (int r = 0; r < 16; ++r) { const float pv = __builtin_amdgcn_exp2f(fmaf(sc[a][r], cc, mc)); sc[a][r] = pv; ls += pv; }
#pragma unroll
      for (int s2 = 0; s2 < 2; ++s2) {
        u32x4 pk;
        pk.x = pk2(sc[a][8 * s2 + 0], sc[a][8 * s2 + 1]);
        pk.y = pk2(sc[a][8 * s2 + 2], sc[a][8 * s2 + 3]);
        pk.z = pk2(sc[a][8 * s2 + 4], sc[a][8 * s2 + 5]);
        pk.w = pk2(sc[a][8 * s2 + 6], sc[a][8 * s2 + 7]);
        pf[a * 2 + s2] = __builtin_bit_cast(bf16x8, pk);
      }
    }
    l += ls;
    const char* vs = vbase + (i & 1) * VST;
#pragma unroll
    for (int ks = 0; ks < 4; ++ks) {
      const bf16x8 v0 = *(const bf16x8*)(vs + v_rd + ks * 32);
      const bf16x8 v1 = *(const bf16x8*)(vs + v_rd + 32 * LROW + ks * 32);
      o[0] = MFMA(v0, pf[ks], o[0]);
      o[1] = MFMA(v1, pf[ks], o[1]);
    }
    if (more2) LSK_(kbase + (i & 1) * KST);
    if (more1) LSV_(vbase + ((i + 1) & 1) * VST);
    __syncthreads();
    sc[0] = sn[0]; sc[1] = sn[1];
  }
#undef GLK_
#undef GLV_
#undef LSK_
#undef LSV_
  const float lt = l + __shfl_xor(l, 32);
  const float inv = 1.0f / lt;
  bf16_t* orow = out + (size_t)(w * 32 + ql) * out_rs;
#pragma unroll
  for (int dt = 0; dt < 2; ++dt)
#pragma unroll
    for (int g = 0; g < 4; ++g) {
      u32x2 p; p.x = pk2(o[dt][4 * g] * inv, o[dt][4 * g + 1] * inv); p.y = pk2(o[dt][4 * g + 2] * inv, o[dt][4 * g + 3] * inv);
      *(u32x2*)(orow + dt * 32 + 8 * g + 4 * h) = p;
    }
}

constexpr bool ATT_PIPE = false;
constexpr int AQT = 2;
constexpr int QBLK = 128 * AQT;
DI void phase_attn(const Ctx& c) {
  const int S = c.S, nseq = TC / S, nqb = S / QBLK;
  const int n_mla = nseq * 8 * nqb, n_gqa = n_mla, n_dil = nseq * 12 * nqb;
  const float* bias = (const float*)(c.ws + OFF_BIAS);
  const int xcd_ = blockIdx.x & 7;
  unsigned* ctr = (unsigned*)(c.ws + OFF_BAR) + CTR_ATTN + (c.chunk * 2 + c.layer) * 8 + xcd_;
  const int n_per_xcd = (n_mla + n_gqa + n_dil) >> 3;
  for (;;) {
    const int jg = grab_next(ctr, c.lds);
    if (jg >= n_per_xcd) break;
    const int item = jg * 8 + xcd_;
    if (item < n_mla) {
      const int hh = item & 7, rest = item >> 3, seq = rest / nqb, qb = rest - seq * nqb;
      const size_t hs = (size_t)(seq * 8 + hh) * S;
      if (ATT_PIPE) attn_dense<96>(wsb(c, OFF_QA) + (hs + qb * QBLK) * 96, wsb(c, OFF_KA) + hs * 96, wsb(c, OFF_VTA) + (size_t)(seq * 8 + hh) * 64 * (S + 64), S + 64,
                     S, 0.10206207261596577f * LOG2E, wsb(c, OFF_OA) + ((size_t)seq * S + qb * QBLK) * LDO + hh * 64, LDO, c.lds);
      else attn_item<96, false, AQT>(wsb(c, OFF_QA) + (hs + qb * QBLK) * 96, wsb(c, OFF_KA) + hs * 96, wsb(c, OFF_VTA) + (size_t)(seq * 8 + hh) * 64 * (S + 64), S + 64,
                     0, S, 0, nullptr, 0.10206207261596577f * LOG2E, wsb(c, OFF_OA) + ((size_t)seq * S + qb * QBLK) * LDO + hh * 64, LDO, nullptr, 0, c.lds);
    } else if (item < n_mla + n_gqa) {
      const int i2 = item - n_mla;
      const int hq = i2 & 7, rest = i2 >> 3, seq = rest / nqb, qb = rest - seq * nqb;
      const size_t hs = (size_t)(seq * 8 + hq) * S, ks = (size_t)(seq * 2 + (hq >> 2)) * S;
      if (ATT_PIPE) attn_dense<64>(wsb(c, OFF_QC) + (hs + qb * QBLK) * 64, wsb(c, OFF_KC) + ks * 64, wsb(c, OFF_VTC) + (size_t)(seq * 2 + (hq >> 2)) * 64 * (S + 64), S + 64,
                     S, 0.125f * LOG2E, wsb(c, OFF_OC) + ((size_t)seq * S + qb * QBLK) * LDO + hq * 64, LDO, c.lds);
      else attn_item<64, false, AQT>(wsb(c, OFF_QC) + (hs + qb * QBLK) * 64, wsb(c, OFF_KC) + ks * 64, wsb(c, OFF_VTC) + (size_t)(seq * 2 + (hq >> 2)) * 64 * (S + 64), S + 64,
                     0, S, 0, nullptr, 0.125f * LOG2E, wsb(c, OFF_OC) + ((size_t)seq * S + qb * QBLK) * LDO + hq * 64, LDO, nullptr, 0, c.lds);
    } else {
      const int i2 = item - n_mla - n_gqa;
      const int hb = i2 % 12, rest = i2 / 12, seq = rest / nqb, blk = rest - seq * nqb;
      const int dsh = 2 * (hb >> 2), L = S >> dsh, dil = 1 << dsh;
      const int srow0 = blk * QBLK, rr = srow0 / L, l0 = srow0 - rr * L;
      const size_t hs = (size_t)(seq * 12 + hb) * S;
      int kb = l0 - 64; if (kb < 0) kb = 0;
      int ke = l0 + QBLK + 64; if (ke > L) ke = L;
      const size_t tok0 = (size_t)seq * S + (size_t)l0 * dil + rr;
      attn_item<64, true, AQT>(wsb(c, OFF_QB) + (hs + srow0) * 64, wsb(c, OFF_KB) + (hs + (size_t)rr * L) * 64, wsb(c, OFF_VTB) + (size_t)(seq * 12 + hb) * 64 * (S + 64) + (size_t)rr * L, S + 64,
                          kb, ke, l0, bias + hb * 132, 0.125f * LOG2E,
                          wsb(c, OFF_OBG) + tok0 * 768 + hb * 64, (size_t)dil * 768, (float*)(c.ws + OFF_LSE) + tok0 * 12 + hb, dil * 12, c.lds);
    }
    __syncthreads();
  }
}

DI void phase_combine(const Ctx& c) {
  const bf16_t* obg = wsb(c, OFF_OBG);
  const float* lse = (const float*)(c.ws + OFF_LSE);
  bf16_t* ob = wsb(c, OFF_OB);
  const int total = TC * 4 * 8;
  for (int idx = blockIdx.x * NTHREADS + tid_(); idx < total; idx += gridDim.x * NTHREADS) {
    const int d8 = idx & 7, j = (idx >> 3) & 3, tl = idx >> 5;
    const float l0 = lse[tl * 12 + j], l1 = lse[tl * 12 + 4 + j], l2 = lse[tl * 12 + 8 + j];
    const float mx = fmaxf(l0, fmaxf(l1, l2));
    float w0 = __expf(l0 - mx), w1 = __expf(l1 - mx), w2 = __expf(l2 - mx);
    const float inv = 1.0f / (w0 + w1 + w2);
    w0 *= inv; w1 *= inv; w2 *= inv;
    const u32x4 a = *(const u32x4*)(obg + (size_t)tl * 768 + j * 64 + d8 * 8);
    const u32x4 b = *(const u32x4*)(obg + (size_t)tl * 768 + (4 + j) * 64 + d8 * 8);
    const u32x4 d = *(const u32x4*)(obg + (size_t)tl * 768 + (8 + j) * 64 + d8 * 8);
    u32x4 r;
#pragma unroll
    for (int e = 0; e < 4; ++e) {
      const float lo = w0 * __uint_as_float(a[e] << 16) + w1 * __uint_as_float(b[e] << 16) + w2 * __uint_as_float(d[e] << 16);
      const float hi = w0 * __uint_as_float(a[e] & 0xffff0000u) + w1 * __uint_as_float(b[e] & 0xffff0000u) + w2 * __uint_as_float(d[e] & 0xffff0000u);
      r[e] = pk2(lo, hi);
    }
    *(u32x4*)(ob + (size_t)tl * LDOB + j * 64 + d8 * 8) = r;
  }
}

DI void phase_merge(const Ctx& c) {
  const bf16_t* xb = wsb(c, OFF_XB);
  const float* ss = ss_site(c, c.layer, 1);
  const float* bgate = inl(c, 21, 3072);
  bf16_t* mrg = wsb(c, OFF_MRG);
  float* cl = (float*)c.lds; float* rr = (float*)(c.lds + OFF_RR);
  const int xcd_ = blockIdx.x & 7, slot_ = blockIdx.x >> 3, nslot_ = gridDim.x >> 3;
  for (int j_ = slot_; j_ < 16 * 8; j_ += nslot_) {
    const int mt = xcd_ * 16 + (j_ & 15), nt = j_ >> 4;
    __syncthreads();
    { const int t0 = tid_(); if (t0 < 128) rr[t0] = rsqrtf(ss[mt * 128 + t0] * (1.0f / DM) + EPS); }
    f32x16 macc[2][2]; zero_acc<2>(macc);
#pragma unroll 1
    for (int k = 0; k < 3; ++k) {
      unsigned gp[2][2][8];
      {
        f32x16 gacc[2][2]; zero_acc<2>(gacc);
        gemm_mainloop_glds<2>(xb + (size_t)mt * 128 * LDX, LDX, wgt(c, W_GATE) + (size_t)(k * 1024 + nt * 128) * LDX, LDX, DM, gacc, c.lds);
        const int tid = tid_(), lane = tid & 63, w = tid >> 6, wm = w >> 1, wn = w & 1, h = lane >> 5, cc = lane & 31;
#pragma unroll
        for (int j = 0; j < 2; ++j) {
          const float bv = bgate[k * 1024 + nt * 128 + wn * 64 + j * 32 + cc];
#pragma unroll
          for (int i = 0; i < 2; ++i)
#pragma unroll
            for (int r2 = 0; r2 < 8; ++r2) {
              const int ra = 2 * r2, rb = 2 * r2 + 1;
              const float r_a = rr[wm * 64 + i * 32 + (ra & 3) + 8 * (ra >> 2) + 4 * h];
              const float r_b = rr[wm * 64 + i * 32 + (rb & 3) + 8 * (rb >> 2) + 4 * h];
              gp[i][j][r2] = pk2(sigmoidf_(gacc[i][j][ra] * r_a + bv), sigmoidf_(gacc[i][j][rb] * r_b + bv));
            }
        }
      }
      {
        f32x16 acc[2][2]; zero_acc<2>(acc);
        const int Kk = (k == 1) ? 256 : 512;
        const bf16_t* Ao = wsb(c, k == 0 ? OFF_OA : (k == 1 ? OFF_OB : OFF_OC));
        const bf16_t* Wo = wgt(c, k == 0 ? W_OA : (k == 1 ? W_OB : W_OC));
        gemm_mainloop_glds<2>(Ao + (size_t)mt * 128 * (Kk + PADK), Kk + PADK, Wo + (size_t)nt * 128 * (Kk + PADK), Kk + PADK, Kk, acc, c.lds);
#pragma unroll
        for (int i = 0; i < 2; ++i)
#pragma unroll
          for (int j = 0; j < 2; ++j)
#pragma unroll
            for (int r2 = 0; r2 < 8; ++r2) {
              const unsigned g2 = gp[i][j][r2];
              macc[i][j][2 * r2] += __uint_as_float(g2 << 16) * acc[i][j][2 * r2];
              macc[i][j][2 * r2 + 1] += __uint_as_float(g2 & 0xffff0000u) * acc[i][j][2 * r2 + 1];
            }
      }
    }
    acc_to_lds<2>(macc, cl);
    __syncthreads();
    const int tid = tid_();
    const int c4 = (tid & 31) * 4, r0 = tid >> 5;
#pragma unroll 4
    for (int it = 0; it < 16; ++it) {
      const int row = r0 + 8 * it;
      const f32x4 v = *(const f32x4*)(cl + row * CLD + c4);
      u32x2 p; p.x = pk2(v[0], v[1]); p.y = pk2(v[2], v[3]);
      *(u32x2*)(mrg + (size_t)(mt * 128 + row) * LDX + nt * 128 + c4) = p;
    }
    __syncthreads();
  }
}

DI void phase_ple(const Ctx& c, bool probe = false) {
  const bf16_t* xb = wsb(c, OFF_XB);
  const float* ss = ss_site(c, c.layer, 3);
  float* ssn = probe ? ss_site(c, 2, 5) : ss_site(c, c.layer + 1, 0);
  const bf16_t* peb = wsb(c, OFF_PEB) + (size_t)c.layer * TC * LDPE;
  float* cl = (float*)c.lds; float* rr = (float*)(c.lds + OFF_RR);
  const int tid = tid_(), lane = tid & 63, w = tid >> 6, wm = w >> 1, h = lane >> 5;
  const int xcd_ = blockIdx.x & 7, slot_ = blockIdx.x >> 3, nslot_ = gridDim.x >> 3;
  for (int j_ = slot_; j_ < 16 * 8; j_ += nslot_) {
    const int mt = xcd_ * 16 + (j_ & 15), nt = j_ >> 4;
    if (tid < 128) rr[tid] = rsqrtf(ss[mt * 128 + tid] * (1.0f / DM) + EPS);
    unsigned gp[2][2][8];
    {
      f32x16 g[2][2]; zero_acc<2>(g);
      gemm_mainloop_glds<2>(xb + (size_t)mt * 128 * LDX, LDX, wgt(c, W_PG) + (size_t)nt * 128 * LDX, LDX, DM, g, c.lds);
#pragma unroll
      for (int i = 0; i < 2; ++i)
#pragma unroll
        for (int j = 0; j < 2; ++j)
#pragma unroll
          for (int r2 = 0; r2 < 8; ++r2) {
            const int ra = 2 * r2, rb = 2 * r2 + 1;
            const float r_a = rr[wm * 64 + i * 32 + (ra & 3) + 8 * (ra >> 2) + 4 * h];
            const float r_b = rr[wm * 64 + i * 32 + (rb & 3) + 8 * (rb >> 2) + 4 * h];
            gp[i][j][r2] = pk2(sigmoidf_(g[i][j][ra] * r_a), sigmoidf_(g[i][j][rb] * r_b));
          }
    }
    f32x16 acc[2][2]; zero_acc<2>(acc);
    gemm_mainloop_glds<2>(peb + (size_t)mt * 128 * LDPE, LDPE, wgt(c, W_PLE) + (size_t)nt * 128 * LDPE, LDPE, 256, acc, c.lds);
#pragma unroll
    for (int i = 0; i < 2; ++i)
#pragma unroll
      for (int j = 0; j < 2; ++j)
#pragma unroll
        for (int r2 = 0; r2 < 8; ++r2) {
          const unsigned g2 = gp[i][j][r2];
          acc[i][j][2 * r2] *= __uint_as_float(g2 << 16);
          acc[i][j][2 * r2 + 1] *= __uint_as_float(g2 & 0xffff0000u);
        }
    acc_to_lds<2>(acc, cl);
    __syncthreads();
    resid_epilogue<2>(c.x, wsb(c, OFF_XB2), ssn, mt, nt, cl, probe ? 0.0f : 1.0f);
    __syncthreads();
  }
}

DI void phase_prologue(const Params& p, char* lds) {
  float* tl = (float*)lds;
  bf16_t* W = (bf16_t*)(p.ws + OFF_W);
  int rot = 0;
  for (int L = 0; L < 2; ++L) {
    bf16_t* wl = W + (size_t)L * W_LAYER;
    transpose_mat(p.in[5] + (size_t)L * 1024 * 5632, 5632, wl + W_FFN1_IN, 5632, 1024, p.in[4] + L * 1024, 1, tl, rot); rot += 88 * 16;
    transpose_mat(p.in[6] + (size_t)L * 2816 * 1024, 1024, wl + W_FFN1_OUT, 1024, 2816, nullptr, 0, tl, rot); rot += 16 * 44;
    transpose_mat(p.in[8] + (size_t)L * 1024 * 3488, 3488, wl + W_IN, 3584, 1024, p.in[7] + L * 1024, 2, tl, rot); rot += 56 * 16;
    transpose_mat(p.in[20] + (size_t)L * 1024 * 3072, 3072, wl + W_GATE, 3072, 1024, p.in[7] + L * 1024, 0, tl, rot); rot += 48 * 16;
    transpose_mat(p.in[11] + (size_t)L * 256 * 768, 768, wl + W_UQ, 768, 256, p.in[9] + L * 256, 3, tl, rot); rot += 12 * 4;
    transpose_mat(p.in[12] + (size_t)L * 128 * 1024, 1024, wl + W_UKV, 1024, 128, p.in[10] + L * 128, 4, tl, rot); rot += 16 * 2;
    transpose_mat(p.in[22] + (size_t)L * 512 * 1024, 1024, wl + W_OA, 1024, 512, nullptr, 0, tl, rot); rot += 16 * 8;
    transpose_mat(p.in[23] + (size_t)L * 256 * 1024, 1024, wl + W_OB, 1024, 256, nullptr, 0, tl, rot); rot += 16 * 4;
    transpose_mat(p.in[24] + (size_t)L * 512 * 1024, 1024, wl + W_OC, 1024, 512, nullptr, 0, tl, rot); rot += 16 * 8;
    transpose_mat(p.in[25] + (size_t)L * 1024 * 1024, 1024, wl + W_OUT, 1024, 1024, nullptr, 0, tl, rot); rot += 16 * 16;
    transpose_mat(p.in[27] + (size_t)L * 1024 * 5632, 5632, wl + W_FFN2_IN, 5632, 1024, p.in[26] + L * 1024, 1, tl, rot); rot += 88 * 16;
    transpose_mat(p.in[28] + (size_t)L * 2816 * 1024, 1024, wl + W_FFN2_OUT, 1024, 2816, nullptr, 0, tl, rot); rot += 16 * 44;
    transpose_mat(p.in[30] + (size_t)L * 1024 * 1024, 1024, wl + W_PG, 1024, 1024, p.in[29] + L * 1024, 0, tl, rot); rot += 16 * 16;
    transpose_mat(p.in[31] + (size_t)L * 256 * 1024, 1024, wl + W_PLE, 1024, 256, nullptr, 0, tl, rot); rot += 16 * 4;
  }
  const int gtid = blockIdx.x * NTHREADS + tid_(), gn = gridDim.x * NTHREADS;
  f32x2* rope = (f32x2*)(p.ws + OFF_ROPE);
  for (int idx = gtid; idx < 16384 * 16; idx += gn) {
    const int pos = idx >> 4, i = idx & 15;
    const float freq = (float)pow(10000.0, -(double)i / 16.0);
    const float ang = (float)pos * freq;
    f32x2 cs; cs.x = (float)cos((double)ang); cs.y = (float)sin((double)ang);
    rope[idx] = cs;
  }
  float* bias = (float*)(p.ws + OFF_BIAS);
  for (int idx = gtid; idx < 12 * 129; idx += gn) {
    const int hb = idx / 129, jj = idx - hb * 129;
    const int dil = 1 << (2 * (hb >> 2));
    const int rel = (jj - 64) * dil;
    const int n = rel < 0 ? -rel : rel;
    int b;
    if (n < 8) b = n;
    else { int lg = 8 + (int)(log((double)n / 8.0) / log(128.0) * 8.0); if (lg > 15) lg = 15; b = lg; }
    if (rel > 0) b += 16;
    bias[hb * 132 + jj] = p.in[17][b * 12 + hb] * LOG2E;
  }
}

DI void phase_init(const Ctx& c) {
  const int tid = tid_(), lane = tid & 63;
  const int gw = blockIdx.x * 4 + (tid >> 6), nw = gridDim.x * 4;
  bf16_t* xb = wsb(c, OFF_XB);
  float* ss0 = ss_site(c, 0, 0);
  for (int row = gw; row < TC; row += nw) {
    float s = 0.f;
#pragma unroll
    for (int i = 0; i < 4; ++i) {
      const size_t gi = (size_t)row * DM + i * 256 + lane * 4;
      const f32x4 v = *(const f32x4*)(c.xin + gi);
      *(f32x4*)(c.x + gi) = v;
      u32x2 p; p.x = pk2(v[0], v[1]); p.y = pk2(v[2], v[3]);
      *(u32x2*)(xb + (size_t)row * LDX + i * 256 + lane * 4) = p;
      s += v[0] * v[0] + v[1] * v[1] + v[2] * v[2] + v[3] * v[3];
    }
#pragma unroll
    for (int o = 32; o >= 1; o >>= 1) s += __shfl_xor(s, o);
    if (lane == 0) ss0[row] = s;
  }
  const int gtid = blockIdx.x * NTHREADS + tid, gn = gridDim.x * NTHREADS;
  float* ssall = (float*)(c.ws + OFF_SS);
  for (int idx = gtid + TC; idx < 3 * 6 * TC; idx += gn) ssall[idx] = 0.f;
  bf16_t* peb = wsb(c, OFF_PEB);
  for (int idx = gtid; idx < 2 * TC * 64; idx += gn) {
    const int L = idx / (TC * 64), r = idx - L * (TC * 64);
    const f32x4 v = *(const f32x4*)(c.pe0 + (size_t)L * c.pe_ls + (size_t)r * 4);
    u32x2 p; p.x = pk2(v[0], v[1]); p.y = pk2(v[2], v[3]);
    *(u32x2*)(peb + ((size_t)L * TC + (r >> 6)) * LDPE + (r & 63) * 4) = p;
  }
}

#ifndef ONLY
#define ONLY -1
#endif
#define PH(n) (ONLY < 0 || ONLY == (n))
#if DUP == 200
#define GSYNC() do { xcd_barrier(xb); xcd_barrier(xb); } while (0)
#else
#define GSYNC() xcd_barrier(xb)
#endif
#define REP(n) for (int rep_ = 0; rep_ < ((DUP == (n) || (DUP == 100 && ((n) == 2 || (n) == 10))) ? 2 : 1); ++rep_)
__global__ void __launch_bounds__(NTHREADS, 2) mega_kernel(Params p) {
  extern __shared__ __attribute__((aligned(16))) char lds[];
  cg::grid_group grid = cg::this_grid();
  volatile LAS unsigned* xst = (volatile LAS unsigned*)(lds + OFF_RR + 512);
  if (threadIdx.x == 0) { xst[0] = 0u; xst[1] = 0u; }
  __syncthreads();
  const XcdBarrier xb = xcd_barrier_post((unsigned*)(p.ws + OFF_BAR), xst);
  REP(0) { if (PH(0)) phase_prologue(p, lds); grid.sync(); }
  for (int chunk = 0; chunk < 3; ++chunk) {
    Ctx c;
    c.p = &p; c.chunk = chunk; c.layer = 0; c.ws = p.ws; c.lds = lds;
    c.S = chunk == 0 ? 4096 : 16384; c.sshift = chunk == 0 ? 12 : 14;
    c.x = p.out + (size_t)chunk * TC * DM;
    c.xin = chunk == 0 ? p.in[0] : p.in[1] + (size_t)(chunk - 1) * TC * DM;
    c.pe0 = chunk == 0 ? p.in[2] : p.in[3] + (size_t)(chunk - 1) * TC * 256;
    c.pe_ls = chunk == 0 ? (size_t)TC * 256 : (size_t)2 * TC * 256;
    REP(1) { if (PH(1)) phase_init(c); GSYNC(); }
#pragma unroll 1
    for (int layer = 0; layer < 2; ++layer) {
      c.layer = layer;
      REP(2) { if (PH(2)) phase_ffn_in(c, wsb(c, layer == 0 ? OFF_XB : OFF_XB2), W_FFN1_IN, 0); GSYNC(); }
#if DUP == 300
      { phase_ffn_probe(c, wsb(c, layer == 0 ? OFF_XB : OFF_XB2), W_FFN1_IN, 0); GSYNC(); }
#endif
      REP(3) { if (PH(3)) phase_resid_gemm(c, wsb(c, OFF_ACT), DFF, W_FFN1_OUT, 0.5f, ss_site(c, layer, 1)); GSYNC(); }
#if DUP == 303
      { phase_resid_gemm(c, wsb(c, OFF_ACT), DFF, W_FFN1_OUT, 0.0f, ss_site(c, 2, 5)); GSYNC(); }
#endif
      REP(4) { if (PH(4)) phase_proj(c); GSYNC(); }
#if DUP == 304
      { phase_proj(c, true); GSYNC(); }
#endif
      REP(5) { if (PH(5)) phase_mlaup(c); GSYNC(); }
      REP(6) { if (PH(6)) phase_attn(c); GSYNC(); }
      REP(7) { if (PH(7)) phase_combine(c); GSYNC(); }
      REP(8) { if (PH(8)) phase_merge(c); GSYNC(); }
      REP(9) { if (PH(9)) phase_resid_gemm(c, wsb(c, OFF_MRG), DM, W_OUT, 1.0f, ss_site(c, layer, 2)); GSYNC(); }
#if DUP == 305
      { phase_resid_gemm(c, wsb(c, OFF_MRG), DM, W_OUT, 0.0f, ss_site(c, 2, 5)); GSYNC(); }
#endif
      REP(10) { if (PH(10)) phase_ffn_in(c, wsb(c, OFF_XB), W_FFN2_IN, 2); GSYNC(); }
      REP(11) { if (PH(11)) phase_resid_gemm(c, wsb(c, OFF_ACT), DFF, W_FFN2_OUT, 0.5f, ss_site(c, layer, 3)); GSYNC(); }
      REP(12) { if (PH(12)) phase_ple(c); GSYNC(); }
#if DUP == 306
      { phase_ple(c, true); GSYNC(); }
#endif
    }
  }
}

extern "C" void kernel_launch(void* const* d_in, const int* in_sizes, int n_in, void* d_out, int out_size, void* d_ws, size_t ws_size, hipStream_t stream) {
  static int grid_blocks = 0;
  if (!grid_blocks) {
    int dev = 0, cus = 0, per_cu = 0;
    hipGetDevice(&dev);
    hipDeviceGetAttribute(&cus, hipDeviceAttributeMultiprocessorCount, dev);
    hipFuncSetAttribute((const void*)mega_kernel, hipFuncAttributeMaxDynamicSharedMemorySize, LDS_BYTES);
    hipOccupancyMaxActiveBlocksPerMultiprocessor(&per_cu, mega_kernel, NTHREADS, LDS_BYTES);
    if (per_cu > 2) per_cu = 2;
    if (per_cu < 1) per_cu = 1;
    grid_blocks = cus * per_cu;
  }
  Params p{};
  for (int i = 0; i < 32; ++i) p.in[i] = (const float*)d_in[i];
  p.out = (float*)d_out;
  p.ws = (char*)d_ws;
  hipMemsetAsync((char*)d_ws + OFF_BAR, 0, 16384, stream);
  void* args[] = {&p};
  hipError_t e = hipLaunchCooperativeKernel((const void*)mega_kernel, dim3(grid_blocks), dim3(NTHREADS), args, LDS_BYTES, stream);
  if (e != hipSuccess) fprintf(stderr, "cooperative launch failed: %s (grid %d)\n", hipGetErrorString(e), grid_blocks);
}
```

```cpp
#ifndef DUP
#define DUP -1
#endif
#include <hip/hip_runtime.h>
#include <hip/hip_cooperative_groups.h>
#include <stdint.h>
#include <cstdio>
namespace cg = cooperative_groups;

typedef unsigned short bf16_t;
typedef short bf16x8 __attribute__((ext_vector_type(8)));
typedef float f32x16 __attribute__((ext_vector_type(16)));
typedef float f32x4 __attribute__((ext_vector_type(4)));
typedef float f32x2 __attribute__((ext_vector_type(2)));
typedef unsigned u32x4 __attribute__((ext_vector_type(4)));
typedef unsigned u32x2 __attribute__((ext_vector_type(2)));
typedef __bf16 bf16x2_t __attribute__((ext_vector_type(2)));
#define DI __device__ __forceinline__
#define MFMA(a, b, c) __builtin_amdgcn_mfma_f32_32x32x16_bf16((a), (b), (c), 0, 0, 0)

constexpr int TC = 16384;
constexpr int DM = 1024;
constexpr int DFF = 2816;
constexpr float EPS = 1e-6f;
constexpr float LOG2E = 1.4426950408889634f;
constexpr float LN2 = 0.6931471805599453f;
constexpr int NTHREADS = 256;
constexpr int PADK = 64;
constexpr int LDX = DM + PADK;
constexpr int LDACT = DFF + PADK;
constexpr int LDCQ = 256 + PADK, LDCKV = 128 + PADK, LDO = 512 + PADK, LDOB = 256 + PADK, LDPE = 256 + PADK;

constexpr size_t W_FFN1_IN = 0;
constexpr size_t W_FFN1_OUT = W_FFN1_IN + (size_t)5632 * LDX;
constexpr size_t W_IN = W_FFN1_OUT + (size_t)1024 * LDACT;
constexpr size_t W_GATE = W_IN + (size_t)3584 * LDX;
constexpr size_t W_UQ = W_GATE + (size_t)3072 * LDX;
constexpr size_t W_UKV = W_UQ + (size_t)768 * LDCQ;
constexpr size_t W_OA = W_UKV + (size_t)1024 * LDCKV;
constexpr size_t W_OB = W_OA + (size_t)1024 * LDO;
constexpr size_t W_OC = W_OB + (size_t)1024 * LDOB;
constexpr size_t W_OUT = W_OC + (size_t)1024 * LDO;
constexpr size_t W_FFN2_IN = W_OUT + (size_t)1024 * LDX;
constexpr size_t W_FFN2_OUT = W_FFN2_IN + (size_t)5632 * LDX;
constexpr size_t W_PG = W_FFN2_OUT + (size_t)1024 * LDACT;
constexpr size_t W_PLE = W_PG + (size_t)1024 * LDX;
constexpr size_t W_LAYER = W_PLE + (size_t)1024 * LDPE;

constexpr size_t AL(size_t x) { return (x + 255) & ~(size_t)255; }
constexpr size_t OFF_W = 0;
constexpr size_t OFF_BAR = AL(OFF_W + 2 * W_LAYER * 2);
constexpr size_t OFF_ROPE = AL(OFF_BAR + 16384);
constexpr size_t OFF_BIAS = AL(OFF_ROPE + (size_t)16384 * 16 * 8);
constexpr size_t OFF_SS = AL(OFF_BIAS + 12 * 132 * 4);
constexpr size_t OFF_XB = AL(OFF_SS + (size_t)3 * 6 * TC * 4);
constexpr size_t OFF_XB2 = AL(OFF_XB + (size_t)TC * LDX * 2);
constexpr size_t OFF_PEB = AL(OFF_XB2 + (size_t)TC * LDX * 2);
constexpr size_t OFF_BIG = AL(OFF_PEB + (size_t)2 * TC * LDPE * 2);
constexpr size_t OFF_ACT = OFF_BIG;
constexpr size_t OFF_CQ = OFF_BIG;
constexpr size_t OFF_CKV = AL(OFF_CQ + (size_t)TC * LDCQ * 2);
constexpr size_t OFF_QA = AL(OFF_CKV + (size_t)TC * LDCKV * 2);
constexpr size_t OFF_KA = AL(OFF_QA + (size_t)TC * 768 * 2);
constexpr size_t OFF_VTA = AL(OFF_KA + (size_t)TC * 768 * 2);
constexpr size_t OFF_QB = AL(OFF_VTA + (size_t)(TC + 256) * 512 * 2);
constexpr size_t OFF_KB = AL(OFF_QB + (size_t)TC * 768 * 2);
constexpr size_t OFF_VTB = AL(OFF_KB + (size_t)TC * 768 * 2);
constexpr size_t OFF_QC = AL(OFF_VTB + (size_t)(TC + 256) * 768 * 2);
constexpr size_t OFF_KC = AL(OFF_QC + (size_t)TC * 512 * 2);
constexpr size_t OFF_VTC = AL(OFF_KC + (size_t)TC * 128 * 2);
constexpr size_t OFF_OA = AL(OFF_VTC + (size_t)(TC + 256) * 128 * 2);
constexpr size_t OFF_OBG = AL(OFF_OA + (size_t)TC * LDO * 2);
constexpr size_t OFF_LSE = AL(OFF_OBG + (size_t)TC * 768 * 2);
constexpr size_t OFF_OB = AL(OFF_LSE + (size_t)TC * 12 * 4);
constexpr size_t OFF_OC = AL(OFF_OB + (size_t)TC * LDOB * 2);
constexpr size_t OFF_MRG = AL(OFF_OC + (size_t)TC * LDO * 2);
constexpr size_t OFF_END = AL(OFF_MRG + (size_t)TC * LDX * 2);
static_assert(OFF_END < (size_t)508 * 1024 * 1024, "workspace too large");
static_assert(OFF_ACT + (size_t)TC * LDACT * 2 <= OFF_END, "act fits");

struct Params {
  const float* in[32];
  float* out;
  char* ws;
};

constexpr int LROW = 144;
constexpr int STAGE_OP = 128 * LROW;
constexpr int STAGE = 2 * STAGE_OP;
constexpr int CLD = 132;
constexpr int OFF_RR = 2 * STAGE;
constexpr int LDS_BYTES = 2 * STAGE + 1024;
static_assert(128 * CLD * 4 <= OFF_RR, "lds");

DI int tid_() { int t = threadIdx.x; asm volatile("" : "+v"(t)); return t; }
DI unsigned pk2(float a, float b) { f32x2 v = {a, b}; bf16x2_t r = __builtin_convertvector(v, bf16x2_t); return __builtin_bit_cast(unsigned, r); }
DI bf16_t f2bf(float a) { return (bf16_t)(pk2(a, 0.f) & 0xffffu); }
DI float bf2f(bf16_t v) { return __uint_as_float(((unsigned)v) << 16); }
DI float sigmoidf_(float x) { return __builtin_amdgcn_rcpf(1.0f + __builtin_amdgcn_exp2f(-x * LOG2E)); }

DI int map_col(int map, int n) {
  switch (map) {
    case 0: return n;
    case 1: { int t = n >> 7, w = n & 127; return w < 64 ? t * 64 + w : DFF + t * 64 + (w - 64); }
    case 2: { int slot = n >> 6, d = n & 63; if (slot < 6) return n; if (slot == 6) return d < 32 ? 384 + d : -1; if (slot < 55) return 416 + (n - 448); return -1; }
    case 3: { if (n < 512) return (n >> 6) * 96 + (n & 63); int i = n - 512; return (i >> 5) * 96 + 64 + (i & 31); }
    default: { if (n < 512) return (n >> 6) * 128 + (n & 63); int i = n - 512; return (i >> 6) * 128 + 64 + (i & 63); }
  }
}

DI void transpose_mat(const float* __restrict__ src, int ld_src, bf16_t* __restrict__ dst, int N, int K, const float* __restrict__ gain, int map, float* lds, int rot) {
  const int ntk = K >> 6, ntn = N >> 6, nt = ntk * ntn;
  const int tid = tid_(), c = tid & 63, rq = tid >> 6;
  int b0 = (int)blockIdx.x - (rot % (int)gridDim.x); if (b0 < 0) b0 += gridDim.x;
  for (int t = b0; t < nt; t += gridDim.x) {
    const int tn = t / ntk, tk = t - tn * ntk;
    const int n0 = tn << 6, k0 = tk << 6;
    const int sc = map_col(map, n0 + c);
#pragma unroll 4
    for (int r = 0; r < 16; ++r) {
      const int kk = r * 4 + rq;
      float v = 0.f;
      if (sc >= 0) { v = src[(size_t)(k0 + kk) * ld_src + sc]; if (gain) v *= gain[k0 + kk]; }
      lds[c * 65 + kk] = v;
    }
    __syncthreads();
#pragma unroll 4
    for (int r = 0; r < 16; ++r) {
      const int nn = r * 4 + rq;
      dst[(size_t)(n0 + nn) * (K + PADK) + k0 + c] = f2bf(lds[nn * 65 + c]);
    }
    __syncthreads();
  }
}

template <int NJ> DI void zero_acc(f32x16 (&acc)[2][NJ]) {
#pragma unroll
  for (int i = 0; i < 2; ++i)
#pragma unroll
    for (int j = 0; j < NJ; ++j)
#pragma unroll
      for (int r = 0; r < 16; ++r) acc[i][j][r] = 0.f;
}

constexpr int GSTG_B = 128 * 128;
constexpr int GSTG = 2 * GSTG_B;
template <int NJ> DI void gemm_mainloop_glds(const bf16_t* __restrict__ A, int lda, const bf16_t* __restrict__ Bt, int ldb, int K, f32x16 (&acc)[2][NJ], char* lds) {
  const int tid = tid_(), lane = tid & 63, w = __builtin_amdgcn_readfirstlane(tid >> 6), wm = w >> 1, wn = w & 1;
  const int ql = lane & 31, h = lane >> 5;
  const int sw_s = (4 * (w & 1) + (lane >> 4)) & 7;
  const int csrc = (lane & 7) ^ sw_s;
  const char* ap = (const char*)A;
  const char* bp = (const char*)Bt;
  const unsigned aoff = (unsigned)((8 * w + (lane >> 3)) * lda + csrc * 8) * 2u, boff = (unsigned)((8 * w + (lane >> 3)) * ldb + csrc * 8) * 2u;
  const unsigned astep = (unsigned)(32 * lda) * 2u, bstep = (unsigned)(32 * ldb) * 2u;
  constexpr int NB = 2 * NJ;
  const int sw_r = (ql >> 1) & 7;
  int a_rd[4], b_rd[4];
#pragma unroll
  for (int ks = 0; ks < 4; ++ks) { const int pos = ((2 * ks + h) ^ sw_r) * 16; a_rd[ks] = (wm * 64 + ql) * 128 + pos; b_rd[ks] = GSTG_B + (wn * 32 * NJ + ql) * 128 + pos; }
#define GSTAGE_(ST) { char* sb_ = lds + (ST) * GSTG + w * 1024; \
    _Pragma("unroll") for (int i_ = 0; i_ < 4; ++i_) __builtin_amdgcn_global_load_lds((const unsigned*)(ap + (aoff + i_ * astep)), (unsigned*)(sb_ + i_ * 4096), 16, 0, 0); \
    _Pragma("unroll") for (int i_ = 0; i_ < NB; ++i_) __builtin_amdgcn_global_load_lds((const unsigned*)(bp + (boff + i_ * bstep)), (unsigned*)(sb_ + GSTG_B + i_ * 4096), 16, 0, 0); \
    ap += 128; bp += 128; }
  GSTAGE_(0);
  asm volatile("s_waitcnt vmcnt(0)" ::: "memory");
  __syncthreads();
  const int nk = K >> 6;
  for (int kt = 0; kt < nk; ++kt) {
    const int cur = kt & 1;
    if (kt + 1 < nk) GSTAGE_(cur ^ 1);
    const char* st_ = lds + cur * GSTG;
#pragma unroll
    for (int ks = 0; ks < 4; ++ks) {
      const bf16x8 a0 = *(const bf16x8*)(st_ + a_rd[ks]);
      const bf16x8 a1 = *(const bf16x8*)(st_ + a_rd[ks] + 4096);
#pragma unroll
      for (int j = 0; j < NJ; ++j) {
        const bf16x8 b = *(const bf16x8*)(st_ + b_rd[ks] + j * 4096);
        acc[0][j] = MFMA(a0, b, acc[0][j]); acc[1][j] = MFMA(a1, b, acc[1][j]);
      }
    }
    asm volatile("s_waitcnt vmcnt(0)" ::: "memory");
    __syncthreads();
  }
#undef GSTAGE_
}

template <int NJ> DI void gemm_mainloop_reg(const bf16_t* __restrict__ A, int lda, const bf16_t* __restrict__ Bt, int ldb, int K, f32x16 (&acc)[2][NJ], char* lds) {
  const int tid = tid_(), lane = tid & 63, w = tid >> 6, wm = w >> 1, wn = w & 1;
  const int lr = tid >> 3, lc = tid & 7;
  const char* ap = (const char*)A;
  const char* bp = (const char*)Bt;
  const unsigned aoff = (unsigned)(lr * lda + lc * 8) * 2u, boff = (unsigned)(lr * ldb + lc * 8) * 2u;
  const unsigned astep = (unsigned)(32 * lda) * 2u, bstep = (unsigned)(32 * ldb) * 2u;
  constexpr int NB = 2 * NJ;
  u32x4 ra0[4], rb0[NB], ra1[4], rb1[NB];
  const int wofs = lr * LROW + lc * 16;
  const int a_rd = (wm * 64 + (lane & 31)) * LROW + (lane >> 5) * 16;
  const int b_rd = STAGE_OP + (wn * 32 * NJ + (lane & 31)) * LROW + (lane >> 5) * 16;
#define GL1_(RA, RB, i) { RA[i] = *(const u32x4*)(ap + (aoff + (i) * astep)); if ((i) < NB) RB[(i) < NB ? (i) : 0] = *(const u32x4*)(bp + (boff + (i) * bstep)); }
#define LS1_(RA, RB, ST, i) { char* sn_ = lds + (ST) * STAGE; *(u32x4*)(sn_ + wofs + (i) * 32 * LROW) = RA[i]; \
                              if ((i) < NB) *(u32x4*)(sn_ + STAGE_OP + wofs + (i) * 32 * LROW) = RB[(i) < NB ? (i) : 0]; }
#define RF_(ks) { fa0 = *(const bf16x8*)(st_ + a_rd + (ks) * 32); fa1 = *(const bf16x8*)(st_ + a_rd + 32 * LROW + (ks) * 32); \
      _Pragma("unroll") for (int j = 0; j < NJ; ++j) fb[j] = *(const bf16x8*)(st_ + b_rd + j * 32 * LROW + (ks) * 32); }
#define STEP_(ST, DOL, RAL, RBL, DOS, RAS, RBS) { const char* st_ = lds + (ST) * STAGE; \
    bf16x8 fa0, fa1, fb[NJ]; RF_(0); \
    _Pragma("unroll") for (int ks = 0; ks < 4; ++ks) { \
      if (DOL) GL1_(RAL, RBL, ks); \
      const bf16x8 ca0 = fa0, ca1 = fa1; bf16x8 cb[NJ]; \
      _Pragma("unroll") for (int j = 0; j < NJ; ++j) cb[j] = fb[j]; \
      if (ks < 3) RF_(ks + 1); \
      _Pragma("unroll") for (int j = 0; j < NJ; ++j) { acc[0][j] = MFMA(ca0, cb[j], acc[0][j]); acc[1][j] = MFMA(ca1, cb[j], acc[1][j]); } \
      if (DOS) LS1_(RAS, RBS, 1 - (ST), ks); \
      __builtin_amdgcn_sched_barrier(0); } \
    if (DOL) { ap += 128; bp += 128; } }
#pragma unroll
  for (int i = 0; i < 4; ++i) GL1_(ra0, rb0, i);
  ap += 128; bp += 128;
#pragma unroll
  for (int i = 0; i < 4; ++i) GL1_(ra1, rb1, i);
  ap += 128; bp += 128;
#pragma unroll
  for (int i = 0; i < 4; ++i) LS1_(ra0, rb0, 0, i);
  __syncthreads();
  const int nk = K >> 6;
  for (int kt = 0; kt < nk; kt += 2) {
    const bool l0 = (kt + 2 < nk), l1 = (kt + 3 < nk);
    STEP_(0, l0, ra0, rb0, true, ra1, rb1);
    __syncthreads();
    STEP_(1, l1, ra1, rb1, l0, ra0, rb0);
    __syncthreads();
  }
#undef GL1_
#undef LS1_
#undef STEP_
#undef RF_
}

template <int NJ> DI void acc_to_lds(const f32x16 (&acc)[2][NJ], float* cl) {
  const int tid = tid_(), lane = tid & 63, w = tid >> 6, wm = w >> 1, wn = w & 1, h = lane >> 5, c = lane & 31;
#pragma unroll
  for (int i = 0; i < 2; ++i)
#pragma unroll
    for (int j = 0; j < NJ; ++j)
#pragma unroll
      for (int r = 0; r < 16; ++r) {
        const int row = wm * 64 + i * 32 + (r & 3) + 8 * (r >> 2) + 4 * h;
        cl[row * CLD + wn * 32 * NJ + j * 32 + c] = acc[i][j][r];
      }
}

template <int NJ> DI void resid_epilogue(float* __restrict__ x, bf16_t* __restrict__ xb, float* __restrict__ ssn, int mt, int nt, const float* cl, float scale) {
  constexpr int LPR = 16 * NJ, RPP = 256 / LPR, NP = 128 / RPP;
  const int tid = tid_(), c4 = (tid & (LPR - 1)) * 4, r0 = tid / LPR;
#pragma unroll 4
  for (int it = 0; it < NP; ++it) {
    const int row = r0 + RPP * it;
    const f32x4 c = *(const f32x4*)(cl + row * CLD + c4);
    const size_t gi = (size_t)(mt * 128 + row) * DM + nt * (64 * NJ) + c4;
    f32x4 xv = *(const f32x4*)(x + gi);
    xv = xv + scale * c;
    *(f32x4*)(x + gi) = xv;
    u32x2 p; p.x = pk2(xv[0], xv[1]); p.y = pk2(xv[2], xv[3]);
    *(u32x2*)(xb + (size_t)(mt * 128 + row) * LDX + nt * (64 * NJ) + c4) = p;
    float s_ = xv[0] * xv[0] + xv[1] * xv[1] + xv[2] * xv[2] + xv[3] * xv[3];
    if (NJ == 2) s_ += __shfl_xor(s_, 16);
    s_ += __shfl_xor(s_, 8); s_ += __shfl_xor(s_, 4); s_ += __shfl_xor(s_, 2); s_ += __shfl_xor(s_, 1);
    if ((tid & (LPR - 1)) == 0) atomicAdd(ssn + mt * 128 + row, s_);
  }
}

#define XB_TMO      128
#define XB_XCNT(j)  (256  + 64 * (j))
#define XB_XSUB(j)  (1280 + 64 * (j))
#define XB_XGEN(j)  (2304 + 64 * (j))
#define XB_TOP      3328
#define XB_TOPGEN   3392
#define XCD_BAR_WORDS 3456
#define XB_SPIN_CAP (1u << 22)
#define LAS __attribute__((address_space(3)))
DI unsigned xb_ld(unsigned* p)              { return __hip_atomic_load(p, __ATOMIC_RELAXED, __HIP_MEMORY_SCOPE_AGENT); }
DI unsigned xb_add(unsigned* p, unsigned v) { return __hip_atomic_fetch_add(p, v, __ATOMIC_RELAXED, __HIP_MEMORY_SCOPE_AGENT); }
DI unsigned xb_xcc_id() { return (unsigned)__builtin_amdgcn_s_getreg((3 << 11) | 20) & 0xFu; }
#define XB_SPIN(cond, bar) do { unsigned _sp = 0; while (cond) { __builtin_amdgcn_s_sleep(1); \
    if ((++_sp & 255u) == 0u) { if (xb_ld(&(bar)[XB_TMO])) break; if (_sp > XB_SPIN_CAP) { atomicAdd(&(bar)[XB_TMO], 1u); break; } } } } while (0)
struct XcdBarrier { unsigned* bar; unsigned x; volatile LAS unsigned* st; };
DI XcdBarrier xcd_barrier_post(unsigned* bar, volatile LAS unsigned* st) {
  XcdBarrier b; b.bar = bar; b.x = xb_xcc_id(); b.st = st;
  if (threadIdx.x == 0) (void)xb_add(&bar[XB_XCNT(b.x)], 1u);
  return b;
}
DI void xcd_barrier_complete(unsigned* bar, unsigned x, unsigned& nloc, unsigned& nx) {
  const unsigned G = gridDim.x * gridDim.y * gridDim.z;
  unsigned sum, cnt, mine, sp = 0u;
  for (;;) {
    sum = 0u; cnt = 0u; mine = 0u;
#pragma unroll
    for (unsigned j = 0; j < 16; ++j) { const unsigned c = xb_ld(&bar[XB_XCNT(j)]); sum += c; cnt += (c > 0u) ? 1u : 0u; mine = (j == x) ? c : mine; }
    if (sum == G) break;
    __builtin_amdgcn_s_sleep(1);
    if ((++sp & 255u) == 0u) { if (xb_ld(&bar[XB_TMO])) break; if (sp > XB_SPIN_CAP) { atomicAdd(&bar[XB_TMO], 1u); break; } }
  }
  nloc = mine > 0u ? mine : 1u; nx = cnt > 0u ? cnt : 1u;
}
DI void xcd_barrier(const XcdBarrier& b) {
  asm volatile("s_waitcnt vmcnt(0)" ::: "memory");
  __syncthreads();
  if (threadIdx.x == 0) {
    unsigned* bar = b.bar;
    __builtin_amdgcn_s_waitcnt(0);
    unsigned nloc = b.st[0], nx = b.st[1];
    if (nloc == 0u) { xcd_barrier_complete(bar, b.x, nloc, nx); b.st[0] = nloc; b.st[1] = nx; }
    const unsigned old = xb_add(&bar[XB_XSUB(b.x)], 1u);
    const unsigned gen = old / nloc;
    if (old + 1u == (gen + 1u) * nloc) {
      __builtin_amdgcn_fence(__ATOMIC_RELEASE, "agent");
      asm volatile("s_waitcnt vmcnt(0)" ::: "memory");
      const unsigned og = xb_add(&bar[XB_TOP], 1u);
      const unsigned tg = og / nx;
      if (og + 1u == (tg + 1u) * nx) xb_add(&bar[XB_TOPGEN], 1u);
      else XB_SPIN(xb_ld(&bar[XB_TOPGEN]) == tg, bar);
      __builtin_amdgcn_fence(__ATOMIC_ACQUIRE, "agent");
      xb_add(&bar[XB_XGEN(b.x)], 1u);
      asm volatile("s_waitcnt vmcnt(0)" ::: "memory");
    } else {
      XB_SPIN(xb_ld(&bar[XB_XGEN(b.x)]) == gen, bar);
      __builtin_amdgcn_fence(__ATOMIC_ACQUIRE, "agent");
      asm volatile("s_waitcnt vmcnt(0)" ::: "memory");
    }
  }
  __syncthreads();
}

constexpr int CTR_ATTN = 3520, CTR_FFN = 3584, CTR_PROJ = 3840;
DI int grab_next(unsigned* ctr, char* lds) {
  volatile int* nx = (volatile int*)(lds + OFF_RR + 528);
  if (tid_() == 0) *nx = (int)__hip_atomic_fetch_add(ctr, 1u, __ATOMIC_RELAXED, __HIP_MEMORY_SCOPE_AGENT);
  __syncthreads();
  const int v = __builtin_amdgcn_readfirstlane(*nx);
  __syncthreads();
  return v;
}

struct Ctx {
  const Params* p;
  int chunk, layer;
  int S, sshift;
  float* x;
  const float* xin;
  const float* pe0; size_t pe_ls;
  char* ws;
  char* lds;
};
DI bf16_t* wsb(const Ctx& c, size_t off) { return (bf16_t*)(c.ws + off); }
DI float* ss_site(const Ctx& c, int layer, int site) { return (float*)(c.ws + OFF_SS) + ((size_t)layer * 6 + site) * TC; }
DI const bf16_t* wgt(const Ctx& c, size_t off) { return (const bf16_t*)(c.ws + OFF_W) + (size_t)c.layer * W_LAYER + off; }
DI const float* inl(const Ctx& c, int idx, size_t per_layer) { return c.p->in[idx] + (size_t)c.layer * per_layer; }

DI void phase_ffn_in(const Ctx& c, const bf16_t* A, size_t woff, int site) {
  const bf16_t* Bt = wgt(c, woff);
  bf16_t* act = wsb(c, OFF_ACT);
  const float* ss = ss_site(c, c.layer, site);
  float* cl = (float*)c.lds; float* rr = (float*)(c.lds + OFF_RR);
  const int tid = tid_();
  const int xcd_ = blockIdx.x & 7;
  unsigned* ctr = (unsigned*)(c.ws + OFF_BAR) + CTR_FFN + ((c.chunk * 2 + c.layer) * 2 + (site == 2 ? 1 : 0)) * 8 + xcd_;
  for (;;) {
    const int j_ = grab_next(ctr, c.lds);
    if (j_ >= 16 * 44) break;
    const int mt = xcd_ * 16 + (j_ & 15), nt = j_ >> 4;
    f32x16 acc[2][2]; zero_acc<2>(acc);
    gemm_mainloop_reg<2>(A + (size_t)mt * 128 * LDX, LDX, Bt + (size_t)nt * 128 * LDX, LDX, DM, acc, c.lds);
    acc_to_lds<2>(acc, cl);
    if (tid < 128) rr[tid] = rsqrtf(ss[mt * 128 + tid] * (1.0f / DM) + EPS);
    __syncthreads();
    const int c4 = (tid & 15) * 4, r0 = tid >> 4;
#pragma unroll 2
    for (int it = 0; it < 8; ++it) {
      const int row = r0 + 16 * it;
      const float r = rr[row];
      const f32x4 a = *(const f32x4*)(cl + row * CLD + c4);
      const f32x4 b = *(const f32x4*)(cl + row * CLD + 64 + c4);
      float o[4];
#pragma unroll
      for (int e = 0; e < 4; ++e) { const float av = a[e] * r, bv = b[e] * r; o[e] = av * sigmoidf_(av) * bv; }
      u32x2 pq; pq.x = pk2(o[0], o[1]); pq.y = pk2(o[2], o[3]);
      *(u32x2*)(act + (size_t)(mt * 128 + row) * LDACT + nt * 64 + c4) = pq;
    }
    __syncthreads();
  }
}

#if DUP == 300
DI void phase_ffn_probe(const Ctx& c, const bf16_t* A, size_t woff, int site) {
  const bf16_t* Bt = wgt(c, woff);
  bf16_t* act = (bf16_t*)(c.ws + OFF_ACT + (size_t)110 * 1024 * 1024);
  const float* ss = ss_site(c, c.layer, site);
  float* cl = (float*)c.lds; float* rr = (float*)(c.lds + OFF_RR);
  const int tid = tid_();
  const int xcd_ = blockIdx.x & 7, slot_ = blockIdx.x >> 3, nslot_ = gridDim.x >> 3;
  for (int j_ = slot_; j_ < 16 * 44; j_ += nslot_) {
    const int mt = xcd_ * 16 + (j_ & 15), nt = j_ >> 4;
    f32x16 acc[2][2]; zero_acc<2>(acc);
    gemm_mainloop_reg<2>(A + (size_t)(mt & 1) * 128 * LDX, LDX, Bt + (size_t)(nt & 1) * 128 * LDX, LDX, DM, acc, c.lds);
    acc_to_lds<2>(acc, cl);
    if (tid < 128) rr[tid] = rsqrtf(ss[mt * 128 + tid] * (1.0f / DM) + EPS);
    __syncthreads();
    const int c4 = (tid & 15) * 4, r0 = tid >> 4;
#pragma unroll 2
    for (int it = 0; it < 8; ++it) {
      const int row = r0 + 16 * it;
      const float r = rr[row];
      const f32x4 a = *(const f32x4*)(cl + row * CLD + c4);
      const f32x4 b = *(const f32x4*)(cl + row * CLD + 64 + c4);
      float o[4];
#pragma unroll
      for (int e = 0; e < 4; ++e) { const float av = a[e] * r, bv = b[e] * r; o[e] = av * sigmoidf_(av) * bv; }
      u32x2 pq; pq.x = pk2(o[0], o[1]); pq.y = pk2(o[2], o[3]);
      *(u32x2*)(act + (size_t)(mt * 128 + row) * LDACT + nt * 64 + c4) = pq;
    }
    __syncthreads();
  }
}
#endif

DI void phase_resid_gemm(const Ctx& c, const bf16_t* A, int K, size_t woff, float scale, float* ssn) {
  const bf16_t* Bt = wgt(c, woff);
  bf16_t* xb = wsb(c, OFF_XB);
  float* cl = (float*)c.lds;
  const int xcd_ = blockIdx.x & 7, slot_ = blockIdx.x >> 3, nslot_ = gridDim.x >> 3;
  for (int j_ = slot_; j_ < 16 * 8; j_ += nslot_) {
    const int mt = xcd_ * 16 + (j_ & 15), nt = j_ >> 4;
    f32x16 acc[2][2]; zero_acc<2>(acc);
    gemm_mainloop_reg<2>(A + (size_t)mt * 128 * (K + PADK), K + PADK, Bt + (size_t)nt * 128 * (K + PADK), K + PADK, K, acc, c.lds);
    acc_to_lds<2>(acc, cl);
    __syncthreads();
    resid_epilogue<2>(c.x, xb, ssn, mt, nt, cl, scale);
    __syncthreads();
  }
}

DI void load_slot(const float* cl, int row, int col0, float (&v)[64]) {
#pragma unroll
  for (int q = 0; q < 16; ++q) { const f32x4 t = *(const f32x4*)(cl + row * CLD + col0 + q * 4); v[4 * q] = t[0]; v[4 * q + 1] = t[1]; v[4 * q + 2] = t[2]; v[4 * q + 3] = t[3]; }
}
template <int N> DI void store_bf16(bf16_t* dst, const float* v) {
#pragma unroll
  for (int q = 0; q < N / 8; ++q) { u32x4 p; p.x = pk2(v[8 * q], v[8 * q + 1]); p.y = pk2(v[8 * q + 2], v[8 * q + 3]); p.z = pk2(v[8 * q + 4], v[8 * q + 5]); p.w = pk2(v[8 * q + 6], v[8 * q + 7]); *(u32x4*)(dst + 8 * q) = p; }
}
template <int N> DI void rmsnorm_inplace(float* v, const float* __restrict__ g) {
  float s = 0.f;
#pragma unroll
  for (int i = 0; i < N; ++i) s += v[i] * v[i];
  const float r = rsqrtf(s * (1.0f / N) + EPS);
#pragma unroll
  for (int i = 0; i < N; ++i) v[i] = v[i] * r * g[i];
}
DI void rope32(float* v, const f32x2* __restrict__ tab  ) {
#pragma unroll
  for (int i = 0; i < 16; ++i) { const f32x2 cs = tab[i]; const float x1 = v[i], x2 = v[i + 16]; v[i] = x1 * cs.x - x2 * cs.y; v[i + 16] = x1 * cs.y + x2 * cs.x; }
}
DI void vt_write(const float* cl, const float* rr, int col0, int u, bf16_t* dst_row  , int dsh, int L, int pos0) {
  const int d = u & 63, th = u >> 6;
  float v[64];
#pragma unroll
  for (int i = 0; i < 64; ++i) v[i] = cl[(th * 64 + i) * CLD + col0 + d] * rr[th * 64 + i];
  const int p0 = pos0 + th * 64;
  if (dsh == 0) {
    store_bf16<64>(dst_row + p0, v);
  } else if (dsh == 2) {
#pragma unroll
    for (int rr_ = 0; rr_ < 4; ++rr_) {
      float t[16];
#pragma unroll
      for (int a = 0; a < 16; ++a) t[a] = v[4 * a + rr_];
      store_bf16<16>(dst_row + rr_ * L + (p0 >> 2), t);
    }
  } else {
#pragma unroll
    for (int rr_ = 0; rr_ < 16; ++rr_) {
      u32x2 p; p.x = pk2(v[rr_], v[16 + rr_]); p.y = pk2(v[32 + rr_], v[48 + rr_]);
      *(u32x2*)(dst_row + rr_ * L + (p0 >> 4)) = p;
    }
  }
}

DI void phase_proj(const Ctx& c, bool dummy_ss = false) {
  const bf16_t* A = wsb(c, OFF_XB);
  const bf16_t* Bt = wgt(c, W_IN);
  const float* ss = ss_site(c, c.layer, 1);
  float* ss_cq = ss_site(c, dummy_ss ? 2 : c.layer, 4);
  float* ss_ckv = ss_site(c, dummy_ss ? 2 : c.layer, 5);
  float* cl = (float*)c.lds; float* rr = (float*)(c.lds + OFF_RR);
  const f32x2* rope = (const f32x2*)(c.ws + OFF_ROPE);
  const int tid0 = tid_();
  const int S = c.S, sshift = c.sshift;
  const int xcd_ = blockIdx.x & 7;
  unsigned* ctr = (unsigned*)(c.ws + OFF_BAR) + CTR_PROJ + (c.chunk * 2 + c.layer + (dummy_ss ? 6 : 0)) * 8 + xcd_;
  for (;;) {
    const int j_ = grab_next(ctr, c.lds);
    if (j_ >= 16 * 28) break;
    const int mt = xcd_ * 16 + (j_ & 15), nt = j_ >> 4;
    f32x16 acc[2][2]; zero_acc<2>(acc);
    gemm_mainloop_reg<2>(A + (size_t)mt * 128 * LDX, LDX, Bt + (size_t)nt * 128 * LDX, LDX, DM, acc, c.lds);
    acc_to_lds<2>(acc, cl);
    const int tid = tid_(), half = __builtin_amdgcn_readfirstlane(tid >> 7), u = tid & 127;
    if (tid < 128) rr[tid] = rsqrtf(ss[mt * 128 + tid] * (1.0f / DM) + EPS);
    __syncthreads();
    const int slot = nt * 2 + half, col0 = half * 64;
    const int tl0 = mt * 128, seq = tl0 >> sshift, pos0 = tl0 & (S - 1);
    const bool is_vb = (slot >= 31 && slot < 43), is_vc = (slot == 53 || slot == 54);
    if (is_vb) {
      const int hb = slot - 31, dsh = 2 * (hb >> 2);
      bf16_t* dst = wsb(c, OFF_VTB) + ((size_t)(seq * 12 + hb) * 64 + (u & 63)) * (S + 64);
      vt_write(cl, rr, col0, u, dst, dsh, S >> dsh, pos0);
    } else if (is_vc) {
      const int hv = slot - 53;
      bf16_t* dst = wsb(c, OFF_VTC) + ((size_t)(seq * 2 + hv) * 64 + (u & 63)) * (S + 64);
      vt_write(cl, rr, col0, u, dst, 0, S, pos0);
    } else if (slot < 55) {
      const int row = u, tl = tl0 + row, pos = pos0 + row;
      const float r = rr[row];
      float v[64];
      load_slot(cl, row, col0, v);
#pragma unroll
      for (int i = 0; i < 64; ++i) v[i] *= r;
      if (slot < 6) {
        float s = 0.f;
#pragma unroll
        for (int i = 0; i < 64; ++i) s += v[i] * v[i];
        if (slot < 4) { store_bf16<64>(wsb(c, OFF_CQ) + (size_t)tl * LDCQ + slot * 64, v); atomicAdd(ss_cq + tl, s); }
        else { store_bf16<64>(wsb(c, OFF_CKV) + (size_t)tl * LDCKV + (slot - 4) * 64, v); atomicAdd(ss_ckv + tl, s); }
      } else if (slot == 6) {
        rmsnorm_inplace<32>(v, inl(c, 14, 96) + 64);
        rope32(v, rope + (size_t)pos * 16);
        bf16_t* dst = wsb(c, OFF_KA) + ((size_t)(seq * 8) * S + pos) * 96 + 64;
#pragma unroll
        for (int hh = 0; hh < 8; ++hh) store_bf16<32>(dst + (size_t)hh * S * 96, v);
      } else if (slot < 31) {
        const bool isq = slot < 19;
        const int hb = isq ? slot - 7 : slot - 19, dsh = 2 * (hb >> 2), L = S >> dsh;
        rmsnorm_inplace<64>(v, inl(c, isq ? 15 : 16, 64));
        const int srow = (pos & ((1 << dsh) - 1)) * L + (pos >> dsh);
        bf16_t* dst = wsb(c, isq ? OFF_QB : OFF_KB) + ((size_t)(seq * 12 + hb) * S + srow) * 64;
        store_bf16<64>(dst, v);
      } else {
        const bool isq = slot < 51;
        rmsnorm_inplace<64>(v, inl(c, isq ? 18 : 19, 64));
        bf16_t* dst = isq ? wsb(c, OFF_QC) + ((size_t)(seq * 8 + (slot - 43)) * S + pos) * 64
                          : wsb(c, OFF_KC) + ((size_t)(seq * 2 + (slot - 51)) * S + pos) * 64;
        asm volatile("" ::: "memory");
        rope32(v, rope + (size_t)(pos >> 6) * 16);
        store_bf16<32>(dst, v);
        asm volatile("" ::: "memory");
        rope32(v + 32, rope + (size_t)(pos & 63) * 16);
        store_bf16<32>(dst + 32, v + 32);
      }
    }
    __syncthreads();
  }
}

DI void phase_mlaup(const Ctx& c) {
  const float* ss_cq = ss_site(c, c.layer, 4);
  const float* ss_ckv = ss_site(c, c.layer, 5);
  float* cl = (float*)c.lds; float* rr = (float*)(c.lds + OFF_RR);
  const f32x2* rope = (const f32x2*)(c.ws + OFF_ROPE);
  const int tid0 = tid_();
  const int S = c.S, sshift = c.sshift;
  const int xcd_ = blockIdx.x & 7, slot_ = blockIdx.x >> 3, nslot_ = gridDim.x >> 3;
  for (int j_ = slot_; j_ < 16 * 14; j_ += nslot_) {
    const int mt = xcd_ * 16 + (j_ & 15), nt = j_ >> 4;
    const bool isq = nt < 6;
    f32x16 acc[2][2]; zero_acc<2>(acc);
    if (isq) gemm_mainloop_reg<2>(wsb(c, OFF_CQ) + (size_t)mt * 128 * LDCQ, LDCQ, wgt(c, W_UQ) + (size_t)nt * 128 * LDCQ, LDCQ, 256, acc, c.lds);
    else gemm_mainloop_reg<2>(wsb(c, OFF_CKV) + (size_t)mt * 128 * LDCKV, LDCKV, wgt(c, W_UKV) + (size_t)(nt - 6) * 128 * LDCKV, LDCKV, 128, acc, c.lds);
    acc_to_lds<2>(acc, cl);
    const int tid = tid_(), half = __builtin_amdgcn_readfirstlane(tid >> 7), u = tid & 127;
    if (tid < 128) rr[tid] = isq ? rsqrtf(ss_cq[mt * 128 + tid] * (1.0f / 256) + EPS) : rsqrtf(ss_ckv[mt * 128 + tid] * (1.0f / 128) + EPS);
    __syncthreads();
    const int col0 = half * 64;
    const int tl0 = mt * 128, seq = tl0 >> sshift, pos0 = tl0 & (S - 1);
    if (!isq && nt >= 10) {
      const int hv = (nt - 10) * 2 + half;
      bf16_t* dst = wsb(c, OFF_VTA) + ((size_t)(seq * 8 + hv) * 64 + (u & 63)) * (S + 64);
      vt_write(cl, rr, col0, u, dst, 0, S, pos0);
    } else {
      const int row = u, pos = pos0 + row;
      const float r = rr[row];
      float v[64];
      load_slot(cl, row, col0, v);
#pragma unroll
      for (int i = 0; i < 64; ++i) v[i] *= r;
      if (isq && nt < 4) {
        const int hh = nt * 2 + half;
        rmsnorm_inplace<64>(v, inl(c, 13, 96));
        store_bf16<64>(wsb(c, OFF_QA) + ((size_t)(seq * 8 + hh) * S + pos) * 96, v);
      } else if (isq) {
        const int h0 = ((nt - 4) * 2 + half) * 2;
        rmsnorm_inplace<32>(v, inl(c, 13, 96) + 64);
        rmsnorm_inplace<32>(v + 32, inl(c, 13, 96) + 64);
        rope32(v, rope + (size_t)pos * 16);
        rope32(v + 32, rope + (size_t)pos * 16);
        store_bf16<32>(wsb(c, OFF_QA) + ((size_t)(seq * 8 + h0) * S + pos) * 96 + 64, v);
        store_bf16<32>(wsb(c, OFF_QA) + ((size_t)(seq * 8 + h0 + 1) * S + pos) * 96 + 64, v + 32);
      } else {
        const int hh = (nt - 6) * 2 + half;
        rmsnorm_inplace<64>(v, inl(c, 14, 96));
        store_bf16<64>(wsb(c, OFF_KA) + ((size_t)(seq * 8 + hh) * S + pos) * 96, v);
      }
    }
    __syncthreads();
  }
}

template <int DQK, bool BAND, int QT>
DI void attn_item(const bf16_t* __restrict__ Q, const bf16_t* __restrict__ Kp, const bf16_t* __restrict__ Vt, int ldv,
                  int kbeg, int kend, int q0, const float* bias_g, float scale_log2,
                  bf16_t* __restrict__ out, size_t out_rs, float* __restrict__ lse, int lse_rs, char* lds) {
  constexpr int KROW = DQK * 2 + 16;
  constexpr int KST = 64 * KROW, VST = 64 * LROW, ST = KST + VST;
  constexpr int NKS = DQK / 16;
  constexpr int KV4 = DQK / 8;
  constexpr int NKL = (64 * KV4) / 256;
  constexpr int WQ = 32 * QT;
  const int tid = tid_(), lane = tid & 63, w = tid >> 6, h = lane >> 5, ql = lane & 31;
  float* bias_l = (float*)(lds + 2 * ST);
  if (BAND) { if (tid < 129) bias_l[tid] = bias_g[tid]; }
  bf16x8 qf[QT][NKS];
#pragma unroll
  for (int qt = 0; qt < QT; ++qt)
#pragma unroll
    for (int ks = 0; ks < NKS; ++ks) qf[qt][ks] = *(const bf16x8*)(Q + (size_t)(w * WQ + qt * 32 + ql) * DQK + ks * 16 + h * 8);
  f32x16 o[2][QT];
#pragma unroll
  for (int a = 0; a < 2; ++a)
#pragma unroll
    for (int b = 0; b < QT; ++b)
#pragma unroll
      for (int r = 0; r < 16; ++r) o[a][b][r] = 0.f;
  float m[QT], l[QT];
#pragma unroll
  for (int qt = 0; qt < QT; ++qt) { m[qt] = -1e30f; l[qt] = 0.f; }
  u32x4 rk[NKL], rv[2];
  const int vrow0 = tid >> 3, vch = tid & 7;
  unsigned klds[NKL];
#pragma unroll
  for (int i = 0; i < NKL; ++i) { const int idx = tid + i * 256, kr = idx / KV4, kc = idx - kr * KV4; klds[i] = kr * KROW + kc * 16; }
  const unsigned koff0 = (unsigned)tid * 16u;
  const unsigned voff0 = (unsigned)(vrow0 * ldv + vch * 8) * 2u, vstep = (unsigned)(32 * ldv) * 2u;
  const unsigned vlds0 = KST + vrow0 * LROW + vch * 16;
  auto gload = [&](int kt) {
    const char* kb = (const char*)Kp + (size_t)kt * (DQK * 2);
    const char* vb = (const char*)Vt + (size_t)kt * 2;
#pragma unroll
    for (int i = 0; i < NKL; ++i) rk[i] = *(const u32x4*)(kb + (koff0 + i * 4096u));
#pragma unroll
    for (int i = 0; i < 2; ++i) rv[i] = *(const u32x4*)(vb + (voff0 + i * vstep));
  };
  auto lstore = [&](char* st) {
#pragma unroll
    for (int i = 0; i < NKL; ++i) *(u32x4*)(st + klds[i]) = rk[i];
#pragma unroll
    for (int i = 0; i < 2; ++i) *(u32x4*)(st + vlds0 + i * 32 * LROW) = rv[i];
  };
  gload(kbeg);
  lstore(lds);
  __syncthreads();
  const int pr = (ql & ~12) | ((ql & 4) << 1) | ((ql & 8) >> 1);
  const int k_rd = pr * KROW + h * 16;
  const int v_rd = KST + ql * LROW + h * 16;
  const int qw0 = q0 + w * WQ;
  int it = 0;
  for (int kt = kbeg; kt < kend; kt += 64, ++it) {
    const char* st = lds + (it & 1) * ST;
    const bool more = (kt + 64 < kend);
    if (more) gload(kt + 64);
    bool need = true;
    if (BAND) need = (kt + 63 >= qw0 - 64) && (kt <= qw0 + WQ - 1 + 64);
    if (need) {
      f32x16 s[2][QT];
#pragma unroll
      for (int a = 0; a < 2; ++a)
#pragma unroll
        for (int b = 0; b < QT; ++b)
#pragma unroll
          for (int r = 0; r < 16; ++r) s[a][b][r] = 0.f;
#pragma unroll
      for (int ks = 0; ks < NKS; ++ks) {
        const bf16x8 k0 = *(const bf16x8*)(st + k_rd + ks * 32);
        const bf16x8 k1 = *(const bf16x8*)(st + k_rd + 32 * KROW + ks * 32);
#pragma unroll
        for (int qt = 0; qt < QT; ++qt) {
          s[0][qt] = MFMA(k0, qf[qt][ks], s[0][qt]);
          s[1][qt] = MFMA(k1, qf[qt][ks], s[1][qt]);
        }
      }
      __builtin_amdgcn_s_setprio(3);
      bf16x8 pf[QT][4];
      const float cc = BAND ? 1.0f : scale_log2;
      const float th = BAND ? 8.0f : 8.0f / scale_log2;
#pragma unroll
      for (int qt = 0; qt < QT; ++qt) {
        if (BAND) {
#pragma unroll
          for (int a = 0; a < 2; ++a)
#pragma unroll
            for (int r = 0; r < 16; ++r) {
              const int kidx = kt + 32 * a + (r & 7) + 8 * h + 16 * (r >> 3);
              const int rel = kidx - (qw0 + qt * 32 + ql);
              const bool ok = (rel >= -64) && (rel <= 64);
              const int bi = ok ? rel + 64 : 0;
              s[a][qt][r] = ok ? fmaf(s[a][qt][r], scale_log2, bias_l[bi]) : -1e30f;
            }
        }
        float mx = s[0][qt][0];
#pragma unroll
        for (int r = 1; r < 16; ++r) mx = fmaxf(mx, s[0][qt][r]);
#pragma unroll
        for (int r = 0; r < 16; ++r) mx = fmaxf(mx, s[1][qt][r]);
        mx = fmaxf(mx, __shfl_xor(mx, 32));
        if (__builtin_amdgcn_ballot_w64(mx > m[qt] + th) != 0) {
          const float mn = fmaxf(m[qt], mx);
          const float alpha = __builtin_amdgcn_exp2f((m[qt] - mn) * cc);
          m[qt] = mn;
          l[qt] *= alpha;
#pragma unroll
          for (int r = 0; r < 16; ++r) { o[0][qt][r] *= alpha; o[1][qt][r] *= alpha; }
        }
        const float mc = -m[qt] * cc;
        float ls = 0.f;
#pragma unroll
        for (int a = 0; a < 2; ++a) {
#pragma unroll
          for (int r = 0; r < 16; ++r) { const float pv = __builtin_amdgcn_exp2f(fmaf(s[a][qt][r], cc, mc)); s[a][qt][r] = pv; ls += pv; }
#pragma unroll
          for (int s2 = 0; s2 < 2; ++s2) {
            u32x4 pk;
            pk.x = pk2(s[a][qt][8 * s2 + 0], s[a][qt][8 * s2 + 1]);
            pk.y = pk2(s[a][qt][8 * s2 + 2], s[a][qt][8 * s2 + 3]);
            pk.z = pk2(s[a][qt][8 * s2 + 4], s[a][qt][8 * s2 + 5]);
            pk.w = pk2(s[a][qt][8 * s2 + 6], s[a][qt][8 * s2 + 7]);
            pf[qt][a * 2 + s2] = __builtin_bit_cast(bf16x8, pk);
          }
        }
        l[qt] += ls;
      }
      __builtin_amdgcn_s_setprio(0);
      if (more) lstore(lds + ((it + 1) & 1) * ST);
#pragma unroll
      for (int ks = 0; ks < 4; ++ks) {
        const bf16x8 v0 = *(const bf16x8*)(st + v_rd + ks * 32);
        const bf16x8 v1 = *(const bf16x8*)(st + v_rd + 32 * LROW + ks * 32);
#pragma unroll
        for (int qt = 0; qt < QT; ++qt) {
          o[0][qt] = MFMA(v0, pf[qt][ks], o[0][qt]);
          o[1][qt] = MFMA(v1, pf[qt][ks], o[1][qt]);
        }
      }
    } else {
      if (more) lstore(lds + ((it + 1) & 1) * ST);
    }
    __syncthreads();
  }
#pragma unroll
  for (int qt = 0; qt < QT; ++qt) {
    const float lt = l[qt] + __shfl_xor(l[qt], 32);
    const float inv = __builtin_amdgcn_rcpf(lt);
    const int qi = w * WQ + qt * 32 + ql;
    bf16_t* orow = out + (size_t)qi * out_rs;
#pragma unroll
    for (int dt = 0; dt < 2; ++dt)
#pragma unroll
      for (int g = 0; g < 4; ++g) {
        u32x2 p; p.x = pk2(o[dt][qt][4 * g] * inv, o[dt][qt][4 * g + 1] * inv); p.y = pk2(o[dt][qt][4 * g + 2] * inv, o[dt][qt][4 * g + 3] * inv);
        *(u32x2*)(orow + dt * 32 + 8 * g + 4 * h) = p;
      }
    if (BAND) { if (h == 0) lse[(size_t)qi * lse_rs] = m[qt] * LN2 + __logf(lt); }
  }
}

template <int DQK>
DI void attn_dense(const bf16_t* __restrict__ Q, const bf16_t* __restrict__ Kp, const bf16_t* __restrict__ Vt, int ldv,
                   int nkeys, float scale_log2, bf16_t* __restrict__ out, size_t out_rs, char* lds) {
  constexpr int KROW = DQK * 2 + 16;
  constexpr int KST = 64 * KROW, VST = 64 * LROW;
  constexpr int NKS = DQK / 16;
  constexpr int KV4 = DQK / 8;
  constexpr int NKL = (64 * KV4) / 256;
  const int tid = tid_(), lane = tid & 63, w = tid >> 6, h = lane >> 5, ql = lane & 31;
  char* const kbase = lds;
  char* const vbase = lds + 2 * KST;
  bf16x8 qf[NKS];
#pragma unroll
  for (int ks = 0; ks < NKS; ++ks) qf[ks] = *(const bf16x8*)(Q + (size_t)(w * 32 + ql) * DQK + ks * 16 + h * 8);
  f32x16 o[2];
#pragma unroll
  for (int a = 0; a < 2; ++a)
#pragma unroll
    for (int r = 0; r < 16; ++r) o[a][r] = 0.f;
  float m = -1e30f, l = 0.f;
  u32x4 rk[NKL], rv[2];
  const int vrow0 = tid >> 3, vch = tid & 7;
#define GLK_(kt) { const int kt_ = (kt); _Pragma("unroll") for (int i_ = 0; i_ < NKL; ++i_) { const int idx = tid + i_ * 256, kr = idx / KV4, kc = idx - kr * KV4; rk[i_] = *(const u32x4*)(Kp + (size_t)(kt_ + kr) * DQK + kc * 8); } }
#define GLV_(kt) { const int kt_ = (kt); _Pragma("unroll") for (int i_ = 0; i_ < 2; ++i_) rv[i_] = *(const u32x4*)(Vt + (size_t)(vrow0 + 32 * i_) * ldv + kt_ + vch * 8); }
#define LSK_(st) { char* st_ = (st); _Pragma("unroll") for (int i_ = 0; i_ < NKL; ++i_) { const int idx = tid + i_ * 256, kr = idx / KV4, kc = idx - kr * KV4; *(u32x4*)(st_ + kr * KROW + kc * 16) = rk[i_]; } }
#define LSV_(st) { char* st_ = (st); _Pragma("unroll") for (int i_ = 0; i_ < 2; ++i_) *(u32x4*)(st_ + (vrow0 + 32 * i_) * LROW + vch * 16) = rv[i_]; }
  const int pr = (ql & ~12) | ((ql & 4) << 1) | ((ql & 8) >> 1);
  const int k_rd = pr * KROW + h * 16;
  const int v_rd = ql * LROW + h * 16;
  GLK_(0); LSK_(kbase);
  GLK_(64); GLV_(0); LSK_(kbase + KST); LSV_(vbase);
  __syncthreads();
  f32x16 sc[2];
#pragma unroll
  for (int a = 0; a < 2; ++a)
#pragma unroll
    for (int r = 0; r < 16; ++r) sc[a][r] = 0.f;
#pragma unroll
  for (int ks = 0; ks < NKS; ++ks) {
    const bf16x8 k0 = *(const bf16x8*)(kbase + k_rd + ks * 32);
    const bf16x8 k1 = *(const bf16x8*)(kbase + k_rd + 32 * KROW + ks * 32);
    sc[0] = MFMA(k0, qf[ks], sc[0]);
    sc[1] = MFMA(k1, qf[ks], sc[1]);
  }
  __syncthreads();
  const int nt = nkeys >> 6;
  const float cc = scale_log2, th = 8.0f / scale_log2;
  for (int i = 0; i < nt; ++i) {
    const bool more1 = (i + 1 < nt), more2 = (i + 2 < nt);
    if (more2) GLK_((i + 2) * 64);
    if (more1) GLV_((i + 1) * 64);
    float mx = sc[0][0];
#pragma unroll
    for (int r = 1; r < 16; ++r) mx = fmaxf(mx, sc[0][r]);
#pragma unroll
    for (int r = 0; r < 16; ++r) mx = fmaxf(mx, sc[1][r]);
    mx = fmaxf(mx, __shfl_xor(mx, 32));
    if (__builtin_amdgcn_ballot_w64(mx > m + th) != 0) {
      const float mn = fmaxf(m, mx);
      const float alpha = __builtin_amdgcn_exp2f((m - mn) * cc);
      m = mn; l *= alpha;
#pragma unroll
      for (int r = 0; r < 16; ++r) { o[0][r] *= alpha; o[1][r] *= alpha; }
    }
    const char* kn = kbase + ((i + 1) & 1) * KST;
    f32x16 sn[2];
#pragma unroll
    for (int a = 0; a < 2; ++a)
#pragma unroll
      for (int r = 0; r < 16; ++r) sn[a][r] = 0.f;
#pragma unroll
    for (int ks = 0; ks < NKS; ++ks) {
      const bf16x8 k0 = *(const bf16x8*)(kn + k_rd + ks * 32);
      const bf16x8 k1 = *(const bf16x8*)(kn + k_rd + 32 * KROW + ks * 32);
      sn[0] = MFMA(k0, qf[ks], sn[0]);
      sn[1] = MFMA(k1, qf[ks], sn[1]);
    }
    const float mc = -m * cc;
    float ls = 0.f;
    bf16x8 pf[4];
#pragma unroll
    for (int a = 0; a < 2; ++a) {
#pragma unroll
      for (int r = 0; r < 16; ++r) { const float pv = __builtin_amdgcn_exp2f(fmaf(sc[a][r], cc, mc)); sc[a][r] = pv; ls += pv; }
#pragma unroll
      for (int s2 = 0; s2 < 2; ++s2) {
        u32x4 pk;
        pk.x = pk2(sc[a][8 * s2 + 0], sc[a][8 * s2 + 1]);
        pk.y = pk2(sc[a][8 * s2 + 2], sc[a][8 * s2 + 3]);
        pk.z = pk2(sc[a][8 * s2 + 4], sc[a][8 * s2 + 5]);
        pk.w = pk2(sc[a][8 * s2 + 6], sc[a][8 * s2 + 7]);
        pf[a * 2 + s2] = __builtin_bit_cast(bf16x8, pk);
      }
    }
    l += ls;
    const char* vs = vbase + (i & 1) * VST;
#pragma unroll
    for (int ks = 0; ks < 4; ++ks) {
      const bf16x8 v0 = *(const bf16x8*)(vs + v_rd + ks * 32);
      const bf16x8 v1 = *(const bf16x8*)(vs + v_rd + 32 * LROW + ks * 32);
      o[0] = MFMA(v0, pf[ks], o[0]);
      o[1] = MFMA(v1, pf[ks], o[1]);
    }
    if (more2) LSK_(kbase + (i & 1) * KST);
    if (more1) LSV_(vbase + ((i + 1) & 1) * VST);
    __syncthreads();
    sc[0] = sn[0]; sc[1] = sn[1];
  }
#undef GLK_
#undef GLV_
#undef LSK_
#undef LSV_
  const float lt = l + __shfl_xor(l, 32);
  const float inv = __builtin_amdgcn_rcpf(lt);
  bf16_t* orow = out + (size_t)(w * 32 + ql) * out_rs;
#pragma unroll
  for (int dt = 0; dt < 2; ++dt)
#pragma unroll
    for (int g = 0; g < 4; ++g) {
      u32x2 p; p.x = pk2(o[dt][4 * g] * inv, o[dt][4 * g + 1] * inv); p.y = pk2(o[dt][4 * g + 2] * inv, o[dt][4 * g + 3] * inv);
      *(u32x2*)(orow + dt * 32 + 8 * g + 4 * h) = p;
    }
}

constexpr bool ATT_PIPE = false;
constexpr int AQT = 2;
constexpr int QBLK = 128 * AQT;
DI void phase_attn(const Ctx& c) {
  const int S = c.S, nseq = TC / S, nqb = S / QBLK;
  const int n_mla = nseq * 8 * nqb, n_gqa = n_mla, n_dil = nseq * 12 * nqb;
  const float* bias = (const float*)(c.ws + OFF_BIAS);
  const int xcd_ = blockIdx.x & 7;
  unsigned* ctr = (unsigned*)(c.ws + OFF_BAR) + CTR_ATTN + (c.chunk * 2 + c.layer) * 8 + xcd_;
  const int n_per_xcd = (n_mla + n_gqa + n_dil) >> 3;
  for (;;) {
    const int jg = grab_next(ctr, c.lds);
    if (jg >= n_per_xcd) break;
    const int item = jg * 8 + xcd_;
    if (item < n_mla) {
      const int hh = item & 7, rest = item >> 3, seq = rest / nqb, qb = rest - seq * nqb;
      const size_t hs = (size_t)(seq * 8 + hh) * S;
      if (ATT_PIPE) attn_dense<96>(wsb(c, OFF_QA) + (hs + qb * QBLK) * 96, wsb(c, OFF_KA) + hs * 96, wsb(c, OFF_VTA) + (size_t)(seq * 8 + hh) * 64 * (S + 64), S + 64,
                     S, 0.10206207261596577f * LOG2E, wsb(c, OFF_OA) + ((size_t)seq * S + qb * QBLK) * LDO + hh * 64, LDO, c.lds);
      else attn_item<96, false, AQT>(wsb(c, OFF_QA) + (hs + qb * QBLK) * 96, wsb(c, OFF_KA) + hs * 96, wsb(c, OFF_VTA) + (size_t)(seq * 8 + hh) * 64 * (S + 64), S + 64,
                     0, S, 0, nullptr, 0.10206207261596577f * LOG2E, wsb(c, OFF_OA) + ((size_t)seq * S + qb * QBLK) * LDO + hh * 64, LDO, nullptr, 0, c.lds);
    } else if (item < n_mla + n_gqa) {
      const int i2 = item - n_mla;
      const int hq = i2 & 7, rest = i2 >> 3, seq = rest / nqb, qb = rest - seq * nqb;
      const size_t hs = (size_t)(seq * 8 + hq) * S, ks = (size_t)(seq * 2 + (hq >> 2)) * S;
      if (ATT_PIPE) attn_dense<64>(wsb(c, OFF_QC) + (hs + qb * QBLK) * 64, wsb(c, OFF_KC) + ks * 64, wsb(c, OFF_VTC) + (size_t)(seq * 2 + (hq >> 2)) * 64 * (S + 64), S + 64,
                     S, 0.125f * LOG2E, wsb(c, OFF_OC) + ((size_t)seq * S + qb * QBLK) * LDO + hq * 64, LDO, c.lds);
      else attn_item<64, false, AQT>(wsb(c, OFF_QC) + (hs + qb * QBLK) * 64, wsb(c, OFF_KC) + ks * 64, wsb(c, OFF_VTC) + (size_t)(seq * 2 + (hq >> 2)) * 64 * (S + 64), S + 64,
                     0, S, 0, nullptr, 0.125f * LOG2E, wsb(c, OFF_OC) + ((size_t)seq * S + qb * QBLK) * LDO + hq * 64, LDO, nullptr, 0, c.lds);
    } else {
      const int i2 = item - n_mla - n_gqa;
      const int hb = i2 % 12, rest = i2 / 12, seq = rest / nqb, blk = rest - seq * nqb;
      const int dsh = 2 * (hb >> 2), L = S >> dsh, dil = 1 << dsh;
      const int srow0 = blk * QBLK, rr = srow0 / L, l0 = srow0 - rr * L;
      const size_t hs = (size_t)(seq * 12 + hb) * S;
      int kb = l0 - 64; if (kb < 0) kb = 0;
      int ke = l0 + QBLK + 64; if (ke > L) ke = L;
      const size_t tok0 = (size_t)seq * S + (size_t)l0 * dil + rr;
      attn_item<64, true, AQT>(wsb(c, OFF_QB) + (hs + srow0) * 64, wsb(c, OFF_KB) + (hs + (size_t)rr * L) * 64, wsb(c, OFF_VTB) + (size_t)(seq * 12 + hb) * 64 * (S + 64) + (size_t)rr * L, S + 64,
                          kb, ke, l0, bias + hb * 132, 0.125f * LOG2E,
                          wsb(c, OFF_OBG) + tok0 * 768 + hb * 64, (size_t)dil * 768, (float*)(c.ws + OFF_LSE) + tok0 * 12 + hb, dil * 12, c.lds);
    }
    __syncthreads();
  }
}

DI void phase_combine(const Ctx& c) {
  const bf16_t* obg = wsb(c, OFF_OBG);
  const float* lse = (const float*)(c.ws + OFF_LSE);
  bf16_t* ob = wsb(c, OFF_OB);
  const int total = TC * 4 * 8;
  for (int idx = blockIdx.x * NTHREADS + tid_(); idx < total; idx += gridDim.x * NTHREADS) {
    const int d8 = idx & 7, j = (idx >> 3) & 3, tl = idx >> 5;
    const float l0 = lse[tl * 12 + j], l1 = lse[tl * 12 + 4 + j], l2 = lse[tl * 12 + 8 + j];
    const float mx = fmaxf(l0, fmaxf(l1, l2));
    float w0 = __expf(l0 - mx), w1 = __expf(l1 - mx), w2 = __expf(l2 - mx);
    const float inv = __builtin_amdgcn_rcpf(w0 + w1 + w2);
    w0 *= inv; w1 *= inv; w2 *= inv;
    const u32x4 a = *(const u32x4*)(obg + (size_t)tl * 768 + j * 64 + d8 * 8);
    const u32x4 b = *(const u32x4*)(obg + (size_t)tl * 768 + (4 + j) * 64 + d8 * 8);
    const u32x4 d = *(const u32x4*)(obg + (size_t)tl * 768 + (8 + j) * 64 + d8 * 8);
    u32x4 r;
#pragma unroll
    for (int e = 0; e < 4; ++e) {
      const float lo = w0 * __uint_as_float(a[e] << 16) + w1 * __uint_as_float(b[e] << 16) + w2 * __uint_as_float(d[e] << 16);
      const float hi = w0 * __uint_as_float(a[e] & 0xffff0000u) + w1 * __uint_as_float(b[e] & 0xffff0000u) + w2 * __uint_as_float(d[e] & 0xffff0000u);
      r[e] = pk2(lo, hi);
    }
    *(u32x4*)(ob + (size_t)tl * LDOB + j * 64 + d8 * 8) = r;
  }
}

DI void phase_merge(const Ctx& c) {
  const bf16_t* xb = wsb(c, OFF_XB);
  const float* ss = ss_site(c, c.layer, 1);
  const float* bgate = inl(c, 21, 3072);
  bf16_t* mrg = wsb(c, OFF_MRG);
  float* cl = (float*)c.lds; float* rr = (float*)(c.lds + OFF_RR);
  const int xcd_ = blockIdx.x & 7, slot_ = blockIdx.x >> 3, nslot_ = gridDim.x >> 3;
  for (int j_ = slot_; j_ < 16 * 8; j_ += nslot_) {
    const int mt = xcd_ * 16 + (j_ & 15), nt = j_ >> 4;
    __syncthreads();
    { const int t0 = tid_(); if (t0 < 128) rr[t0] = rsqrtf(ss[mt * 128 + t0] * (1.0f / DM) + EPS); }
    f32x16 macc[2][2]; zero_acc<2>(macc);
#pragma unroll 1
    for (int k = 0; k < 3; ++k) {
      unsigned gp[2][2][8];
      {
        f32x16 gacc[2][2]; zero_acc<2>(gacc);
        gemm_mainloop_glds<2>(xb + (size_t)mt * 128 * LDX, LDX, wgt(c, W_GATE) + (size_t)(k * 1024 + nt * 128) * LDX, LDX, DM, gacc, c.lds);
        const int tid = tid_(), lane = tid & 63, w = tid >> 6, wm = w >> 1, wn = w & 1, h = lane >> 5, cc = lane & 31;
#pragma unroll
        for (int j = 0; j < 2; ++j) {
          const float bv = bgate[k * 1024 + nt * 128 + wn * 64 + j * 32 + cc];
#pragma unroll
          for (int i = 0; i < 2; ++i)
#pragma unroll
            for (int r2 = 0; r2 < 8; ++r2) {
              const int ra = 2 * r2, rb = 2 * r2 + 1;
              const float r_a = rr[wm * 64 + i * 32 + (ra & 3) + 8 * (ra >> 2) + 4 * h];
              const float r_b = rr[wm * 64 + i * 32 + (rb & 3) + 8 * (rb >> 2) + 4 * h];
              gp[i][j][r2] = pk2(sigmoidf_(gacc[i][j][ra] * r_a + bv), sigmoidf_(gacc[i][j][rb] * r_b + bv));
            }
        }
      }
      {
        f32x16 acc[2][2]; zero_acc<2>(acc);
        const int Kk = (k == 1) ? 256 : 512;
        const bf16_t* Ao = wsb(c, k == 0 ? OFF_OA : (k == 1 ? OFF_OB : OFF_OC));
        const bf16_t* Wo = wgt(c, k == 0 ? W_OA : (k == 1 ? W_OB : W_OC));
        gemm_mainloop_glds<2>(Ao + (size_t)mt * 128 * (Kk + PADK), Kk + PADK, Wo + (size_t)nt * 128 * (Kk + PADK), Kk + PADK, Kk, acc, c.lds);
#pragma unroll
        for (int i = 0; i < 2; ++i)
#pragma unroll
          for (int j = 0; j < 2; ++j)
#pragma unroll
            for (int r2 = 0; r2 < 8; ++r2) {
              const unsigned g2 = gp[i][j][r2];
              macc[i][j][2 * r2] += __uint_as_float(g2 << 16) * acc[i][j][2 * r2];
              macc[i][j][2 * r2 + 1] += __uint_as_float(g2 & 0xffff0000u) * acc[i][j][2 * r2 + 1];
            }
      }
    }
    acc_to_lds<2>(macc, cl);
    __syncthreads();
    const int tid = tid_();
    const int c4 = (tid & 31) * 4, r0 = tid >> 5;
#pragma unroll 4
    for (int it = 0; it < 16; ++it) {
      const int row = r0 + 8 * it;
      const f32x4 v = *(const f32x4*)(cl + row * CLD + c4);
      u32x2 p; p.x = pk2(v[0], v[1]); p.y = pk2(v[2], v[3]);
      *(u32x2*)(mrg + (size_t)(mt * 128 + row) * LDX + nt * 128 + c4) = p;
    }
    __syncthreads();
  }
}

DI void phase_ple(const Ctx& c, bool probe = false) {
  const bf16_t* xb = wsb(c, OFF_XB);
  const float* ss = ss_site(c, c.layer, 3);
  float* ssn = probe ? ss_site(c, 2, 5) : ss_site(c, c.layer + 1, 0);
  const bf16_t* peb = wsb(c, OFF_PEB) + (size_t)c.layer * TC * LDPE;
  float* cl = (float*)c.lds; float* rr = (float*)(c.lds + OFF_RR);
  const int tid = tid_(), lane = tid & 63, w = tid >> 6, wm = w >> 1, h = lane >> 5;
  const int xcd_ = blockIdx.x & 7, slot_ = blockIdx.x >> 3, nslot_ = gridDim.x >> 3;
  for (int j_ = slot_; j_ < 16 * 8; j_ += nslot_) {
    const int mt = xcd_ * 16 + (j_ & 15), nt = j_ >> 4;
    if (tid < 128) rr[tid] = rsqrtf(ss[mt * 128 + tid] * (1.0f / DM) + EPS);
    unsigned gp[2][2][8];
    {
      f32x16 g[2][2]; zero_acc<2>(g);
      gemm_mainloop_glds<2>(xb + (size_t)mt * 128 * LDX, LDX, wgt(c, W_PG) + (size_t)nt * 128 * LDX, LDX, DM, g, c.lds);
#pragma unroll
      for (int i = 0; i < 2; ++i)
#pragma unroll
        for (int j = 0; j < 2; ++j)
#pragma unroll
          for (int r2 = 0; r2 < 8; ++r2) {
            const int ra = 2 * r2, rb = 2 * r2 + 1;
            const float r_a = rr[wm * 64 + i * 32 + (ra & 3) + 8 * (ra >> 2) + 4 * h];
            const float r_b = rr[wm * 64 + i * 32 + (rb & 3) + 8 * (rb >> 2) + 4 * h];
            gp[i][j][r2] = pk2(sigmoidf_(g[i][j][ra] * r_a), sigmoidf_(g[i][j][rb] * r_b));
          }
    }
    f32x16 acc[2][2]; zero_acc<2>(acc);
    gemm_mainloop_glds<2>(peb + (size_t)mt * 128 * LDPE, LDPE, wgt(c, W_PLE) + (size_t)nt * 128 * LDPE, LDPE, 256, acc, c.lds);
#pragma unroll
    for (int i = 0; i < 2; ++i)
#pragma unroll
      for (int j = 0; j < 2; ++j)
#pragma unroll
        for (int r2 = 0; r2 < 8; ++r2) {
          const unsigned g2 = gp[i][j][r2];
          acc[i][j][2 * r2] *= __uint_as_float(g2 << 16);
          acc[i][j][2 * r2 + 1] *= __uint_as_float(g2 & 0xffff0000u);
        }
    acc_to_lds<2>(acc, cl);
    __syncthreads();
    resid_epilogue<2>(c.x, wsb(c, OFF_XB2), ssn, mt, nt, cl, probe ? 0.0f : 1.0f);
    __syncthreads();
  }
}

DI void phase_prologue(const Params& p, char* lds) {
  float* tl = (float*)lds;
  bf16_t* W = (bf16_t*)(p.ws + OFF_W);
  int rot = 0;
  for (int L = 0; L < 2; ++L) {
    bf16_t* wl = W + (size_t)L * W_LAYER;
    transpose_mat(p.in[5] + (size_t)L * 1024 * 5632, 5632, wl + W_FFN1_IN, 5632, 1024, p.in[4] + L * 1024, 1, tl, rot); rot += 88 * 16;
    transpose_mat(p.in[6] + (size_t)L * 2816 * 1024, 1024, wl + W_FFN1_OUT, 1024, 2816, nullptr, 0, tl, rot); rot += 16 * 44;
    transpose_mat(p.in[8] + (size_t)L * 1024 * 3488, 3488, wl + W_IN, 3584, 1024, p.in[7] + L * 1024, 2, tl, rot); rot += 56 * 16;
    transpose_mat(p.in[20] + (size_t)L * 1024 * 3072, 3072, wl + W_GATE, 3072, 1024, p.in[7] + L * 1024, 0, tl, rot); rot += 48 * 16;
    transpose_mat(p.in[11] + (size_t)L * 256 * 768, 768, wl + W_UQ, 768, 256, p.in[9] + L * 256, 3, tl, rot); rot += 12 * 4;
    transpose_mat(p.in[12] + (size_t)L * 128 * 1024, 1024, wl + W_UKV, 1024, 128, p.in[10] + L * 128, 4, tl, rot); rot += 16 * 2;
    transpose_mat(p.in[22] + (size_t)L * 512 * 1024, 1024, wl + W_OA, 1024, 512, nullptr, 0, tl, rot); rot += 16 * 8;
    transpose_mat(p.in[23] + (size_t)L * 256 * 1024, 1024, wl + W_OB, 1024, 256, nullptr, 0, tl, rot); rot += 16 * 4;
    transpose_mat(p.in[24] + (size_t)L * 512 * 1024, 1024, wl + W_OC, 1024, 512, nullptr, 0, tl, rot); rot += 16 * 8;
    transpose_mat(p.in[25] + (size_t)L * 1024 * 1024, 1024, wl + W_OUT, 1024, 1024, nullptr, 0, tl, rot); rot += 16 * 16;
    transpose_mat(p.in[27] + (size_t)L * 1024 * 5632, 5632, wl + W_FFN2_IN, 5632, 1024, p.in[26] + L * 1024, 1, tl, rot); rot += 88 * 16;
    transpose_mat(p.in[28] + (size_t)L * 2816 * 1024, 1024, wl + W_FFN2_OUT, 1024, 2816, nullptr, 0, tl, rot); rot += 16 * 44;
    transpose_mat(p.in[30] + (size_t)L * 1024 * 1024, 1024, wl + W_PG, 1024, 1024, p.in[29] + L * 1024, 0, tl, rot); rot += 16 * 16;
    transpose_mat(p.in[31] + (size_t)L * 256 * 1024, 1024, wl + W_PLE, 1024, 256, nullptr, 0, tl, rot); rot += 16 * 4;
  }
  const int gtid = blockIdx.x * NTHREADS + tid_(), gn = gridDim.x * NTHREADS;
  f32x2* rope = (f32x2*)(p.ws + OFF_ROPE);
  for (int idx = gtid; idx < 16384 * 16; idx += gn) {
    const int pos = idx >> 4, i = idx & 15;
    const float freq = (float)pow(10000.0, -(double)i / 16.0);
    const float ang = (float)pos * freq;
    f32x2 cs; cs.x = (float)cos((double)ang); cs.y = (float)sin((double)ang);
    rope[idx] = cs;
  }
  float* bias = (float*)(p.ws + OFF_BIAS);
  for (int idx = gtid; idx < 12 * 129; idx += gn) {
    const int hb = idx / 129, jj = idx - hb * 129;
    const int dil = 1 << (2 * (hb >> 2));
    const int rel = (jj - 64) * dil;
    const int n = rel < 0 ? -rel : rel;
    int b;
    if (n < 8) b = n;
    else { int lg = 8 + (int)(log((double)n / 8.0) / log(128.0) * 8.0); if (lg > 15) lg = 15; b = lg; }
    if (rel > 0) b += 16;
    bias[hb * 132 + jj] = p.in[17][b * 12 + hb] * LOG2E;
  }
}

DI void phase_init(const Ctx& c) {
  const int tid = tid_(), lane = tid & 63;
  const int gw = blockIdx.x * 4 + (tid >> 6), nw = gridDim.x * 4;
  bf16_t* xb = wsb(c, OFF_XB);
  float* ss0 = ss_site(c, 0, 0);
  for (int row = gw; row < TC; row += nw) {
    float s = 0.f;
#pragma unroll
    for (int i = 0; i < 4; ++i) {
      const size_t gi = (size_t)row * DM + i * 256 + lane * 4;
      const f32x4 v = *(const f32x4*)(c.xin + gi);
      *(f32x4*)(c.x + gi) = v;
      u32x2 p; p.x = pk2(v[0], v[1]); p.y = pk2(v[2], v[3]);
      *(u32x2*)(xb + (size_t)row * LDX + i * 256 + lane * 4) = p;
      s += v[0] * v[0] + v[1] * v[1] + v[2] * v[2] + v[3] * v[3];
    }
#pragma unroll
    for (int o = 32; o >= 1; o >>= 1) s += __shfl_xor(s, o);
    if (lane == 0) ss0[row] = s;
  }
  const int gtid = blockIdx.x * NTHREADS + tid, gn = gridDim.x * NTHREADS;
  float* ssall = (float*)(c.ws + OFF_SS);
  for (int idx = gtid + TC; idx < 3 * 6 * TC; idx += gn) ssall[idx] = 0.f;
  bf16_t* peb = wsb(c, OFF_PEB);
  for (int idx = gtid; idx < 2 * TC * 64; idx += gn) {
    const int L = idx / (TC * 64), r = idx - L * (TC * 64);
    const f32x4 v = *(const f32x4*)(c.pe0 + (size_t)L * c.pe_ls + (size_t)r * 4);
    u32x2 p; p.x = pk2(v[0], v[1]); p.y = pk2(v[2], v[3]);
    *(u32x2*)(peb + ((size_t)L * TC + (r >> 6)) * LDPE + (r & 63) * 4) = p;
  }
}

#ifndef ONLY
#define ONLY -1
#endif
#define PH(n) (ONLY < 0 || ONLY == (n))
#if DUP == 200
#define GSYNC() do { xcd_barrier(xb); xcd_barrier(xb); } while (0)
#else
#define GSYNC() xcd_barrier(xb)
#endif
#define REP(n) for (int rep_ = 0; rep_ < ((DUP == (n) || (DUP == 100 && ((n) == 2 || (n) == 10))) ? 2 : 1); ++rep_)
__global__ void __launch_bounds__(NTHREADS, 2) mega_kernel(Params p) {
  extern __shared__ __attribute__((aligned(16))) char lds[];
  cg::grid_group grid = cg::this_grid();
  volatile LAS unsigned* xst = (volatile LAS unsigned*)(lds + OFF_RR + 512);
  if (threadIdx.x == 0) { xst[0] = 0u; xst[1] = 0u; }
  __syncthreads();
  const XcdBarrier xb = xcd_barrier_post((unsigned*)(p.ws + OFF_BAR), xst);
  REP(0) { if (PH(0)) phase_prologue(p, lds); grid.sync(); }
  for (int chunk = 0; chunk < 3; ++chunk) {
    Ctx c;
    c.p = &p; c.chunk = chunk; c.layer = 0; c.ws = p.ws; c.lds = lds;
    c.S = chunk == 0 ? 4096 : 16384; c.sshift = chunk == 0 ? 12 : 14;
    c.x = p.out + (size_t)chunk * TC * DM;
    c.xin = chunk == 0 ? p.in[0] : p.in[1] + (size_t)(chunk - 1) * TC * DM;
    c.pe0 = chunk == 0 ? p.in[2] : p.in[3] + (size_t)(chunk - 1) * TC * 256;
    c.pe_ls = chunk == 0 ? (size_t)TC * 256 : (size_t)2 * TC * 256;
    REP(1) { if (PH(1)) phase_init(c); GSYNC(); }
#pragma unroll 1
    for (int layer = 0; layer < 2; ++layer) {
      c.layer = layer;
      REP(2) { if (PH(2)) phase_ffn_in(c, wsb(c, layer == 0 ? OFF_XB : OFF_XB2), W_FFN1_IN, 0); GSYNC(); }
#if DUP == 300
      { phase_ffn_probe(c, wsb(c, layer == 0 ? OFF_XB : OFF_XB2), W_FFN1_IN, 0); GSYNC(); }
#endif
      REP(3) { if (PH(3)) phase_resid_gemm(c, wsb(c, OFF_ACT), DFF, W_FFN1_OUT, 0.5f, ss_site(c, layer, 1)); GSYNC(); }
#if DUP == 303
      { phase_resid_gemm(c, wsb(c, OFF_ACT), DFF, W_FFN1_OUT, 0.0f, ss_site(c, 2, 5)); GSYNC(); }
#endif
      REP(4) { if (PH(4)) phase_proj(c); GSYNC(); }
#if DUP == 304
      { phase_proj(c, true); GSYNC(); }
#endif
      REP(5) { if (PH(5)) phase_mlaup(c); GSYNC(); }
      REP(6) { if (PH(6)) phase_attn(c); GSYNC(); }
      REP(7) { if (PH(7)) phase_combine(c); GSYNC(); }
      REP(8) { if (PH(8)) phase_merge(c); GSYNC(); }
      REP(9) { if (PH(9)) phase_resid_gemm(c, wsb(c, OFF_MRG), DM, W_OUT, 1.0f, ss_site(c, layer, 2)); GSYNC(); }
#if DUP == 305
      { phase_resid_gemm(c, wsb(c, OFF_MRG), DM, W_OUT, 0.0f, ss_site(c, 2, 5)); GSYNC(); }
#endif
      REP(10) { if (PH(10)) phase_ffn_in(c, wsb(c, OFF_XB), W_FFN2_IN, 2); GSYNC(); }
      REP(11) { if (PH(11)) phase_resid_gemm(c, wsb(c, OFF_ACT), DFF, W_FFN2_OUT, 0.5f, ss_site(c, layer, 3)); GSYNC(); }
      REP(12) { if (PH(12)) phase_ple(c); GSYNC(); }
#if DUP == 306
      { phase_ple(c, true); GSYNC(); }
#endif
    }
  }
}

extern "C" void kernel_launch(void* const* d_in, const int* in_sizes, int n_in, void* d_out, int out_size, void* d_ws, size_t ws_size, hipStream_t stream) {
  static int grid_blocks = 0;
  if (!grid_blocks) {
    int dev = 0, cus = 0, per_cu = 0;
    hipGetDevice(&dev);
    hipDeviceGetAttribute(&cus, hipDeviceAttributeMultiprocessorCount, dev);
    hipFuncSetAttribute((const void*)mega_kernel, hipFuncAttributeMaxDynamicSharedMemorySize, LDS_BYTES);
    hipOccupancyMaxActiveBlocksPerMultiprocessor(&per_cu, mega_kernel, NTHREADS, LDS_BYTES);
    if (per_cu > 2) per_cu = 2;
    if (per_cu < 1) per_cu = 1;
    grid_blocks = cus * per_cu;
  }
  Params p{};
  for (int i = 0; i < 32; ++i) p.in[i] = (const float*)d_in[i];
  p.out = (float*)d_out;
  p.ws = (char*)d_ws;
  hipMemsetAsync((char*)d_ws + OFF_BAR, 0, 16384, stream);
  void* args[] = {&p};
  hipError_t e = hipLaunchCooperativeKernel((const void*)mega_kernel, dim3(grid_blocks), dim3(NTHREADS), args, LDS_BYTES, stream);
  if (e != hipSuccess) fprintf(stderr, "cooperative launch failed: %s (grid %d)\n", hipGetErrorString(e), grid_blocks);
}
```
